# Optimizing an MI355X kernel written in HIP

```python
import math
import jax, jax.numpy as jnp
from jax import lax
import numpy as np

D_MODEL = 1024
BATCH = 8
SEQ = 2048
DEPTH = 1
DEC_BATCH = 16
DEC_SEQ = 64
PAST_LEN = 1024

CHUNK = 64
Q_BLOCK = 128
SB_HEADS = 8
SB_HEAD_DIM = 64
SB_WIDTH = SB_HEADS * SB_HEAD_DIM
ML_HEADS = 4
ML_HEAD_DIM = 128
ML_WIDTH = ML_HEADS * ML_HEAD_DIM
CONV_W = 4
D_FF = -(-8 * D_MODEL // (3 * 256)) * 256
EPS = 1e-6
IN_SPLITS = (SB_WIDTH, SB_WIDTH, SB_WIDTH,
             2 * ML_WIDTH,
             ML_WIDTH, ML_WIDTH,
             ML_HEADS, ML_HEADS,
             D_MODEL, D_MODEL)
IN_WIDTH = 3 * SB_WIDTH + 4 * ML_WIDTH + 2 * ML_HEADS + 2 * D_MODEL

kernel_name = 'stickbreak_mlstm_parallel_adaln_stream_step'


def _rmsnorm(x, g):
    xf = x.astype(jnp.float32)
    y = xf * lax.rsqrt(jnp.mean(xf * xf, axis=-1, keepdims=True) + EPS) * g.astype(jnp.float32)
    return y.astype(x.dtype)


def _stick_breaking(q, k, v, q_start):
    B, L, H, dh = q.shape
    T = k.shape[1]
    blk = min(Q_BLOCK, L)
    nb = L // blk
    qb = jnp.moveaxis(q.reshape(B, nb, blk, H, dh), 1, 0)
    pos = (q_start + jnp.arange(L)).reshape(nb, blk)
    k_pos = jnp.arange(T)
    scale = 1.0 / math.sqrt(dh)

    def one_block(args):
        qi, pi = args
        z = jnp.einsum('bqhd,bkhd->bhqk', qi, k).astype(jnp.float32) * scale
        mask = k_pos[None, :] < pi[:, None]
        log_1mb = jnp.where(mask, jax.nn.log_sigmoid(-z), 0.0)
        tail = lax.cumsum(log_1mb, axis=3, reverse=True) - log_1mb
        a = jnp.where(mask, jnp.exp(jax.nn.log_sigmoid(z) + tail), 0.0)
        return jnp.einsum('bhqk,bkhd->bqhd', a.astype(v.dtype), v)

    out = lax.map(one_block, (qb, pos))
    return jnp.moveaxis(out, 0, 1).reshape(B, L, H * dh)


def _mlstm_chunk(carry, inp):
    C, n, m = carry
    q, k, v, log_i, log_f = inp
    L = q.shape[2]
    b = jnp.cumsum(log_f, axis=-1)
    tril = jnp.tril(jnp.ones((L, L), bool))
    d_log = b[..., :, None] - b[..., None, :] + log_i[..., None, :]
    d_log = jnp.where(tril, d_log, -jnp.inf)
    inter = b + m[..., None]
    m_t = jnp.maximum(inter, jnp.max(d_log, axis=-1))
    w_intra = jnp.exp(d_log - m_t[..., None])
    w_inter = jnp.exp(inter - m_t)
    s = jnp.einsum('bhtd,bhsd->bhts', q, k) * w_intra
    num = jnp.einsum('bhts,bhsd->bhtd', s, v) + w_inter[..., None] * jnp.einsum('bhvk,bhtk->bhtv', C, q)
    den = jnp.sum(s, axis=-1) + w_inter * jnp.einsum('bhk,bhtk->bht', n, q)
    h = num / jnp.maximum(jnp.abs(den), jnp.exp(-m_t))[..., None]
    b_last = b[..., -1]
    g = b_last[..., None] - b + log_i
    m_new = jnp.maximum(b_last + m, jnp.max(g, axis=-1))
    wg = jnp.exp(g - m_new[..., None])
    decay = jnp.exp(b_last + m - m_new)
    C_new = decay[..., None, None] * C + jnp.einsum('bhs,bhsv,bhsk->bhvk', wg, v, k)
    n_new = decay[..., None] * n + jnp.einsum('bhs,bhsk->bhk', wg, k)
    return (C_new, n_new, m_new), h


def _to_chunks(a, n_chunks, csz):
    B, H = a.shape[:2]
    a = a.reshape((B, H, n_chunks, csz) + a.shape[3:])
    return jnp.moveaxis(a, 2, 0)


def _mlstm(q, k, v, log_i, log_f, C0, n0, m0):
    B, L, H, d = q.shape
    f32 = jnp.float32
    qh, kh, vh = (jnp.swapaxes(a.astype(f32), 1, 2) for a in (q, k, v))
    li, lf = (jnp.swapaxes(a.astype(f32), 1, 2) for a in (log_i, log_f))
    csz = min(CHUNK, L)
    nc = L // csz
    xs = tuple(_to_chunks(a, nc, csz) for a in (qh, kh, vh, li, lf))
    carry0 = (C0.astype(f32), n0.astype(f32), m0.astype(f32))
    (C1, n1, m1), hs = lax.scan(_mlstm_chunk, carry0, xs)
    h = jnp.moveaxis(hs, 0, 2).reshape(B, H, L, d)
    return jnp.swapaxes(h, 1, 2), C1, n1, m1


def _layer(x, c, sb_k_past, sb_v_past, C0, n0, m0, conv0,
           norm1_g, norm2_g, w_ada, b_ada, w_in, b_if, w_conv, b_conv, ml_norm_g,
           w_a, w_b, w_out, w_ff_gate, w_ff_up, w_ff_down):
    B, L, _ = x.shape
    q_start = sb_k_past.shape[1]
    mod = jax.nn.silu(c) @ w_ada + b_ada
    sh1, sc1, g1, sh2, sc2, g2 = jnp.split(mod[:, None, :], 6, axis=-1)

    u = _rmsnorm(x, norm1_g) * (1 + sc1) + sh1
    proj = u @ w_in
    idx = np.cumsum(IN_SPLITS)[:-1]
    sq, sk, sv, mqk_pre, mv, mo, mi, mf, ga, gb = jnp.split(proj, idx, axis=-1)

    k_new = sk.reshape(B, L, SB_HEADS, SB_HEAD_DIM)
    v_new = sv.reshape(B, L, SB_HEADS, SB_HEAD_DIM)
    k_all = jnp.concatenate([sb_k_past.astype(k_new.dtype), k_new], axis=1)
    v_all = jnp.concatenate([sb_v_past.astype(v_new.dtype), v_new], axis=1)
    y_a = _stick_breaking(sq.reshape(B, L, SB_HEADS, SB_HEAD_DIM), k_all, v_all, q_start)

    xpad = jnp.concatenate([conv0.astype(mqk_pre.dtype), mqk_pre], axis=1)
    conv = b_conv + sum(xpad[:, j:j + L, :] * w_conv[j] for j in range(CONV_W))
    conv = jax.nn.silu(conv)
    conv_new = xpad[:, L:, :]
    mq, mk = jnp.split(conv, 2, axis=-1)
    mq = mq.reshape(B, L, ML_HEADS, ML_HEAD_DIM)
    mk = mk.reshape(B, L, ML_HEADS, ML_HEAD_DIM) * (1.0 / math.sqrt(ML_HEAD_DIM))
    mvh = mv.reshape(B, L, ML_HEADS, ML_HEAD_DIM)
    log_i = (mi + b_if[:ML_HEADS]).astype(jnp.float32)
    log_f = jax.nn.log_sigmoid((mf + b_if[ML_HEADS:]).astype(jnp.float32))
    h, C1, n1, m1 = _mlstm(mq, mk, mvh, log_i, log_f, C0, n0, m0)
    h = h * lax.rsqrt(jnp.mean(h * h, axis=-1, keepdims=True) + EPS)
    h = (h.reshape(B, L, ML_WIDTH) * ml_norm_g.astype(jnp.float32)).astype(x.dtype)
    y_b = jax.nn.sigmoid(mo) * h

    merged = jax.nn.sigmoid(ga) * (y_a @ w_a) + jax.nn.sigmoid(gb) * (y_b @ w_b)
    x = x + g1 * (merged @ w_out)

    u2 = _rmsnorm(x, norm2_g) * (1 + sc2) + sh2
    x = x + g2 * ((jax.nn.silu(u2 @ w_ff_gate) * (u2 @ w_ff_up)) @ w_ff_down)
    return x, (k_new, v_new, C1, n1, m1, conv_new)


def setup_inputs(seed: int = 0) -> dict:
    key = jax.random.key(seed)
    ks = iter(jax.random.split(key, 40))
    f32 = jnp.float32

    def nrm(shape, scale):
        return jax.random.normal(next(ks), shape, f32) * scale

    def gain(shape):
        return 1.0 + nrm(shape, 0.02)

    b_if = jnp.concatenate([nrm((DEPTH, ML_HEADS), 0.1),
                            jnp.linspace(3.0, 6.0, ML_HEADS, dtype=f32)[None, :] + nrm((DEPTH, ML_HEADS), 0.1)], axis=-1)
    return {
        'x_prompt': nrm((BATCH, SEQ, D_MODEL), 1.0),
        'x_sample': nrm((DEC_BATCH, DEC_SEQ, D_MODEL), 1.0),
        'c_prompt': nrm((BATCH, D_MODEL), 1.0),
        'c_sample': nrm((DEC_BATCH, D_MODEL), 1.0),
        'cache_sb_k': nrm((DEPTH, DEC_BATCH, PAST_LEN, SB_HEADS, SB_HEAD_DIM), 1.0),
        'cache_sb_v': nrm((DEPTH, DEC_BATCH, PAST_LEN, SB_HEADS, SB_HEAD_DIM), 1.0),
        'state_mlstm_C': nrm((DEPTH, DEC_BATCH, ML_HEADS, ML_HEAD_DIM, ML_HEAD_DIM), 0.3),
        'state_mlstm_n': nrm((DEPTH, DEC_BATCH, ML_HEADS, ML_HEAD_DIM), 0.3),
        'state_mlstm_m': nrm((DEPTH, DEC_BATCH, ML_HEADS), 1.0),
        'state_conv': nrm((DEPTH, DEC_BATCH, CONV_W - 1, 2 * ML_WIDTH), 1.0),
        'norm1_g': gain((DEPTH, D_MODEL)),
        'norm2_g': gain((DEPTH, D_MODEL)),
        'w_ada': nrm((DEPTH, D_MODEL, 6 * D_MODEL), 0.5 * D_MODEL ** -0.5),
        'b_ada': nrm((DEPTH, 6 * D_MODEL), 0.02),
        'w_in': nrm((DEPTH, D_MODEL, IN_WIDTH), D_MODEL ** -0.5),
        'b_if': b_if,
        'w_conv': nrm((DEPTH, CONV_W, 2 * ML_WIDTH), CONV_W ** -0.5),
        'b_conv': nrm((DEPTH, 2 * ML_WIDTH), 0.02),
        'ml_norm_g': gain((DEPTH, ML_WIDTH)),
        'w_a': nrm((DEPTH, SB_WIDTH, D_MODEL), SB_WIDTH ** -0.5),
        'w_b': nrm((DEPTH, ML_WIDTH, D_MODEL), ML_WIDTH ** -0.5),
        'w_out': nrm((DEPTH, D_MODEL, D_MODEL), D_MODEL ** -0.5),
        'w_ff_gate': nrm((DEPTH, D_MODEL, D_FF), D_MODEL ** -0.5),
        'w_ff_up': nrm((DEPTH, D_MODEL, D_FF), D_MODEL ** -0.5),
        'w_ff_down': nrm((DEPTH, D_FF, D_MODEL), D_FF ** -0.5),
        'final_g': gain((D_MODEL,)),
    }


def reference(x_prompt, x_sample, c_prompt, c_sample, cache_sb_k, cache_sb_v,
              state_mlstm_C, state_mlstm_n, state_mlstm_m, state_conv,
              norm1_g, norm2_g, w_ada, b_ada, w_in, b_if, w_conv, b_conv, ml_norm_g,
              w_a, w_b, w_out, w_ff_gate, w_ff_up, w_ff_down, final_g):
    f32 = jnp.float32
    bp = x_prompt.shape[0]
    hp, hs = x_prompt, x_sample
    p_states, s_states = [], []
    for l in range(DEPTH):
        params = (norm1_g[l], norm2_g[l], w_ada[l], b_ada[l], w_in[l], b_if[l], w_conv[l], b_conv[l],
                  ml_norm_g[l], w_a[l], w_b[l], w_out[l], w_ff_gate[l], w_ff_up[l], w_ff_down[l])
        empty_kv = jnp.zeros((bp, 0, SB_HEADS, SB_HEAD_DIM), x_prompt.dtype)
        hp, sp = _layer(hp, c_prompt, empty_kv, empty_kv,
                        jnp.zeros((bp, ML_HEADS, ML_HEAD_DIM, ML_HEAD_DIM), f32),
                        jnp.zeros((bp, ML_HEADS, ML_HEAD_DIM), f32),
                        jnp.zeros((bp, ML_HEADS), f32),
                        jnp.zeros((bp, CONV_W - 1, 2 * ML_WIDTH), x_prompt.dtype),
                        *params)
        hs, ss = _layer(hs, c_sample, cache_sb_k[l], cache_sb_v[l], state_mlstm_C[l],
                        state_mlstm_n[l], state_mlstm_m[l], state_conv[l], *params)
        p_states.append(sp)
        s_states.append(ss)
    y_prompt = _rmsnorm(hp, final_g)
    y_sample = _rmsnorm(hs, final_g)
    pk, pv, pC, pn, pm, pconv = (jnp.stack([st[i] for st in p_states]) for i in range(6))
    sk, sv, sC, sn, sm, sconv = (jnp.stack([st[i] for st in s_states]) for i in range(6))
    return (y_prompt, y_sample, pk, pv, pC, pn, pm, pconv, sk, sv, sC, sn, sm, sconv)
```

```cpp
#include <hip/hip_runtime.h>
#include <hip/hip_cooperative_groups.h>
#include <stdint.h>
#include <stdio.h>
namespace cg = cooperative_groups;

#ifndef ONE_LAUNCH
#define ONE_LAUNCH 1
#endif

typedef unsigned short bf16_t;
using bf16x8 = __attribute__((ext_vector_type(8))) short;
using f32x4 = __attribute__((ext_vector_type(4))) float;

#define NTHREADS 512
#define LDS_BYTES 131072
constexpr int kNP = 16384;
constexpr int kT = 17408;
constexpr int kINW = 5640;

struct Params {
  const float *x_prompt, *x_sample, *c_prompt, *c_sample, *cache_k, *cache_v, *st_C, *st_n, *st_m, *st_conv;
  const float *norm1_g, *norm2_g, *w_ada, *b_ada, *w_in, *b_if, *w_conv, *b_conv, *ml_norm_g, *w_a, *w_b, *w_out,
      *w_gate, *w_up, *w_down, *final_g;
  float* out;
  bf16_t *Wt_in, *Wt_a, *Wt_b, *Wt_out, *Wt_gu, *Wt_down;
  float *wg, *modp, *modf;
  bf16_t *U, *Qb, *Kp, *Ks, *VTp, *VTs, *MQK, *MVTp, *MVTs, *SO, *GA, *GB;
  float *GI, *LF;
  bf16_t *YA, *YB, *MER;
  float* X1;
  bf16_t* HFF;
  unsigned* counter;
};

constexpr size_t O_YP = 0;
constexpr size_t O_YS = O_YP + 16777216;
constexpr size_t O_KP = O_YS + 1048576;
constexpr size_t O_VP = O_KP + 8388608;
constexpr size_t O_CP = O_VP + 8388608;
constexpr size_t O_NP = O_CP + 524288;
constexpr size_t O_MP = O_NP + 4096;
constexpr size_t O_CVP = O_MP + 32;
constexpr size_t O_KS = O_CVP + 24576;
constexpr size_t O_VS = O_KS + 524288;
constexpr size_t O_CS = O_VS + 524288;
constexpr size_t O_NS = O_CS + 1048576;
constexpr size_t O_MS = O_NS + 8192;
constexpr size_t O_CVS = O_MS + 64;

__device__ __forceinline__ bf16_t f2bf(float f) {
  unsigned u = __float_as_uint(f);
  u += 0x7fffu + ((u >> 16) & 1u);
  return (bf16_t)(u >> 16);
}
__device__ __forceinline__ float bf2f(bf16_t h) { return __uint_as_float(((unsigned)h) << 16); }
__device__ __forceinline__ unsigned pack2(float a, float b) { return (unsigned)f2bf(a) | ((unsigned)f2bf(b) << 16); }
__device__ __forceinline__ float sigm(float x) { return 1.0f / (1.0f + __expf(-x)); }
__device__ __forceinline__ float silu(float x) { return x / (1.0f + __expf(-x)); }
__device__ __forceinline__ float logsig(float x) { return fminf(x, 0.f) - __logf(1.0f + __expf(-fabsf(x))); }
__device__ __forceinline__ float wave_sum(float v) {
#pragma unroll
  for (int o = 32; o > 0; o >>= 1) v += __shfl_xor(v, o);
  return v;
}
__device__ __forceinline__ float wave_max(float v) {
#pragma unroll
  for (int o = 32; o > 0; o >>= 1) v = fmaxf(v, __shfl_xor(v, o));
  return v;
}
__device__ __forceinline__ int seq_of(int row) { return row < kNP ? (row >> 11) : 8 + ((row - kNP) >> 6); }
__device__ __forceinline__ const float* xrow(const Params& p, int row) {
  return row < kNP ? p.x_prompt + (size_t)row * 1024 : p.x_sample + (size_t)(row - kNP) * 1024;
}
__device__ __forceinline__ bf16x8 lds8(const void* p) { return *(const bf16x8*)p; }
#define MFMA(a, b, c) __builtin_amdgcn_mfma_f32_16x16x32_bf16(a, b, c, 0, 0, 0)

__device__ __forceinline__ void glds16(const void* g, void* l) {
  __builtin_amdgcn_global_load_lds((const unsigned*)g, (unsigned*)l, 16, 0, 0);
}
__device__ __forceinline__ void gemm_stage(const bf16_t* __restrict__ A, int lda, const bf16_t* __restrict__ B, int ldb,
                                           int k0, char* st) {
  const int tid = threadIdx.x;
#pragma unroll
  for (int i = 0; i < 4; i++) {
    int b = tid + i * 512;
    int row = b >> 3;
    int ch = (b & 7) ^ (row & 7);
    glds16(A + (size_t)row * lda + k0 + ch * 8, st + b * 16);
  }
#pragma unroll
  for (int i = 0; i < 2; i++) {
    int b = tid + i * 512;
    int row = b >> 3;
    int ch = (b & 7) ^ (row & 7);
    glds16(B + (size_t)row * ldb + k0 + ch * 8, st + 32768 + b * 16);
  }
}
__device__ __forceinline__ void gemm_mainloop(const bf16_t* __restrict__ A, int lda, const bf16_t* __restrict__ B,
                                              int ldb, int K, char* smem, f32x4 (&acc)[4][4]) {
  const int tid = threadIdx.x, lane = tid & 63, w = tid >> 6, wr = w >> 1, wc = w & 1;
  const int fr = lane & 15, fq = lane >> 4;
  const int nt = K >> 6;
  __syncthreads();
  gemm_stage(A, lda, B, ldb, 0, smem);
  for (int t = 0; t < nt; t++) {
    asm volatile("s_waitcnt vmcnt(0)" ::: "memory");
    __syncthreads();
    if (t + 1 < nt) gemm_stage(A, lda, B, ldb, (t + 1) << 6, smem + ((t + 1) & 1) * 49152);
    const char* sa = smem + (t & 1) * 49152;
    const char* sb = sa + 32768;
#pragma unroll
    for (int ks = 0; ks < 2; ks++) {
      bf16x8 af[4], bfr[4];
      const int ch = ((ks * 4 + fq) ^ (fr & 7)) * 16;
#pragma unroll
      for (int m = 0; m < 4; m++) af[m] = lds8(sa + (wr * 64 + m * 16 + fr) * 128 + ch);
#pragma unroll
      for (int n = 0; n < 4; n++) bfr[n] = lds8(sb + (wc * 64 + n * 16 + fr) * 128 + ch);
#pragma unroll
      for (int m = 0; m < 4; m++)
#pragma unroll
        for (int n = 0; n < 4; n++) acc[m][n] = MFMA(af[m], bfr[n], acc[m][n]);
    }
  }
}
__device__ __forceinline__ void tile_map(int tile, int MT, int NT, int& mt, int& nt) {
  int per = 8 * NT;
  int g = tile / per, r = tile - g * per;
  int gsz = min(8, MT - g * 8);
  mt = g * 8 + r % gsz;
  nt = r / gsz;
}
__device__ __forceinline__ void zero_acc(f32x4 (&acc)[4][4]) {
#pragma unroll
  for (int m = 0; m < 4; m++)
#pragma unroll
    for (int n = 0; n < 4; n++) acc[m][n] = (f32x4){0.f, 0.f, 0.f, 0.f};
}

__device__ void transpose_tile(const float* __restrict__ src, int lds_, bf16_t* __restrict__ dst, int ldd, int k0,
                               int nbase, int mode, char* smem) {
  float* tl = (float*)smem;
  const int tid = threadIdx.x;
  __syncthreads();
#pragma unroll
  for (int i = 0; i < 2; i++) {
    int idx = tid + i * 512;
    int k = idx >> 4, n4 = (idx & 15) * 4;
    float4 v = *(const float4*)(src + (size_t)k * lds_ + n4);
    tl[k * 65 + n4 + 0] = v.x;
    tl[k * 65 + n4 + 1] = v.y;
    tl[k * 65 + n4 + 2] = v.z;
    tl[k * 65 + n4 + 3] = v.w;
  }
  __syncthreads();
  int n = tid >> 3, kc = (tid & 7) * 8;
  float v[8];
#pragma unroll
  for (int e = 0; e < 8; e++) v[e] = tl[(kc + e) * 65 + n];
  int nrow = (mode == 0) ? (nbase + n) : (nbase + (n >> 5) * 64 + (n & 31));
  uint4 o;
  o.x = pack2(v[0], v[1]);
  o.y = pack2(v[2], v[3]);
  o.z = pack2(v[4], v[5]);
  o.w = pack2(v[6], v[7]);
  *(uint4*)(dst + (size_t)nrow * ldd + k0 + kc) = o;
}

constexpr int A_MOD = 96;
constexpr int A_WT = 4032;
constexpr int A_VC = 2048;
constexpr int A_KC = 256;
constexpr int A_PAD = 128;
constexpr int A_MISC = 1;
constexpr int A_TOTAL = A_MOD + A_WT + A_VC + A_KC + A_PAD + A_MISC;

__device__ void phase_a(const Params& p, char* smem) {
  const int tid = threadIdx.x;
  for (int task = blockIdx.x; task < A_TOTAL; task += gridDim.x) {
    int id = task;
    if (id < A_MOD) {
      int cgp = id % 12, ks = id / 12;
      float* sc = (float*)smem;
      __syncthreads();
      for (int i = tid; i < 24 * 128; i += 512) {
        int s = i >> 7, kk = i & 127, k = ks * 128 + kk;
        float cv = s < 8 ? p.c_prompt[s * 1024 + k] : p.c_sample[(s - 8) * 1024 + k];
        sc[i] = silu(cv);
      }
      __syncthreads();
      int col = cgp * 512 + tid;
      float acc[24];
#pragma unroll
      for (int s = 0; s < 24; s++) acc[s] = 0.f;
      const float* wp = p.w_ada + (size_t)(ks * 128) * 6144 + col;
#pragma unroll 8
      for (int kk = 0; kk < 128; kk++) {
        float wv = wp[(size_t)kk * 6144];
#pragma unroll
        for (int s = 0; s < 24; s++) acc[s] += sc[s * 128 + kk] * wv;
      }
#pragma unroll
      for (int s = 0; s < 24; s++) p.modp[(size_t)(ks * 24 + s) * 6144 + col] = acc[s];
      continue;
    }
    id -= A_MOD;
    if (id < A_WT) {
      if (id < 1408) {
        int kt = id / 88, nt = id % 88;
        int scol = nt < 56 ? nt * 64 : 3592 + (nt - 56) * 64;
        int drow = nt < 56 ? nt * 64 : 3584 + (nt - 56) * 64;
        transpose_tile(p.w_in + (size_t)kt * 64 * kINW + scol, kINW, p.Wt_in, 1024, kt * 64, drow, 0, smem);
      } else if (id < 1536) {
        int i2 = id - 1408, kt = i2 / 16, nt = i2 % 16;
        transpose_tile(p.w_a + (size_t)kt * 64 * 1024 + nt * 64, 1024, p.Wt_a, 512, kt * 64, nt * 64, 0, smem);
      } else if (id < 1664) {
        int i2 = id - 1536, kt = i2 / 16, nt = i2 % 16;
        transpose_tile(p.w_b + (size_t)kt * 64 * 1024 + nt * 64, 1024, p.Wt_b, 512, kt * 64, nt * 64, 0, smem);
      } else if (id < 1920) {
        int i2 = id - 1664, kt = i2 / 16, nt = i2 % 16;
        transpose_tile(p.w_out + (size_t)kt * 64 * 1024 + nt * 64, 1024, p.Wt_out, 1024, kt * 64, nt * 64, 0, smem);
      } else if (id < 2624) {
        int i2 = id - 1920, kt = i2 / 44, nt = i2 % 44;
        transpose_tile(p.w_gate + (size_t)kt * 64 * 2816 + nt * 64, 2816, p.Wt_gu, 1024, kt * 64, nt * 128, 1, smem);
      } else if (id < 3328) {
        int i2 = id - 2624, kt = i2 / 44, nt = i2 % 44;
        transpose_tile(p.w_up + (size_t)kt * 64 * 2816 + nt * 64, 2816, p.Wt_gu, 1024, kt * 64, nt * 128 + 32, 1, smem);
      } else {
        int i2 = id - 3328, kt = i2 / 16, nt = i2 % 16;
        transpose_tile(p.w_down + (size_t)kt * 64 * 1024 + nt * 64, 1024, p.Wt_down, 2816, kt * 64, nt * 64, 0, smem);
      }
      continue;
    }
    id -= A_WT;
    if (id < A_VC) {
      int bh = id >> 4, jt = id & 15;
      int b = bh >> 3, h = bh & 7;
      transpose_tile(p.cache_v + ((size_t)(b * 1024 + jt * 64) * 8 + h) * 64, 512, p.VTs + (size_t)bh * 64 * 1152, 1152,
                     jt * 64, 0, 0, smem);
      continue;
    }
    id -= A_VC;
    if (id < A_KC) {
      int b = id >> 4, jb = id & 15;
#pragma unroll
      for (int it = 0; it < 8; it++) {
        int g = tid + it * 512;
        int j = g >> 6, col = (g & 63) * 8;
        int h = col >> 6, d = col & 63;
        const float* src = p.cache_k + ((size_t)(b * 1024 + jb * 64 + j)) * 512 + col;
        float4 v0 = *(const float4*)src, v1 = *(const float4*)(src + 4);
        uint4 o;
        o.x = pack2(v0.x, v0.y);
        o.y = pack2(v0.z, v0.w);
        o.z = pack2(v1.x, v1.y);
        o.w = pack2(v1.z, v1.w);
        *(uint4*)(p.Ks + ((size_t)((b * 8 + h) * 1152 + jb * 64 + j)) * 64 + d) = o;
      }
      continue;
    }
    id -= A_KC;
    if (id < A_PAD) {
      int bh = id;
      uint4 z = {0u, 0u, 0u, 0u};
      *(uint4*)(p.Ks + ((size_t)bh * 1152 + 1088) * 64 + tid * 8) = z;
      int d = tid >> 3, chn = tid & 7;
      *(uint4*)(p.VTs + ((size_t)bh * 64 + d) * 1152 + 1088 + chn * 8) = z;
      continue;
    }
    for (int i = tid; i < 8192; i += 512) {
      int g = i >> 10, k = i & 1023;
      p.wg[i] = p.w_in[(size_t)k * kINW + 3584 + g];
    }
    if (tid == 0) p.counter[0] = 0u;
  }
}

__device__ void norm_task(const Params& p, int task, int which, char* smem) {
  float* sm_scale = (float*)smem;
  float* sm_shift = sm_scale + 1024;
  const int tid = threadIdx.x, lane = tid & 63, w = tid >> 6;
  const int row0 = task * 32;
  const int seq = seq_of(row0);
  const float* g = which ? p.norm2_g : p.norm1_g;
  const int sh_off = which ? 3072 : 0, sc_off = which ? 4096 : 1024;
  __syncthreads();
  for (int c = tid; c < 1024; c += 512) {
    float sh, sc;
    if (which == 0) {
      sh = p.b_ada[sh_off + c];
      sc = p.b_ada[sc_off + c];
#pragma unroll
      for (int ks = 0; ks < 8; ks++) {
        sh += p.modp[(size_t)(ks * 24 + seq) * 6144 + sh_off + c];
        sc += p.modp[(size_t)(ks * 24 + seq) * 6144 + sc_off + c];
      }
    } else {
      sh = p.modf[seq * 6144 + sh_off + c];
      sc = p.modf[seq * 6144 + sc_off + c];
    }
    sm_scale[c] = g[c] * (1.0f + sc);
    sm_shift[c] = sh;
  }
  __syncthreads();
  for (int i = 0; i < 4; i++) {
    int row = row0 + w * 4 + i;
    const float* xr = which ? (p.X1 + (size_t)row * 1024) : xrow(p, row);
    float4 v[4];
    float ss = 0.f;
#pragma unroll
    for (int j = 0; j < 4; j++) {
      v[j] = *(const float4*)(xr + j * 256 + lane * 4);
      ss += v[j].x * v[j].x + v[j].y * v[j].y + v[j].z * v[j].z + v[j].w * v[j].w;
    }
    ss = wave_sum(ss);
    float rstd = rsqrtf(ss * (1.0f / 1024.0f) + 1e-6f);
#pragma unroll
    for (int j = 0; j < 4; j++) {
      int c = j * 256 + lane * 4;
      float4 sc = *(const float4*)(sm_scale + c), sh = *(const float4*)(sm_shift + c);
      v[j].x = v[j].x * rstd * sc.x + sh.x;
      v[j].y = v[j].y * rstd * sc.y + sh.y;
      v[j].z = v[j].z * rstd * sc.z + sh.z;
      v[j].w = v[j].w * rstd * sc.w + sh.w;
      uint2 o;
      o.x = pack2(v[j].x, v[j].y);
      o.y = pack2(v[j].z, v[j].w);
      *(uint2*)(p.U + (size_t)row * 1024 + c) = o;
    }
    if (which == 0) {
      float gv[8];
#pragma unroll
      for (int gi = 0; gi < 8; gi++) {
        float a = 0.f;
#pragma unroll
        for (int j = 0; j < 4; j++) {
          float4 wv = *(const float4*)(p.wg + gi * 1024 + j * 256 + lane * 4);
          a += v[j].x * wv.x + v[j].y * wv.y + v[j].z * wv.z + v[j].w * wv.w;
        }
        gv[gi] = wave_sum(a);
      }
      if (lane == 0) {
#pragma unroll
        for (int h = 0; h < 4; h++) {
          p.GI[row * 4 + h] = gv[h] + p.b_if[h];
          p.LF[row * 4 + h] = logsig(gv[4 + h] + p.b_if[4 + h]);
        }
      }
    }
  }
}
__device__ void phase_b(const Params& p, char* smem) {
  const int NTASK = kT / 32;
  for (int task = blockIdx.x; task < NTASK + 288; task += gridDim.x) {
    if (task < NTASK) {
      norm_task(p, task, 0, smem);
    } else {
      int i = (task - NTASK) * 512 + threadIdx.x;
      int s = i / 6144, c = i - s * 6144;
      float a = p.b_ada[c];
#pragma unroll
      for (int ks = 0; ks < 8; ks++) a += p.modp[(size_t)(ks * 24 + s) * 6144 + c];
      p.modf[i] = a;
    }
  }
}
__device__ void phase_g(const Params& p, char* smem) {
  for (int task = blockIdx.x; task < kT / 32; task += gridDim.x) norm_task(p, task, 1, smem);
}

__device__ void phase_c(const Params& p, char* smem) {
  const int MT = 68, NT = 44;
  const int tid = threadIdx.x, lane = tid & 63, w = tid >> 6, wr = w >> 1, wc = w & 1, fr = lane & 15, fq = lane >> 4;
  for (int tile = blockIdx.x; tile < MT * NT; tile += gridDim.x) {
    int mt, nt;
    tile_map(tile, MT, NT, mt, nt);
    f32x4 acc[4][4];
    zero_acc(acc);
    gemm_mainloop(p.U + (size_t)mt * 256 * 1024, 1024, p.Wt_in + (size_t)nt * 128 * 1024, 1024, 1024, smem, acc);
    const int rbase = mt * 256 + wr * 64;
    const int seq = seq_of(rbase);
    const bool isp = seq < 8;
    const int sb = seq - 8;
    const int srow0 = isp ? seq * 2048 : kNP + sb * 64;
    const int L = isp ? 2048 : 64;
    const int cbase = nt * 128 + wc * 64;
    const int tb = rbase - srow0;
#pragma unroll
    for (int m = 0; m < 4; m++) {
#pragma unroll
      for (int n = 0; n < 4; n++) {
        const int col = cbase + n * 16 + fr;
        const int t4 = tb + m * 16 + fq * 4;
        const int row4 = rbase + m * 16 + fq * 4;
        f32x4 v = acc[m][n];
        if (cbase < 512) {
#pragma unroll
          for (int r = 0; r < 4; r++) p.Qb[(size_t)(row4 + r) * 512 + col] = f2bf(v[r]);
        } else if (cbase < 1024) {
          const int c = col - 512, h = c >> 6, d = c & 63;
          float* o = isp ? p.out + O_KP + (size_t)row4 * 512 + c : p.out + O_KS + (size_t)(row4 - kNP) * 512 + c;
          bf16_t* kb = isp ? p.Kp + ((size_t)(seq * 8 + h) * 2048 + t4) * 64 + d
                           : p.Ks + ((size_t)(sb * 8 + h) * 1152 + 1024 + t4) * 64 + d;
#pragma unroll
          for (int r = 0; r < 4; r++) {
            o[r * 512] = v[r];
            kb[r * 64] = f2bf(v[r]);
          }
        } else if (cbase < 1536) {
          const int c = col - 1024, h = c >> 6, d = c & 63;
          float* o = isp ? p.out + O_VP + (size_t)row4 * 512 + c : p.out + O_VS + (size_t)(row4 - kNP) * 512 + c;
#pragma unroll
          for (int r = 0; r < 4; r++) o[r * 512] = v[r];
          bf16_t* vt = isp ? p.VTp + ((size_t)(seq * 8 + h) * 64 + d) * 2048 + t4
                           : p.VTs + ((size_t)(sb * 8 + h) * 64 + d) * 1152 + 1024 + t4;
          uint2 pk;
          pk.x = pack2(v[0], v[1]);
          pk.y = pack2(v[2], v[3]);
          *(uint2*)vt = pk;
        } else if (cbase < 2560) {
          const int c = col - 1536;
#pragma unroll
          for (int r = 0; r < 4; r++) {
            p.MQK[(size_t)(row4 + r) * 1024 + c] = f2bf(v[r]);
            int t = t4 + r;
            if (t >= L - 3) {
              float* o = isp ? p.out + O_CVP + (size_t)(seq * 3 + (t - (L - 3))) * 1024 + c
                             : p.out + O_CVS + (size_t)(sb * 3 + (t - (L - 3))) * 1024 + c;
              *o = v[r];
            }
          }
        } else if (cbase < 3072) {
          const int c = col - 2560, h = c >> 7, d = c & 127;
          bf16_t* vt = isp ? p.MVTp + ((size_t)(seq * 4 + h) * 128 + d) * 2048 + t4
                           : p.MVTs + ((size_t)(sb * 4 + h) * 128 + d) * 64 + t4;
          uint2 pk;
          pk.x = pack2(v[0], v[1]);
          pk.y = pack2(v[2], v[3]);
          *(uint2*)vt = pk;
        } else if (cbase < 3584) {
          const int c = col - 3072;
#pragma unroll
          for (int r = 0; r < 4; r++) p.SO[(size_t)(row4 + r) * 512 + c] = f2bf(sigm(v[r]));
        } else if (cbase < 4608) {
          const int c = col - 3584;
#pragma unroll
          for (int r = 0; r < 4; r++) p.GA[(size_t)(row4 + r) * 1024 + c] = f2bf(sigm(v[r]));
        } else {
          const int c = col - 4608;
#pragma unroll
          for (int r = 0; r < 4; r++) p.GB[(size_t)(row4 + r) * 1024 + c] = f2bf(sigm(v[r]));
        }
      }
    }
  }
}

__device__ void attn_task(const Params& p, int seq, int h, int qt, char* smem) {
  const int tid = threadIdx.x, lane = tid & 63, w = tid >> 6, fr = lane & 15, fq = lane >> 4;
  const bool isp = seq < 8;
  const int sb = seq - 8;
  const int past = isp ? 0 : 1024;
  const int Tlen = isp ? 2048 : 1152;
  const int row0 = (isp ? seq * 2048 : kNP + sb * 64) + qt * 64;
  const int p0 = past + qt * 64;
  const bf16_t* Kb = isp ? p.Kp + (size_t)(seq * 8 + h) * 2048 * 64 : p.Ks + (size_t)(sb * 8 + h) * 1152 * 64;
  const bf16_t* VT = isp ? p.VTp + (size_t)(seq * 8 + h) * 64 * 2048 : p.VTs + (size_t)(sb * 8 + h) * 64 * 1152;
  bf16_t* sQ = (bf16_t*)smem;
  bf16_t* sK = sQ + 64 * 72;
  bf16_t* sVT = sK + 128 * 72;
  bf16_t* sP = sVT + 64 * 136;
  float* sZ = (float*)(sP + 64 * 136);
  int* sFlag = (int*)(sZ + 64 * 132);

  __syncthreads();
  {
    int r = tid >> 3, chn = tid & 7;
    uint4 q = *(const uint4*)(p.Qb + (size_t)(row0 + r) * 512 + h * 64 + chn * 8);
    *(uint4*)(sQ + r * 72 + chn * 8) = q;
  }
  const int kt_d = (p0 + 62) >> 7;
  const int ki0 = tid, ki1 = tid + 512;
  const bf16_t* kptr0 = Kb + (size_t)(ki0 >> 3) * 64 + (ki0 & 7) * 8;
  const bf16_t* kptr1 = Kb + (size_t)(ki1 >> 3) * 64 + (ki1 & 7) * 8;
  const bf16_t* vptr0 = VT + (size_t)(ki0 >> 4) * Tlen + (ki0 & 15) * 8;
  const bf16_t* vptr1 = VT + (size_t)(ki1 >> 4) * Tlen + (ki1 & 15) * 8;
  uint4 kr0 = *(const uint4*)(kptr0 + (size_t)kt_d * 8192);
  uint4 kr1 = *(const uint4*)(kptr1 + (size_t)kt_d * 8192);
  uint4 vr0 = *(const uint4*)(vptr0 + kt_d * 128);
  uint4 vr1 = *(const uint4*)(vptr1 + kt_d * 128);
  float R = 0.f;
  f32x4 oacc[2];
  oacc[0] = (f32x4){0.f, 0.f, 0.f, 0.f};
  oacc[1] = (f32x4){0.f, 0.f, 0.f, 0.f};
  const int mf = w & 3;
  for (int kt = kt_d; kt >= 0; kt--) {
    __syncthreads();
    *(uint4*)(sK + (ki0 >> 3) * 72 + (ki0 & 7) * 8) = kr0;
    *(uint4*)(sK + (ki1 >> 3) * 72 + (ki1 & 7) * 8) = kr1;
    *(uint4*)(sVT + (ki0 >> 4) * 136 + (ki0 & 15) * 8) = vr0;
    *(uint4*)(sVT + (ki1 >> 4) * 136 + (ki1 & 15) * 8) = vr1;
    if (tid == 0) *sFlag = 0;
    __syncthreads();
    if (kt > 0) {
      kr0 = *(const uint4*)(kptr0 + (size_t)(kt - 1) * 8192);
      kr1 = *(const uint4*)(kptr1 + (size_t)(kt - 1) * 8192);
      vr0 = *(const uint4*)(vptr0 + (kt - 1) * 128);
      vr1 = *(const uint4*)(vptr1 + (kt - 1) * 128);
    }
    {
      const int nf0 = (w >> 2) * 4;
      bf16x8 a0 = lds8(sQ + (mf * 16 + fr) * 72 + fq * 8);
      bf16x8 a1 = lds8(sQ + (mf * 16 + fr) * 72 + 32 + fq * 8);
#pragma unroll
      for (int n = 0; n < 4; n++) {
        bf16x8 b0 = lds8(sK + ((nf0 + n) * 16 + fr) * 72 + fq * 8);
        bf16x8 b1 = lds8(sK + ((nf0 + n) * 16 + fr) * 72 + 32 + fq * 8);
        f32x4 s = (f32x4){0.f, 0.f, 0.f, 0.f};
        s = MFMA(a0, b0, s);
        s = MFMA(a1, b1, s);
#pragma unroll
        for (int r = 0; r < 4; r++) sZ[(mf * 16 + fq * 4 + r) * 132 + (nf0 + n) * 16 + fr] = s[r] * 0.125f;
      }
    }
    __syncthreads();
    {
      const int row = tid >> 3, part = tid & 7;
      const int pos = p0 + row;
      const int j0 = kt * 128 + part * 16;
      float z[16], ls[16];
#pragma unroll
      for (int i4 = 0; i4 < 4; i4++) {
        float4 t4 = *(const float4*)(sZ + row * 132 + part * 16 + i4 * 4);
        z[i4 * 4 + 0] = t4.x;
        z[i4 * 4 + 1] = t4.y;
        z[i4 * 4 + 2] = t4.z;
        z[i4 * 4 + 3] = t4.w;
      }
      float run = 0.f;
      float tl[16];
#pragma unroll
      for (int i = 15; i >= 0; i--) {
        bool valid = (j0 + i) < pos;
        float l = valid ? -(fmaxf(z[i], 0.f) + __logf(1.0f + __expf(-fabsf(z[i])))) : 0.f;
        ls[i] = l;
        tl[i] = run;
        run += l;
      }
      float incl = run;
#pragma unroll
      for (int dlt = 1; dlt < 8; dlt <<= 1) {
        float t = __shfl_down(incl, dlt, 8);
        if (part + dlt < 8) incl += t;
      }
      float excl = incl - run;
      float tot = __shfl(incl, 0, 8);
      float base = R + excl;
      unsigned pk[8];
#pragma unroll
      for (int i = 0; i < 16; i += 2) {
        bool v0 = (j0 + i) < pos, v1 = (j0 + i + 1) < pos;
        float a0 = v0 ? __expf(z[i] + ls[i] + tl[i] + base) : 0.f;
        float a1 = v1 ? __expf(z[i + 1] + ls[i + 1] + tl[i + 1] + base) : 0.f;
        pk[i >> 1] = pack2(a0, a1);
      }
      *(uint4*)(sP + row * 136 + part * 16) = (uint4){pk[0], pk[1], pk[2], pk[3]};
      *(uint4*)(sP + row * 136 + part * 16 + 8) = (uint4){pk[4], pk[5], pk[6], pk[7]};
      R += tot;
      if (R > -110.f) *sFlag = 1;
    }
    __syncthreads();
    const int more = *sFlag;
    {
      const int nf0 = (w >> 2) * 2;
#pragma unroll
      for (int ks = 0; ks < 4; ks++) {
        bf16x8 a = lds8(sP + (mf * 16 + fr) * 136 + ks * 32 + fq * 8);
#pragma unroll
        for (int n = 0; n < 2; n++) {
          bf16x8 b = lds8(sVT + ((nf0 + n) * 16 + fr) * 136 + ks * 32 + fq * 8);
          oacc[n] = MFMA(a, b, oacc[n]);
        }
      }
    }
    if (!more) break;
  }
  {
    const int nf0 = (w >> 2) * 2;
#pragma unroll
    for (int n = 0; n < 2; n++)
#pragma unroll
      for (int r = 0; r < 4; r++)
        p.YA[(size_t)(row0 + mf * 16 + fq * 4 + r) * 512 + h * 64 + (nf0 + n) * 16 + fr] = f2bf(oacc[n][r]);
  }
}

__device__ void mlstm_task(const Params& p, int seq, int h, char* smem) {
  const int tid = threadIdx.x, lane = tid & 63, w = tid >> 6, fr = lane & 15, fq = lane >> 4;
  const bool isp = seq < 8;
  const int sb = seq - 8;
  const int L = isp ? 2048 : 64;
  const int nchunks = L >> 6;
  const int grow0 = isp ? seq * 2048 : kNP + sb * 64;
  const bf16_t* MVT = isp ? p.MVTp + (size_t)(seq * 4 + h) * 128 * 2048 : p.MVTs + (size_t)(sb * 4 + h) * 128 * 64;
  bf16_t* sQ = (bf16_t*)smem;
  bf16_t* sK = sQ + 64 * 136;
  bf16_t* sKT = sK + 64 * 136;
  bf16_t* sVT = sKT + 128 * 72;
  bf16_t* sCb = sVT + 128 * 72;
  bf16_t* sSw = sCb + 128 * 136;
  float* sF = (float*)(sSw + 64 * 72);
  float* sBt = sF;
  float* sAs = sF + 64;
  float* sWi = sF + 128;
  float* sWg = sF + 192;
  float* sEm = sF + 256;
  float* sDen = sF + 320;
  float* sNq = sF + 384;
  float* sSS = sF + 448;
  float* sN = sF + 512;
  float* sSc = sF + 640;

  __syncthreads();
  f32x4 Cacc[8];
  float m_run;
  if (isp) {
#pragma unroll
    for (int n = 0; n < 8; n++) Cacc[n] = (f32x4){0.f, 0.f, 0.f, 0.f};
    m_run = 0.f;
    if (tid < 128) sN[tid] = 0.f;
  } else {
    const float* C0 = p.st_C + (size_t)(sb * 4 + h) * 16384;
#pragma unroll
    for (int n = 0; n < 8; n++)
#pragma unroll
      for (int r = 0; r < 4; r++) Cacc[n][r] = C0[(w * 16 + fq * 4 + r) * 128 + n * 16 + fr];
    if (tid < 128) sN[tid] = p.st_n[(sb * 4 + h) * 128 + tid];
    m_run = p.st_m[sb * 4 + h];
  }
#pragma unroll
  for (int n = 0; n < 8; n++)
#pragma unroll
    for (int r = 0; r < 4; r++) sCb[(w * 16 + fq * 4 + r) * 136 + n * 16 + fr] = f2bf(Cacc[n][r]);

  float* sCw = sF + 656;
  for (int i = tid; i < 1280; i += 512) {
    int j = i >> 8, cc = i & 255;
    int gch = (cc >= 128 ? 512 : 0) + h * 128 + (cc & 127);
    sCw[i] = (j < 4) ? p.w_conv[j * 1024 + gch] : p.b_conv[gch];
  }
  for (int c = 0; c < nchunks; c++) {
    const int t0 = c * 64;
    int tidv = threadIdx.x;
    asm volatile("" : "+v"(tidv));
    const int tid = tidv, lane = tid & 63, w = tid >> 6, fr = lane & 15, fq = lane >> 4;
    const int rb = tid >> 5, cgp = tid & 31;
    const bool isk = cgp >= 16;
    const int ch = (isk ? 512 : 0) + h * 128 + (cgp & 15) * 8;
    uint4 xr0, xr1, xr2, xr3, xr4, xr5, xr6, vr0, vr1;
    {
      const int tb0 = t0 + rb * 4 - 3;
      const bf16_t* xp = p.MQK + (size_t)(grow0 + tb0) * 1024 + ch;
#define LDX(i, dst)                                                                   \
  if (tb0 + i >= 0) dst = *(const uint4*)(xp + (size_t)i * 1024);                     \
  else if (isp) dst = (uint4){0u, 0u, 0u, 0u};                                        \
  else {                                                                              \
    const float* s0 = p.st_conv + (size_t)(sb * 3 + (tb0 + i + 3)) * 1024 + ch;       \
    dst = (uint4){pack2(s0[0], s0[1]), pack2(s0[2], s0[3]), pack2(s0[4], s0[5]), pack2(s0[6], s0[7])}; \
  }
      LDX(0, xr0) LDX(1, xr1) LDX(2, xr2)
      xr3 = *(const uint4*)(xp + (size_t)3 * 1024);
      xr4 = *(const uint4*)(xp + (size_t)4 * 1024);
      xr5 = *(const uint4*)(xp + (size_t)5 * 1024);
      xr6 = *(const uint4*)(xp + (size_t)6 * 1024);
#undef LDX
      vr0 = *(const uint4*)(MVT + (size_t)(tid >> 3) * L + t0 + (tid & 7) * 8);
      vr1 = *(const uint4*)(MVT + (size_t)((tid + 512) >> 3) * L + t0 + (tid & 7) * 8);
    }
    if (w == 0) {
      int row = grow0 + t0 + lane;
      float li = p.GI[row * 4 + h], lf = p.LF[row * 4 + h];
      float b = lf;
#pragma unroll
      for (int d = 1; d < 64; d <<= 1) {
        float t_ = __shfl_up(b, d);
        if (lane >= d) b += t_;
      }
      float a_s = li - b;
      float pm = a_s;
#pragma unroll
      for (int d = 1; d < 64; d <<= 1) {
        float t_ = __shfl_up(pm, d);
        if (lane >= d) pm = fmaxf(pm, t_);
      }
      float mt = b + fmaxf(m_run, pm);
      float blast = __shfl(b, 63);
      float g = blast - b + li;
      float G = wave_max(g);
      float m_new = fmaxf(blast + m_run, G);
      sBt[lane] = b - mt;
      sAs[lane] = a_s;
      sWi[lane] = __expf(b + m_run - mt);
      sWg[lane] = __expf(g - m_new);
      sEm[lane] = __expf(-mt);
      sDen[lane] = 0.f;
      sSS[lane] = 0.f;
      if (lane == 0) {
        sSc[0] = __expf(blast + m_run - m_new);
        sSc[1] = m_new;
      }
    }
    __syncthreads();
    {
      float o0[8], o1[8], o2[8], o3[8];
      {
        const float* cwp = sCw + cgp * 8;
        float4 b0 = *(const float4*)(cwp + 1024), b1 = *(const float4*)(cwp + 1028);
        o0[0] = b0.x; o0[1] = b0.y; o0[2] = b0.z; o0[3] = b0.w; o0[4] = b1.x; o0[5] = b1.y; o0[6] = b1.z; o0[7] = b1.w;
#pragma unroll
        for (int e = 0; e < 8; e++) { o1[e] = o0[e]; o2[e] = o0[e]; o3[e] = o0[e]; }
#define FMAW(j, o, x) { float4 a0 = *(const float4*)(cwp + j * 256), a1 = *(const float4*)(cwp + j * 256 + 4); \
  o[0] += a0.x * x[0]; o[1] += a0.y * x[1]; o[2] += a0.z * x[2]; o[3] += a0.w * x[3];                              \
  o[4] += a1.x * x[4]; o[5] += a1.y * x[5]; o[6] += a1.z * x[6]; o[7] += a1.w * x[7]; }
#define UNP(xv, x) float x[8]; x[0] = __uint_as_float(xv.x << 16); x[1] = __uint_as_float(xv.x & 0xffff0000u); \
  x[2] = __uint_as_float(xv.y << 16); x[3] = __uint_as_float(xv.y & 0xffff0000u);                             \
  x[4] = __uint_as_float(xv.z << 16); x[5] = __uint_as_float(xv.z & 0xffff0000u);                             \
  x[6] = __uint_as_float(xv.w << 16); x[7] = __uint_as_float(xv.w & 0xffff0000u);
        { UNP(xr0, x) FMAW(0, o0, x) }
        { UNP(xr1, x) FMAW(1, o0, x) FMAW(0, o1, x) }
        { UNP(xr2, x) FMAW(2, o0, x) FMAW(1, o1, x) FMAW(0, o2, x) }
        { UNP(xr3, x) FMAW(3, o0, x) FMAW(2, o1, x) FMAW(1, o2, x) FMAW(0, o3, x) }
        { UNP(xr4, x) FMAW(3, o1, x) FMAW(2, o2, x) FMAW(1, o3, x) }
        { UNP(xr5, x) FMAW(3, o2, x) FMAW(2, o3, x) }
        { UNP(xr6, x) FMAW(3, o3, x) }
#undef FMAW
#undef UNP
      }
      const float ksc = isk ? 0.08838834764831845f : 1.0f;
#pragma unroll
      for (int e = 0; e < 8; e++) {
        o0[e] = silu(o0[e]) * ksc; o1[e] = silu(o1[e]) * ksc; o2[e] = silu(o2[e]) * ksc; o3[e] = silu(o3[e]) * ksc;
      }
      bf16_t* dstp = (isk ? sK + (cgp - 16) * 8 : sQ + cgp * 8) + (rb * 4) * 136;
      *(uint4*)(dstp) = (uint4){pack2(o0[0], o0[1]), pack2(o0[2], o0[3]), pack2(o0[4], o0[5]), pack2(o0[6], o0[7])};
      *(uint4*)(dstp + 136) = (uint4){pack2(o1[0], o1[1]), pack2(o1[2], o1[3]), pack2(o1[4], o1[5]), pack2(o1[6], o1[7])};
      *(uint4*)(dstp + 272) = (uint4){pack2(o2[0], o2[1]), pack2(o2[2], o2[3]), pack2(o2[4], o2[5]), pack2(o2[6], o2[7])};
      *(uint4*)(dstp + 408) = (uint4){pack2(o3[0], o3[1]), pack2(o3[2], o3[3]), pack2(o3[4], o3[5]), pack2(o3[6], o3[7])};
      if (isk) {
        float g0 = sWg[rb * 4], g1 = sWg[rb * 4 + 1], g2 = sWg[rb * 4 + 2], g3 = sWg[rb * 4 + 3];
#pragma unroll
        for (int e = 0; e < 8; e++) {
          uint2 pk;
          pk.x = pack2(o0[e] * g0, o1[e] * g1);
          pk.y = pack2(o2[e] * g2, o3[e] * g3);
          *(uint2*)(sKT + ((cgp - 16) * 8 + e) * 72 + rb * 4) = pk;
        }
      }
      *(uint4*)(sVT + (tid >> 3) * 72 + (tid & 7) * 8) = vr0;
      *(uint4*)(sVT + ((tid + 512) >> 3) * 72 + (tid & 7) * 8) = vr1;
    }
    __syncthreads();
    {
      const int mf = w >> 1, nf0 = (w & 1) * 2;
      f32x4 sa[2];
      sa[0] = (f32x4){0.f, 0.f, 0.f, 0.f};
      sa[1] = (f32x4){0.f, 0.f, 0.f, 0.f};
#pragma unroll
      for (int ks = 0; ks < 4; ks++) {
        bf16x8 a = lds8(sQ + (mf * 16 + fr) * 136 + ks * 32 + fq * 8);
#pragma unroll
        for (int n = 0; n < 2; n++) {
          bf16x8 b = lds8(sK + ((nf0 + n) * 16 + fr) * 136 + ks * 32 + fq * 8);
          sa[n] = MFMA(a, b, sa[n]);
        }
      }
#pragma unroll
      for (int r = 0; r < 4; r++) {
        const int t = mf * 16 + fq * 4 + r;
        const float bt = sBt[t];
        float rs = 0.f;
#pragma unroll
        for (int n = 0; n < 2; n++) {
          const int s = (nf0 + n) * 16 + fr;
          float wgt = (s <= t) ? __expf(bt + sAs[s]) : 0.f;
          float v = sa[n][r] * wgt;
          rs += v;
          sSw[t * 72 + s] = f2bf(v);
        }
        rs += __shfl_xor(rs, 1);
        rs += __shfl_xor(rs, 2);
        rs += __shfl_xor(rs, 4);
        rs += __shfl_xor(rs, 8);
        if (fr == 0) atomicAdd(&sDen[t], rs);
      }
      {
        const int t = tid >> 3, part = tid & 7;
        float a = 0.f;
#pragma unroll
        for (int i = 0; i < 16; i++) a += bf2f(sQ[t * 136 + part * 16 + i]) * sN[part * 16 + i];
        a += __shfl_xor(a, 1);
        a += __shfl_xor(a, 2);
        a += __shfl_xor(a, 4);
        if (part == 0) sNq[t] = a;
      }
    }
    __syncthreads();
    const int mf = w & 3, nf0 = (w >> 2) * 4;
    f32x4 hacc[4];
    {
#pragma unroll
      for (int n = 0; n < 4; n++) hacc[n] = (f32x4){0.f, 0.f, 0.f, 0.f};
#pragma unroll
      for (int ks = 0; ks < 4; ks++) {
        bf16x8 a = lds8(sQ + (mf * 16 + fr) * 136 + ks * 32 + fq * 8);
#pragma unroll
        for (int n = 0; n < 4; n++) {
          bf16x8 b = lds8(sCb + ((nf0 + n) * 16 + fr) * 136 + ks * 32 + fq * 8);
          hacc[n] = MFMA(a, b, hacc[n]);
        }
      }
#pragma unroll
      for (int r = 0; r < 4; r++) {
        float wi = sWi[mf * 16 + fq * 4 + r];
#pragma unroll
        for (int n = 0; n < 4; n++) hacc[n][r] *= wi;
      }
#pragma unroll
      for (int ks = 0; ks < 2; ks++) {
        bf16x8 a = lds8(sSw + (mf * 16 + fr) * 72 + ks * 32 + fq * 8);
#pragma unroll
        for (int n = 0; n < 4; n++) {
          bf16x8 b = lds8(sVT + ((nf0 + n) * 16 + fr) * 72 + ks * 32 + fq * 8);
          hacc[n] = MFMA(a, b, hacc[n]);
        }
      }
#pragma unroll
      for (int r = 0; r < 4; r++) {
        const int t = mf * 16 + fq * 4 + r;
        float den = sDen[t] + sWi[t] * sNq[t];
        float dn = fmaxf(fabsf(den), sEm[t]);
        float inv = 1.0f / dn;
        float ss = 0.f;
#pragma unroll
        for (int n = 0; n < 4; n++) {
          hacc[n][r] *= inv;
          ss += hacc[n][r] * hacc[n][r];
        }
        ss += __shfl_xor(ss, 1);
        ss += __shfl_xor(ss, 2);
        ss += __shfl_xor(ss, 4);
        ss += __shfl_xor(ss, 8);
        if (fr == 0) atomicAdd(&sSS[t], ss);
      }
    }
    __syncthreads();
    {
#pragma unroll
      for (int r = 0; r < 4; r++) {
        const int t = mf * 16 + fq * 4 + r;
        const float rstd = rsqrtf(sSS[t] * (1.0f / 128.0f) + 1e-6f);
        const size_t grow = (size_t)(grow0 + t0 + t);
#pragma unroll
        for (int n = 0; n < 4; n++) {
          const int cidx = h * 128 + (nf0 + n) * 16 + fr;
          float val = hacc[n][r] * rstd * p.ml_norm_g[cidx];
          float so = bf2f(p.SO[grow * 512 + cidx]);
          p.YB[grow * 512 + cidx] = f2bf(so * val);
        }
      }
      const float decay = sSc[0];
#pragma unroll
      for (int n = 0; n < 8; n++) {
        Cacc[n][0] *= decay;
        Cacc[n][1] *= decay;
        Cacc[n][2] *= decay;
        Cacc[n][3] *= decay;
      }
#pragma unroll
      for (int ks = 0; ks < 2; ks++) {
        bf16x8 a = lds8(sVT + (w * 16 + fr) * 72 + ks * 32 + fq * 8);
#pragma unroll
        for (int n = 0; n < 8; n++) {
          bf16x8 b = lds8(sKT + (n * 16 + fr) * 72 + ks * 32 + fq * 8);
          Cacc[n] = MFMA(a, b, Cacc[n]);
        }
      }
#pragma unroll
      for (int n = 0; n < 8; n++)
#pragma unroll
        for (int r = 0; r < 4; r++) sCb[(w * 16 + fq * 4 + r) * 136 + n * 16 + fr] = f2bf(Cacc[n][r]);
      if (tid < 128) {
        float a = 0.f;
#pragma unroll 8
        for (int s = 0; s < 64; s++) a += bf2f(sKT[tid * 72 + s]);
        sN[tid] = decay * sN[tid] + a;
      }
      m_run = sSc[1];
    }
    __syncthreads();
  }
  {
    float* Cout = isp ? p.out + O_CP + (size_t)(seq * 4 + h) * 16384 : p.out + O_CS + (size_t)(sb * 4 + h) * 16384;
#pragma unroll
    for (int n = 0; n < 8; n++)
#pragma unroll
      for (int r = 0; r < 4; r++) Cout[(w * 16 + fq * 4 + r) * 128 + n * 16 + fr] = Cacc[n][r];
    float* nout = isp ? p.out + O_NP + (seq * 4 + h) * 128 : p.out + O_NS + (sb * 4 + h) * 128;
    if (tid < 128) nout[tid] = sN[tid];
    if (tid == 0) {
      if (isp) p.out[O_MP + seq * 4 + h] = m_run;
      else p.out[O_MS + sb * 4 + h] = m_run;
    }
  }
}

constexpr int D_ML_P = 32;
constexpr int D_AT_P = 2048;
constexpr int D_AT_S = 128;
constexpr int D_ML_S = 64;
constexpr int D_TOTAL = D_ML_P + D_AT_P + D_AT_S + D_ML_S;

__device__ void phase_d(const Params& p, char* smem) {
  int* sTask = (int*)(smem + LDS_BYTES - 16);
  for (;;) {
    __syncthreads();
    if (threadIdx.x == 0) *sTask = (int)atomicAdd(p.counter, 1u);
    __syncthreads();
    int task = __builtin_amdgcn_readfirstlane(*sTask);
    if (task >= D_TOTAL) break;
    int kind, seq, h, qt = 0;
    if (task < D_ML_P) {
      kind = 0; seq = task >> 2; h = task & 3;
    } else if (task < D_ML_P + D_AT_P) {
      int t2 = task - D_ML_P;
      kind = 1; qt = 31 - (t2 >> 6); seq = (t2 & 63) >> 3; h = t2 & 7;
    } else if (task < D_ML_P + D_AT_P + D_AT_S) {
      int t2 = task - D_ML_P - D_AT_P;
      kind = 1; seq = 8 + (t2 >> 3); h = t2 & 7;
    } else {
      int t2 = task - D_ML_P - D_AT_P - D_AT_S;
      kind = 0; seq = 8 + (t2 >> 2); h = t2 & 3;
    }
    if (kind == 0) mlstm_task(p, seq, h, smem);
    else attn_task(p, seq, h, qt, smem);
  }
}

__device__ void phase_e(const Params& p, char* smem) {
  const int MT = 68, NT = 8;
  const int tid = threadIdx.x, lane = tid & 63, w = tid >> 6, wr = w >> 1, wc = w & 1, fr = lane & 15, fq = lane >> 4;
  for (int tile = blockIdx.x; tile < MT * NT; tile += gridDim.x) {
    int mt, nt;
    tile_map(tile, MT, NT, mt, nt);
    f32x4 acc[4][4];
    uint2 res[4][4];
    zero_acc(acc);
    gemm_mainloop(p.YA + (size_t)mt * 256 * 512, 512, p.Wt_a + (size_t)nt * 128 * 512, 512, 512, smem, acc);
#pragma unroll
    for (int m = 0; m < 4; m++)
#pragma unroll
      for (int n = 0; n < 4; n++) {
        const int col = nt * 128 + wc * 64 + n * 16 + fr;
        const int row4 = mt * 256 + wr * 64 + m * 16 + fq * 4;
        const bf16_t* gp = p.GA + (size_t)row4 * 1024 + col;
        res[m][n].x = pack2(acc[m][n][0] * bf2f(gp[0]), acc[m][n][1] * bf2f(gp[1024]));
        res[m][n].y = pack2(acc[m][n][2] * bf2f(gp[2048]), acc[m][n][3] * bf2f(gp[3072]));
      }
    zero_acc(acc);
    gemm_mainloop(p.YB + (size_t)mt * 256 * 512, 512, p.Wt_b + (size_t)nt * 128 * 512, 512, 512, smem, acc);
#pragma unroll
    for (int m = 0; m < 4; m++)
#pragma unroll
      for (int n = 0; n < 4; n++) {
        const int col = nt * 128 + wc * 64 + n * 16 + fr;
        const int row4 = mt * 256 + wr * 64 + m * 16 + fq * 4;
        const bf16_t* gp = p.GB + (size_t)row4 * 1024 + col;
        bf16_t* mp = p.MER + (size_t)row4 * 1024 + col;
        mp[0] = f2bf(__uint_as_float(res[m][n].x << 16) + acc[m][n][0] * bf2f(gp[0]));
        mp[1024] = f2bf(__uint_as_float(res[m][n].x & 0xffff0000u) + acc[m][n][1] * bf2f(gp[1024]));
        mp[2048] = f2bf(__uint_as_float(res[m][n].y << 16) + acc[m][n][2] * bf2f(gp[2048]));
        mp[3072] = f2bf(__uint_as_float(res[m][n].y & 0xffff0000u) + acc[m][n][3] * bf2f(gp[3072]));
      }
  }
}
__device__ void phase_f(const Params& p, char* smem) {
  const int MT = 68, NT = 8;
  const int tid = threadIdx.x, lane = tid & 63, w = tid >> 6, wr = w >> 1, wc = w & 1, fr = lane & 15, fq = lane >> 4;
  for (int tile = blockIdx.x; tile < MT * NT; tile += gridDim.x) {
    int mt, nt;
    tile_map(tile, MT, NT, mt, nt);
    f32x4 acc[4][4];
    zero_acc(acc);
    gemm_mainloop(p.MER + (size_t)mt * 256 * 1024, 1024, p.Wt_out + (size_t)nt * 128 * 1024, 1024, 1024, smem, acc);
    const int seq = seq_of(mt * 256 + wr * 64);
#pragma unroll
    for (int n = 0; n < 4; n++) {
      const int col = nt * 128 + wc * 64 + n * 16 + fr;
      const float g1 = p.modf[seq * 6144 + 2048 + col];
#pragma unroll
      for (int m = 0; m < 4; m++) {
        const int row4 = mt * 256 + wr * 64 + m * 16 + fq * 4;
#pragma unroll
        for (int r = 0; r < 4; r++) {
          const int row = row4 + r;
          p.X1[(size_t)row * 1024 + col] = xrow(p, row)[col] + g1 * acc[m][n][r];
        }
      }
    }
  }
}
__device__ void phase_h(const Params& p, char* smem) {
  const int MT = 68, NT = 44;
  const int tid = threadIdx.x, lane = tid & 63, w = tid >> 6, wr = w >> 1, wc = w & 1, fr = lane & 15, fq = lane >> 4;
  for (int tile = blockIdx.x; tile < MT * NT; tile += gridDim.x) {
    int mt, nt;
    tile_map(tile, MT, NT, mt, nt);
    f32x4 acc[4][4];
    zero_acc(acc);
    gemm_mainloop(p.U + (size_t)mt * 256 * 1024, 1024, p.Wt_gu + (size_t)nt * 128 * 1024, 1024, 1024, smem, acc);
#pragma unroll
    for (int m = 0; m < 4; m++)
#pragma unroll
      for (int n = 0; n < 2; n++) {
        const int f = nt * 64 + wc * 32 + n * 16 + fr;
        const int row4 = mt * 256 + wr * 64 + m * 16 + fq * 4;
#pragma unroll
        for (int r = 0; r < 4; r++)
          p.HFF[(size_t)(row4 + r) * 2816 + f] = f2bf(silu(acc[m][n][r]) * acc[m][n + 2][r]);
      }
  }
}
__device__ void phase_i(const Params& p, char* smem) {
  const int MT = 68, NT = 8;
  const int tid = threadIdx.x, lane = tid & 63, w = tid >> 6, wr = w >> 1, wc = w & 1, fr = lane & 15, fq = lane >> 4;
  for (int tile = blockIdx.x; tile < MT * NT; tile += gridDim.x) {
    int mt, nt;
    tile_map(tile, MT, NT, mt, nt);
    f32x4 acc[4][4];
    zero_acc(acc);
    gemm_mainloop(p.HFF + (size_t)mt * 256 * 2816, 2816, p.Wt_down + (size_t)nt * 128 * 2816, 2816, 2816, smem, acc);
    const int seq = seq_of(mt * 256 + wr * 64);
#pragma unroll
    for (int n = 0; n < 4; n++) {
      const int col = nt * 128 + wc * 64 + n * 16 + fr;
      const float g2 = p.modf[seq * 6144 + 5120 + col];
#pragma unroll
      for (int m = 0; m < 4; m++) {
        const int row4 = mt * 256 + wr * 64 + m * 16 + fq * 4;
#pragma unroll
        for (int r = 0; r < 4; r++) {
          float* px = p.X1 + (size_t)(row4 + r) * 1024 + col;
          *px = *px + g2 * acc[m][n][r];
        }
      }
    }
  }
}
__device__ void phase_j(const Params& p) {
  const int tid = threadIdx.x, lane = tid & 63, w = tid >> 6;
  for (int rb = blockIdx.x; rb < kT / 8; rb += gridDim.x) {
    int row = rb * 8 + w;
    const float* xr = p.X1 + (size_t)row * 1024;
    float4 v[4];
    float ss = 0.f;
#pragma unroll
    for (int j = 0; j < 4; j++) {
      v[j] = *(const float4*)(xr + j * 256 + lane * 4);
      ss += v[j].x * v[j].x + v[j].y * v[j].y + v[j].z * v[j].z + v[j].w * v[j].w;
    }
    ss = wave_sum(ss);
    float rstd = rsqrtf(ss * (1.0f / 1024.0f) + 1e-6f);
    float* o = p.out + (row < kNP ? O_YP + (size_t)row * 1024 : O_YS + (size_t)(row - kNP) * 1024);
#pragma unroll
    for (int j = 0; j < 4; j++) {
      int c = j * 256 + lane * 4;
      float4 g = *(const float4*)(p.final_g + c);
      float4 r4;
      r4.x = v[j].x * rstd * g.x;
      r4.y = v[j].y * rstd * g.y;
      r4.z = v[j].z * rstd * g.z;
      r4.w = v[j].w * rstd * g.w;
      *(float4*)(o + c) = r4;
    }
  }
}

extern __shared__ __attribute__((aligned(16))) char dyn_smem[];

__device__ __forceinline__ void run_phase(const Params& p, int ph, char* smem) {
  switch (ph) {
    case 0: phase_a(p, smem); break;
    case 1: phase_b(p, smem); break;
    case 2: phase_c(p, smem); break;
    case 3: phase_d(p, smem); break;
    case 4: phase_e(p, smem); break;
    case 5: phase_f(p, smem); break;
    case 6: phase_g(p, smem); break;
    case 7: phase_h(p, smem); break;
    case 8: phase_i(p, smem); break;
    default: phase_j(p); break;
  }
}

__global__ void __launch_bounds__(NTHREADS) mega_kernel(Params p) {
  cg::grid_group grid = cg::this_grid();
  phase_a(p, dyn_smem);
  grid.sync();
  phase_b(p, dyn_smem);
  grid.sync();
  phase_c(p, dyn_smem);
  grid.sync();
  phase_d(p, dyn_smem);
  grid.sync();
  phase_e(p, dyn_smem);
  grid.sync();
  phase_f(p, dyn_smem);
  grid.sync();
  phase_g(p, dyn_smem);
  grid.sync();
  phase_h(p, dyn_smem);
  grid.sync();
  phase_i(p, dyn_smem);
  grid.sync();
  phase_j(p);
}
__global__ void __launch_bounds__(NTHREADS) phase_kernel(Params p, int ph) { run_phase(p, ph, dyn_smem); }

extern "C" void kernel_launch(void* const* d_in, const int* in_sizes, int n_in, void* d_out, int out_size, void* d_ws,
                              size_t ws_size, hipStream_t stream) {
  Params p{};
  const float** pin = (const float**)&p;
  for (int i = 0; i < 26; i++) pin[i] = (const float*)d_in[i];
  p.out = (float*)d_out;
  char* ws = (char*)d_ws;
  size_t off = 0;
  auto alloc = [&](size_t bytes) {
    char* r = ws + off;
    off += (bytes + 255) & ~(size_t)255;
    return r;
  };
  p.Wt_in = (bf16_t*)alloc((size_t)5632 * 1024 * 2);
  p.Wt_a = (bf16_t*)alloc((size_t)1024 * 512 * 2);
  p.Wt_b = (bf16_t*)alloc((size_t)1024 * 512 * 2);
  p.Wt_out = (bf16_t*)alloc((size_t)1024 * 1024 * 2);
  p.Wt_gu = (bf16_t*)alloc((size_t)5632 * 1024 * 2);
  p.Wt_down = (bf16_t*)alloc((size_t)1024 * 2816 * 2);
  p.wg = (float*)alloc(8192 * 4);
  p.modp = (float*)alloc((size_t)8 * 24 * 6144 * 4);
  p.modf = (float*)alloc((size_t)24 * 6144 * 4);
  p.U = (bf16_t*)alloc((size_t)kT * 1024 * 2);
  p.Qb = (bf16_t*)alloc((size_t)kT * 512 * 2);
  p.Kp = (bf16_t*)alloc((size_t)64 * 2048 * 64 * 2);
  p.Ks = (bf16_t*)alloc((size_t)128 * 1152 * 64 * 2);
  p.VTp = (bf16_t*)alloc((size_t)64 * 64 * 2048 * 2);
  p.VTs = (bf16_t*)alloc((size_t)128 * 64 * 1152 * 2);
  p.MQK = (bf16_t*)alloc((size_t)kT * 1024 * 2);
  p.MVTp = (bf16_t*)alloc((size_t)32 * 128 * 2048 * 2);
  p.MVTs = (bf16_t*)alloc((size_t)64 * 128 * 64 * 2);
  p.SO = (bf16_t*)alloc((size_t)kT * 512 * 2);
  p.GA = (bf16_t*)alloc((size_t)kT * 1024 * 2);
  p.GB = (bf16_t*)alloc((size_t)kT * 1024 * 2);
  p.GI = (float*)alloc((size_t)kT * 4 * 4);
  p.LF = (float*)alloc((size_t)kT * 4 * 4);
  p.YA = (bf16_t*)alloc((size_t)kT * 512 * 2);
  p.YB = (bf16_t*)alloc((size_t)kT * 512 * 2);
  p.MER = (bf16_t*)alloc((size_t)kT * 1024 * 2);
  p.X1 = (float*)alloc((size_t)kT * 1024 * 4);
  p.HFF = (bf16_t*)alloc((size_t)kT * 2816 * 2);
  p.counter = (unsigned*)alloc(256);

#if ONE_LAUNCH
  static int grid_blocks = 0;
  if (!grid_blocks) {
    int dev = 0, cus = 0, per_cu = 0;
    hipGetDevice(&dev);
    hipDeviceGetAttribute(&cus, hipDeviceAttributeMultiprocessorCount, dev);
    hipFuncSetAttribute((const void*)mega_kernel, hipFuncAttributeMaxDynamicSharedMemorySize, LDS_BYTES);
    hipOccupancyMaxActiveBlocksPerMultiprocessor(&per_cu, mega_kernel, NTHREADS, LDS_BYTES);
    if (per_cu < 1) per_cu = 1;
    grid_blocks = cus * per_cu;
  }
  void* args[] = {&p};
  hipError_t e = hipLaunchCooperativeKernel((void*)mega_kernel, dim3(grid_blocks), dim3(NTHREADS), args, LDS_BYTES, stream);
  if (e != hipSuccess) fprintf(stderr, "cooperative launch failed: %s (grid %d)\n", hipGetErrorString(e), grid_blocks);
#else
  static int init = 0;
  if (!init) {
    hipFuncSetAttribute((const void*)phase_kernel, hipFuncAttributeMaxDynamicSharedMemorySize, LDS_BYTES);
    init = 1;
  }
  for (int ph = 0; ph < 10; ph++) phase_kernel<<<256, NTHREADS, LDS_BYTES, stream>>>(p, ph);
#endif
}
```

```cpp
#include <hip/hip_runtime.h>
#include <hip/hip_cooperative_groups.h>
#include <stdint.h>
#include <stdio.h>
namespace cg = cooperative_groups;

#ifndef ONE_LAUNCH
#define ONE_LAUNCH 1
#endif

typedef unsigned short bf16_t;
using bf16x8 = __attribute__((ext_vector_type(8))) short;
using f32x4 = __attribute__((ext_vector_type(4))) float;

#define NTHREADS 512
#define LDS_BYTES 131072
constexpr int kNP = 16384;
constexpr int kT = 17408;
constexpr int kINW = 5640;

struct Params {
  const float *x_prompt, *x_sample, *c_prompt, *c_sample, *cache_k, *cache_v, *st_C, *st_n, *st_m, *st_conv;
  const float *norm1_g, *norm2_g, *w_ada, *b_ada, *w_in, *b_if, *w_conv, *b_conv, *ml_norm_g, *w_a, *w_b, *w_out,
      *w_gate, *w_up, *w_down, *final_g;
  float* out;
  bf16_t *Wt_in, *Wt_a, *Wt_b, *Wt_out, *Wt_gu, *Wt_down;
  float *wg, *modp, *modf;
  bf16_t *U, *Qb, *Kp, *Ks, *VTp, *VTs, *MQK, *MVTp, *MVTs, *SO, *GA, *GB;
  float *GI, *LF, *GV, *DENc;
  bf16_t *Qc, *KTc, *SWc;
  bf16_t *YA, *YB, *MER;
  float* X1;
  bf16_t* HFF;
  unsigned* counter;
};

constexpr size_t O_YP = 0;
constexpr size_t O_YS = O_YP + 16777216;
constexpr size_t O_KP = O_YS + 1048576;
constexpr size_t O_VP = O_KP + 8388608;
constexpr size_t O_CP = O_VP + 8388608;
constexpr size_t O_NP = O_CP + 524288;
constexpr size_t O_MP = O_NP + 4096;
constexpr size_t O_CVP = O_MP + 32;
constexpr size_t O_KS = O_CVP + 24576;
constexpr size_t O_VS = O_KS + 524288;
constexpr size_t O_CS = O_VS + 524288;
constexpr size_t O_NS = O_CS + 1048576;
constexpr size_t O_MS = O_NS + 8192;
constexpr size_t O_CVS = O_MS + 64;

typedef __bf16 hwbf16x2_t __attribute__((ext_vector_type(2)));
typedef float hwf32x2_t __attribute__((ext_vector_type(2)));
__device__ __forceinline__ bf16_t f2bf(float f) {
  __bf16 r = (__bf16)f;
  return __builtin_bit_cast(unsigned short, r);
}
__device__ __forceinline__ float bf2f(bf16_t h) { return __uint_as_float(((unsigned)h) << 16); }
__device__ __forceinline__ unsigned pack2(float a, float b) {
  hwf32x2_t v = {a, b};
  hwbf16x2_t r = __builtin_convertvector(v, hwbf16x2_t);
  return __builtin_bit_cast(unsigned, r);
}
__device__ __forceinline__ float sigm(float x) { return __builtin_amdgcn_rcpf(1.0f + __expf(-x)); }
__device__ __forceinline__ float silu(float x) { return x * __builtin_amdgcn_rcpf(1.0f + __expf(-x)); }
__device__ __forceinline__ float logsig(float x) { return fminf(x, 0.f) - __logf(1.0f + __expf(-fabsf(x))); }
__device__ __forceinline__ float wave_sum(float v) {
#pragma unroll
  for (int o = 32; o > 0; o >>= 1) v += __shfl_xor(v, o);
  return v;
}
__device__ __forceinline__ float wave_max(float v) {
#pragma unroll
  for (int o = 32; o > 0; o >>= 1) v = fmaxf(v, __shfl_xor(v, o));
  return v;
}
__device__ __forceinline__ int seq_of(int row) { return row < kNP ? (row >> 11) : 8 + ((row - kNP) >> 6); }
__device__ __forceinline__ const float* xrow(const Params& p, int row) {
  return row < kNP ? p.x_prompt + (size_t)row * 1024 : p.x_sample + (size_t)(row - kNP) * 1024;
}
__device__ __forceinline__ int launder_tid() {
  int t = threadIdx.x;
  asm volatile("" : "+v"(t));
  return t;
}
__device__ __forceinline__ bf16x8 lds8(const void* p) { return *(const bf16x8*)p; }
#define MFMA(a, b, c) __builtin_amdgcn_mfma_f32_16x16x32_bf16(a, b, c, 0, 0, 0)

__device__ __forceinline__ void glds16(const void* g, void* l) {
  __builtin_amdgcn_global_load_lds((const unsigned*)g, (unsigned*)l, 16, 0, 0);
}
__device__ __forceinline__ void gemm_stage(const bf16_t* __restrict__ A, int lda, const bf16_t* __restrict__ B, int ldb,
                                           int k0, char* st) {
  const int tid = launder_tid();
#pragma unroll
  for (int i = 0; i < 4; i++) {
    int b = tid + i * 512;
    int row = b >> 3;
    int ch = (b & 7) ^ (row & 7);
    glds16(A + (size_t)row * lda + k0 + ch * 8, st + b * 16);
  }
#pragma unroll
  for (int i = 0; i < 2; i++) {
    int b = tid + i * 512;
    int row = b >> 3;
    int ch = (b & 7) ^ (row & 7);
    glds16(B + (size_t)row * ldb + k0 + ch * 8, st + 32768 + b * 16);
  }
}
__device__ __forceinline__ void gemm_mainloop(const bf16_t* __restrict__ A, int lda, const bf16_t* __restrict__ B,
                                              int ldb, int K, char* smem, f32x4 (&acc)[4][4]) {
  const int tid = launder_tid(), lane = tid & 63, w = tid >> 6, wr = w >> 1, wc = w & 1;
  const int fr = lane & 15, fq = lane >> 4;
  const int nt = K >> 6;
  __syncthreads();
  gemm_stage(A, lda, B, ldb, 0, smem);
  for (int t = 0; t < nt; t++) {
    asm volatile("s_waitcnt vmcnt(0)" ::: "memory");
    __syncthreads();
    if (t + 1 < nt) gemm_stage(A, lda, B, ldb, (t + 1) << 6, smem + ((t + 1) & 1) * 49152);
    const char* sa = smem + (t & 1) * 49152;
    const char* sb = sa + 32768;
#pragma unroll
    for (int ks = 0; ks < 2; ks++) {
      bf16x8 af[4], bfr[4];
      const int ch = ((ks * 4 + fq) ^ (fr & 7)) * 16;
#pragma unroll
      for (int m = 0; m < 4; m++) af[m] = lds8(sa + (wr * 64 + m * 16 + fr) * 128 + ch);
#pragma unroll
      for (int n = 0; n < 4; n++) bfr[n] = lds8(sb + (wc * 64 + n * 16 + fr) * 128 + ch);
#pragma unroll
      for (int m = 0; m < 4; m++)
#pragma unroll
        for (int n = 0; n < 4; n++) acc[m][n] = MFMA(af[m], bfr[n], acc[m][n]);
    }
  }
}
__device__ __forceinline__ void tile_map(int tile, int MT, int NT, int& mt, int& nt) {
  int per = 8 * NT;
  int g = tile / per, r = tile - g * per;
  int gsz = min(8, MT - g * 8);
  mt = g * 8 + r % gsz;
  nt = r / gsz;
}
__device__ __forceinline__ void zero_acc(f32x4 (&acc)[4][4]) {
#pragma unroll
  for (int m = 0; m < 4; m++)
#pragma unroll
    for (int n = 0; n < 4; n++) acc[m][n] = (f32x4){0.f, 0.f, 0.f, 0.f};
}

__device__ void transpose_tile(const float* __restrict__ src, int lds_, bf16_t* __restrict__ dst, int ldd, int k0,
                               int nbase, int mode, char* smem) {
  float* tl = (float*)smem;
  const int tid = launder_tid();
  __syncthreads();
#pragma unroll
  for (int i = 0; i < 2; i++) {
    int idx = tid + i * 512;
    int k = idx >> 4, n4 = (idx & 15) * 4;
    float4 v = *(const float4*)(src + (size_t)k * lds_ + n4);
    tl[k * 65 + n4 + 0] = v.x;
    tl[k * 65 + n4 + 1] = v.y;
    tl[k * 65 + n4 + 2] = v.z;
    tl[k * 65 + n4 + 3] = v.w;
  }
  __syncthreads();
  int n = tid >> 3, kc = (tid & 7) * 8;
  float v[8];
#pragma unroll
  for (int e = 0; e < 8; e++) v[e] = tl[(kc + e) * 65 + n];
  int nrow = (mode == 0) ? (nbase + n) : (nbase + (n >> 5) * 64 + (n & 31));
  uint4 o;
  o.x = pack2(v[0], v[1]);
  o.y = pack2(v[2], v[3]);
  o.z = pack2(v[4], v[5]);
  o.w = pack2(v[6], v[7]);
  *(uint4*)(dst + (size_t)nrow * ldd + k0 + kc) = o;
}

constexpr int A_MOD = 96;
constexpr int A_WT = 4032;
constexpr int A_VC = 2048;
constexpr int A_KC = 256;
constexpr int A_PAD = 128;
constexpr int A_MISC = 1;
constexpr int A_TOTAL = A_MOD + A_WT + A_VC + A_KC + A_PAD + A_MISC;

__device__ void phase_a(const Params& p, char* smem) {
  const int tid = launder_tid();
  for (int task = blockIdx.x; task < A_TOTAL; task += gridDim.x) {
    int id = task;
    if (id < A_MOD) {
      int cgp = id % 12, ks = id / 12;
      float* sc = (float*)smem;
      __syncthreads();
      for (int i = tid; i < 24 * 128; i += 512) {
        int s = i >> 7, kk = i & 127, k = ks * 128 + kk;
        float cv = s < 8 ? p.c_prompt[s * 1024 + k] : p.c_sample[(s - 8) * 1024 + k];
        sc[i] = silu(cv);
      }
      __syncthreads();
      int col = cgp * 512 + tid;
      float acc[24];
#pragma unroll
      for (int s = 0; s < 24; s++) acc[s] = 0.f;
      const float* wp = p.w_ada + (size_t)(ks * 128) * 6144 + col;
#pragma unroll 8
      for (int kk = 0; kk < 128; kk++) {
        float wv = wp[(size_t)kk * 6144];
#pragma unroll
        for (int s = 0; s < 24; s++) acc[s] += sc[s * 128 + kk] * wv;
      }
#pragma unroll
      for (int s = 0; s < 24; s++) p.modp[(size_t)(ks * 24 + s) * 6144 + col] = acc[s];
      continue;
    }
    id -= A_MOD;
    if (id < A_WT) {
      if (id < 1408) {
        int kt = id / 88, nt = id % 88;
        int scol = nt < 56 ? nt * 64 : 3592 + (nt - 56) * 64;
        int drow = nt < 56 ? nt * 64 : 3584 + (nt - 56) * 64;
        transpose_tile(p.w_in + (size_t)kt * 64 * kINW + scol, kINW, p.Wt_in, 1024, kt * 64, drow, 0, smem);
      } else if (id < 1536) {
        int i2 = id - 1408, kt = i2 / 16, nt = i2 % 16;
        transpose_tile(p.w_a + (size_t)kt * 64 * 1024 + nt * 64, 1024, p.Wt_a, 512, kt * 64, nt * 64, 0, smem);
      } else if (id < 1664) {
        int i2 = id - 1536, kt = i2 / 16, nt = i2 % 16;
        transpose_tile(p.w_b + (size_t)kt * 64 * 1024 + nt * 64, 1024, p.Wt_b, 512, kt * 64, nt * 64, 0, smem);
      } else if (id < 1920) {
        int i2 = id - 1664, kt = i2 / 16, nt = i2 % 16;
        transpose_tile(p.w_out + (size_t)kt * 64 * 1024 + nt * 64, 1024, p.Wt_out, 1024, kt * 64, nt * 64, 0, smem);
      } else if (id < 2624) {
        int i2 = id - 1920, kt = i2 / 44, nt = i2 % 44;
        transpose_tile(p.w_gate + (size_t)kt * 64 * 2816 + nt * 64, 2816, p.Wt_gu, 1024, kt * 64, nt * 128, 1, smem);
      } else if (id < 3328) {
        int i2 = id - 2624, kt = i2 / 44, nt = i2 % 44;
        transpose_tile(p.w_up + (size_t)kt * 64 * 2816 + nt * 64, 2816, p.Wt_gu, 1024, kt * 64, nt * 128 + 32, 1, smem);
      } else {
        int i2 = id - 3328, kt = i2 / 16, nt = i2 % 16;
        transpose_tile(p.w_down + (size_t)kt * 64 * 1024 + nt * 64, 1024, p.Wt_down, 2816, kt * 64, nt * 64, 0, smem);
      }
      continue;
    }
    id -= A_WT;
    if (id < A_VC) {
      int bh = id >> 4, jt = id & 15;
      int b = bh >> 3, h = bh & 7;
      transpose_tile(p.cache_v + ((size_t)(b * 1024 + jt * 64) * 8 + h) * 64, 512, p.VTs + (size_t)bh * 64 * 1152, 1152,
                     jt * 64, 0, 0, smem);
      continue;
    }
    id -= A_VC;
    if (id < A_KC) {
      int b = id >> 4, jb = id & 15;
#pragma unroll
      for (int it = 0; it < 8; it++) {
        int g = tid + it * 512;
        int j = g >> 6, col = (g & 63) * 8;
        int h = col >> 6, d = col & 63;
        const float* src = p.cache_k + ((size_t)(b * 1024 + jb * 64 + j)) * 512 + col;
        float4 v0 = *(const float4*)src, v1 = *(const float4*)(src + 4);
        uint4 o;
        o.x = pack2(v0.x, v0.y);
        o.y = pack2(v0.z, v0.w);
        o.z = pack2(v1.x, v1.y);
        o.w = pack2(v1.z, v1.w);
        *(uint4*)(p.Ks + ((size_t)((b * 8 + h) * 1152 + jb * 64 + j)) * 64 + d) = o;
      }
      continue;
    }
    id -= A_KC;
    if (id < A_PAD) {
      int bh = id;
      uint4 z = {0u, 0u, 0u, 0u};
      *(uint4*)(p.Ks + ((size_t)bh * 1152 + 1088) * 64 + tid * 8) = z;
      int d = tid >> 3, chn = tid & 7;
      *(uint4*)(p.VTs + ((size_t)bh * 64 + d) * 1152 + 1088 + chn * 8) = z;
      continue;
    }
    for (int i = tid; i < 8192; i += 512) {
      int g = i >> 10, k = i & 1023;
      p.wg[i] = p.w_in[(size_t)k * kINW + 3584 + g];
    }
    if (tid < 8) p.counter[tid] = 0u;
  }
}

__device__ void norm_task(const Params& p, int task, int which, char* smem) {
  float* sm_scale = (float*)smem;
  float* sm_shift = sm_scale + 1024;
  const int tid = launder_tid(), lane = tid & 63, w = tid >> 6;
  const int row0 = task * 32;
  const int seq = seq_of(row0);
  const float* g = which ? p.norm2_g : p.norm1_g;
  const int sh_off = which ? 3072 : 0, sc_off = which ? 4096 : 1024;
  __syncthreads();
  for (int c = tid; c < 1024; c += 512) {
    float sh, sc;
    if (which == 0) {
      sh = p.b_ada[sh_off + c];
      sc = p.b_ada[sc_off + c];
#pragma unroll
      for (int ks = 0; ks < 8; ks++) {
        sh += p.modp[(size_t)(ks * 24 + seq) * 6144 + sh_off + c];
        sc += p.modp[(size_t)(ks * 24 + seq) * 6144 + sc_off + c];
      }
    } else {
      sh = p.modf[seq * 6144 + sh_off + c];
      sc = p.modf[seq * 6144 + sc_off + c];
    }
    sm_scale[c] = g[c] * (1.0f + sc);
    sm_shift[c] = sh;
  }
  __syncthreads();
  for (int i = 0; i < 4; i++) {
    int row = row0 + w * 4 + i;
    const float* xr = which ? (p.X1 + (size_t)row * 1024) : xrow(p, row);
    float4 v[4];
    float ss = 0.f;
#pragma unroll
    for (int j = 0; j < 4; j++) {
      v[j] = *(const float4*)(xr + j * 256 + lane * 4);
      ss += v[j].x * v[j].x + v[j].y * v[j].y + v[j].z * v[j].z + v[j].w * v[j].w;
    }
    ss = wave_sum(ss);
    float rstd = rsqrtf(ss * (1.0f / 1024.0f) + 1e-6f);
#pragma unroll
    for (int j = 0; j < 4; j++) {
      int c = j * 256 + lane * 4;
      float4 sc = *(const float4*)(sm_scale + c), sh = *(const float4*)(sm_shift + c);
      v[j].x = v[j].x * rstd * sc.x + sh.x;
      v[j].y = v[j].y * rstd * sc.y + sh.y;
      v[j].z = v[j].z * rstd * sc.z + sh.z;
      v[j].w = v[j].w * rstd * sc.w + sh.w;
      uint2 o;
      o.x = pack2(v[j].x, v[j].y);
      o.y = pack2(v[j].z, v[j].w);
      *(uint2*)(p.U + (size_t)row * 1024 + c) = o;
    }
    if (which == 0) {
      float gv[8];
#pragma unroll
      for (int gi = 0; gi < 8; gi++) {
        float a = 0.f;
#pragma unroll
        for (int j = 0; j < 4; j++) {
          float4 wv = *(const float4*)(p.wg + gi * 1024 + j * 256 + lane * 4);
          a += v[j].x * wv.x + v[j].y * wv.y + v[j].z * wv.z + v[j].w * wv.w;
        }
        gv[gi] = wave_sum(a);
      }
      if (lane == 0) {
#pragma unroll
        for (int h = 0; h < 4; h++) {
          p.GI[row * 4 + h] = gv[h] + p.b_if[h];
          p.LF[row * 4 + h] = logsig(gv[4 + h] + p.b_if[4 + h]);
        }
      }
    }
  }
}
__device__ void phase_b(const Params& p, char* smem) {
  const int NTASK = kT / 32;
  for (int task = blockIdx.x; task < NTASK + 288; task += gridDim.x) {
    if (task < NTASK) {
      norm_task(p, task, 0, smem);
    } else {
      int i = (task - NTASK) * 512 + threadIdx.x;
      int s = i / 6144, c = i - s * 6144;
      float a = p.b_ada[c];
#pragma unroll
      for (int ks = 0; ks < 8; ks++) a += p.modp[(size_t)(ks * 24 + s) * 6144 + c];
      p.modf[i] = a;
    }
  }
}
__device__ void phase_g(const Params& p, char* smem) {
  for (int task = blockIdx.x; task < kT / 32; task += gridDim.x) norm_task(p, task, 1, smem);
}

__device__ void gate_task(const Params& p, int seq, int h, char* smem);
__device__ void phase_c(const Params& p, char* smem) {
  const int MT = 68, NT = 44;
  const int tid = launder_tid(), lane = tid & 63, w = tid >> 6, wr = w >> 1, wc = w & 1, fr = lane & 15, fq = lane >> 4;
  for (int item = blockIdx.x; item < 96 + MT * NT; item += gridDim.x) {
    if (item < 96) {
      if (item < 32) gate_task(p, item >> 2, item & 3, smem);
      else gate_task(p, 8 + ((item - 32) >> 2), item & 3, smem);
      continue;
    }
    const int tile = item - 96;
    int mt, nt;
    tile_map(tile, MT, NT, mt, nt);
    f32x4 acc[4][4];
    zero_acc(acc);
    gemm_mainloop(p.U + (size_t)mt * 256 * 1024, 1024, p.Wt_in + (size_t)nt * 128 * 1024, 1024, 1024, smem, acc);
    const int rbase = mt * 256 + wr * 64;
    const int seq = seq_of(rbase);
    const bool isp = seq < 8;
    const int sb = seq - 8;
    const int srow0 = isp ? seq * 2048 : kNP + sb * 64;
    const int L = isp ? 2048 : 64;
    const int cbase = nt * 128 + wc * 64;
    const int tb = rbase - srow0;
#pragma unroll
    for (int m = 0; m < 4; m++) {
#pragma unroll
      for (int n = 0; n < 4; n++) {
        const int col = cbase + n * 16 + fr;
        const int t4 = tb + m * 16 + fq * 4;
        const int row4 = rbase + m * 16 + fq * 4;
        f32x4 v = acc[m][n];
        if (cbase < 512) {
#pragma unroll
          for (int r = 0; r < 4; r++) p.Qb[(size_t)(row4 + r) * 512 + col] = f2bf(v[r]);
        } else if (cbase < 1024) {
          const int c = col - 512, h = c >> 6, d = c & 63;
          float* o = isp ? p.out + O_KP + (size_t)row4 * 512 + c : p.out + O_KS + (size_t)(row4 - kNP) * 512 + c;
          bf16_t* kb = isp ? p.Kp + ((size_t)(seq * 8 + h) * 2048 + t4) * 64 + d
                           : p.Ks + ((size_t)(sb * 8 + h) * 1152 + 1024 + t4) * 64 + d;
#pragma unroll
          for (int r = 0; r < 4; r++) {
            o[r * 512] = v[r];
            kb[r * 64] = f2bf(v[r]);
          }
        } else if (cbase < 1536) {
          const int c = col - 1024, h = c >> 6, d = c & 63;
          float* o = isp ? p.out + O_VP + (size_t)row4 * 512 + c : p.out + O_VS + (size_t)(row4 - kNP) * 512 + c;
#pragma unroll
          for (int r = 0; r < 4; r++) o[r * 512] = v[r];
          bf16_t* vt = isp ? p.VTp + ((size_t)(seq * 8 + h) * 64 + d) * 2048 + t4
                           : p.VTs + ((size_t)(sb * 8 + h) * 64 + d) * 1152 + 1024 + t4;
          uint2 pk;
          pk.x = pack2(v[0], v[1]);
          pk.y = pack2(v[2], v[3]);
          *(uint2*)vt = pk;
        } else if (cbase < 2560) {
          const int c = col - 1536;
#pragma unroll
          for (int r = 0; r < 4; r++) {
            p.MQK[(size_t)(row4 + r) * 1024 + c] = f2bf(v[r]);
            int t = t4 + r;
            if (t >= L - 3) {
              float* o = isp ? p.out + O_CVP + (size_t)(seq * 3 + (t - (L - 3))) * 1024 + c
                             : p.out + O_CVS + (size_t)(sb * 3 + (t - (L - 3))) * 1024 + c;
              *o = v[r];
            }
          }
        } else if (cbase < 3072) {
          const int c = col - 2560, h = c >> 7, d = c & 127;
          bf16_t* vt = isp ? p.MVTp + ((size_t)(seq * 4 + h) * 128 + d) * 2048 + t4
                           : p.MVTs + ((size_t)(sb * 4 + h) * 128 + d) * 64 + t4;
          uint2 pk;
          pk.x = pack2(v[0], v[1]);
          pk.y = pack2(v[2], v[3]);
          *(uint2*)vt = pk;
        } else if (cbase < 3584) {
          const int c = col - 3072;
#pragma unroll
          for (int r = 0; r < 4; r++) p.SO[(size_t)(row4 + r) * 512 + c] = f2bf(sigm(v[r]));
        } else if (cbase < 4608) {
          const int c = col - 3584;
#pragma unroll
          for (int r = 0; r < 4; r++) p.GA[(size_t)(row4 + r) * 1024 + c] = f2bf(sigm(v[r]));
        } else {
          const int c = col - 4608;
#pragma unroll
          for (int r = 0; r < 4; r++) p.GB[(size_t)(row4 + r) * 1024 + c] = f2bf(sigm(v[r]));
        }
      }
    }
  }
}

__device__ __forceinline__ void lds_barrier() { asm volatile("s_waitcnt lgkmcnt(0)\n\ts_barrier" ::: "memory"); }
__device__ void attn_task(const Params& p, int seq, int h, int qt, char* smem) {
  const int tid = launder_tid(), lane = tid & 63, w = tid >> 6, fr = lane & 15, fq = lane >> 4;
  const bool isp = seq < 8;
  const int sb = seq - 8;
  const int past = isp ? 0 : 1024;
  const int Tlen = isp ? 2048 : 1152;
  const int row0 = (isp ? seq * 2048 : kNP + sb * 64) + qt * 64;
  const int p0 = past + qt * 64;
  const bf16_t* Kb = isp ? p.Kp + (size_t)(seq * 8 + h) * 2048 * 64 : p.Ks + (size_t)(sb * 8 + h) * 1152 * 64;
  const bf16_t* VT = isp ? p.VTp + (size_t)(seq * 8 + h) * 64 * 2048 : p.VTs + (size_t)(sb * 8 + h) * 64 * 1152;
  bf16_t* sQ = (bf16_t*)smem;
  bf16_t* sK = sQ + 64 * 72;
  bf16_t* sVT = sK + 128 * 72;
  bf16_t* sP = sVT + 64 * 136;
  float* sZ = (float*)(sP + 64 * 136);
  int* sFlag = (int*)(sZ + 64 * 132);

  __syncthreads();
  {
    int r = tid >> 3, chn = tid & 7;
    uint4 q = *(const uint4*)(p.Qb + (size_t)(row0 + r) * 512 + h * 64 + chn * 8);
    *(uint4*)(sQ + r * 72 + chn * 8) = q;
  }
  const int kt_d = (p0 + 62) >> 7;
  const int ki0 = tid, ki1 = tid + 512;
  const bf16_t* kptr0 = Kb + (size_t)(ki0 >> 3) * 64 + (ki0 & 7) * 8;
  const bf16_t* kptr1 = Kb + (size_t)(ki1 >> 3) * 64 + (ki1 & 7) * 8;
  const bf16_t* vptr0 = VT + (size_t)(ki0 >> 4) * Tlen + (ki0 & 15) * 8;
  const bf16_t* vptr1 = VT + (size_t)(ki1 >> 4) * Tlen + (ki1 & 15) * 8;
  uint4 kr0 = *(const uint4*)(kptr0 + (size_t)kt_d * 8192);
  uint4 kr1 = *(const uint4*)(kptr1 + (size_t)kt_d * 8192);
  uint4 vr0 = *(const uint4*)(vptr0 + kt_d * 128);
  uint4 vr1 = *(const uint4*)(vptr1 + kt_d * 128);
  float R = 0.f;
  f32x4 oacc[2];
  oacc[0] = (f32x4){0.f, 0.f, 0.f, 0.f};
  oacc[1] = (f32x4){0.f, 0.f, 0.f, 0.f};
  const int mf = w & 3;
  for (int kt = kt_d; kt >= 0; kt--) {
    lds_barrier();
    *(uint4*)(sK + (ki0 >> 3) * 72 + (ki0 & 7) * 8) = kr0;
    *(uint4*)(sK + (ki1 >> 3) * 72 + (ki1 & 7) * 8) = kr1;
    *(uint4*)(sVT + (ki0 >> 4) * 136 + (ki0 & 15) * 8) = vr0;
    *(uint4*)(sVT + (ki1 >> 4) * 136 + (ki1 & 15) * 8) = vr1;
    if (tid == 0) *sFlag = 0;
    lds_barrier();
    if (kt > 0) {
      kr0 = *(const uint4*)(kptr0 + (size_t)(kt - 1) * 8192);
      kr1 = *(const uint4*)(kptr1 + (size_t)(kt - 1) * 8192);
      vr0 = *(const uint4*)(vptr0 + (kt - 1) * 128);
      vr1 = *(const uint4*)(vptr1 + (kt - 1) * 128);
    }
    {
      const int nf0 = (w >> 2) * 4;
      bf16x8 a0 = lds8(sQ + (mf * 16 + fr) * 72 + fq * 8);
      bf16x8 a1 = lds8(sQ + (mf * 16 + fr) * 72 + 32 + fq * 8);
#pragma unroll
      for (int n = 0; n < 4; n++) {
        bf16x8 b0 = lds8(sK + ((nf0 + n) * 16 + fr) * 72 + fq * 8);
        bf16x8 b1 = lds8(sK + ((nf0 + n) * 16 + fr) * 72 + 32 + fq * 8);
        f32x4 s = (f32x4){0.f, 0.f, 0.f, 0.f};
        s = MFMA(a0, b0, s);
        s = MFMA(a1, b1, s);
#pragma unroll
        for (int r = 0; r < 4; r++) sZ[(mf * 16 + fq * 4 + r) * 132 + (nf0 + n) * 16 + fr] = s[r] * 0.125f;
      }
    }
    lds_barrier();
    {
      const int row = tid >> 3, part = tid & 7;
      const int pos = p0 + row;
      const int j0 = kt * 128 + part * 16;
      float z[16], ls[16];
#pragma unroll
      for (int i4 = 0; i4 < 4; i4++) {
        float4 t4 = *(const float4*)(sZ + row * 132 + part * 16 + i4 * 4);
        z[i4 * 4 + 0] = t4.x;
        z[i4 * 4 + 1] = t4.y;
        z[i4 * 4 + 2] = t4.z;
        z[i4 * 4 + 3] = t4.w;
      }
      float run = 0.f;
      float tl[16];
#pragma unroll
      for (int i = 15; i >= 0; i--) {
        bool valid = (j0 + i) < pos;
        float l = valid ? -(fmaxf(z[i], 0.f) + __logf(1.0f + __expf(-fabsf(z[i])))) : 0.f;
        ls[i] = l;
        tl[i] = run;
        run += l;
      }
      float incl = run;
#pragma unroll
      for (int dlt = 1; dlt < 8; dlt <<= 1) {
        float t = __shfl_down(incl, dlt, 8);
        if (part + dlt < 8) incl += t;
      }
      float excl = incl - run;
      float tot = __shfl(incl, 0, 8);
      float base = R + excl;
      unsigned pk[8];
#pragma unroll
      for (int i = 0; i < 16; i += 2) {
        bool v0 = (j0 + i) < pos, v1 = (j0 + i + 1) < pos;
        float a0 = v0 ? __expf(z[i] + ls[i] + tl[i] + base) : 0.f;
        float a1 = v1 ? __expf(z[i + 1] + ls[i + 1] + tl[i + 1] + base) : 0.f;
        pk[i >> 1] = pack2(a0, a1);
      }
      *(uint4*)(sP + row * 136 + part * 16) = (uint4){pk[0], pk[1], pk[2], pk[3]};
      *(uint4*)(sP + row * 136 + part * 16 + 8) = (uint4){pk[4], pk[5], pk[6], pk[7]};
      R += tot;
      if (R > -110.f) *sFlag = 1;
    }
    lds_barrier();
    const int more = *sFlag;
    {
      const int nf0 = (w >> 2) * 2;
#pragma unroll
      for (int ks = 0; ks < 4; ks++) {
        bf16x8 a = lds8(sP + (mf * 16 + fr) * 136 + ks * 32 + fq * 8);
#pragma unroll
        for (int n = 0; n < 2; n++) {
          bf16x8 b = lds8(sVT + ((nf0 + n) * 16 + fr) * 136 + ks * 32 + fq * 8);
          oacc[n] = MFMA(a, b, oacc[n]);
        }
      }
    }
    if (!more) break;
  }
  {
    const int nf0 = (w >> 2) * 2;
#pragma unroll
    for (int n = 0; n < 2; n++)
#pragma unroll
      for (int r = 0; r < 4; r++)
        p.YA[(size_t)(row0 + mf * 16 + fq * 4 + r) * 512 + h * 64 + (nf0 + n) * 16 + fr] = f2bf(oacc[n][r]);
  }
}


__device__ void gate_task(const Params& p, int seq, int h, char* smem) {
  const int tid = launder_tid(), lane = tid & 63, w = tid >> 6;
  const bool isp = seq < 8;
  const int sb = seq - 8;
  const int nchunks = isp ? 32 : 1;
  const int grow0 = isp ? seq * 2048 : kNP + sb * 64;
  float* gv = p.GV + (size_t)(isp ? (seq * 4 + h) * 32 : 1024 + sb * 4 + h) * 384;
  float* sBl = (float*)smem;
  float* sG = sBl + 32;
  float* sM = sG + 32;
  __syncthreads();
  float b_[4], as_[4], pm_[4], g_[4];
#pragma unroll
  for (int i = 0; i < 4; i++) {
    const int c = w + i * 8;
    b_[i] = 0.f; as_[i] = 0.f; pm_[i] = 0.f; g_[i] = 0.f;
    if (c < nchunks) {
      const int row = grow0 + c * 64 + lane;
      float li = p.GI[row * 4 + h], lf = p.LF[row * 4 + h];
      float b = lf;
#pragma unroll
      for (int d = 1; d < 64; d <<= 1) {
        float t_ = __shfl_up(b, d);
        if (lane >= d) b += t_;
      }
      float a_s = li - b;
      float pm = a_s;
#pragma unroll
      for (int d = 1; d < 64; d <<= 1) {
        float t_ = __shfl_up(pm, d);
        if (lane >= d) pm = fmaxf(pm, t_);
      }
      float blast = __shfl(b, 63);
      float g = blast - b + li;
      float G = wave_max(g);
      b_[i] = b; as_[i] = a_s; pm_[i] = pm; g_[i] = g;
      if (lane == 0) {
        sBl[c] = blast;
        sG[c] = G;
      }
    }
  }
  __syncthreads();
  if (tid == 0) {
    float m = isp ? 0.f : p.st_m[sb * 4 + h];
    for (int c = 0; c < nchunks; c++) {
      sM[c] = m;
      m = fmaxf(sBl[c] + m, sG[c]);
    }
    sM[nchunks] = m;
    if (isp) p.out[O_MP + seq * 4 + h] = m;
    else p.out[O_MS + sb * 4 + h] = m;
  }
  __syncthreads();
#pragma unroll
  for (int i = 0; i < 4; i++) {
    const int c = w + i * 8;
    if (c < nchunks) {
      const float m_run = sM[c], m_new = sM[c + 1];
      const float mt = b_[i] + fmaxf(m_run, pm_[i]);
      float* o = gv + (size_t)c * 384;
      o[lane] = b_[i] - mt;
      o[64 + lane] = as_[i];
      o[128 + lane] = __expf(b_[i] + m_run - mt);
      o[192 + lane] = __expf(g_[i] - m_new);
      o[256 + lane] = __expf(-mt);
      if (lane == 0) o[320] = __expf(sBl[c] + m_run - m_new);
    }
  }
}

__device__ void mlpre_task(const Params& p, int seq, int h, int c, char* smem) {
  const bool isp = seq < 8;
  const int sb = seq - 8;
  const int grow0 = isp ? seq * 2048 : kNP + sb * 64;
  const int t0 = c * 64;
  const int cid = isp ? (seq * 4 + h) * 32 + c : 1024 + sb * 4 + h;
  bf16_t* sQ = (bf16_t*)smem;
  bf16_t* sK = sQ + 64 * 136;
  bf16_t* sKT = sK + 64 * 136;
  bf16_t* sSw = sKT + 128 * 72;
  float* sF = (float*)(sSw + 64 * 72);
  float* sV = sF;
  float* sDen = sF + 384;
  float* sCw = sF + 448;
  const float* sBt = sV;
  const float* sAs = sV + 64;
  const float* sWg = sV + 192;
  __syncthreads();
  uint4 xr0, xr1, xr2, xr3, xr4, xr5, xr6;
  {
    const int tid = launder_tid();
    for (int i = tid; i < 1280; i += 512) {
      int j = i >> 8, cc = i & 255;
      int gch = (cc >= 128 ? 512 : 0) + h * 128 + (cc & 127);
      sCw[i] = (j < 4) ? p.w_conv[j * 1024 + gch] : p.b_conv[gch];
    }
    if (tid < 384) sV[tid] = p.GV[(size_t)cid * 384 + tid];
    if (tid < 64) sDen[tid] = 0.f;
    const int rb_ = tid >> 5, cgp_ = tid & 31;
    const int ch_ = (cgp_ >= 16 ? 512 : 0) + h * 128 + (cgp_ & 15) * 8;
    const int tb0 = t0 + rb_ * 4 - 3;
    const bf16_t* xp = p.MQK + (size_t)(grow0 + tb0) * 1024 + ch_;
#define LDX(i, dst)                                                                                           \
  if (tb0 + i >= 0) dst = *(const uint4*)(xp + (size_t)i * 1024);                                             \
  else if (isp) dst = (uint4){0u, 0u, 0u, 0u};                                                                \
  else {                                                                                                      \
    const float* s0 = p.st_conv + (size_t)(sb * 3 + (tb0 + i + 3)) * 1024 + ch_;                              \
    dst = (uint4){pack2(s0[0], s0[1]), pack2(s0[2], s0[3]), pack2(s0[4], s0[5]), pack2(s0[6], s0[7])};        \
  }
    LDX(0, xr0) LDX(1, xr1) LDX(2, xr2)
#undef LDX
    xr3 = *(const uint4*)(xp + (size_t)3 * 1024);
    xr4 = *(const uint4*)(xp + (size_t)4 * 1024);
    xr5 = *(const uint4*)(xp + (size_t)5 * 1024);
    xr6 = *(const uint4*)(xp + (size_t)6 * 1024);
  }
  __syncthreads();
  {
    const int tid = launder_tid();
    const int rb = tid >> 5, cgp = tid & 31;
    const bool isk = cgp >= 16;
    float o0[8], o1[8], o2[8], o3[8];
    {
      const float* cwp = sCw + cgp * 8;
      float4 b0 = *(const float4*)(cwp + 1024), b1 = *(const float4*)(cwp + 1028);
      o0[0] = b0.x; o0[1] = b0.y; o0[2] = b0.z; o0[3] = b0.w; o0[4] = b1.x; o0[5] = b1.y; o0[6] = b1.z; o0[7] = b1.w;
#pragma unroll
      for (int e = 0; e < 8; e++) { o1[e] = o0[e]; o2[e] = o0[e]; o3[e] = o0[e]; }
#define FMAW(j, o, x) { float4 a0 = *(const float4*)(cwp + j * 256), a1 = *(const float4*)(cwp + j * 256 + 4); \
  o[0] += a0.x * x[0]; o[1] += a0.y * x[1]; o[2] += a0.z * x[2]; o[3] += a0.w * x[3];                              \
  o[4] += a1.x * x[4]; o[5] += a1.y * x[5]; o[6] += a1.z * x[6]; o[7] += a1.w * x[7]; }
#define UNP(xv, x) float x[8]; x[0] = __uint_as_float(xv.x << 16); x[1] = __uint_as_float(xv.x & 0xffff0000u); \
  x[2] = __uint_as_float(xv.y << 16); x[3] = __uint_as_float(xv.y & 0xffff0000u);                             \
  x[4] = __uint_as_float(xv.z << 16); x[5] = __uint_as_float(xv.z & 0xffff0000u);                             \
  x[6] = __uint_as_float(xv.w << 16); x[7] = __uint_as_float(xv.w & 0xffff0000u);
      { UNP(xr0, x) FMAW(0, o0, x) }
      { UNP(xr1, x) FMAW(1, o0, x) FMAW(0, o1, x) }
      { UNP(xr2, x) FMAW(2, o0, x) FMAW(1, o1, x) FMAW(0, o2, x) }
      { UNP(xr3, x) FMAW(3, o0, x) FMAW(2, o1, x) FMAW(1, o2, x) FMAW(0, o3, x) }
      { UNP(xr4, x) FMAW(3, o1, x) FMAW(2, o2, x) FMAW(1, o3, x) }
      { UNP(xr5, x) FMAW(3, o2, x) FMAW(2, o3, x) }
      { UNP(xr6, x) FMAW(3, o3, x) }
#undef FMAW
#undef UNP
    }
    const float ksc = isk ? 0.08838834764831845f : 1.0f;
#pragma unroll
    for (int e = 0; e < 8; e++) {
      o0[e] = silu(o0[e]) * ksc; o1[e] = silu(o1[e]) * ksc; o2[e] = silu(o2[e]) * ksc; o3[e] = silu(o3[e]) * ksc;
    }
    bf16_t* dstp = (isk ? sK + (cgp - 16) * 8 : sQ + cgp * 8) + (rb * 4) * 136;
    *(uint4*)(dstp) = (uint4){pack2(o0[0], o0[1]), pack2(o0[2], o0[3]), pack2(o0[4], o0[5]), pack2(o0[6], o0[7])};
    *(uint4*)(dstp + 136) = (uint4){pack2(o1[0], o1[1]), pack2(o1[2], o1[3]), pack2(o1[4], o1[5]), pack2(o1[6], o1[7])};
    *(uint4*)(dstp + 272) = (uint4){pack2(o2[0], o2[1]), pack2(o2[2], o2[3]), pack2(o2[4], o2[5]), pack2(o2[6], o2[7])};
    *(uint4*)(dstp + 408) = (uint4){pack2(o3[0], o3[1]), pack2(o3[2], o3[3]), pack2(o3[4], o3[5]), pack2(o3[6], o3[7])};
    if (isk) {
      float g0 = sWg[rb * 4], g1 = sWg[rb * 4 + 1], g2 = sWg[rb * 4 + 2], g3 = sWg[rb * 4 + 3];
#pragma unroll
      for (int e = 0; e < 8; e++) {
        uint2 pk;
        pk.x = pack2(o0[e] * g0, o1[e] * g1);
        pk.y = pack2(o2[e] * g2, o3[e] * g3);
        *(uint2*)(sKT + ((cgp - 16) * 8 + e) * 72 + rb * 4) = pk;
      }
    }
  }
  __syncthreads();
  {
    const int tid = launder_tid(), lane = tid & 63, w = tid >> 6, fr = lane & 15, fq = lane >> 4;
    const int mf = w >> 1, nf0 = (w & 1) * 2;
    f32x4 sa[2];
    sa[0] = (f32x4){0.f, 0.f, 0.f, 0.f};
    sa[1] = (f32x4){0.f, 0.f, 0.f, 0.f};
#pragma unroll
    for (int ks = 0; ks < 4; ks++) {
      bf16x8 a = lds8(sQ + (mf * 16 + fr) * 136 + ks * 32 + fq * 8);
#pragma unroll
      for (int n = 0; n < 2; n++) {
        bf16x8 b = lds8(sK + ((nf0 + n) * 16 + fr) * 136 + ks * 32 + fq * 8);
        sa[n] = MFMA(a, b, sa[n]);
      }
    }
#pragma unroll
    for (int r = 0; r < 4; r++) {
      const int t = mf * 16 + fq * 4 + r;
      const float bt = sBt[t];
      float rs = 0.f;
#pragma unroll
      for (int n = 0; n < 2; n++) {
        const int s = (nf0 + n) * 16 + fr;
        float wgt = (s <= t) ? __expf(bt + sAs[s]) : 0.f;
        float v = sa[n][r] * wgt;
        rs += v;
        sSw[t * 72 + s] = f2bf(v);
      }
      rs += __shfl_xor(rs, 1);
      rs += __shfl_xor(rs, 2);
      rs += __shfl_xor(rs, 4);
      rs += __shfl_xor(rs, 8);
      if (fr == 0) atomicAdd(&sDen[t], rs);
    }
  }
  __syncthreads();
  {
    const int tid = launder_tid();
    bf16_t* qo = p.Qc + (size_t)cid * 8192;
    bf16_t* ko = p.KTc + (size_t)cid * 8192;
    bf16_t* so = p.SWc + (size_t)cid * 4096;
    *(uint4*)(qo + tid * 8) = *(const uint4*)(sQ + (tid >> 4) * 136 + (tid & 15) * 8);
    *(uint4*)(qo + 4096 + tid * 8) = *(const uint4*)(sQ + (32 + (tid >> 4)) * 136 + (tid & 15) * 8);
    *(uint4*)(ko + tid * 8) = *(const uint4*)(sKT + (tid >> 3) * 72 + (tid & 7) * 8);
    *(uint4*)(ko + 4096 + tid * 8) = *(const uint4*)(sKT + (64 + (tid >> 3)) * 72 + (tid & 7) * 8);
    *(uint4*)(so + tid * 8) = *(const uint4*)(sSw + (tid >> 3) * 72 + (tid & 7) * 8);
    if (tid < 64) p.DENc[(size_t)cid * 64 + tid] = sDen[tid];
  }
}

__device__ void mlstm_task(const Params& p, int seq, int h, char* smem) {
  const bool isp = seq < 8;
  const int sb = seq - 8;
  const int L = isp ? 2048 : 64;
  const int nchunks = L >> 6;
  const int grow0 = isp ? seq * 2048 : kNP + sb * 64;
  const int cid0 = isp ? (seq * 4 + h) * 32 : 1024 + sb * 4 + h;
  const bf16_t* MVT = isp ? p.MVTp + (size_t)(seq * 4 + h) * 128 * 2048 : p.MVTs + (size_t)(sb * 4 + h) * 128 * 64;
  bf16_t* sQ = (bf16_t*)smem;
  bf16_t* sH = sQ + 64 * 136;
  bf16_t* sKT = sH + 64 * 136;
  bf16_t* sVT = sKT + 128 * 72;
  bf16_t* sCb = sVT + 128 * 72;
  bf16_t* sSw = sCb + 128 * 136;
  float* sF = (float*)(sSw + 64 * 72);
  float* sVec = sF;
  float* sNq = sF + 512;
  float* sSS = sF + 576;
  float* sN = sF + 640;

  __syncthreads();
  f32x4 Cacc[8];
  {
    const int tid = launder_tid(), lane = tid & 63, w = tid >> 6, fr = lane & 15, fq = lane >> 4;
    if (isp) {
#pragma unroll
      for (int n = 0; n < 8; n++) Cacc[n] = (f32x4){0.f, 0.f, 0.f, 0.f};
      if (tid < 128) sN[tid] = 0.f;
    } else {
      const float* C0 = p.st_C + (size_t)(sb * 4 + h) * 16384;
#pragma unroll
      for (int n = 0; n < 8; n++)
#pragma unroll
        for (int r = 0; r < 4; r++) Cacc[n][r] = C0[(w * 16 + fq * 4 + r) * 128 + n * 16 + fr];
      if (tid < 128) sN[tid] = p.st_n[(sb * 4 + h) * 128 + tid];
    }
#pragma unroll
    for (int n = 0; n < 8; n++)
#pragma unroll
      for (int r = 0; r < 4; r++) sCb[(w * 16 + fq * 4 + r) * 136 + n * 16 + fr] = f2bf(Cacc[n][r]);
  }
  float mg0, mg1, mg2, mg3;
  {
    const int tid = launder_tid(), lane = tid & 63, w = tid >> 6, fr = lane & 15;
    const int cidx = h * 128 + (w >> 2) * 64 + fr;
    mg0 = p.ml_norm_g[cidx];
    mg1 = p.ml_norm_g[cidx + 16];
    mg2 = p.ml_norm_g[cidx + 32];
    mg3 = p.ml_norm_g[cidx + 48];
  }
  uint4 q0, q1, k0, k1, v0, v1, sw0;
  float gwi = 0.f, gem = 0.f, gden = 0.f, gdec = 0.f;
#define LOAD_CHUNK(C)                                                                         \
  {                                                                                           \
    const int tid_ = launder_tid();                                                           \
    const size_t cid_ = (size_t)(cid0 + (C));                                                 \
    const bf16_t* qp = p.Qc + cid_ * 8192 + tid_ * 8;                                         \
    const bf16_t* kp = p.KTc + cid_ * 8192 + tid_ * 8;                                        \
    q0 = *(const uint4*)qp;                                                                   \
    q1 = *(const uint4*)(qp + 4096);                                                          \
    k0 = *(const uint4*)kp;                                                                   \
    k1 = *(const uint4*)(kp + 4096);                                                          \
    sw0 = *(const uint4*)(p.SWc + cid_ * 4096 + tid_ * 8);                                    \
    v0 = *(const uint4*)(MVT + (size_t)(tid_ >> 3) * L + (C) * 64 + (tid_ & 7) * 8);          \
    v1 = *(const uint4*)(MVT + (size_t)((tid_ + 512) >> 3) * L + (C) * 64 + (tid_ & 7) * 8);  \
    if (tid_ < 64) {                                                                          \
      gwi = p.GV[cid_ * 384 + 128 + tid_];                                                    \
      gem = p.GV[cid_ * 384 + 256 + tid_];                                                    \
      gden = p.DENc[cid_ * 64 + tid_];                                                        \
      gdec = p.GV[cid_ * 384 + 320];                                                          \
    }                                                                                         \
  }
  LOAD_CHUNK(0)
  lds_barrier();

  for (int c = 0; c < nchunks; c++) {
    const int t0 = c * 64;
    float* sV = sVec + (c & 1) * 256;
    const float* sNo = sN + (c & 1) * 128;
    float* sNn = sN + ((c + 1) & 1) * 128;
    uint4 so0, so1;
    {
      const int tid = launder_tid();
      *(uint4*)(sQ + (tid >> 4) * 136 + (tid & 15) * 8) = q0;
      *(uint4*)(sQ + (32 + (tid >> 4)) * 136 + (tid & 15) * 8) = q1;
      *(uint4*)(sKT + (tid >> 3) * 72 + (tid & 7) * 8) = k0;
      *(uint4*)(sKT + (64 + (tid >> 3)) * 72 + (tid & 7) * 8) = k1;
      *(uint4*)(sVT + (tid >> 3) * 72 + (tid & 7) * 8) = v0;
      *(uint4*)(sVT + (64 + (tid >> 3)) * 72 + (tid & 7) * 8) = v1;
      *(uint4*)(sSw + (tid >> 3) * 72 + (tid & 7) * 8) = sw0;
      float decay = gdec;
      if (tid < 64) {
        sV[tid] = gwi;
        sV[64 + tid] = gem;
        sV[128 + tid] = gden;
        sSS[tid] = 0.f;
        if (tid == 0) sV[192] = gdec;
      }
      decay = __shfl(decay, 0);
#define UNP8(VV, AR) float AR[8]; AR[0] = __uint_as_float(VV.x << 16); AR[1] = __uint_as_float(VV.x & 0xffff0000u); \
  AR[2] = __uint_as_float(VV.y << 16); AR[3] = __uint_as_float(VV.y & 0xffff0000u);                                 \
  AR[4] = __uint_as_float(VV.z << 16); AR[5] = __uint_as_float(VV.z & 0xffff0000u);                                 \
  AR[6] = __uint_as_float(VV.w << 16); AR[7] = __uint_as_float(VV.w & 0xffff0000u);
      {
        const float4 n0 = *(const float4*)(sNo + (tid & 15) * 8), n1 = *(const float4*)(sNo + (tid & 15) * 8 + 4);
        UNP8(q0, a)
        UNP8(q1, b)
        float d0 = a[0] * n0.x + a[1] * n0.y + a[2] * n0.z + a[3] * n0.w + a[4] * n1.x + a[5] * n1.y + a[6] * n1.z + a[7] * n1.w;
        float d1 = b[0] * n0.x + b[1] * n0.y + b[2] * n0.z + b[3] * n0.w + b[4] * n1.x + b[5] * n1.y + b[6] * n1.z + b[7] * n1.w;
#pragma unroll
        for (int o = 1; o < 16; o <<= 1) {
          d0 += __shfl_xor(d0, o);
          d1 += __shfl_xor(d1, o);
        }
        if ((tid & 15) == 0) {
          sNq[tid >> 4] = d0;
          sNq[32 + (tid >> 4)] = d1;
        }
      }
      {
        UNP8(k0, a)
        UNP8(k1, b)
        float d0 = ((a[0] + a[1]) + (a[2] + a[3])) + ((a[4] + a[5]) + (a[6] + a[7]));
        float d1 = ((b[0] + b[1]) + (b[2] + b[3])) + ((b[4] + b[5]) + (b[6] + b[7]));
#pragma unroll
        for (int o = 1; o < 8; o <<= 1) {
          d0 += __shfl_xor(d0, o);
          d1 += __shfl_xor(d1, o);
        }
        if ((tid & 7) == 0) {
          sNn[tid >> 3] = d0;
          sNn[64 + (tid >> 3)] = d1;
        }
      }
#undef UNP8
      {
        const bf16_t* sop = p.SO + (size_t)(grow0 + t0 + (tid >> 4)) * 512 + h * 128 + (tid & 15) * 8;
        so0 = *(const uint4*)sop;
        so1 = *(const uint4*)(sop + (size_t)32 * 512);
      }
    }
    if (c + 1 < nchunks) LOAD_CHUNK(c + 1)
    lds_barrier();
    f32x4 hacc[4];
    {
      const int tid = launder_tid(), lane = tid & 63, w = tid >> 6, fr = lane & 15, fq = lane >> 4;
      const int mf = w & 3, nf0 = (w >> 2) * 4;
      const float* sWi = sV;
      const float* sEm = sV + 64;
      const float* sDn = sV + 128;
#pragma unroll
      for (int n = 0; n < 4; n++) hacc[n] = (f32x4){0.f, 0.f, 0.f, 0.f};
#pragma unroll
      for (int ks = 0; ks < 4; ks++) {
        bf16x8 a = lds8(sQ + (mf * 16 + fr) * 136 + ks * 32 + fq * 8);
#pragma unroll
        for (int n = 0; n < 4; n++) {
          bf16x8 b = lds8(sCb + ((nf0 + n) * 16 + fr) * 136 + ks * 32 + fq * 8);
          hacc[n] = MFMA(a, b, hacc[n]);
        }
      }
#pragma unroll
      for (int r = 0; r < 4; r++) {
        float wi = sWi[mf * 16 + fq * 4 + r];
#pragma unroll
        for (int n = 0; n < 4; n++) hacc[n][r] *= wi;
      }
#pragma unroll
      for (int ks = 0; ks < 2; ks++) {
        bf16x8 a = lds8(sSw + (mf * 16 + fr) * 72 + ks * 32 + fq * 8);
#pragma unroll
        for (int n = 0; n < 4; n++) {
          bf16x8 b = lds8(sVT + ((nf0 + n) * 16 + fr) * 72 + ks * 32 + fq * 8);
          hacc[n] = MFMA(a, b, hacc[n]);
        }
      }
#pragma unroll
      for (int r = 0; r < 4; r++) {
        const int t = mf * 16 + fq * 4 + r;
        float den = sDn[t] + sWi[t] * sNq[t];
        float dn = fmaxf(fabsf(den), sEm[t]);
        float inv = __builtin_amdgcn_rcpf(dn);
        float ss = 0.f;
#pragma unroll
        for (int n = 0; n < 4; n++) {
          hacc[n][r] *= inv;
          ss += hacc[n][r] * hacc[n][r];
        }
        ss += __shfl_xor(ss, 1);
        ss += __shfl_xor(ss, 2);
        ss += __shfl_xor(ss, 4);
        ss += __shfl_xor(ss, 8);
        if (fr == 0) atomicAdd(&sSS[t], ss);
      }
    }
    lds_barrier();
    {
      const int tid = launder_tid(), lane = tid & 63, w = tid >> 6, fr = lane & 15, fq = lane >> 4;
      const int mf = w & 3, nf0 = (w >> 2) * 4;
#pragma unroll
      for (int r = 0; r < 4; r++) {
        const int t = mf * 16 + fq * 4 + r;
        const float rstd = rsqrtf(sSS[t] * (1.0f / 128.0f) + 1e-6f);
        bf16_t* hp = sH + t * 136 + nf0 * 16 + fr;
        hp[0] = f2bf(hacc[0][r] * rstd * mg0);
        hp[16] = f2bf(hacc[1][r] * rstd * mg1);
        hp[32] = f2bf(hacc[2][r] * rstd * mg2);
        hp[48] = f2bf(hacc[3][r] * rstd * mg3);
      }
      const float decay = sV[192];
#pragma unroll
      for (int n = 0; n < 8; n++) {
        Cacc[n][0] *= decay;
        Cacc[n][1] *= decay;
        Cacc[n][2] *= decay;
        Cacc[n][3] *= decay;
      }
#pragma unroll
      for (int ks = 0; ks < 2; ks++) {
        bf16x8 a = lds8(sVT + (w * 16 + fr) * 72 + ks * 32 + fq * 8);
#pragma unroll
        for (int n = 0; n < 8; n++) {
          bf16x8 b = lds8(sKT + (n * 16 + fr) * 72 + ks * 32 + fq * 8);
          Cacc[n] = MFMA(a, b, Cacc[n]);
        }
      }
#pragma unroll
      for (int n = 0; n < 8; n++)
#pragma unroll
        for (int r = 0; r < 4; r++) sCb[(w * 16 + fq * 4 + r) * 136 + n * 16 + fr] = f2bf(Cacc[n][r]);
      if (tid < 128) sNn[tid] = decay * sNo[tid] + sNn[tid];
    }
    lds_barrier();
    {
      const int tid = launder_tid();
      const int row = tid >> 4, c8 = (tid & 15) * 8;
      bf16_t* yp = p.YB + (size_t)(grow0 + t0 + row) * 512 + h * 128 + c8;
      uint4 h0 = *(const uint4*)(sH + row * 136 + c8);
      uint4 h1 = *(const uint4*)(sH + (row + 32) * 136 + c8);
#define MUL2(a, b) pack2(__uint_as_float((a) << 16) * __uint_as_float((b) << 16), \
                         __uint_as_float((a) & 0xffff0000u) * __uint_as_float((b) & 0xffff0000u))
      uint4 y0 = {MUL2(h0.x, so0.x), MUL2(h0.y, so0.y), MUL2(h0.z, so0.z), MUL2(h0.w, so0.w)};
      uint4 y1 = {MUL2(h1.x, so1.x), MUL2(h1.y, so1.y), MUL2(h1.z, so1.z), MUL2(h1.w, so1.w)};
#undef MUL2
      *(uint4*)yp = y0;
      *(uint4*)(yp + (size_t)32 * 512) = y1;
    }
  }
#undef LOAD_CHUNK
  lds_barrier();
  {
    const int tid = launder_tid(), lane = tid & 63, w = tid >> 6, fr = lane & 15, fq = lane >> 4;
    float* Cout = isp ? p.out + O_CP + (size_t)(seq * 4 + h) * 16384 : p.out + O_CS + (size_t)(sb * 4 + h) * 16384;
#pragma unroll
    for (int n = 0; n < 8; n++)
#pragma unroll
      for (int r = 0; r < 4; r++) Cout[(w * 16 + fq * 4 + r) * 128 + n * 16 + fr] = Cacc[n][r];
    float* nout = isp ? p.out + O_NP + (seq * 4 + h) * 128 : p.out + O_NS + (sb * 4 + h) * 128;
    if (tid < 128) nout[tid] = sN[(nchunks & 1) * 128 + tid];
  }
}

constexpr int D_ML_P = 32;
constexpr int D_AT_P = 2048;
constexpr int D_AT_S = 128;
constexpr int D_ML_S = 64;
constexpr int D_TOTAL = D_ML_P + D_AT_P + D_AT_S + D_ML_S;

__device__ void phase_d0(const Params& p, char* smem) {
  for (int item = blockIdx.x; item < 1088; item += gridDim.x) {
    if (item < 1024) mlpre_task(p, item >> 7, (item >> 5) & 3, item & 31, smem);
    else mlpre_task(p, 8 + ((item - 1024) >> 2), item & 3, 0, smem);
  }
}
__device__ void phase_d(const Params& p, char* smem, int cidx) {
  int* sTask = (int*)(smem + LDS_BYTES - 16);
  for (;;) {
    __syncthreads();
    if (threadIdx.x == 0) *sTask = (int)atomicAdd(p.counter + cidx, 1u);
    __syncthreads();
    int task = __builtin_amdgcn_readfirstlane(*sTask);
    if (task >= D_TOTAL) break;
    int kind, seq, h, qt = 0;
    if (task < D_ML_P) {
      kind = 0; seq = task >> 2; h = task & 3;
    } else if (task < D_ML_P + D_AT_P) {
      int t2 = task - D_ML_P;
      kind = 1; qt = 31 - (t2 >> 6); seq = (t2 & 63) >> 3; h = t2 & 7;
    } else if (task < D_ML_P + D_AT_P + D_AT_S) {
      int t2 = task - D_ML_P - D_AT_P;
      kind = 1; seq = 8 + (t2 >> 3); h = t2 & 7;
    } else {
      int t2 = task - D_ML_P - D_AT_P - D_AT_S;
      kind = 0; seq = 8 + (t2 >> 2); h = t2 & 3;
    }
    if (kind == 0) mlstm_task(p, seq, h, smem);
    else attn_task(p, seq, h, qt, smem);
  }
}

__device__ void phase_e(const Params& p, char* smem) {
  const int MT = 68, NT = 8;
  const int tid = launder_tid(), lane = tid & 63, w = tid >> 6, wr = w >> 1, wc = w & 1, fr = lane & 15, fq = lane >> 4;
  for (int tile = blockIdx.x; tile < MT * NT; tile += gridDim.x) {
    int mt, nt;
    tile_map(tile, MT, NT, mt, nt);
    f32x4 acc[4][4];
    uint2 res[4][4];
    zero_acc(acc);
    gemm_mainloop(p.YA + (size_t)mt * 256 * 512, 512, p.Wt_a + (size_t)nt * 128 * 512, 512, 512, smem, acc);
#pragma unroll
    for (int m = 0; m < 4; m++)
#pragma unroll
      for (int n = 0; n < 4; n++) {
        const int col = nt * 128 + wc * 64 + n * 16 + fr;
        const int row4 = mt * 256 + wr * 64 + m * 16 + fq * 4;
        const bf16_t* gp = p.GA + (size_t)row4 * 1024 + col;
        res[m][n].x = pack2(acc[m][n][0] * bf2f(gp[0]), acc[m][n][1] * bf2f(gp[1024]));
        res[m][n].y = pack2(acc[m][n][2] * bf2f(gp[2048]), acc[m][n][3] * bf2f(gp[3072]));
      }
    zero_acc(acc);
    gemm_mainloop(p.YB + (size_t)mt * 256 * 512, 512, p.Wt_b + (size_t)nt * 128 * 512, 512, 512, smem, acc);
#pragma unroll
    for (int m = 0; m < 4; m++)
#pragma unroll
      for (int n = 0; n < 4; n++) {
        const int col = nt * 128 + wc * 64 + n * 16 + fr;
        const int row4 = mt * 256 + wr * 64 + m * 16 + fq * 4;
        const bf16_t* gp = p.GB + (size_t)row4 * 1024 + col;
        bf16_t* mp = p.MER + (size_t)row4 * 1024 + col;
        mp[0] = f2bf(__uint_as_float(res[m][n].x << 16) + acc[m][n][0] * bf2f(gp[0]));
        mp[1024] = f2bf(__uint_as_float(res[m][n].x & 0xffff0000u) + acc[m][n][1] * bf2f(gp[1024]));
        mp[2048] = f2bf(__uint_as_float(res[m][n].y << 16) + acc[m][n][2] * bf2f(gp[2048]));
        mp[3072] = f2bf(__uint_as_float(res[m][n].y & 0xffff0000u) + acc[m][n][3] * bf2f(gp[3072]));
      }
  }
}
__device__ void phase_f(const Params& p, char* smem) {
  const int MT = 68, NT = 8;
  const int tid = launder_tid(), lane = tid & 63, w = tid >> 6, wr = w >> 1, wc = w & 1, fr = lane & 15, fq = lane >> 4;
  for (int tile = blockIdx.x; tile < MT * NT; tile += gridDim.x) {
    int mt, nt;
    tile_map(tile, MT, NT, mt, nt);
    f32x4 acc[4][4];
    zero_acc(acc);
    gemm_mainloop(p.MER + (size_t)mt * 256 * 1024, 1024, p.Wt_out + (size_t)nt * 128 * 1024, 1024, 1024, smem, acc);
    const int seq = seq_of(mt * 256 + wr * 64);
#pragma unroll
    for (int n = 0; n < 4; n++) {
      const int col = nt * 128 + wc * 64 + n * 16 + fr;
      const float g1 = p.modf[seq * 6144 + 2048 + col];
#pragma unroll
      for (int m = 0; m < 4; m++) {
        const int row4 = mt * 256 + wr * 64 + m * 16 + fq * 4;
#pragma unroll
        for (int r = 0; r < 4; r++) {
          const int row = row4 + r;
          p.X1[(size_t)row * 1024 + col] = xrow(p, row)[col] + g1 * acc[m][n][r];
        }
      }
    }
  }
}
__device__ void phase_h(const Params& p, char* smem) {
  const int MT = 68, NT = 44;
  const int tid = launder_tid(), lane = tid & 63, w = tid >> 6, wr = w >> 1, wc = w & 1, fr = lane & 15, fq = lane >> 4;
  for (int tile = blockIdx.x; tile < MT * NT; tile += gridDim.x) {
    int mt, nt;
    tile_map(tile, MT, NT, mt, nt);
    f32x4 acc[4][4];
    zero_acc(acc);
    gemm_mainloop(p.U + (size_t)mt * 256 * 1024, 1024, p.Wt_gu + (size_t)nt * 128 * 1024, 1024, 1024, smem, acc);
#pragma unroll
    for (int m = 0; m < 4; m++)
#pragma unroll
      for (int n = 0; n < 2; n++) {
        const int f = nt * 64 + wc * 32 + n * 16 + fr;
        const int row4 = mt * 256 + wr * 64 + m * 16 + fq * 4;
#pragma unroll
        for (int r = 0; r < 4; r++)
          p.HFF[(size_t)(row4 + r) * 2816 + f] = f2bf(silu(acc[m][n][r]) * acc[m][n + 2][r]);
      }
  }
}
__device__ void phase_i(const Params& p, char* smem) {
  const int MT = 68, NT = 8;
  const int tid = launder_tid(), lane = tid & 63, w = tid >> 6, wr = w >> 1, wc = w & 1, fr = lane & 15, fq = lane >> 4;
  for (int tile = blockIdx.x; tile < MT * NT; tile += gridDim.x) {
    int mt, nt;
    tile_map(tile, MT, NT, mt, nt);
    f32x4 acc[4][4];
    zero_acc(acc);
    gemm_mainloop(p.HFF + (size_t)mt * 256 * 2816, 2816, p.Wt_down + (size_t)nt * 128 * 2816, 2816, 2816, smem, acc);
    const int seq = seq_of(mt * 256 + wr * 64);
#pragma unroll
    for (int n = 0; n < 4; n++) {
      const int col = nt * 128 + wc * 64 + n * 16 + fr;
      const float g2 = p.modf[seq * 6144 + 5120 + col];
#pragma unroll
      for (int m = 0; m < 4; m++) {
        const int row4 = mt * 256 + wr * 64 + m * 16 + fq * 4;
#pragma unroll
        for (int r = 0; r < 4; r++) {
          float* px = p.X1 + (size_t)(row4 + r) * 1024 + col;
          *px = *px + g2 * acc[m][n][r];
        }
      }
    }
  }
}
__device__ void phase_j(const Params& p) {
  const int tid = launder_tid(), lane = tid & 63, w = tid >> 6;
  for (int rb = blockIdx.x; rb < kT / 8; rb += gridDim.x) {
    int row = rb * 8 + w;
    const float* xr = p.X1 + (size_t)row * 1024;
    float4 v[4];
    float ss = 0.f;
#pragma unroll
    for (int j = 0; j < 4; j++) {
      v[j] = *(const float4*)(xr + j * 256 + lane * 4);
      ss += v[j].x * v[j].x + v[j].y * v[j].y + v[j].z * v[j].z + v[j].w * v[j].w;
    }
    ss = wave_sum(ss);
    float rstd = rsqrtf(ss * (1.0f / 1024.0f) + 1e-6f);
    float* o = p.out + (row < kNP ? O_YP + (size_t)row * 1024 : O_YS + (size_t)(row - kNP) * 1024);
#pragma unroll
    for (int j = 0; j < 4; j++) {
      int c = j * 256 + lane * 4;
      float4 g = *(const float4*)(p.final_g + c);
      float4 r4;
      r4.x = v[j].x * rstd * g.x;
      r4.y = v[j].y * rstd * g.y;
      r4.z = v[j].z * rstd * g.z;
      r4.w = v[j].w * rstd * g.w;
      *(float4*)(o + c) = r4;
    }
  }
}

extern __shared__ __attribute__((aligned(16))) char dyn_smem[];

__device__ __forceinline__ void run_phase(const Params& p, int ph, char* smem) {
  switch (ph) {
    case 0: phase_a(p, smem); break;
    case 1: phase_b(p, smem); break;
    case 2: phase_c(p, smem); break;
    case 3: phase_d(p, smem, 0); break;
    case 10: phase_d0(p, smem); break;
    case 4: phase_e(p, smem); break;
    case 5: phase_f(p, smem); break;
    case 6: phase_g(p, smem); break;
    case 7: phase_h(p, smem); break;
    case 8: phase_i(p, smem); break;
    default: phase_j(p); break;
  }
}

#ifndef REP_A
#define REP_A 1
#endif
#ifndef REP_C
#define REP_C 1
#endif
#ifndef REP_D
#define REP_D 1
#endif
#ifndef REP_H
#define REP_H 1
#endif
#ifndef REP_E
#define REP_E 1
#endif
__global__ void __launch_bounds__(NTHREADS) mega_kernel(Params p) {
  cg::grid_group grid = cg::this_grid();
#pragma unroll 1
  for (int r = 0; r < REP_A; r++) {
    phase_a(p, dyn_smem);
    grid.sync();
  }
  phase_b(p, dyn_smem);
  grid.sync();
#pragma unroll 1
  for (int r = 0; r < REP_C; r++) {
    phase_c(p, dyn_smem);
    grid.sync();
  }
  phase_d0(p, dyn_smem);
  grid.sync();
#pragma unroll 1
  for (int r = 0; r < REP_D; r++) {
    phase_d(p, dyn_smem, r);
    grid.sync();
  }
#pragma unroll 1
  for (int r = 0; r < REP_E; r++) {
    phase_e(p, dyn_smem);
    grid.sync();
  }
  phase_f(p, dyn_smem);
  grid.sync();
  phase_g(p, dyn_smem);
  grid.sync();
#pragma unroll 1
  for (int r = 0; r < REP_H; r++) {
    phase_h(p, dyn_smem);
    grid.sync();
  }
  phase_i(p, dyn_smem);
  grid.sync();
  phase_j(p);
}
__global__ void __launch_bounds__(NTHREADS) phase_kernel(Params p, int ph) { run_phase(p, ph, dyn_smem); }

extern "C" void kernel_launch(void* const* d_in, const int* in_sizes, int n_in, void* d_out, int out_size, void* d_ws,
                              size_t ws_size, hipStream_t stream) {
  Params p{};
  const float** pin = (const float**)&p;
  for (int i = 0; i < 26; i++) pin[i] = (const float*)d_in[i];
  p.out = (float*)d_out;
  char* ws = (char*)d_ws;
  size_t off = 0;
  auto alloc = [&](size_t bytes) {
    char* r = ws + off;
    off += (bytes + 255) & ~(size_t)255;
    return r;
  };
  p.Wt_in = (bf16_t*)alloc((size_t)5632 * 1024 * 2);
  p.Wt_a = (bf16_t*)alloc((size_t)1024 * 512 * 2);
  p.Wt_b = (bf16_t*)alloc((size_t)1024 * 512 * 2);
  p.Wt_out = (bf16_t*)alloc((size_t)1024 * 1024 * 2);
  p.Wt_gu = (bf16_t*)alloc((size_t)5632 * 1024 * 2);
  p.Wt_down = (bf16_t*)alloc((size_t)1024 * 2816 * 2);
  p.wg = (float*)alloc(8192 * 4);
  p.modp = (float*)alloc((size_t)8 * 24 * 6144 * 4);
  p.modf = (float*)alloc((size_t)24 * 6144 * 4);
  p.U = (bf16_t*)alloc((size_t)kT * 1024 * 2);
  p.Qb = (bf16_t*)alloc((size_t)kT * 512 * 2);
  p.Kp = (bf16_t*)alloc((size_t)64 * 2048 * 64 * 2);
  p.Ks = (bf16_t*)alloc((size_t)128 * 1152 * 64 * 2);
  p.VTp = (bf16_t*)alloc((size_t)64 * 64 * 2048 * 2);
  p.VTs = (bf16_t*)alloc((size_t)128 * 64 * 1152 * 2);
  p.MQK = (bf16_t*)alloc((size_t)kT * 1024 * 2);
  p.MVTp = (bf16_t*)alloc((size_t)32 * 128 * 2048 * 2);
  p.MVTs = (bf16_t*)alloc((size_t)64 * 128 * 64 * 2);
  p.SO = (bf16_t*)alloc((size_t)kT * 512 * 2);
  p.GA = (bf16_t*)alloc((size_t)kT * 1024 * 2);
  p.GB = (bf16_t*)alloc((size_t)kT * 1024 * 2);
  p.GI = (float*)alloc((size_t)kT * 4 * 4);
  p.LF = (float*)alloc((size_t)kT * 4 * 4);
  p.GV = (float*)alloc((size_t)1088 * 384 * 4);
  p.DENc = (float*)alloc((size_t)1088 * 64 * 4);
  p.Qc = (bf16_t*)alloc((size_t)1088 * 8192 * 2);
  p.KTc = (bf16_t*)alloc((size_t)1088 * 8192 * 2);
  p.SWc = (bf16_t*)alloc((size_t)1088 * 4096 * 2);
  p.YA = (bf16_t*)alloc((size_t)kT * 512 * 2);
  p.YB = (bf16_t*)alloc((size_t)kT * 512 * 2);
  p.MER = (bf16_t*)alloc((size_t)kT * 1024 * 2);
  p.X1 = (float*)alloc((size_t)kT * 1024 * 4);
  p.HFF = (bf16_t*)alloc((size_t)kT * 2816 * 2);
  p.counter = (unsigned*)alloc(256);

#if ONE_LAUNCH
  static int grid_blocks = 0;
  if (!grid_blocks) {
    int dev = 0, cus = 0, per_cu = 0;
    hipGetDevice(&dev);
    hipDeviceGetAttribute(&cus, hipDeviceAttributeMultiprocessorCount, dev);
    hipFuncSetAttribute((const void*)mega_kernel, hipFuncAttributeMaxDynamicSharedMemorySize, LDS_BYTES);
    hipOccupancyMaxActiveBlocksPerMultiprocessor(&per_cu, mega_kernel, NTHREADS, LDS_BYTES);
    if (per_cu < 1) per_cu = 1;
    grid_blocks = cus * per_cu;
  }
  void* args[] = {&p};
  hipError_t e = hipLaunchCooperativeKernel((void*)mega_kernel, dim3(grid_blocks), dim3(NTHREADS), args, LDS_BYTES, stream);
  if (e != hipSuccess) fprintf(stderr, "cooperative launch failed: %s (grid %d)\n", hipGetErrorString(e), grid_blocks);
#else
  static int init = 0;
  if (!init) {
    hipFuncSetAttribute((const void*)phase_kernel, hipFuncAttributeMaxDynamicSharedMemorySize, LDS_BYTES);
    init = 1;
  }
  for (int ph = 0; ph < 10; ph++) phase_kernel<<<256, NTHREADS, LDS_BYTES, stream>>>(p, ph);
#endif
}
```

```cpp
#include <hip/hip_runtime.h>
#include <hip/hip_cooperative_groups.h>
#include <stdint.h>
#include <stdio.h>
namespace cg = cooperative_groups;

#ifndef ONE_LAUNCH
#define ONE_LAUNCH 1
#endif

typedef unsigned short bf16_t;
using bf16x8 = __attribute__((ext_vector_type(8))) short;
using f32x4 = __attribute__((ext_vector_type(4))) float;

#define NTHREADS 512
#define LDS_BYTES 155648
constexpr int kNP = 16384;
constexpr int kT = 17408;
constexpr int kINW = 5640;

struct Params {
  const float *x_prompt, *x_sample, *c_prompt, *c_sample, *cache_k, *cache_v, *st_C, *st_n, *st_m, *st_conv;
  const float *norm1_g, *norm2_g, *w_ada, *b_ada, *w_in, *b_if, *w_conv, *b_conv, *ml_norm_g, *w_a, *w_b, *w_out,
      *w_gate, *w_up, *w_down, *final_g;
  float* out;
  bf16_t *Wt_in, *Wt_a, *Wt_b, *Wt_out, *Wt_gu, *Wt_down;
  float *wg, *modp, *modf;
  bf16_t *U, *Qb, *Kp, *Ks, *VTp, *VTs, *MQK, *MVTp, *MVTs, *SO, *GA, *GB;
  float *GI, *LF, *GV, *DENc;
  bf16_t *Qc, *KTc, *SWc;
  bf16_t *YA, *YB, *MER;
  float* X1;
  bf16_t* HFF;
  unsigned* counter;
  unsigned* bar;
};

constexpr size_t O_YP = 0;
constexpr size_t O_YS = O_YP + 16777216;
constexpr size_t O_KP = O_YS + 1048576;
constexpr size_t O_VP = O_KP + 8388608;
constexpr size_t O_CP = O_VP + 8388608;
constexpr size_t O_NP = O_CP + 524288;
constexpr size_t O_MP = O_NP + 4096;
constexpr size_t O_CVP = O_MP + 32;
constexpr size_t O_KS = O_CVP + 24576;
constexpr size_t O_VS = O_KS + 524288;
constexpr size_t O_CS = O_VS + 524288;
constexpr size_t O_NS = O_CS + 1048576;
constexpr size_t O_MS = O_NS + 8192;
constexpr size_t O_CVS = O_MS + 64;

typedef __bf16 hwbf16x2_t __attribute__((ext_vector_type(2)));
typedef float hwf32x2_t __attribute__((ext_vector_type(2)));
__device__ __forceinline__ bf16_t f2bf(float f) {
  __bf16 r = (__bf16)f;
  return __builtin_bit_cast(unsigned short, r);
}
__device__ __forceinline__ float bf2f(bf16_t h) { return __uint_as_float(((unsigned)h) << 16); }
__device__ __forceinline__ unsigned pack2(float a, float b) {
  hwf32x2_t v = {a, b};
  hwbf16x2_t r = __builtin_convertvector(v, hwbf16x2_t);
  return __builtin_bit_cast(unsigned, r);
}
__device__ __forceinline__ float sigm(float x) { return __builtin_amdgcn_rcpf(1.0f + __expf(-x)); }
__device__ __forceinline__ float silu(float x) { return x * __builtin_amdgcn_rcpf(1.0f + __expf(-x)); }
__device__ __forceinline__ float logsig(float x) { return fminf(x, 0.f) - __logf(1.0f + __expf(-fabsf(x))); }
__device__ __forceinline__ float wave_sum(float v) {
#pragma unroll
  for (int o = 32; o > 0; o >>= 1) v += __shfl_xor(v, o);
  return v;
}
__device__ __forceinline__ float wave_max(float v) {
#pragma unroll
  for (int o = 32; o > 0; o >>= 1) v = fmaxf(v, __shfl_xor(v, o));
  return v;
}
__device__ __forceinline__ int seq_of(int row) { return row < kNP ? (row >> 11) : 8 + ((row - kNP) >> 6); }
__device__ __forceinline__ const float* xrow(const Params& p, int row) {
  return row < kNP ? p.x_prompt + (size_t)row * 1024 : p.x_sample + (size_t)(row - kNP) * 1024;
}
__device__ __forceinline__ int launder_tid() {
  int t = threadIdx.x;
  asm volatile("" : "+v"(t));
  return t;
}
__device__ __forceinline__ bf16x8 lds8(const void* p) { return *(const bf16x8*)p; }
#define MFMA(a, b, c) __builtin_amdgcn_mfma_f32_16x16x32_bf16(a, b, c, 0, 0, 0)

__device__ __forceinline__ void glds16(const void* g, void* l) {
  __builtin_amdgcn_global_load_lds((const unsigned*)g, (unsigned*)l, 16, 0, 0);
}
__device__ __forceinline__ void gemm_stage(const bf16_t* __restrict__ A, int lda, const bf16_t* __restrict__ B, int ldb,
                                           int k0, char* st) {
  const int tid = launder_tid();
#pragma unroll
  for (int i = 0; i < 4; i++) {
    int b = tid + i * 512;
    int row = b >> 3;
    int ch = (b & 7) ^ ((row >> 1) & 7);
    glds16(A + (size_t)row * lda + k0 + ch * 8, st + b * 16);
  }
#pragma unroll
  for (int i = 0; i < 2; i++) {
    int b = tid + i * 512;
    int row = b >> 3;
    int ch = (b & 7) ^ ((row >> 1) & 7);
    glds16(B + (size_t)row * ldb + k0 + ch * 8, st + 32768 + b * 16);
  }
}
__device__ __forceinline__ void gemm_prologue(const bf16_t* __restrict__ A, int lda, const bf16_t* __restrict__ B, int ldb,
                                              char* smem, int& cur) {
  __syncthreads();
  cur = 0;
  gemm_stage(A, lda, B, ldb, 0, smem);
  gemm_stage(A, lda, B, ldb, 64, smem + 49152);
}
template <bool BATCH = true>
__device__ __forceinline__ void gemm_tile(const bf16_t* __restrict__ A, int lda, const bf16_t* __restrict__ B, int ldb,
                                          int K, const bf16_t* __restrict__ nA, int nlda, const bf16_t* __restrict__ nB,
                                          int nldb, bool has_next, char* smem, f32x4 (&acc)[4][4], int& cur) {
  const int tid = launder_tid(), lane = tid & 63, w = tid >> 6, wr = w >> 1, wc = w & 1;
  const int fr = lane & 15, fq = lane >> 4;
  const int nt = K >> 6;
  for (int t = 0; t < nt; t++) {
    if (t == 0) asm volatile("s_waitcnt vmcnt(0)" ::: "memory");
    else if (t + 1 < nt || has_next) asm volatile("s_waitcnt vmcnt(6)" ::: "memory");
    else asm volatile("s_waitcnt vmcnt(0)" ::: "memory");
    __builtin_amdgcn_s_barrier();
    asm volatile("" ::: "memory");
    {
      int nxt = cur + 2;
      if (nxt >= 3) nxt -= 3;
      if (t + 2 < nt) gemm_stage(A, lda, B, ldb, (t + 2) << 6, smem + nxt * 49152);
      else if (has_next) gemm_stage(nA, nlda, nB, nldb, (t + 2 - nt) << 6, smem + nxt * 49152);
    }
    const char* sa = smem + cur * 49152;
    cur = (cur == 2) ? 0 : cur + 1;
    const char* sb = sa + 32768;
    if (BATCH) {
      bf16x8 af[2][4], bfr[2][4];
#pragma unroll
      for (int ks = 0; ks < 2; ks++) {
        const int ch = ((ks * 4 + fq) ^ ((fr >> 1) & 7)) * 16;
#pragma unroll
        for (int m = 0; m < 4; m++) af[ks][m] = lds8(sa + (wr * 64 + m * 16 + fr) * 128 + ch);
#pragma unroll
        for (int n = 0; n < 4; n++) bfr[ks][n] = lds8(sb + (wc * 64 + n * 16 + fr) * 128 + ch);
      }
      __builtin_amdgcn_s_setprio(1);
#pragma unroll
      for (int ks = 0; ks < 2; ks++) {
#pragma unroll
        for (int m = 0; m < 4; m++)
#pragma unroll
          for (int n = 0; n < 4; n++) acc[m][n] = MFMA(af[ks][m], bfr[ks][n], acc[m][n]);
      }
      __builtin_amdgcn_s_setprio(0);
    } else {
#pragma unroll
      for (int ks = 0; ks < 2; ks++) {
        bf16x8 af[4], bfr[4];
        const int ch = ((ks * 4 + fq) ^ ((fr >> 1) & 7)) * 16;
#pragma unroll
        for (int m = 0; m < 4; m++) af[m] = lds8(sa + (wr * 64 + m * 16 + fr) * 128 + ch);
#pragma unroll
        for (int n = 0; n < 4; n++) bfr[n] = lds8(sb + (wc * 64 + n * 16 + fr) * 128 + ch);
#pragma unroll
        for (int m = 0; m < 4; m++)
#pragma unroll
          for (int n = 0; n < 4; n++) acc[m][n] = MFMA(af[m], bfr[n], acc[m][n]);
      }
    }
  }
}
__device__ __forceinline__ void tile_map(int tile, int MT, int NT, int& mt, int& nt) {
  int per = 8 * NT;
  int g = tile / per, r = tile - g * per;
  int gsz = min(8, MT - g * 8);
  mt = g * 8 + r % gsz;
  nt = r / gsz;
}
__device__ __forceinline__ void zero_acc(f32x4 (&acc)[4][4]) {
#pragma unroll
  for (int m = 0; m < 4; m++)
#pragma unroll
    for (int n = 0; n < 4; n++) acc[m][n] = (f32x4){0.f, 0.f, 0.f, 0.f};
}

__device__ __forceinline__ void transpose_quad(const float* __restrict__ src, int lds_, size_t sstep, bf16_t* __restrict__ dst, int ldd,
                               int k0, int kstep, int nbase, int nstep, int mode, char* smem) {
  float* tl = (float*)smem;
  const int tid = launder_tid();
  float4 v[4][2];
#pragma unroll
  for (int q = 0; q < 4; q++)
#pragma unroll
    for (int i = 0; i < 2; i++) {
      int idx = tid + i * 512;
      int k = idx >> 4, n4 = (idx & 15) * 4;
      v[q][i] = *(const float4*)(src + q * sstep + (size_t)k * lds_ + n4);
    }
  __syncthreads();
#pragma unroll
  for (int q = 0; q < 4; q++)
#pragma unroll
    for (int i = 0; i < 2; i++) {
      int idx = tid + i * 512;
      int k = idx >> 4, n4 = (idx & 15) * 4;
      float* t = tl + q * 4160 + k * 65 + n4;
      t[0] = v[q][i].x;
      t[1] = v[q][i].y;
      t[2] = v[q][i].z;
      t[3] = v[q][i].w;
    }
  __syncthreads();
  const int n = tid >> 3, kc = (tid & 7) * 8;
#pragma unroll
  for (int q = 0; q < 4; q++) {
    float o[8];
#pragma unroll
    for (int e = 0; e < 8; e++) o[e] = tl[q * 4160 + (kc + e) * 65 + n];
    const int nb = nbase + q * nstep;
    const int nrow = (mode == 0) ? (nb + n) : (nb + (n >> 5) * 64 + (n & 31));
    uint4 pk = {pack2(o[0], o[1]), pack2(o[2], o[3]), pack2(o[4], o[5]), pack2(o[6], o[7])};
    *(uint4*)(dst + (size_t)nrow * ldd + k0 + q * kstep + kc) = pk;
  }
}

constexpr int A_MOD = 96;
constexpr int A_WT = 1008;
constexpr int A_VC = 512;
constexpr int A_KC = 256;
constexpr int A_PAD = 128;
constexpr int A_MISC = 1;
constexpr int A_TOTAL = A_MOD + A_WT + A_VC + A_KC + A_PAD + A_MISC;

__device__ __forceinline__ void phase_a(const Params& p, char* smem) {
  const int tid = launder_tid();
  for (int task = blockIdx.x; task < A_TOTAL; task += gridDim.x) {
    int id = task;
    if (id < A_MOD) {
      int cgp = id % 12, ks = id / 12;
      float* sc = (float*)smem;
      __syncthreads();
      for (int i = tid; i < 24 * 128; i += 512) {
        int s = i >> 7, kk = i & 127, k = ks * 128 + kk;
        float cv = s < 8 ? p.c_prompt[s * 1024 + k] : p.c_sample[(s - 8) * 1024 + k];
        sc[i] = silu(cv);
      }
      __syncthreads();
      int col = cgp * 512 + tid;
      float acc[24];
#pragma unroll
      for (int s = 0; s < 24; s++) acc[s] = 0.f;
      const float* wp = p.w_ada + (size_t)(ks * 128) * 6144 + col;
#pragma unroll 1
      for (int kb = 0; kb < 128; kb += 32) {
        float wv[32];
#pragma unroll
        for (int j = 0; j < 32; j++) wv[j] = wp[(size_t)(kb + j) * 6144];
#pragma unroll
        for (int j = 0; j < 32; j++)
#pragma unroll
          for (int s = 0; s < 24; s++) acc[s] += sc[s * 128 + kb + j] * wv[j];
      }
#pragma unroll
      for (int s = 0; s < 24; s++) p.modp[(size_t)(ks * 24 + s) * 6144 + col] = acc[s];
      continue;
    }
    id -= A_MOD;
    if (id < A_WT) {
      if (id < 352) {
        int kt = id / 22, nq = id % 22;
        int scol = nq < 14 ? nq * 256 : 3592 + (nq - 14) * 256;
        int drow = nq < 14 ? nq * 256 : 3584 + (nq - 14) * 256;
        transpose_quad(p.w_in + (size_t)kt * 64 * kINW + scol, kINW, 64, p.Wt_in, 1024, kt * 64, 0, drow, 64, 0, smem);
      } else if (id < 384) {
        int i2 = id - 352, kt = i2 / 4, nq = i2 % 4;
        transpose_quad(p.w_a + (size_t)kt * 64 * 1024 + nq * 256, 1024, 64, p.Wt_a, 512, kt * 64, 0, nq * 256, 64, 0, smem);
      } else if (id < 416) {
        int i2 = id - 384, kt = i2 / 4, nq = i2 % 4;
        transpose_quad(p.w_b + (size_t)kt * 64 * 1024 + nq * 256, 1024, 64, p.Wt_b, 512, kt * 64, 0, nq * 256, 64, 0, smem);
      } else if (id < 480) {
        int i2 = id - 416, kt = i2 / 4, nq = i2 % 4;
        transpose_quad(p.w_out + (size_t)kt * 64 * 1024 + nq * 256, 1024, 64, p.Wt_out, 1024, kt * 64, 0, nq * 256, 64, 0, smem);
      } else if (id < 656) {
        int i2 = id - 480, kt = i2 / 11, nq = i2 % 11;
        transpose_quad(p.w_gate + (size_t)kt * 64 * 2816 + nq * 256, 2816, 64, p.Wt_gu, 1024, kt * 64, 0, nq * 512, 128, 1, smem);
      } else if (id < 832) {
        int i2 = id - 656, kt = i2 / 11, nq = i2 % 11;
        transpose_quad(p.w_up + (size_t)kt * 64 * 2816 + nq * 256, 2816, 64, p.Wt_gu, 1024, kt * 64, 0, nq * 512 + 32, 128, 1, smem);
      } else {
        int i2 = id - 832, kt = i2 / 4, nq = i2 % 4;
        transpose_quad(p.w_down + (size_t)kt * 64 * 1024 + nq * 256, 1024, 64, p.Wt_down, 2816, kt * 64, 0, nq * 256, 64, 0, smem);
      }
      continue;
    }
    id -= A_WT;
    if (id < A_VC) {
      int bh = id >> 2, jq = id & 3;
      int b = bh >> 3, h = bh & 7;
      transpose_quad(p.cache_v + ((size_t)(b * 1024 + jq * 256) * 8 + h) * 64, 512, (size_t)64 * 512,
                     p.VTs + (size_t)bh * 64 * 1152, 1152, jq * 256, 64, 0, 0, 0, smem);
      continue;
    }
    id -= A_VC;
    if (id < A_KC) {
      int b = id >> 4, jb = id & 15;
#pragma unroll
      for (int it = 0; it < 8; it++) {
        int g = tid + it * 512;
        int j = g >> 6, col = (g & 63) * 8;
        int h = col >> 6, d = col & 63;
        const float* src = p.cache_k + ((size_t)(b * 1024 + jb * 64 + j)) * 512 + col;
        float4 v0 = *(const float4*)src, v1 = *(const float4*)(src + 4);
        uint4 o;
        o.x = pack2(v0.x, v0.y);
        o.y = pack2(v0.z, v0.w);
        o.z = pack2(v1.x, v1.y);
        o.w = pack2(v1.z, v1.w);
        *(uint4*)(p.Ks + ((size_t)((b * 8 + h) * 1152 + jb * 64 + j)) * 64 + d) = o;
      }
      continue;
    }
    id -= A_KC;
    if (id < A_PAD) {
      int bh = id;
      uint4 z = {0u, 0u, 0u, 0u};
      *(uint4*)(p.Ks + ((size_t)bh * 1152 + 1088) * 64 + tid * 8) = z;
      int d = tid >> 3, chn = tid & 7;
      *(uint4*)(p.VTs + ((size_t)bh * 64 + d) * 1152 + 1088 + chn * 8) = z;
      continue;
    }
    for (int i = tid; i < 8192; i += 512) {
      int g = i >> 10, k = i & 1023;
      p.wg[i] = p.w_in[(size_t)k * kINW + 3584 + g];
    }
    if (tid < 8) p.counter[tid] = 0u;
  }
}

__device__ __forceinline__ void norm_task(const Params& p, int task, int which, char* smem) {
  float* sm_scale = (float*)smem;
  float* sm_shift = sm_scale + 1024;
  const float* sm_wg = sm_shift + 1024;
  const int tid = launder_tid(), lane = tid & 63, w = tid >> 6;
  const int row0 = task * 32;
  const int seq = seq_of(row0);
  const float* g = which ? p.norm2_g : p.norm1_g;
  const int sh_off = which ? 3072 : 0, sc_off = which ? 4096 : 1024;
  __syncthreads();
  for (int c = tid; c < 1024; c += 512) {
    float sh, sc;
    if (which == 0) {
      sh = p.b_ada[sh_off + c];
      sc = p.b_ada[sc_off + c];
#pragma unroll
      for (int ks = 0; ks < 8; ks++) {
        sh += p.modp[(size_t)(ks * 24 + seq) * 6144 + sh_off + c];
        sc += p.modp[(size_t)(ks * 24 + seq) * 6144 + sc_off + c];
      }
    } else {
      sh = p.modf[seq * 6144 + sh_off + c];
      sc = p.modf[seq * 6144 + sc_off + c];
    }
    sm_scale[c] = g[c] * (1.0f + sc);
    sm_shift[c] = sh;
  }
  __syncthreads();
  float4 v[4][4];
#pragma unroll
  for (int i = 0; i < 4; i++) {
    const int row = row0 + w * 4 + i;
    const float* xr = which ? (p.X1 + (size_t)row * 1024) : xrow(p, row);
#pragma unroll
    for (int j = 0; j < 4; j++) v[i][j] = *(const float4*)(xr + j * 256 + lane * 4);
  }
#pragma unroll
  for (int i = 0; i < 4; i++) {
    const int row = row0 + w * 4 + i;
    float ss = 0.f;
#pragma unroll
    for (int j = 0; j < 4; j++)
      ss += v[i][j].x * v[i][j].x + v[i][j].y * v[i][j].y + v[i][j].z * v[i][j].z + v[i][j].w * v[i][j].w;
    ss = wave_sum(ss);
    float rstd = rsqrtf(ss * (1.0f / 1024.0f) + 1e-6f);
#pragma unroll
    for (int j = 0; j < 4; j++) {
      int c = j * 256 + lane * 4;
      float4 sc = *(const float4*)(sm_scale + c), sh = *(const float4*)(sm_shift + c);
      v[i][j].x = v[i][j].x * rstd * sc.x + sh.x;
      v[i][j].y = v[i][j].y * rstd * sc.y + sh.y;
      v[i][j].z = v[i][j].z * rstd * sc.z + sh.z;
      v[i][j].w = v[i][j].w * rstd * sc.w + sh.w;
      uint2 o;
      o.x = pack2(v[i][j].x, v[i][j].y);
      o.y = pack2(v[i][j].z, v[i][j].w);
      *(uint2*)(p.U + (size_t)row * 1024 + c) = o;
    }
    if (which == 0) {
      float gv[8];
#pragma unroll
      for (int gi = 0; gi < 8; gi++) {
        float a = 0.f;
#pragma unroll
        for (int j = 0; j < 4; j++) {
          float4 wv = *(const float4*)(sm_wg + gi * 1024 + j * 256 + lane * 4);
          a += v[i][j].x * wv.x + v[i][j].y * wv.y + v[i][j].z * wv.z + v[i][j].w * wv.w;
        }
        gv[gi] = wave_sum(a);
      }
      if (lane == 0) {
#pragma unroll
        for (int h = 0; h < 4; h++) {
          p.GI[row * 4 + h] = gv[h] + p.b_if[h];
          p.LF[row * 4 + h] = logsig(gv[4 + h] + p.b_if[4 + h]);
        }
      }
    }
  }
}
__device__ __forceinline__ void phase_b(const Params& p, char* smem) {
  const int NTASK = kT / 32;
  {
    float* swg = (float*)smem + 2048;
    for (int i = threadIdx.x; i < 8192; i += 512) swg[i] = p.w_in[(size_t)(i & 1023) * kINW + 3584 + (i >> 10)];
  }
  for (int task = blockIdx.x; task < NTASK + 288; task += gridDim.x) {
    if (task < NTASK) {
      norm_task(p, task, 0, smem);
    } else {
      int i = (task - NTASK) * 512 + threadIdx.x;
      int s = i / 6144, c = i - s * 6144;
      float a = p.b_ada[c];
#pragma unroll
      for (int ks = 0; ks < 8; ks++) a += p.modp[(size_t)(ks * 24 + s) * 6144 + c];
      p.modf[i] = a;
    }
  }
}
__device__ __forceinline__ void phase_g(const Params& p, char* smem) {
  for (int task = blockIdx.x; task < kT / 32; task += gridDim.x) norm_task(p, task, 1, smem);
}

__device__ __forceinline__ void gate_task(const Params& p, int seq, int h, char* smem);
__device__ __forceinline__ void phase_c(const Params& p, char* smem) {
  const int MT = 68, NT = 44;
  const int tid = launder_tid(), lane = tid & 63, w = tid >> 6, wr = w >> 1, wc = w & 1, fr = lane & 15, fq = lane >> 4;
  for (int item = blockIdx.x; item < 96; item += gridDim.x) {
    if (item < 32) gate_task(p, item >> 2, item & 3, smem);
    else gate_task(p, 8 + ((item - 32) >> 2), item & 3, smem);
  }
  int cur = 0;
  {
    int mt0, nt0;
    tile_map(blockIdx.x, MT, NT, mt0, nt0);
    gemm_prologue(p.U + (size_t)mt0 * 256 * 1024, 1024, p.Wt_in + (size_t)nt0 * 128 * 1024, 1024, smem, cur);
  }
  for (int tile = blockIdx.x; tile < MT * NT; tile += gridDim.x) {
    int mt, nt, nmt, nnt;
    tile_map(tile, MT, NT, mt, nt);
    const bool hn = tile + (int)gridDim.x < MT * NT;
    tile_map(hn ? tile + (int)gridDim.x : tile, MT, NT, nmt, nnt);
    f32x4 acc[4][4];
    zero_acc(acc);
    gemm_tile(p.U + (size_t)mt * 256 * 1024, 1024, p.Wt_in + (size_t)nt * 128 * 1024, 1024, 1024,
              p.U + (size_t)nmt * 256 * 1024, 1024, p.Wt_in + (size_t)nnt * 128 * 1024, 1024, hn, smem, acc, cur);
    const int rbase = mt * 256 + wr * 64;
    const int seq = seq_of(rbase);
    const bool isp = seq < 8;
    const int sb = seq - 8;
    const int srow0 = isp ? seq * 2048 : kNP + sb * 64;
    const int L = isp ? 2048 : 64;
    const int cbase = nt * 128 + wc * 64;
    const int tb = rbase - srow0;
#pragma unroll
    for (int m = 0; m < 4; m++) {
#pragma unroll
      for (int n = 0; n < 4; n++) {
        const int col = cbase + n * 16 + fr;
        const int t4 = tb + m * 16 + fq * 4;
        const int row4 = rbase + m * 16 + fq * 4;
        f32x4 v = acc[m][n];
        if (cbase < 512) {
#pragma unroll
          for (int r = 0; r < 4; r++) p.Qb[(size_t)(row4 + r) * 512 + col] = f2bf(v[r]);
        } else if (cbase < 1024) {
          const int c = col - 512, h = c >> 6, d = c & 63;
          float* o = isp ? p.out + O_KP + (size_t)row4 * 512 + c : p.out + O_KS + (size_t)(row4 - kNP) * 512 + c;
          bf16_t* kb = isp ? p.Kp + ((size_t)(seq * 8 + h) * 2048 + t4) * 64 + d
                           : p.Ks + ((size_t)(sb * 8 + h) * 1152 + 1024 + t4) * 64 + d;
#pragma unroll
          for (int r = 0; r < 4; r++) {
            o[r * 512] = v[r];
            kb[r * 64] = f2bf(v[r]);
          }
        } else if (cbase < 1536) {
          const int c = col - 1024, h = c >> 6, d = c & 63;
          float* o = isp ? p.out + O_VP + (size_t)row4 * 512 + c : p.out + O_VS + (size_t)(row4 - kNP) * 512 + c;
#pragma unroll
          for (int r = 0; r < 4; r++) o[r * 512] = v[r];
          bf16_t* vt = isp ? p.VTp + ((size_t)(seq * 8 + h) * 64 + d) * 2048 + t4
                           : p.VTs + ((size_t)(sb * 8 + h) * 64 + d) * 1152 + 1024 + t4;
          uint2 pk;
          pk.x = pack2(v[0], v[1]);
          pk.y = pack2(v[2], v[3]);
          *(uint2*)vt = pk;
        } else if (cbase < 2560) {
          const int c = col - 1536;
#pragma unroll
          for (int r = 0; r < 4; r++) {
            p.MQK[(size_t)(row4 + r) * 1024 + c] = f2bf(v[r]);
            int t = t4 + r;
            if (t >= L - 3) {
              float* o = isp ? p.out + O_CVP + (size_t)(seq * 3 + (t - (L - 3))) * 1024 + c
                             : p.out + O_CVS + (size_t)(sb * 3 + (t - (L - 3))) * 1024 + c;
              *o = v[r];
            }
          }
        } else if (cbase < 3072) {
          const int c = col - 2560, h = c >> 7, d = c & 127;
          bf16_t* vt = isp ? p.MVTp + ((size_t)(seq * 4 + h) * 128 + d) * 2048 + t4
                           : p.MVTs + ((size_t)(sb * 4 + h) * 128 + d) * 64 + t4;
          uint2 pk;
          pk.x = pack2(v[0], v[1]);
          pk.y = pack2(v[2], v[3]);
          *(uint2*)vt = pk;
        } else if (cbase < 3584) {
          const int c = col - 3072;
#pragma unroll
          for (int r = 0; r < 4; r++) p.SO[(size_t)(row4 + r) * 512 + c] = f2bf(sigm(v[r]));
        } else if (cbase < 4608) {
          const int c = col - 3584;
#pragma unroll
          for (int r = 0; r < 4; r++) p.GA[(size_t)(row4 + r) * 1024 + c] = f2bf(sigm(v[r]));
        } else {
          const int c = col - 4608;
#pragma unroll
          for (int r = 0; r < 4; r++) p.GB[(size_t)(row4 + r) * 1024 + c] = f2bf(sigm(v[r]));
        }
      }
    }
  }
}

__device__ __forceinline__ void lds_barrier() { asm volatile("s_waitcnt lgkmcnt(0)\n\ts_barrier" ::: "memory"); }
__device__ __forceinline__ void attn_task(const Params& p, int seq, int h, int qt, char* smem) {
  const int tid = launder_tid(), lane = tid & 63, w = tid >> 6, fr = lane & 15, fq = lane >> 4;
  const bool isp = seq < 8;
  const int sb = seq - 8;
  const int past = isp ? 0 : 1024;
  const int Tlen = isp ? 2048 : 1152;
  const int row0 = (isp ? seq * 2048 : kNP + sb * 64) + qt * 64;
  const int p0 = past + qt * 64;
  const bf16_t* Kb = isp ? p.Kp + (size_t)(seq * 8 + h) * 2048 * 64 : p.Ks + (size_t)(sb * 8 + h) * 1152 * 64;
  const bf16_t* VT = isp ? p.VTp + (size_t)(seq * 8 + h) * 64 * 2048 : p.VTs + (size_t)(sb * 8 + h) * 64 * 1152;
  bf16_t* sQ = (bf16_t*)smem;
  bf16_t* sK = sQ + 64 * 72;
  bf16_t* sVT = sK + 128 * 72;
  bf16_t* sP = sVT + 64 * 136;
  float* sZ = (float*)(sP + 64 * 136);
  int* sFlag = (int*)(sZ + 64 * 132);

  __syncthreads();
  {
    int r = tid >> 3, chn = tid & 7;
    uint4 q = *(const uint4*)(p.Qb + (size_t)(row0 + r) * 512 + h * 64 + chn * 8);
    *(uint4*)(sQ + r * 72 + chn * 8) = q;
  }
  const int kt_d = (p0 + 62) >> 7;
  const int ki0 = tid, ki1 = tid + 512;
  const bf16_t* kptr0 = Kb + (size_t)(ki0 >> 3) * 64 + (ki0 & 7) * 8;
  const bf16_t* kptr1 = Kb + (size_t)(ki1 >> 3) * 64 + (ki1 & 7) * 8;
  const bf16_t* vptr0 = VT + (size_t)(ki0 >> 4) * Tlen + (ki0 & 15) * 8;
  const bf16_t* vptr1 = VT + (size_t)(ki1 >> 4) * Tlen + (ki1 & 15) * 8;
  uint4 kr0 = *(const uint4*)(kptr0 + (size_t)kt_d * 8192);
  uint4 kr1 = *(const uint4*)(kptr1 + (size_t)kt_d * 8192);
  uint4 vr0 = *(const uint4*)(vptr0 + kt_d * 128);
  uint4 vr1 = *(const uint4*)(vptr1 + kt_d * 128);
  float R = 0.f;
  f32x4 oacc[2];
  oacc[0] = (f32x4){0.f, 0.f, 0.f, 0.f};
  oacc[1] = (f32x4){0.f, 0.f, 0.f, 0.f};
  const int mf = w & 3;
  for (int kt = kt_d; kt >= 0; kt--) {
    lds_barrier();
    *(uint4*)(sK + (ki0 >> 3) * 72 + (ki0 & 7) * 8) = kr0;
    *(uint4*)(sK + (ki1 >> 3) * 72 + (ki1 & 7) * 8) = kr1;
    *(uint4*)(sVT + (ki0 >> 4) * 136 + (ki0 & 15) * 8) = vr0;
    *(uint4*)(sVT + (ki1 >> 4) * 136 + (ki1 & 15) * 8) = vr1;
    if (tid == 0) *sFlag = 0;
    lds_barrier();
    if (kt > 0) {
      kr0 = *(const uint4*)(kptr0 + (size_t)(kt - 1) * 8192);
      kr1 = *(const uint4*)(kptr1 + (size_t)(kt - 1) * 8192);
      vr0 = *(const uint4*)(vptr0 + (kt - 1) * 128);
      vr1 = *(const uint4*)(vptr1 + (kt - 1) * 128);
    }
    {
      const int nf0 = (w >> 2) * 4;
      bf16x8 a0 = lds8(sQ + (mf * 16 + fr) * 72 + fq * 8);
      bf16x8 a1 = lds8(sQ + (mf * 16 + fr) * 72 + 32 + fq * 8);
#pragma unroll
      for (int n = 0; n < 4; n++) {
        bf16x8 b0 = lds8(sK + ((nf0 + n) * 16 + fr) * 72 + fq * 8);
        bf16x8 b1 = lds8(sK + ((nf0 + n) * 16 + fr) * 72 + 32 + fq * 8);
        f32x4 s = (f32x4){0.f, 0.f, 0.f, 0.f};
        s = MFMA(a0, b0, s);
        s = MFMA(a1, b1, s);
#pragma unroll
        for (int r = 0; r < 4; r++) sZ[(mf * 16 + fq * 4 + r) * 132 + (nf0 + n) * 16 + fr] = s[r] * 0.125f;
      }
    }
    lds_barrier();
    {
      const int row = tid >> 3, part = tid & 7;
      const int pos = p0 + row;
      const int j0 = kt * 128 + part * 16;
      float z[16], ls[16];
#pragma unroll
      for (int i4 = 0; i4 < 4; i4++) {
        float4 t4 = *(const float4*)(sZ + row * 132 + part * 16 + i4 * 4);
        z[i4 * 4 + 0] = t4.x;
        z[i4 * 4 + 1] = t4.y;
        z[i4 * 4 + 2] = t4.z;
        z[i4 * 4 + 3] = t4.w;
      }
      float run = 0.f;
      float tl[16];
#pragma unroll
      for (int i = 15; i >= 0; i--) {
        bool valid = (j0 + i) < pos;
        float l = valid ? -(fmaxf(z[i], 0.f) + __logf(1.0f + __expf(-fabsf(z[i])))) : 0.f;
        ls[i] = l;
        tl[i] = run;
        run += l;
      }
      float incl = run;
#pragma unroll
      for (int dlt = 1; dlt < 8; dlt <<= 1) {
        float t = __shfl_down(incl, dlt, 8);
        if (part + dlt < 8) incl += t;
      }
      float excl = incl - run;
      float tot = __shfl(incl, 0, 8);
      float base = R + excl;
      unsigned pk[8];
#pragma unroll
      for (int i = 0; i < 16; i += 2) {
        bool v0 = (j0 + i) < pos, v1 = (j0 + i + 1) < pos;
        float a0 = v0 ? __expf(z[i] + ls[i] + tl[i] + base) : 0.f;
        float a1 = v1 ? __expf(z[i + 1] + ls[i + 1] + tl[i + 1] + base) : 0.f;
        pk[i >> 1] = pack2(a0, a1);
      }
      *(uint4*)(sP + row * 136 + part * 16) = (uint4){pk[0], pk[1], pk[2], pk[3]};
      *(uint4*)(sP + row * 136 + part * 16 + 8) = (uint4){pk[4], pk[5], pk[6], pk[7]};
      R += tot;
      if (R > -110.f) *sFlag = 1;
    }
    lds_barrier();
    const int more = *sFlag;
    {
      const int nf0 = (w >> 2) * 2;
#pragma unroll
      for (int ks = 0; ks < 4; ks++) {
        bf16x8 a = lds8(sP + (mf * 16 + fr) * 136 + ks * 32 + fq * 8);
#pragma unroll
        for (int n = 0; n < 2; n++) {
          bf16x8 b = lds8(sVT + ((nf0 + n) * 16 + fr) * 136 + ks * 32 + fq * 8);
          oacc[n] = MFMA(a, b, oacc[n]);
        }
      }
    }
    if (!more) break;
  }
  {
    const int nf0 = (w >> 2) * 2;
#pragma unroll
    for (int n = 0; n < 2; n++)
#pragma unroll
      for (int r = 0; r < 4; r++)
        p.YA[(size_t)(row0 + mf * 16 + fq * 4 + r) * 512 + h * 64 + (nf0 + n) * 16 + fr] = f2bf(oacc[n][r]);
  }
}


__device__ __forceinline__ void gate_task(const Params& p, int seq, int h, char* smem) {
  const int tid = launder_tid(), lane = tid & 63, w = tid >> 6;
  const bool isp = seq < 8;
  const int sb = seq - 8;
  const int nchunks = isp ? 32 : 1;
  const int grow0 = isp ? seq * 2048 : kNP + sb * 64;
  float* gv = p.GV + (size_t)(isp ? (seq * 4 + h) * 32 : 1024 + sb * 4 + h) * 384;
  float* sBl = (float*)smem;
  float* sG = sBl + 32;
  float* sM = sG + 32;
  __syncthreads();
  float b_[4], as_[4], pm_[4], g_[4];
#pragma unroll
  for (int i = 0; i < 4; i++) {
    const int c = w + i * 8;
    b_[i] = 0.f; as_[i] = 0.f; pm_[i] = 0.f; g_[i] = 0.f;
    if (c < nchunks) {
      const int row = grow0 + c * 64 + lane;
      float li = p.GI[row * 4 + h], lf = p.LF[row * 4 + h];
      float b = lf;
#pragma unroll
      for (int d = 1; d < 64; d <<= 1) {
        float t_ = __shfl_up(b, d);
        if (lane >= d) b += t_;
      }
      float a_s = li - b;
      float pm = a_s;
#pragma unroll
      for (int d = 1; d < 64; d <<= 1) {
        float t_ = __shfl_up(pm, d);
        if (lane >= d) pm = fmaxf(pm, t_);
      }
      float blast = __shfl(b, 63);
      float g = blast - b + li;
      float G = wave_max(g);
      b_[i] = b; as_[i] = a_s; pm_[i] = pm; g_[i] = g;
      if (lane == 0) {
        sBl[c] = blast;
        sG[c] = G;
      }
    }
  }
  __syncthreads();
  if (tid == 0) {
    float m = isp ? 0.f : p.st_m[sb * 4 + h];
    for (int c = 0; c < nchunks; c++) {
      sM[c] = m;
      m = fmaxf(sBl[c] + m, sG[c]);
    }
    sM[nchunks] = m;
    if (isp) p.out[O_MP + seq * 4 + h] = m;
    else p.out[O_MS + sb * 4 + h] = m;
  }
  __syncthreads();
#pragma unroll
  for (int i = 0; i < 4; i++) {
    const int c = w + i * 8;
    if (c < nchunks) {
      const float m_run = sM[c], m_new = sM[c + 1];
      const float mt = b_[i] + fmaxf(m_run, pm_[i]);
      float* o = gv + (size_t)c * 384;
      o[lane] = b_[i] - mt;
      o[64 + lane] = as_[i];
      o[128 + lane] = __expf(b_[i] + m_run - mt);
      o[192 + lane] = __expf(g_[i] - m_new);
      o[256 + lane] = __expf(-mt);
      if (lane == 0) o[320] = __expf(sBl[c] + m_run - m_new);
    }
  }
}

__device__ __forceinline__ void mlpre_task(const Params& p, int seq, int h, int c, char* smem) {
  const bool isp = seq < 8;
  const int sb = seq - 8;
  const int grow0 = isp ? seq * 2048 : kNP + sb * 64;
  const int t0 = c * 64;
  const int cid = isp ? (seq * 4 + h) * 32 + c : 1024 + sb * 4 + h;
  bf16_t* sQ = (bf16_t*)smem;
  bf16_t* sK = sQ + 64 * 136;
  bf16_t* sKT = sK + 64 * 136;
  bf16_t* sSw = sKT + 128 * 72;
  float* sF = (float*)(sSw + 64 * 72);
  float* sV = sF;
  float* sDen = sF + 384;
  float* sCw = sF + 448;
  const float* sBt = sV;
  const float* sAs = sV + 64;
  const float* sWg = sV + 192;
  __syncthreads();
  uint4 xr0, xr1, xr2, xr3, xr4, xr5, xr6;
  {
    const int tid = launder_tid();
    for (int i = tid; i < 1280; i += 512) {
      int j = i >> 8, cc = i & 255;
      int gch = (cc >= 128 ? 512 : 0) + h * 128 + (cc & 127);
      sCw[i] = (j < 4) ? p.w_conv[j * 1024 + gch] : p.b_conv[gch];
    }
    if (tid < 384) sV[tid] = p.GV[(size_t)cid * 384 + tid];
    if (tid < 64) sDen[tid] = 0.f;
    const int rb_ = tid >> 5, cgp_ = tid & 31;
    const int ch_ = (cgp_ >= 16 ? 512 : 0) + h * 128 + (cgp_ & 15) * 8;
    const int tb0 = t0 + rb_ * 4 - 3;
    const bf16_t* xp = p.MQK + (size_t)(grow0 + tb0) * 1024 + ch_;
#define LDX(i, dst)                                                                                           \
  if (tb0 + i >= 0) dst = *(const uint4*)(xp + (size_t)i * 1024);                                             \
  else if (isp) dst = (uint4){0u, 0u, 0u, 0u};                                                                \
  else {                                                                                                      \
    const float* s0 = p.st_conv + (size_t)(sb * 3 + (tb0 + i + 3)) * 1024 + ch_;                              \
    dst = (uint4){pack2(s0[0], s0[1]), pack2(s0[2], s0[3]), pack2(s0[4], s0[5]), pack2(s0[6], s0[7])};        \
  }
    LDX(0, xr0) LDX(1, xr1) LDX(2, xr2)
#undef LDX
    xr3 = *(const uint4*)(xp + (size_t)3 * 1024);
    xr4 = *(const uint4*)(xp + (size_t)4 * 1024);
    xr5 = *(const uint4*)(xp + (size_t)5 * 1024);
    xr6 = *(const uint4*)(xp + (size_t)6 * 1024);
  }
  __syncthreads();
  {
    const int tid = launder_tid();
    const int rb = tid >> 5, cgp = tid & 31;
    const bool isk = cgp >= 16;
    float o0[8], o1[8], o2[8], o3[8];
    {
      const float* cwp = sCw + cgp * 8;
      float4 b0 = *(const float4*)(cwp + 1024), b1 = *(const float4*)(cwp + 1028);
      o0[0] = b0.x; o0[1] = b0.y; o0[2] = b0.z; o0[3] = b0.w; o0[4] = b1.x; o0[5] = b1.y; o0[6] = b1.z; o0[7] = b1.w;
#pragma unroll
      for (int e = 0; e < 8; e++) { o1[e] = o0[e]; o2[e] = o0[e]; o3[e] = o0[e]; }
#define FMAW(j, o, x) { float4 a0 = *(const float4*)(cwp + j * 256), a1 = *(const float4*)(cwp + j * 256 + 4); \
  o[0] += a0.x * x[0]; o[1] += a0.y * x[1]; o[2] += a0.z * x[2]; o[3] += a0.w * x[3];                              \
  o[4] += a1.x * x[4]; o[5] += a1.y * x[5]; o[6] += a1.z * x[6]; o[7] += a1.w * x[7]; }
#define UNP(xv, x) float x[8]; x[0] = __uint_as_float(xv.x << 16); x[1] = __uint_as_float(xv.x & 0xffff0000u); \
  x[2] = __uint_as_float(xv.y << 16); x[3] = __uint_as_float(xv.y & 0xffff0000u);                             \
  x[4] = __uint_as_float(xv.z << 16); x[5] = __uint_as_float(xv.z & 0xffff0000u);                             \
  x[6] = __uint_as_float(xv.w << 16); x[7] = __uint_as_float(xv.w & 0xffff0000u);
      { UNP(xr0, x) FMAW(0, o0, x) }
      { UNP(xr1, x) FMAW(1, o0, x) FMAW(0, o1, x) }
      { UNP(xr2, x) FMAW(2, o0, x) FMAW(1, o1, x) FMAW(0, o2, x) }
      { UNP(xr3, x) FMAW(3, o0, x) FMAW(2, o1, x) FMAW(1, o2, x) FMAW(0, o3, x) }
      { UNP(xr4, x) FMAW(3, o1, x) FMAW(2, o2, x) FMAW(1, o3, x) }
      { UNP(xr5, x) FMAW(3, o2, x) FMAW(2, o3, x) }
      { UNP(xr6, x) FMAW(3, o3, x) }
#undef FMAW
#undef UNP
    }
    const float ksc = isk ? 0.08838834764831845f : 1.0f;
#pragma unroll
    for (int e = 0; e < 8; e++) {
      o0[e] = silu(o0[e]) * ksc; o1[e] = silu(o1[e]) * ksc; o2[e] = silu(o2[e]) * ksc; o3[e] = silu(o3[e]) * ksc;
    }
    bf16_t* dstp = (isk ? sK + (cgp - 16) * 8 : sQ + cgp * 8) + (rb * 4) * 136;
    *(uint4*)(dstp) = (uint4){pack2(o0[0], o0[1]), pack2(o0[2], o0[3]), pack2(o0[4], o0[5]), pack2(o0[6], o0[7])};
    *(uint4*)(dstp + 136) = (uint4){pack2(o1[0], o1[1]), pack2(o1[2], o1[3]), pack2(o1[4], o1[5]), pack2(o1[6], o1[7])};
    *(uint4*)(dstp + 272) = (uint4){pack2(o2[0], o2[1]), pack2(o2[2], o2[3]), pack2(o2[4], o2[5]), pack2(o2[6], o2[7])};
    *(uint4*)(dstp + 408) = (uint4){pack2(o3[0], o3[1]), pack2(o3[2], o3[3]), pack2(o3[4], o3[5]), pack2(o3[6], o3[7])};
    if (isk) {
      float g0 = sWg[rb * 4], g1 = sWg[rb * 4 + 1], g2 = sWg[rb * 4 + 2], g3 = sWg[rb * 4 + 3];
#pragma unroll
      for (int e = 0; e < 8; e++) {
        uint2 pk;
        pk.x = pack2(o0[e] * g0, o1[e] * g1);
        pk.y = pack2(o2[e] * g2, o3[e] * g3);
        *(uint2*)(sKT + ((cgp - 16) * 8 + e) * 72 + rb * 4) = pk;
      }
    }
  }
  __syncthreads();
  {
    const int tid = launder_tid(), lane = tid & 63, w = tid >> 6, fr = lane & 15, fq = lane >> 4;
    const int mf = w >> 1, nf0 = (w & 1) * 2;
    f32x4 sa[2];
    sa[0] = (f32x4){0.f, 0.f, 0.f, 0.f};
    sa[1] = (f32x4){0.f, 0.f, 0.f, 0.f};
#pragma unroll
    for (int ks = 0; ks < 4; ks++) {
      bf16x8 a = lds8(sQ + (mf * 16 + fr) * 136 + ks * 32 + fq * 8);
#pragma unroll
      for (int n = 0; n < 2; n++) {
        bf16x8 b = lds8(sK + ((nf0 + n) * 16 + fr) * 136 + ks * 32 + fq * 8);
        sa[n] = MFMA(a, b, sa[n]);
      }
    }
#pragma unroll
    for (int r = 0; r < 4; r++) {
      const int t = mf * 16 + fq * 4 + r;
      const float bt = sBt[t];
      float rs = 0.f;
#pragma unroll
      for (int n = 0; n < 2; n++) {
        const int s = (nf0 + n) * 16 + fr;
        float wgt = (s <= t) ? __expf(bt + sAs[s]) : 0.f;
        float v = sa[n][r] * wgt;
        rs += v;
        sSw[t * 72 + s] = f2bf(v);
      }
      rs += __shfl_xor(rs, 1);
      rs += __shfl_xor(rs, 2);
      rs += __shfl_xor(rs, 4);
      rs += __shfl_xor(rs, 8);
      if (fr == 0) atomicAdd(&sDen[t], rs);
    }
  }
  __syncthreads();
  {
    const int tid = launder_tid();
    bf16_t* qo = p.Qc + (size_t)cid * 8192;
    bf16_t* ko = p.KTc + (size_t)cid * 8192;
    bf16_t* so = p.SWc + (size_t)cid * 4096;
    *(uint4*)(qo + tid * 8) = *(const uint4*)(sQ + (tid >> 4) * 136 + (tid & 15) * 8);
    *(uint4*)(qo + 4096 + tid * 8) = *(const uint4*)(sQ + (32 + (tid >> 4)) * 136 + (tid & 15) * 8);
    *(uint4*)(ko + tid * 8) = *(const uint4*)(sKT + (tid >> 3) * 72 + (tid & 7) * 8);
    *(uint4*)(ko + 4096 + tid * 8) = *(const uint4*)(sKT + (64 + (tid >> 3)) * 72 + (tid & 7) * 8);
    *(uint4*)(so + tid * 8) = *(const uint4*)(sSw + (tid >> 3) * 72 + (tid & 7) * 8);
    if (tid < 64) p.DENc[(size_t)cid * 64 + tid] = sDen[tid];
  }
}

__device__ __forceinline__ void mlstm_task(const Params& p, int seq, int h, char* smem) {
  const bool isp = seq < 8;
  const int sb = seq - 8;
  const int L = isp ? 2048 : 64;
  const int nchunks = L >> 6;
  const int grow0 = isp ? seq * 2048 : kNP + sb * 64;
  const int cid0 = isp ? (seq * 4 + h) * 32 : 1024 + sb * 4 + h;
  const bf16_t* MVT = isp ? p.MVTp + (size_t)(seq * 4 + h) * 128 * 2048 : p.MVTs + (size_t)(sb * 4 + h) * 128 * 64;
  bf16_t* sQ = (bf16_t*)smem;
  bf16_t* sH = sQ + 64 * 136;
  bf16_t* sKT = sH + 64 * 136;
  bf16_t* sVT = sKT + 128 * 72;
  bf16_t* sCb = sVT + 128 * 72;
  bf16_t* sSw = sCb + 128 * 136;
  float* sF = (float*)(sSw + 64 * 72);
  float* sVec = sF;
  float* sNq = sF + 512;
  float* sSS = sF + 576;
  float* sN = sF + 640;

  __syncthreads();
  f32x4 Cacc[8];
  {
    const int tid = launder_tid(), lane = tid & 63, w = tid >> 6, fr = lane & 15, fq = lane >> 4;
    if (isp) {
#pragma unroll
      for (int n = 0; n < 8; n++) Cacc[n] = (f32x4){0.f, 0.f, 0.f, 0.f};
      if (tid < 128) sN[tid] = 0.f;
    } else {
      const float* C0 = p.st_C + (size_t)(sb * 4 + h) * 16384;
#pragma unroll
      for (int n = 0; n < 8; n++)
#pragma unroll
        for (int r = 0; r < 4; r++) Cacc[n][r] = C0[(w * 16 + fq * 4 + r) * 128 + n * 16 + fr];
      if (tid < 128) sN[tid] = p.st_n[(sb * 4 + h) * 128 + tid];
    }
#pragma unroll
    for (int n = 0; n < 8; n++)
#pragma unroll
      for (int r = 0; r < 4; r++) sCb[(w * 16 + fq * 4 + r) * 136 + n * 16 + fr] = f2bf(Cacc[n][r]);
  }
  float mg0, mg1, mg2, mg3;
  {
    const int tid = launder_tid(), lane = tid & 63, w = tid >> 6, fr = lane & 15;
    const int cidx = h * 128 + (w >> 2) * 64 + fr;
    mg0 = p.ml_norm_g[cidx];
    mg1 = p.ml_norm_g[cidx + 16];
    mg2 = p.ml_norm_g[cidx + 32];
    mg3 = p.ml_norm_g[cidx + 48];
  }
  uint4 q0, q1, k0, k1, v0, v1, sw0;
  float gwi = 0.f, gem = 0.f, gden = 0.f, gdec = 0.f;
#define LOAD_CHUNK(C)                                                                         \
  {                                                                                           \
    const int tid_ = launder_tid();                                                           \
    const size_t cid_ = (size_t)(cid0 + (C));                                                 \
    const bf16_t* qp = p.Qc + cid_ * 8192 + tid_ * 8;                                         \
    const bf16_t* kp = p.KTc + cid_ * 8192 + tid_ * 8;                                        \
    q0 = *(const uint4*)qp;                                                                   \
    q1 = *(const uint4*)(qp + 4096);                                                          \
    k0 = *(const uint4*)kp;                                                                   \
    k1 = *(const uint4*)(kp + 4096);                                                          \
    sw0 = *(const uint4*)(p.SWc + cid_ * 4096 + tid_ * 8);                                    \
    v0 = *(const uint4*)(MVT + (size_t)(tid_ >> 3) * L + (C) * 64 + (tid_ & 7) * 8);          \
    v1 = *(const uint4*)(MVT + (size_t)((tid_ + 512) >> 3) * L + (C) * 64 + (tid_ & 7) * 8);  \
    if (tid_ < 64) {                                                                          \
      gwi = p.GV[cid_ * 384 + 128 + tid_];                                                    \
      gem = p.GV[cid_ * 384 + 256 + tid_];                                                    \
      gden = p.DENc[cid_ * 64 + tid_];                                                        \
      gdec = p.GV[cid_ * 384 + 320];                                                          \
    }                                                                                         \
  }
  LOAD_CHUNK(0)
  lds_barrier();

  for (int c = 0; c < nchunks; c++) {
    const int t0 = c * 64;
    float* sV = sVec + (c & 1) * 256;
    const float* sNo = sN + (c & 1) * 128;
    float* sNn = sN + ((c + 1) & 1) * 128;
    uint4 so0, so1;
    {
      const int tid = launder_tid();
      *(uint4*)(sQ + (tid >> 4) * 136 + (tid & 15) * 8) = q0;
      *(uint4*)(sQ + (32 + (tid >> 4)) * 136 + (tid & 15) * 8) = q1;
      *(uint4*)(sKT + (tid >> 3) * 72 + (tid & 7) * 8) = k0;
      *(uint4*)(sKT + (64 + (tid >> 3)) * 72 + (tid & 7) * 8) = k1;
      *(uint4*)(sVT + (tid >> 3) * 72 + (tid & 7) * 8) = v0;
      *(uint4*)(sVT + (64 + (tid >> 3)) * 72 + (tid & 7) * 8) = v1;
      *(uint4*)(sSw + (tid >> 3) * 72 + (tid & 7) * 8) = sw0;
      float decay = gdec;
      if (tid < 64) {
        sV[tid] = gwi;
        sV[64 + tid] = gem;
        sV[128 + tid] = gden;
        sSS[tid] = 0.f;
        if (tid == 0) sV[192] = gdec;
      }
      decay = __shfl(decay, 0);
#define UNP8(VV, AR) float AR[8]; AR[0] = __uint_as_float(VV.x << 16); AR[1] = __uint_as_float(VV.x & 0xffff0000u); \
  AR[2] = __uint_as_float(VV.y << 16); AR[3] = __uint_as_float(VV.y & 0xffff0000u);                                 \
  AR[4] = __uint_as_float(VV.z << 16); AR[5] = __uint_as_float(VV.z & 0xffff0000u);                                 \
  AR[6] = __uint_as_float(VV.w << 16); AR[7] = __uint_as_float(VV.w & 0xffff0000u);
      {
        const float4 n0 = *(const float4*)(sNo + (tid & 15) * 8), n1 = *(const float4*)(sNo + (tid & 15) * 8 + 4);
        UNP8(q0, a)
        UNP8(q1, b)
        float d0 = a[0] * n0.x + a[1] * n0.y + a[2] * n0.z + a[3] * n0.w + a[4] * n1.x + a[5] * n1.y + a[6] * n1.z + a[7] * n1.w;
        float d1 = b[0] * n0.x + b[1] * n0.y + b[2] * n0.z + b[3] * n0.w + b[4] * n1.x + b[5] * n1.y + b[6] * n1.z + b[7] * n1.w;
#pragma unroll
        for (int o = 1; o < 16; o <<= 1) {
          d0 += __shfl_xor(d0, o);
          d1 += __shfl_xor(d1, o);
        }
        if ((tid & 15) == 0) {
          sNq[tid >> 4] = d0;
          sNq[32 + (tid >> 4)] = d1;
        }
      }
      {
        UNP8(k0, a)
        UNP8(k1, b)
        float d0 = ((a[0] + a[1]) + (a[2] + a[3])) + ((a[4] + a[5]) + (a[6] + a[7]));
        float d1 = ((b[0] + b[1]) + (b[2] + b[3])) + ((b[4] + b[5]) + (b[6] + b[7]));
#pragma unroll
        for (int o = 1; o < 8; o <<= 1) {
          d0 += __shfl_xor(d0, o);
          d1 += __shfl_xor(d1, o);
        }
        if ((tid & 7) == 0) {
          sNn[tid >> 3] = d0;
          sNn[64 + (tid >> 3)] = d1;
        }
      }
#undef UNP8
      {
        const bf16_t* sop = p.SO + (size_t)(grow0 + t0 + (tid >> 4)) * 512 + h * 128 + (tid & 15) * 8;
        so0 = *(const uint4*)sop;
        so1 = *(const uint4*)(sop + (size_t)32 * 512);
      }
    }
    if (c + 1 < nchunks) LOAD_CHUNK(c + 1)
    lds_barrier();
    f32x4 hacc[4];
    {
      const int tid = launder_tid(), lane = tid & 63, w = tid >> 6, fr = lane & 15, fq = lane >> 4;
      const int mf = w & 3, nf0 = (w >> 2) * 4;
      const float* sWi = sV;
      const float* sEm = sV + 64;
      const float* sDn = sV + 128;
#pragma unroll
      for (int n = 0; n < 4; n++) hacc[n] = (f32x4){0.f, 0.f, 0.f, 0.f};
#pragma unroll
      for (int ks = 0; ks < 4; ks++) {
        bf16x8 a = lds8(sQ + (mf * 16 + fr) * 136 + ks * 32 + fq * 8);
#pragma unroll
        for (int n = 0; n < 4; n++) {
          bf16x8 b = lds8(sCb + ((nf0 + n) * 16 + fr) * 136 + ks * 32 + fq * 8);
          hacc[n] = MFMA(a, b, hacc[n]);
        }
      }
#pragma unroll
      for (int r = 0; r < 4; r++) {
        float wi = sWi[mf * 16 + fq * 4 + r];
#pragma unroll
        for (int n = 0; n < 4; n++) hacc[n][r] *= wi;
      }
#pragma unroll
      for (int ks = 0; ks < 2; ks++) {
        bf16x8 a = lds8(sSw + (mf * 16 + fr) * 72 + ks * 32 + fq * 8);
#pragma unroll
        for (int n = 0; n < 4; n++) {
          bf16x8 b = lds8(sVT + ((nf0 + n) * 16 + fr) * 72 + ks * 32 + fq * 8);
          hacc[n] = MFMA(a, b, hacc[n]);
        }
      }
#pragma unroll
      for (int r = 0; r < 4; r++) {
        const int t = mf * 16 + fq * 4 + r;
        float den = sDn[t] + sWi[t] * sNq[t];
        float dn = fmaxf(fabsf(den), sEm[t]);
        float inv = __builtin_amdgcn_rcpf(dn);
        float ss = 0.f;
#pragma unroll
        for (int n = 0; n < 4; n++) {
          hacc[n][r] *= inv;
          ss += hacc[n][r] * hacc[n][r];
        }
        ss += __shfl_xor(ss, 1);
        ss += __shfl_xor(ss, 2);
        ss += __shfl_xor(ss, 4);
        ss += __shfl_xor(ss, 8);
        if (fr == 0) atomicAdd(&sSS[t], ss);
      }
    }
    lds_barrier();
    {
      const int tid = launder_tid(), lane = tid & 63, w = tid >> 6, fr = lane & 15, fq = lane >> 4;
      const int mf = w & 3, nf0 = (w >> 2) * 4;
#pragma unroll
      for (int r = 0; r < 4; r++) {
        const int t = mf * 16 + fq * 4 + r;
        const float rstd = rsqrtf(sSS[t] * (1.0f / 128.0f) + 1e-6f);
        bf16_t* hp = sH + t * 136 + nf0 * 16 + fr;
        hp[0] = f2bf(hacc[0][r] * rstd * mg0);
        hp[16] = f2bf(hacc[1][r] * rstd * mg1);
        hp[32] = f2bf(hacc[2][r] * rstd * mg2);
        hp[48] = f2bf(hacc[3][r] * rstd * mg3);
      }
      const float decay = sV[192];
#pragma unroll
      for (int n = 0; n < 8; n++) {
        Cacc[n][0] *= decay;
        Cacc[n][1] *= decay;
        Cacc[n][2] *= decay;
        Cacc[n][3] *= decay;
      }
#pragma unroll
      for (int ks = 0; ks < 2; ks++) {
        bf16x8 a = lds8(sVT + (w * 16 + fr) * 72 + ks * 32 + fq * 8);
#pragma unroll
        for (int n = 0; n < 8; n++) {
          bf16x8 b = lds8(sKT + (n * 16 + fr) * 72 + ks * 32 + fq * 8);
          Cacc[n] = MFMA(a, b, Cacc[n]);
        }
      }
#pragma unroll
      for (int n = 0; n < 8; n++)
#pragma unroll
        for (int r = 0; r < 4; r++) sCb[(w * 16 + fq * 4 + r) * 136 + n * 16 + fr] = f2bf(Cacc[n][r]);
      if (tid < 128) sNn[tid] = decay * sNo[tid] + sNn[tid];
    }
    lds_barrier();
    {
      const int tid = launder_tid();
      const int row = tid >> 4, c8 = (tid & 15) * 8;
      bf16_t* yp = p.YB + (size_t)(grow0 + t0 + row) * 512 + h * 128 + c8;
      uint4 h0 = *(const uint4*)(sH + row * 136 + c8);
      uint4 h1 = *(const uint4*)(sH + (row + 32) * 136 + c8);
#define MUL2(a, b) pack2(__uint_as_float((a) << 16) * __uint_as_float((b) << 16), \
                         __uint_as_float((a) & 0xffff0000u) * __uint_as_float((b) & 0xffff0000u))
      uint4 y0 = {MUL2(h0.x, so0.x), MUL2(h0.y, so0.y), MUL2(h0.z, so0.z), MUL2(h0.w, so0.w)};
      uint4 y1 = {MUL2(h1.x, so1.x), MUL2(h1.y, so1.y), MUL2(h1.z, so1.z), MUL2(h1.w, so1.w)};
#undef MUL2
      *(uint4*)yp = y0;
      *(uint4*)(yp + (size_t)32 * 512) = y1;
    }
  }
#undef LOAD_CHUNK
  lds_barrier();
  {
    const int tid = launder_tid(), lane = tid & 63, w = tid >> 6, fr = lane & 15, fq = lane >> 4;
    float* Cout = isp ? p.out + O_CP + (size_t)(seq * 4 + h) * 16384 : p.out + O_CS + (size_t)(sb * 4 + h) * 16384;
#pragma unroll
    for (int n = 0; n < 8; n++)
#pragma unroll
      for (int r = 0; r < 4; r++) Cout[(w * 16 + fq * 4 + r) * 128 + n * 16 + fr] = Cacc[n][r];
    float* nout = isp ? p.out + O_NP + (seq * 4 + h) * 128 : p.out + O_NS + (sb * 4 + h) * 128;
    if (tid < 128) nout[tid] = sN[(nchunks & 1) * 128 + tid];
  }
}

constexpr int D_ML_P = 32;
constexpr int D_AT_P = 2048;
constexpr int D_AT_S = 128;
constexpr int D_ML_S = 64;
constexpr int D_TOTAL = D_ML_P + D_AT_P + D_AT_S + D_ML_S;

__device__ __forceinline__ void phase_d0(const Params& p, char* smem) {
  for (int item = blockIdx.x; item < 1088; item += gridDim.x) {
    if (item < 1024) mlpre_task(p, item >> 7, (item >> 5) & 3, item & 31, smem);
    else mlpre_task(p, 8 + ((item - 1024) >> 2), item & 3, 0, smem);
  }
}
__device__ __forceinline__ void phase_d(const Params& p, char* smem, int cidx) {
  int* sTask = (int*)(smem + LDS_BYTES - 16);
  for (;;) {
    __syncthreads();
    if (threadIdx.x == 0) *sTask = (int)atomicAdd(p.counter + cidx, 1u);
    __syncthreads();
    int task = __builtin_amdgcn_readfirstlane(*sTask);
    if (task >= D_TOTAL) break;
    int kind, seq, h, qt = 0;
    if (task < D_ML_P) {
      kind = 0; seq = task >> 2; h = task & 3;
    } else if (task < D_ML_P + D_AT_P) {
      int t2 = task - D_ML_P;
      kind = 1; qt = 31 - (t2 >> 6); seq = (t2 & 63) >> 3; h = t2 & 7;
    } else if (task < D_ML_P + D_AT_P + D_AT_S) {
      int t2 = task - D_ML_P - D_AT_P;
      kind = 1; seq = 8 + (t2 >> 3); h = t2 & 7;
    } else {
      int t2 = task - D_ML_P - D_AT_P - D_AT_S;
      kind = 0; seq = 8 + (t2 >> 2); h = t2 & 3;
    }
    if (kind == 0) mlstm_task(p, seq, h, smem);
    else attn_task(p, seq, h, qt, smem);
  }
}

__device__ __forceinline__ void phase_e(const Params& p, char* smem) {
  const int MT = 68, NT = 8;
  const int tid = launder_tid(), lane = tid & 63, w = tid >> 6, wr = w >> 1, wc = w & 1, fr = lane & 15, fq = lane >> 4;
  int cur = 0;
  {
    int mt0, nt0;
    tile_map(blockIdx.x, MT, NT, mt0, nt0);
    gemm_prologue(p.YA + (size_t)mt0 * 256 * 512, 512, p.Wt_a + (size_t)nt0 * 128 * 512, 512, smem, cur);
  }
  for (int tile = blockIdx.x; tile < MT * NT; tile += gridDim.x) {
    int mt, nt;
    tile_map(tile, MT, NT, mt, nt);
    f32x4 acc[4][4];
    zero_acc(acc);
    const bool hn = tile + (int)gridDim.x < MT * NT;
    int nmt, nnt;
    tile_map(hn ? tile + (int)gridDim.x : tile, MT, NT, nmt, nnt);
    gemm_tile(p.YA + (size_t)mt * 256 * 512, 512, p.Wt_a + (size_t)nt * 128 * 512, 512, 512,
              p.YB + (size_t)mt * 256 * 512, 512, p.Wt_b + (size_t)nt * 128 * 512, 512, true, smem, acc, cur);
#pragma unroll
    for (int m = 0; m < 4; m++)
#pragma unroll
      for (int n = 0; n < 4; n++) {
        const int col = nt * 128 + wc * 64 + n * 16 + fr;
        const int row4 = mt * 256 + wr * 64 + m * 16 + fq * 4;
        const bf16_t* gp = p.GA + (size_t)row4 * 1024 + col;
        bf16_t* mp = p.MER + (size_t)row4 * 1024 + col;
        mp[0] = f2bf(acc[m][n][0] * bf2f(gp[0]));
        mp[1024] = f2bf(acc[m][n][1] * bf2f(gp[1024]));
        mp[2048] = f2bf(acc[m][n][2] * bf2f(gp[2048]));
        mp[3072] = f2bf(acc[m][n][3] * bf2f(gp[3072]));
      }
    zero_acc(acc);
    gemm_tile(p.YB + (size_t)mt * 256 * 512, 512, p.Wt_b + (size_t)nt * 128 * 512, 512, 512,
              p.YA + (size_t)nmt * 256 * 512, 512, p.Wt_a + (size_t)nnt * 128 * 512, 512, hn, smem, acc, cur);
#pragma unroll
    for (int m = 0; m < 4; m++)
#pragma unroll
      for (int n = 0; n < 4; n++) {
        const int col = nt * 128 + wc * 64 + n * 16 + fr;
        const int row4 = mt * 256 + wr * 64 + m * 16 + fq * 4;
        const bf16_t* gp = p.GB + (size_t)row4 * 1024 + col;
        bf16_t* mp = p.MER + (size_t)row4 * 1024 + col;
        mp[0] = f2bf(bf2f(mp[0]) + acc[m][n][0] * bf2f(gp[0]));
        mp[1024] = f2bf(bf2f(mp[1024]) + acc[m][n][1] * bf2f(gp[1024]));
        mp[2048] = f2bf(bf2f(mp[2048]) + acc[m][n][2] * bf2f(gp[2048]));
        mp[3072] = f2bf(bf2f(mp[3072]) + acc[m][n][3] * bf2f(gp[3072]));
      }
  }
}
__device__ __forceinline__ void phase_f(const Params& p, char* smem) {
  const int MT = 68, NT = 8;
  const int tid = launder_tid(), lane = tid & 63, w = tid >> 6, wr = w >> 1, wc = w & 1, fr = lane & 15, fq = lane >> 4;
  int cur = 0;
  {
    int mt0, nt0;
    tile_map(blockIdx.x, MT, NT, mt0, nt0);
    gemm_prologue(p.MER + (size_t)mt0 * 256 * 1024, 1024, p.Wt_out + (size_t)nt0 * 128 * 1024, 1024, smem, cur);
  }
  for (int tile = blockIdx.x; tile < MT * NT; tile += gridDim.x) {
    int mt, nt, nmt, nnt;
    tile_map(tile, MT, NT, mt, nt);
    const bool hn = tile + (int)gridDim.x < MT * NT;
    tile_map(hn ? tile + (int)gridDim.x : tile, MT, NT, nmt, nnt);
    f32x4 acc[4][4];
    zero_acc(acc);
    gemm_tile(p.MER + (size_t)mt * 256 * 1024, 1024, p.Wt_out + (size_t)nt * 128 * 1024, 1024, 1024,
              p.MER + (size_t)nmt * 256 * 1024, 1024, p.Wt_out + (size_t)nnt * 128 * 1024, 1024, hn, smem, acc, cur);
    const int seq = seq_of(mt * 256 + wr * 64);
#pragma unroll
    for (int n = 0; n < 4; n++) {
      const int col = nt * 128 + wc * 64 + n * 16 + fr;
      const float g1 = p.modf[seq * 6144 + 2048 + col];
#pragma unroll
      for (int m = 0; m < 4; m++) {
        const int row4 = mt * 256 + wr * 64 + m * 16 + fq * 4;
#pragma unroll
        for (int r = 0; r < 4; r++) {
          const int row = row4 + r;
          p.X1[(size_t)row * 1024 + col] = xrow(p, row)[col] + g1 * acc[m][n][r];
        }
      }
    }
  }
}
__device__ __forceinline__ void phase_h(const Params& p, char* smem) {
  const int MT = 68, NT = 44;
  const int tid = launder_tid(), lane = tid & 63, w = tid >> 6, wr = w >> 1, wc = w & 1, fr = lane & 15, fq = lane >> 4;
  int cur = 0;
  {
    int mt0, nt0;
    tile_map(blockIdx.x, MT, NT, mt0, nt0);
    gemm_prologue(p.U + (size_t)mt0 * 256 * 1024, 1024, p.Wt_gu + (size_t)nt0 * 128 * 1024, 1024, smem, cur);
  }
  for (int tile = blockIdx.x; tile < MT * NT; tile += gridDim.x) {
    int mt, nt, nmt, nnt;
    tile_map(tile, MT, NT, mt, nt);
    const bool hn = tile + (int)gridDim.x < MT * NT;
    tile_map(hn ? tile + (int)gridDim.x : tile, MT, NT, nmt, nnt);
    f32x4 acc[4][4];
    zero_acc(acc);
    gemm_tile(p.U + (size_t)mt * 256 * 1024, 1024, p.Wt_gu + (size_t)nt * 128 * 1024, 1024, 1024,
              p.U + (size_t)nmt * 256 * 1024, 1024, p.Wt_gu + (size_t)nnt * 128 * 1024, 1024, hn, smem, acc, cur);
#pragma unroll
    for (int m = 0; m < 4; m++)
#pragma unroll
      for (int n = 0; n < 2; n++) {
        const int f = nt * 64 + wc * 32 + n * 16 + fr;
        const int row4 = mt * 256 + wr * 64 + m * 16 + fq * 4;
#pragma unroll
        for (int r = 0; r < 4; r++)
          p.HFF[(size_t)(row4 + r) * 2816 + f] = f2bf(silu(acc[m][n][r]) * acc[m][n + 2][r]);
      }
  }
}
__device__ __forceinline__ void phase_i(const Params& p, char* smem) {
  const int MT = 68, NT = 8;
  const int tid = launder_tid(), lane = tid & 63, w = tid >> 6, wr = w >> 1, wc = w & 1, fr = lane & 15, fq = lane >> 4;
  int cur = 0;
  {
    int mt0, nt0;
    tile_map(blockIdx.x, MT, NT, mt0, nt0);
    gemm_prologue(p.HFF + (size_t)mt0 * 256 * 2816, 2816, p.Wt_down + (size_t)nt0 * 128 * 2816, 2816, smem, cur);
  }
  for (int tile = blockIdx.x; tile < MT * NT; tile += gridDim.x) {
    int mt, nt, nmt, nnt;
    tile_map(tile, MT, NT, mt, nt);
    const bool hn = tile + (int)gridDim.x < MT * NT;
    tile_map(hn ? tile + (int)gridDim.x : tile, MT, NT, nmt, nnt);
    f32x4 acc[4][4];
    zero_acc(acc);
    gemm_tile(p.HFF + (size_t)mt * 256 * 2816, 2816, p.Wt_down + (size_t)nt * 128 * 2816, 2816, 2816,
              p.HFF + (size_t)nmt * 256 * 2816, 2816, p.Wt_down + (size_t)nnt * 128 * 2816, 2816, hn, smem, acc, cur);
    const int seq = seq_of(mt * 256 + wr * 64);
#pragma unroll
    for (int n = 0; n < 4; n++) {
      const int col = nt * 128 + wc * 64 + n * 16 + fr;
      const float g2 = p.modf[seq * 6144 + 5120 + col];
#pragma unroll
      for (int m = 0; m < 4; m++) {
        const int row4 = mt * 256 + wr * 64 + m * 16 + fq * 4;
#pragma unroll
        for (int r = 0; r < 4; r++) {
          float* px = p.X1 + (size_t)(row4 + r) * 1024 + col;
          *px = *px + g2 * acc[m][n][r];
        }
      }
    }
  }
}
__device__ __forceinline__ void phase_j(const Params& p) {
  const int tid = launder_tid(), lane = tid & 63, w = tid >> 6;
  for (int g = blockIdx.x * 8 + w; g < kT / 4; g += gridDim.x * 8) {
    float4 v[4][4];
#pragma unroll
    for (int i = 0; i < 4; i++)
#pragma unroll
      for (int j = 0; j < 4; j++) v[i][j] = *(const float4*)(p.X1 + (size_t)(g * 4 + i) * 1024 + j * 256 + lane * 4);
#pragma unroll
    for (int i = 0; i < 4; i++) {
      const int row = g * 4 + i;
      float ss = 0.f;
#pragma unroll
      for (int j = 0; j < 4; j++)
        ss += v[i][j].x * v[i][j].x + v[i][j].y * v[i][j].y + v[i][j].z * v[i][j].z + v[i][j].w * v[i][j].w;
      ss = wave_sum(ss);
      float rstd = rsqrtf(ss * (1.0f / 1024.0f) + 1e-6f);
      float* o = p.out + (row < kNP ? O_YP + (size_t)row * 1024 : O_YS + (size_t)(row - kNP) * 1024);
#pragma unroll
      for (int j = 0; j < 4; j++) {
        int c = j * 256 + lane * 4;
        float4 gg = *(const float4*)(p.final_g + c);
        float4 r4;
        r4.x = v[i][j].x * rstd * gg.x;
        r4.y = v[i][j].y * rstd * gg.y;
        r4.z = v[i][j].z * rstd * gg.z;
        r4.w = v[i][j].w * rstd * gg.w;
        *(float4*)(o + c) = r4;
      }
    }
  }
}

#define XB_TMO      128
#define XB_XCNT(j)  (256  + 64 * (j))
#define XB_XSUB(j)  (1280 + 64 * (j))
#define XB_XGEN(j)  (2304 + 64 * (j))
#define XB_TOP      3328
#define XB_TOPGEN   3392
#define XCD_BAR_WORDS 3456
#define XB_SPIN_CAP (1u << 18)
#define LAS __attribute__((address_space(3)))

__device__ __forceinline__ unsigned xb_ld(unsigned* p)              { return __hip_atomic_load(p, __ATOMIC_RELAXED, __HIP_MEMORY_SCOPE_AGENT); }
__device__ __forceinline__ unsigned xb_add(unsigned* p, unsigned v) { return __hip_atomic_fetch_add(p, v, __ATOMIC_RELAXED, __HIP_MEMORY_SCOPE_AGENT); }
__device__ __forceinline__ unsigned xb_xcc_id() { return (unsigned)__builtin_amdgcn_s_getreg((3 << 11) | 20) & 0xFu; }
#define XB_SPIN(cond, bar) do { unsigned _sp = 0; while (cond) { __builtin_amdgcn_s_sleep(1); \
    if ((++_sp & 255u) == 0u) { if (xb_ld(&(bar)[XB_TMO])) break; if (_sp > XB_SPIN_CAP) { atomicAdd(&(bar)[XB_TMO], 1u); break; } } } } while (0)

struct XcdBarrier {
    unsigned* bar; unsigned x;
    volatile LAS unsigned* st;
};

__device__ __forceinline__ XcdBarrier xcd_barrier_post(unsigned* bar, volatile LAS unsigned* st) {
    XcdBarrier b; b.bar = bar; b.x = xb_xcc_id(); b.st = st;
    if (threadIdx.x == 0) (void)xb_add(&bar[XB_XCNT(b.x)], 1u);
    return b;
}
__device__ __forceinline__ void xcd_barrier_complete(unsigned* bar, unsigned x, unsigned& nloc, unsigned& nx) {
    const unsigned G = gridDim.x * gridDim.y * gridDim.z;
    unsigned sum, cnt, mine, sp = 0u;
    for (;;) {
        sum = 0u; cnt = 0u; mine = 0u;
#pragma unroll
        for (unsigned j = 0; j < 16; ++j) { const unsigned c = xb_ld(&bar[XB_XCNT(j)]); sum += c; cnt += (c > 0u) ? 1u : 0u; mine = (j == x) ? c : mine; }
        if (sum == G) break;
        __builtin_amdgcn_s_sleep(1);
        if ((++sp & 255u) == 0u) { if (xb_ld(&bar[XB_TMO])) break; if (sp > XB_SPIN_CAP) { atomicAdd(&bar[XB_TMO], 1u); break; } }
    }
    nloc = mine > 0u ? mine : 1u; nx = cnt > 0u ? cnt : 1u;
}

__device__ __forceinline__ void xcd_barrier(const XcdBarrier& b) {
    asm volatile("s_waitcnt vmcnt(0)" ::: "memory");
    __syncthreads();
    if (threadIdx.x == 0) {
        unsigned* bar = b.bar;
        __builtin_amdgcn_s_waitcnt(0);
        unsigned nloc = b.st[0], nx = b.st[1];
        if (nloc == 0u) { xcd_barrier_complete(bar, b.x, nloc, nx); b.st[0] = nloc; b.st[1] = nx; }
        const unsigned old = xb_add(&bar[XB_XSUB(b.x)], 1u);
        const unsigned gen = old / nloc;
        if (old + 1u == (gen + 1u) * nloc) {
            __builtin_amdgcn_fence(__ATOMIC_RELEASE, "agent");
            asm volatile("s_waitcnt vmcnt(0)" ::: "memory");
            const unsigned og = xb_add(&bar[XB_TOP], 1u);
            const unsigned tg = og / nx;
            if (og + 1u == (tg + 1u) * nx) xb_add(&bar[XB_TOPGEN], 1u);
            else XB_SPIN(xb_ld(&bar[XB_TOPGEN]) == tg, bar);
            __builtin_amdgcn_fence(__ATOMIC_ACQUIRE, "agent");
            xb_add(&bar[XB_XGEN(b.x)], 1u);
            asm volatile("s_waitcnt vmcnt(0)" ::: "memory");
        } else {
            XB_SPIN(xb_ld(&bar[XB_XGEN(b.x)]) == gen, bar);
            __builtin_amdgcn_fence(__ATOMIC_ACQUIRE, "agent");
            asm volatile("s_waitcnt vmcnt(0)" ::: "memory");
        }
    }
    __syncthreads();
}


extern __shared__ __attribute__((aligned(16))) char dyn_smem[];

#ifndef REP_A
#define REP_A 1
#endif
#ifndef REP_C
#define REP_C 1
#endif
#ifndef REP_D
#define REP_D 1
#endif
#ifndef REP_H
#define REP_H 1
#endif
#ifndef REP_E
#define REP_E 1
#endif
__global__ void __launch_bounds__(NTHREADS) mega_kernel(Params p) {
  cg::grid_group grid = cg::this_grid();
  volatile LAS unsigned* xst = (volatile LAS unsigned*)(dyn_smem + LDS_BYTES - 32);
  if (threadIdx.x < 4) xst[threadIdx.x] = 0u;
  __syncthreads();
  XcdBarrier xb = xcd_barrier_post(p.bar, xst);
#pragma unroll 1
  for (int r = 0; r < REP_A; r++) {
    phase_a(p, dyn_smem);
    grid.sync();
  }
  phase_b(p, dyn_smem);
  xcd_barrier(xb);
#pragma unroll 1
  for (int r = 0; r < REP_C; r++) {
    phase_c(p, dyn_smem);
    xcd_barrier(xb);
  }
  phase_d0(p, dyn_smem);
  xcd_barrier(xb);
#pragma unroll 1
  for (int r = 0; r < REP_D; r++) {
    phase_d(p, dyn_smem, r);
    xcd_barrier(xb);
  }
#pragma unroll 1
  for (int r = 0; r < REP_E; r++) {
    phase_e(p, dyn_smem);
    xcd_barrier(xb);
  }
  phase_f(p, dyn_smem);
  xcd_barrier(xb);
  phase_g(p, dyn_smem);
  xcd_barrier(xb);
#pragma unroll 1
  for (int r = 0; r < REP_H; r++) {
    phase_h(p, dyn_smem);
    xcd_barrier(xb);
  }
  phase_i(p, dyn_smem);
  xcd_barrier(xb);
  phase_j(p);
}
extern "C" void kernel_launch(void* const* d_in, const int* in_sizes, int n_in, void* d_out, int out_size, void* d_ws,
                              size_t ws_size, hipStream_t stream) {
  Params p{};
  const float** pin = (const float**)&p;
  for (int i = 0; i < 26; i++) pin[i] = (const float*)d_in[i];
  p.out = (float*)d_out;
  char* ws = (char*)d_ws;
  size_t off = 0;
  auto alloc = [&](size_t bytes) {
    char* r = ws + off;
    off += (bytes + 255) & ~(size_t)255;
    return r;
  };
  p.Wt_in = (bf16_t*)alloc((size_t)5632 * 1024 * 2);
  p.Wt_a = (bf16_t*)alloc((size_t)1024 * 512 * 2);
  p.Wt_b = (bf16_t*)alloc((size_t)1024 * 512 * 2);
  p.Wt_out = (bf16_t*)alloc((size_t)1024 * 1024 * 2);
  p.Wt_gu = (bf16_t*)alloc((size_t)5632 * 1024 * 2);
  p.Wt_down = (bf16_t*)alloc((size_t)1024 * 2816 * 2);
  p.wg = (float*)alloc(8192 * 4);
  p.modp = (float*)alloc((size_t)8 * 24 * 6144 * 4);
  p.modf = (float*)alloc((size_t)24 * 6144 * 4);
  p.U = (bf16_t*)alloc((size_t)kT * 1024 * 2);
  p.Qb = (bf16_t*)alloc((size_t)kT * 512 * 2);
  p.Kp = (bf16_t*)alloc((size_t)64 * 2048 * 64 * 2);
  p.Ks = (bf16_t*)alloc((size_t)128 * 1152 * 64 * 2);
  p.VTp = (bf16_t*)alloc((size_t)64 * 64 * 2048 * 2);
  p.VTs = (bf16_t*)alloc((size_t)128 * 64 * 1152 * 2);
  p.MQK = (bf16_t*)alloc((size_t)kT * 1024 * 2);
  p.MVTp = (bf16_t*)alloc((size_t)32 * 128 * 2048 * 2);
  p.MVTs = (bf16_t*)alloc((size_t)64 * 128 * 64 * 2);
  p.SO = (bf16_t*)alloc((size_t)kT * 512 * 2);
  p.GA = (bf16_t*)alloc((size_t)kT * 1024 * 2);
  p.GB = (bf16_t*)alloc((size_t)kT * 1024 * 2);
  p.GI = (float*)alloc((size_t)kT * 4 * 4);
  p.LF = (float*)alloc((size_t)kT * 4 * 4);
  p.GV = (float*)alloc((size_t)1088 * 384 * 4);
  p.DENc = (float*)alloc((size_t)1088 * 64 * 4);
  p.Qc = (bf16_t*)alloc((size_t)1088 * 8192 * 2);
  p.KTc = (bf16_t*)alloc((size_t)1088 * 8192 * 2);
  p.SWc = (bf16_t*)alloc((size_t)1088 * 4096 * 2);
  p.YA = (bf16_t*)alloc((size_t)kT * 512 * 2);
  p.YB = (bf16_t*)alloc((size_t)kT * 512 * 2);
  p.MER = (bf16_t*)alloc((size_t)kT * 1024 * 2);
  p.X1 = (float*)alloc((size_t)kT * 1024 * 4);
  p.HFF = (bf16_t*)alloc((size_t)kT * 2816 * 2);
  p.counter = (unsigned*)alloc(256);
  p.bar = (unsigned*)alloc(XCD_BAR_WORDS * 4);

#if ONE_LAUNCH
  static int grid_blocks = 0;
  if (!grid_blocks) {
    int dev = 0, cus = 0, per_cu = 0;
    hipGetDevice(&dev);
    hipDeviceGetAttribute(&cus, hipDeviceAttributeMultiprocessorCount, dev);
    hipFuncSetAttribute((const void*)mega_kernel, hipFuncAttributeMaxDynamicSharedMemorySize, LDS_BYTES);
    hipOccupancyMaxActiveBlocksPerMultiprocessor(&per_cu, mega_kernel, NTHREADS, LDS_BYTES);
    if (per_cu < 1) per_cu = 1;
    grid_blocks = cus * per_cu;
  }
  (void)hipMemsetAsync(p.bar, 0, XCD_BAR_WORDS * 4, stream);
  void* args[] = {&p};
  hipError_t e = hipLaunchCooperativeKernel((void*)mega_kernel, dim3(grid_blocks), dim3(NTHREADS), args, LDS_BYTES, stream);
  if (e != hipSuccess) fprintf(stderr, "cooperative launch failed: %s (grid %d)\n", hipGetErrorString(e), grid_blocks);
#endif
}
```

```cpp
#include <hip/hip_runtime.h>
#include <hip/hip_cooperative_groups.h>
#include <stdint.h>
#include <stdio.h>
namespace cg = cooperative_groups;

#ifndef ONE_LAUNCH
#define ONE_LAUNCH 1
#endif

typedef unsigned short bf16_t;
using bf16x8 = __attribute__((ext_vector_type(8))) short;
using f32x4 = __attribute__((ext_vector_type(4))) float;

#define NTHREADS 512
#define LDS_BYTES 155648
constexpr int kNP = 16384;
constexpr int kT = 17408;
constexpr int kINW = 5640;

struct Params {
  const float *x_prompt, *x_sample, *c_prompt, *c_sample, *cache_k, *cache_v, *st_C, *st_n, *st_m, *st_conv;
  const float *norm1_g, *norm2_g, *w_ada, *b_ada, *w_in, *b_if, *w_conv, *b_conv, *ml_norm_g, *w_a, *w_b, *w_out,
      *w_gate, *w_up, *w_down, *final_g;
  float* out;
  bf16_t *Wt_in, *Wt_a, *Wt_b, *Wt_out, *Wt_gu, *Wt_down;
  float *wg, *modp, *modf;
  bf16_t *U, *Qb, *Kp, *Ks, *VTp, *VTs, *MQK, *MVTp, *MVTs, *SO, *GA, *GB;
  float *GI, *LF, *GV, *DENc;
  bf16_t *Qc, *KTc, *SWc;
  bf16_t *YA, *YB, *MER;
  float* X1;
  bf16_t* HFF;
  unsigned* counter;
  unsigned* bar;
};

constexpr size_t O_YP = 0;
constexpr size_t O_YS = O_YP + 16777216;
constexpr size_t O_KP = O_YS + 1048576;
constexpr size_t O_VP = O_KP + 8388608;
constexpr size_t O_CP = O_VP + 8388608;
constexpr size_t O_NP = O_CP + 524288;
constexpr size_t O_MP = O_NP + 4096;
constexpr size_t O_CVP = O_MP + 32;
constexpr size_t O_KS = O_CVP + 24576;
constexpr size_t O_VS = O_KS + 524288;
constexpr size_t O_CS = O_VS + 524288;
constexpr size_t O_NS = O_CS + 1048576;
constexpr size_t O_MS = O_NS + 8192;
constexpr size_t O_CVS = O_MS + 64;

typedef __bf16 hwbf16x2_t __attribute__((ext_vector_type(2)));
typedef float hwf32x2_t __attribute__((ext_vector_type(2)));
__device__ __forceinline__ bf16_t f2bf(float f) {
  __bf16 r = (__bf16)f;
  return __builtin_bit_cast(unsigned short, r);
}
__device__ __forceinline__ float bf2f(bf16_t h) { return __uint_as_float(((unsigned)h) << 16); }
__device__ __forceinline__ unsigned pack2(float a, float b) {
  hwf32x2_t v = {a, b};
  hwbf16x2_t r = __builtin_convertvector(v, hwbf16x2_t);
  return __builtin_bit_cast(unsigned, r);
}
__device__ __forceinline__ float sigm(float x) { return __builtin_amdgcn_rcpf(1.0f + __expf(-x)); }
__device__ __forceinline__ float silu(float x) { return x * __builtin_amdgcn_rcpf(1.0f + __expf(-x)); }
__device__ __forceinline__ float logsig(float x) { return fminf(x, 0.f) - __logf(1.0f + __expf(-fabsf(x))); }
__device__ __forceinline__ float wave_sum(float v) {
#pragma unroll
  for (int o = 32; o > 0; o >>= 1) v += __shfl_xor(v, o);
  return v;
}
__device__ __forceinline__ float wave_max(float v) {
#pragma unroll
  for (int o = 32; o > 0; o >>= 1) v = fmaxf(v, __shfl_xor(v, o));
  return v;
}
__device__ __forceinline__ int seq_of(int row) { return row < kNP ? (row >> 11) : 8 + ((row - kNP) >> 6); }
__device__ __forceinline__ const float* xrow(const Params& p, int row) {
  return row < kNP ? p.x_prompt + (size_t)row * 1024 : p.x_sample + (size_t)(row - kNP) * 1024;
}
__device__ __forceinline__ int launder_tid() {
  int t = threadIdx.x;
  asm volatile("" : "+v"(t));
  return t;
}
__device__ __forceinline__ bf16x8 lds8(const void* p) { return *(const bf16x8*)p; }
#define MFMA(a, b, c) __builtin_amdgcn_mfma_f32_16x16x32_bf16(a, b, c, 0, 0, 0)

__device__ __forceinline__ void glds16(const void* g, void* l) {
  __builtin_amdgcn_global_load_lds((const unsigned*)g, (unsigned*)l, 16, 0, 0);
}
__device__ __forceinline__ void gemm_stage(const bf16_t* __restrict__ A, int lda, const bf16_t* __restrict__ B, int ldb,
                                           int k0, char* st) {
  const int tid = launder_tid();
#pragma unroll
  for (int i = 0; i < 4; i++) {
    int b = tid + i * 512;
    int row = b >> 3;
    int ch = (b & 7) ^ ((row >> 1) & 7);
    glds16(A + (size_t)row * lda + k0 + ch * 8, st + b * 16);
  }
#pragma unroll
  for (int i = 0; i < 2; i++) {
    int b = tid + i * 512;
    int row = b >> 3;
    int ch = (b & 7) ^ ((row >> 1) & 7);
    glds16(B + (size_t)row * ldb + k0 + ch * 8, st + 32768 + b * 16);
  }
}
__device__ __forceinline__ void gemm_prologue(const bf16_t* __restrict__ A, int lda, const bf16_t* __restrict__ B, int ldb,
                                              char* smem, int& cur) {
  __syncthreads();
  cur = 0;
  gemm_stage(A, lda, B, ldb, 0, smem);
  gemm_stage(A, lda, B, ldb, 64, smem + 49152);
}
template <bool BATCH = true>
__device__ __forceinline__ void gemm_tile(const bf16_t* __restrict__ A, int lda, const bf16_t* __restrict__ B, int ldb,
                                          int K, const bf16_t* __restrict__ nA, int nlda, const bf16_t* __restrict__ nB,
                                          int nldb, bool has_next, char* smem, f32x4 (&acc)[4][4], int& cur) {
  const int tid = launder_tid(), lane = tid & 63, w = tid >> 6, wr = w >> 1, wc = w & 1;
  const int fr = lane & 15, fq = lane >> 4;
  const int nt = K >> 6;
  for (int t = 0; t < nt; t++) {
    if (t == 0) asm volatile("s_waitcnt vmcnt(0)" ::: "memory");
    else if (t + 1 < nt || has_next) asm volatile("s_waitcnt vmcnt(6)" ::: "memory");
    else asm volatile("s_waitcnt vmcnt(0)" ::: "memory");
    __builtin_amdgcn_s_barrier();
    asm volatile("" ::: "memory");
    {
      int nxt = cur + 2;
      if (nxt >= 3) nxt -= 3;
      if (t + 2 < nt) gemm_stage(A, lda, B, ldb, (t + 2) << 6, smem + nxt * 49152);
      else if (has_next) gemm_stage(nA, nlda, nB, nldb, (t + 2 - nt) << 6, smem + nxt * 49152);
    }
    const char* sa = smem + cur * 49152;
    cur = (cur == 2) ? 0 : cur + 1;
    const char* sb = sa + 32768;
    if (BATCH) {
      bf16x8 af[2][4], bfr[2][4];
#pragma unroll
      for (int ks = 0; ks < 2; ks++) {
        const int ch = ((ks * 4 + fq) ^ ((fr >> 1) & 7)) * 16;
#pragma unroll
        for (int m = 0; m < 4; m++) af[ks][m] = lds8(sa + (wr * 64 + m * 16 + fr) * 128 + ch);
#pragma unroll
        for (int n = 0; n < 4; n++) bfr[ks][n] = lds8(sb + (wc * 64 + n * 16 + fr) * 128 + ch);
      }
      __builtin_amdgcn_s_setprio(1);
#pragma unroll
      for (int ks = 0; ks < 2; ks++) {
#pragma unroll
        for (int m = 0; m < 4; m++)
#pragma unroll
          for (int n = 0; n < 4; n++) acc[m][n] = MFMA(af[ks][m], bfr[ks][n], acc[m][n]);
      }
      __builtin_amdgcn_s_setprio(0);
    } else {
#pragma unroll
      for (int ks = 0; ks < 2; ks++) {
        bf16x8 af[4], bfr[4];
        const int ch = ((ks * 4 + fq) ^ ((fr >> 1) & 7)) * 16;
#pragma unroll
        for (int m = 0; m < 4; m++) af[m] = lds8(sa + (wr * 64 + m * 16 + fr) * 128 + ch);
#pragma unroll
        for (int n = 0; n < 4; n++) bfr[n] = lds8(sb + (wc * 64 + n * 16 + fr) * 128 + ch);
#pragma unroll
        for (int m = 0; m < 4; m++)
#pragma unroll
          for (int n = 0; n < 4; n++) acc[m][n] = MFMA(af[m], bfr[n], acc[m][n]);
      }
    }
  }
}
__device__ __forceinline__ void gemm256_stage(const bf16_t* __restrict__ A, int lda, const bf16_t* __restrict__ B, int ldb,
                                              int k0, char* st) {
  const int tid = threadIdx.x;
#pragma unroll
  for (int i = 0; i < 4; i++) {
    int b = tid + i * 512;
    int row = b >> 3;
    int ch = (b & 7) ^ ((row >> 1) & 7);
    glds16(A + (size_t)row * lda + k0 + ch * 8, st + b * 16);
  }
#pragma unroll
  for (int i = 0; i < 4; i++) {
    int b = tid + i * 512;
    int row = b >> 3;
    int ch = (b & 7) ^ ((row >> 1) & 7);
    glds16(B + (size_t)row * ldb + k0 + ch * 8, st + 32768 + b * 16);
  }
}
__device__ __forceinline__ void gemm256_prologue(const bf16_t* __restrict__ A, int lda, const bf16_t* __restrict__ B,
                                                 int ldb, char* smem, int& cur) {
  __syncthreads();
  cur = 0;
  gemm256_stage(A, lda, B, ldb, 0, smem);
}
__device__ __forceinline__ void gemm256_tile(const bf16_t* __restrict__ A, int lda, const bf16_t* __restrict__ B, int ldb,
                                             int K, const bf16_t* __restrict__ nA, int nlda,
                                             const bf16_t* __restrict__ nB, int nldb, bool has_next, char* smem,
                                             f32x4 (&acc)[8][4], int& cur) {
  const int tid = launder_tid(), lane = tid & 63, w = tid >> 6, wr = w >> 2, wc = w & 3;
  const int fr = lane & 15, fq = lane >> 4;
  const int nt = K >> 6;
  asm volatile("" : "+s"(A), "+s"(B), "+s"(nA), "+s"(nB), "+s"(lda), "+s"(ldb), "+s"(nlda), "+s"(nldb));
  for (int t = 0; t < nt; t++) {
    asm volatile("s_waitcnt vmcnt(0)" ::: "memory");
    __builtin_amdgcn_s_barrier();
    asm volatile("" ::: "memory");
    {
      char* nb = smem + (cur ^ 1) * 65536;
      if (t + 1 < nt) gemm256_stage(A, lda, B, ldb, (t + 1) << 6, nb);
      else if (has_next) gemm256_stage(nA, nlda, nB, nldb, 0, nb);
    }
    const char* sa = smem + cur * 65536;
    const char* sb = sa + 32768;
    cur ^= 1;
#pragma unroll
    for (int ks = 0; ks < 2; ks++) {
      bf16x8 bfr[4];
      const int ch = ((ks * 4 + fq) ^ ((fr >> 1) & 7)) * 16;
#pragma unroll
      for (int n = 0; n < 4; n++) bfr[n] = lds8(sb + (wc * 64 + n * 16 + fr) * 128 + ch);
#pragma unroll
      for (int mh = 0; mh < 2; mh++) {
        bf16x8 af[4];
#pragma unroll
        for (int m = 0; m < 4; m++) af[m] = lds8(sa + (wr * 128 + mh * 64 + m * 16 + fr) * 128 + ch);
#pragma unroll
        for (int m = 0; m < 4; m++)
#pragma unroll
          for (int n = 0; n < 4; n++) acc[mh * 4 + m][n] = MFMA(af[m], bfr[n], acc[mh * 4 + m][n]);
      }
    }
  }
}
__device__ __forceinline__ void tile_map(int tile, int MT, int NT, int& mt, int& nt) {
  int per = 8 * NT;
  int g = tile / per, r = tile - g * per;
  int gsz = min(8, MT - g * 8);
  mt = g * 8 + r % gsz;
  nt = r / gsz;
}
__device__ __forceinline__ void zero_acc(f32x4 (&acc)[4][4]) {
#pragma unroll
  for (int m = 0; m < 4; m++)
#pragma unroll
    for (int n = 0; n < 4; n++) acc[m][n] = (f32x4){0.f, 0.f, 0.f, 0.f};
}

__device__ __forceinline__ void transpose_quad(const float* __restrict__ src, int lds_, size_t sstep, bf16_t* __restrict__ dst, int ldd,
                               int k0, int kstep, int nbase, int nstep, int mode, char* smem) {
  float* tl = (float*)smem;
  const int tid = launder_tid();
  float4 v[4][2];
#pragma unroll
  for (int q = 0; q < 4; q++)
#pragma unroll
    for (int i = 0; i < 2; i++) {
      int idx = tid + i * 512;
      int k = idx >> 4, n4 = (idx & 15) * 4;
      v[q][i] = *(const float4*)(src + q * sstep + (size_t)k * lds_ + n4);
    }
  __syncthreads();
#pragma unroll
  for (int q = 0; q < 4; q++)
#pragma unroll
    for (int i = 0; i < 2; i++) {
      int idx = tid + i * 512;
      int k = idx >> 4, n4 = (idx & 15) * 4;
      float* t = tl + q * 4160 + k * 65 + n4;
      t[0] = v[q][i].x;
      t[1] = v[q][i].y;
      t[2] = v[q][i].z;
      t[3] = v[q][i].w;
    }
  __syncthreads();
  const int n = tid >> 3, kc = (tid & 7) * 8;
#pragma unroll
  for (int q = 0; q < 4; q++) {
    float o[8];
#pragma unroll
    for (int e = 0; e < 8; e++) o[e] = tl[q * 4160 + (kc + e) * 65 + n];
    const int nb = nbase + q * nstep;
    const int nrow = (mode == 0) ? (nb + n) : (nb + (n >> 5) * 64 + (n & 31));
    uint4 pk = {pack2(o[0], o[1]), pack2(o[2], o[3]), pack2(o[4], o[5]), pack2(o[6], o[7])};
    *(uint4*)(dst + (size_t)nrow * ldd + k0 + q * kstep + kc) = pk;
  }
}

constexpr int A_MOD = 96;
constexpr int A_WT = 1008;
constexpr int A_VC = 512;
constexpr int A_KC = 256;
constexpr int A_PAD = 128;
constexpr int A_MISC = 1;
constexpr int A_TOTAL = A_MOD + A_WT + A_VC + A_KC + A_PAD + A_MISC;

__device__ __forceinline__ void phase_a(const Params& p, char* smem) {
  const int tid = launder_tid();
  for (int task = blockIdx.x; task < A_TOTAL; task += gridDim.x) {
    int id = task;
    if (id < A_MOD) {
      int cgp = id % 12, ks = id / 12;
      float* sc = (float*)smem;
      __syncthreads();
      for (int i = tid; i < 24 * 128; i += 512) {
        int s = i >> 7, kk = i & 127, k = ks * 128 + kk;
        float cv = s < 8 ? p.c_prompt[s * 1024 + k] : p.c_sample[(s - 8) * 1024 + k];
        sc[i] = silu(cv);
      }
      __syncthreads();
      int col = cgp * 512 + tid;
      float acc[24];
#pragma unroll
      for (int s = 0; s < 24; s++) acc[s] = 0.f;
      const float* wp = p.w_ada + (size_t)(ks * 128) * 6144 + col;
#pragma unroll 1
      for (int kb = 0; kb < 128; kb += 32) {
        float wv[32];
#pragma unroll
        for (int j = 0; j < 32; j++) wv[j] = wp[(size_t)(kb + j) * 6144];
#pragma unroll
        for (int j = 0; j < 32; j++)
#pragma unroll
          for (int s = 0; s < 24; s++) acc[s] += sc[s * 128 + kb + j] * wv[j];
      }
#pragma unroll
      for (int s = 0; s < 24; s++) p.modp[(size_t)(ks * 24 + s) * 6144 + col] = acc[s];
      continue;
    }
    id -= A_MOD;
    if (id < A_WT) {
      if (id < 352) {
        int kt = id / 22, nq = id % 22;
        int scol = nq < 14 ? nq * 256 : 3592 + (nq - 14) * 256;
        int drow = nq < 14 ? nq * 256 : 3584 + (nq - 14) * 256;
        transpose_quad(p.w_in + (size_t)kt * 64 * kINW + scol, kINW, 64, p.Wt_in, 1024, kt * 64, 0, drow, 64, 0, smem);
      } else if (id < 384) {
        int i2 = id - 352, kt = i2 / 4, nq = i2 % 4;
        transpose_quad(p.w_a + (size_t)kt * 64 * 1024 + nq * 256, 1024, 64, p.Wt_a, 512, kt * 64, 0, nq * 256, 64, 0, smem);
      } else if (id < 416) {
        int i2 = id - 384, kt = i2 / 4, nq = i2 % 4;
        transpose_quad(p.w_b + (size_t)kt * 64 * 1024 + nq * 256, 1024, 64, p.Wt_b, 512, kt * 64, 0, nq * 256, 64, 0, smem);
      } else if (id < 480) {
        int i2 = id - 416, kt = i2 / 4, nq = i2 % 4;
        transpose_quad(p.w_out + (size_t)kt * 64 * 1024 + nq * 256, 1024, 64, p.Wt_out, 1024, kt * 64, 0, nq * 256, 64, 0, smem);
      } else if (id < 656) {
        int i2 = id - 480, kt = i2 / 11, nq = i2 % 11;
        transpose_quad(p.w_gate + (size_t)kt * 64 * 2816 + nq * 256, 2816, 64, p.Wt_gu, 1024, kt * 64, 0, nq * 512, 128, 1, smem);
      } else if (id < 832) {
        int i2 = id - 656, kt = i2 / 11, nq = i2 % 11;
        transpose_quad(p.w_up + (size_t)kt * 64 * 2816 + nq * 256, 2816, 64, p.Wt_gu, 1024, kt * 64, 0, nq * 512 + 32, 128, 1, smem);
      } else {
        int i2 = id - 832, kt = i2 / 4, nq = i2 % 4;
        transpose_quad(p.w_down + (size_t)kt * 64 * 1024 + nq * 256, 1024, 64, p.Wt_down, 2816, kt * 64, 0, nq * 256, 64, 0, smem);
      }
      continue;
    }
    id -= A_WT;
    if (id < A_VC) {
      int bh = id >> 2, jq = id & 3;
      int b = bh >> 3, h = bh & 7;
      transpose_quad(p.cache_v + ((size_t)(b * 1024 + jq * 256) * 8 + h) * 64, 512, (size_t)64 * 512,
                     p.VTs + (size_t)bh * 64 * 1152, 1152, jq * 256, 64, 0, 0, 0, smem);
      continue;
    }
    id -= A_VC;
    if (id < A_KC) {
      int b = id >> 4, jb = id & 15;
#pragma unroll
      for (int it = 0; it < 8; it++) {
        int g = tid + it * 512;
        int j = g >> 6, col = (g & 63) * 8;
        int h = col >> 6, d = col & 63;
        const float* src = p.cache_k + ((size_t)(b * 1024 + jb * 64 + j)) * 512 + col;
        float4 v0 = *(const float4*)src, v1 = *(const float4*)(src + 4);
        uint4 o;
        o.x = pack2(v0.x, v0.y);
        o.y = pack2(v0.z, v0.w);
        o.z = pack2(v1.x, v1.y);
        o.w = pack2(v1.z, v1.w);
        *(uint4*)(p.Ks + ((size_t)((b * 8 + h) * 1152 + jb * 64 + j)) * 64 + d) = o;
      }
      continue;
    }
    id -= A_KC;
    if (id < A_PAD) {
      int bh = id;
      uint4 z = {0u, 0u, 0u, 0u};
      *(uint4*)(p.Ks + ((size_t)bh * 1152 + 1088) * 64 + tid * 8) = z;
      int d = tid >> 3, chn = tid & 7;
      *(uint4*)(p.VTs + ((size_t)bh * 64 + d) * 1152 + 1088 + chn * 8) = z;
      continue;
    }
    for (int i = tid; i < 8192; i += 512) {
      int g = i >> 10, k = i & 1023;
      p.wg[i] = p.w_in[(size_t)k * kINW + 3584 + g];
    }
    if (tid < 8) p.counter[tid] = 0u;
  }
}

__device__ __forceinline__ void norm_task(const Params& p, int task, int which, char* smem) {
  float* sm_scale = (float*)smem;
  float* sm_shift = sm_scale + 1024;
  const float* sm_wg = sm_shift + 1024;
  const int tid = launder_tid(), lane = tid & 63, w = tid >> 6;
  const int row0 = task * 32;
  const int seq = seq_of(row0);
  const float* g = which ? p.norm2_g : p.norm1_g;
  const int sh_off = which ? 3072 : 0, sc_off = which ? 4096 : 1024;
  __syncthreads();
  for (int c = tid; c < 1024; c += 512) {
    float sh, sc;
    if (which == 0) {
      sh = p.b_ada[sh_off + c];
      sc = p.b_ada[sc_off + c];
#pragma unroll
      for (int ks = 0; ks < 8; ks++) {
        sh += p.modp[(size_t)(ks * 24 + seq) * 6144 + sh_off + c];
        sc += p.modp[(size_t)(ks * 24 + seq) * 6144 + sc_off + c];
      }
    } else {
      sh = p.modf[seq * 6144 + sh_off + c];
      sc = p.modf[seq * 6144 + sc_off + c];
    }
    sm_scale[c] = g[c] * (1.0f + sc);
    sm_shift[c] = sh;
  }
  __syncthreads();
  float4 v[4][4];
#pragma unroll
  for (int i = 0; i < 4; i++) {
    const int row = row0 + w * 4 + i;
    const float* xr = which ? (p.X1 + (size_t)row * 1024) : xrow(p, row);
#pragma unroll
    for (int j = 0; j < 4; j++) v[i][j] = *(const float4*)(xr + j * 256 + lane * 4);
  }
#pragma unroll
  for (int i = 0; i < 4; i++) {
    const int row = row0 + w * 4 + i;
    float ss = 0.f;
#pragma unroll
    for (int j = 0; j < 4; j++)
      ss += v[i][j].x * v[i][j].x + v[i][j].y * v[i][j].y + v[i][j].z * v[i][j].z + v[i][j].w * v[i][j].w;
    ss = wave_sum(ss);
    float rstd = rsqrtf(ss * (1.0f / 1024.0f) + 1e-6f);
#pragma unroll
    for (int j = 0; j < 4; j++) {
      int c = j * 256 + lane * 4;
      float4 sc = *(const float4*)(sm_scale + c), sh = *(const float4*)(sm_shift + c);
      v[i][j].x = v[i][j].x * rstd * sc.x + sh.x;
      v[i][j].y = v[i][j].y * rstd * sc.y + sh.y;
      v[i][j].z = v[i][j].z * rstd * sc.z + sh.z;
      v[i][j].w = v[i][j].w * rstd * sc.w + sh.w;
      uint2 o;
      o.x = pack2(v[i][j].x, v[i][j].y);
      o.y = pack2(v[i][j].z, v[i][j].w);
      *(uint2*)(p.U + (size_t)row * 1024 + c) = o;
    }
    if (which == 0) {
      float gv[8];
#pragma unroll
      for (int gi = 0; gi < 8; gi++) {
        float a = 0.f;
#pragma unroll
        for (int j = 0; j < 4; j++) {
          float4 wv = *(const float4*)(sm_wg + gi * 1024 + j * 256 + lane * 4);
          a += v[i][j].x * wv.x + v[i][j].y * wv.y + v[i][j].z * wv.z + v[i][j].w * wv.w;
        }
        gv[gi] = wave_sum(a);
      }
      if (lane == 0) {
#pragma unroll
        for (int h = 0; h < 4; h++) {
          p.GI[row * 4 + h] = gv[h] + p.b_if[h];
          p.LF[row * 4 + h] = logsig(gv[4 + h] + p.b_if[4 + h]);
        }
      }
    }
  }
}
__device__ __forceinline__ void phase_b(const Params& p, char* smem) {
  const int NTASK = kT / 32;
  {
    float* swg = (float*)smem + 2048;
    for (int i = threadIdx.x; i < 8192; i += 512) swg[i] = p.w_in[(size_t)(i & 1023) * kINW + 3584 + (i >> 10)];
  }
  for (int task = blockIdx.x; task < NTASK + 288; task += gridDim.x) {
    if (task < NTASK) {
      norm_task(p, task, 0, smem);
    } else {
      int i = (task - NTASK) * 512 + threadIdx.x;
      int s = i / 6144, c = i - s * 6144;
      float a = p.b_ada[c];
#pragma unroll
      for (int ks = 0; ks < 8; ks++) a += p.modp[(size_t)(ks * 24 + s) * 6144 + c];
      p.modf[i] = a;
    }
  }
}
__device__ __forceinline__ void phase_g(const Params& p, char* smem) {
  for (int task = blockIdx.x; task < kT / 32; task += gridDim.x) norm_task(p, task, 1, smem);
}

__device__ __forceinline__ void gate_task(const Params& p, int seq, int h, char* smem);
__device__ __forceinline__ void phase_c(const Params& p, char* smem) {
  const int MT = 68, NT = 22;
  const int tid = launder_tid(), lane = tid & 63, w = tid >> 6, wr = w >> 2, wc = w & 3, fr = lane & 15, fq = lane >> 4;
  for (int item = blockIdx.x; item < 96; item += gridDim.x) {
    if (item < 32) gate_task(p, item >> 2, item & 3, smem);
    else gate_task(p, 8 + ((item - 32) >> 2), item & 3, smem);
  }
  int cur = 0;
  {
    int mt0, nt0;
    tile_map(blockIdx.x, MT, NT, mt0, nt0);
    gemm256_prologue(p.U + (size_t)mt0 * 256 * 1024, 1024, p.Wt_in + (size_t)nt0 * 256 * 1024, 1024, smem, cur);
  }
  for (int tile = blockIdx.x; tile < MT * NT; tile += gridDim.x) {
    int mt, nt, nmt, nnt;
    tile_map(tile, MT, NT, mt, nt);
    const bool hn = tile + (int)gridDim.x < MT * NT;
    tile_map(hn ? tile + (int)gridDim.x : tile, MT, NT, nmt, nnt);
    f32x4 acc[8][4];
#pragma unroll
    for (int m = 0; m < 8; m++)
#pragma unroll
      for (int n = 0; n < 4; n++) acc[m][n] = (f32x4){0.f, 0.f, 0.f, 0.f};
    gemm256_tile(p.U + (size_t)mt * 256 * 1024, 1024, p.Wt_in + (size_t)nt * 256 * 1024, 1024, 1024,
                 p.U + (size_t)nmt * 256 * 1024, 1024, p.Wt_in + (size_t)nnt * 256 * 1024, 1024, hn, smem, acc, cur);
#pragma unroll
    for (int mh = 0; mh < 2; mh++) {
    const int tid2 = launder_tid(), lane2 = tid2 & 63, w2 = tid2 >> 6;
    const int wr = w2 >> 2, wc = w2 & 3, fr = lane2 & 15, fq = lane2 >> 4;
    const int rbase = mt * 256 + wr * 128 + mh * 64;
    const int seq = seq_of(rbase);
    const bool isp = seq < 8;
    const int sb = seq - 8;
    const int srow0 = isp ? seq * 2048 : kNP + sb * 64;
    const int L = isp ? 2048 : 64;
    const int cbase = nt * 256 + wc * 64;
    const int tb = rbase - srow0;
#pragma unroll
    for (int m = 0; m < 4; m++) {
#pragma unroll
      for (int n = 0; n < 4; n++) {
        const int col = cbase + n * 16 + fr;
        const int t4 = tb + m * 16 + fq * 4;
        const int row4 = rbase + m * 16 + fq * 4;
        f32x4 v = acc[mh * 4 + m][n];
        if (cbase < 512) {
#pragma unroll
          for (int r = 0; r < 4; r++) p.Qb[(size_t)(row4 + r) * 512 + col] = f2bf(v[r]);
        } else if (cbase < 1024) {
          const int c = col - 512, h = c >> 6, d = c & 63;
          float* o = isp ? p.out + O_KP + (size_t)row4 * 512 + c : p.out + O_KS + (size_t)(row4 - kNP) * 512 + c;
          bf16_t* kb = isp ? p.Kp + ((size_t)(seq * 8 + h) * 2048 + t4) * 64 + d
                           : p.Ks + ((size_t)(sb * 8 + h) * 1152 + 1024 + t4) * 64 + d;
#pragma unroll
          for (int r = 0; r < 4; r++) {
            o[r * 512] = v[r];
            kb[r * 64] = f2bf(v[r]);
          }
        } else if (cbase < 1536) {
          const int c = col - 1024, h = c >> 6, d = c & 63;
          float* o = isp ? p.out + O_VP + (size_t)row4 * 512 + c : p.out + O_VS + (size_t)(row4 - kNP) * 512 + c;
#pragma unroll
          for (int r = 0; r < 4; r++) o[r * 512] = v[r];
          bf16_t* vt = isp ? p.VTp + ((size_t)(seq * 8 + h) * 64 + d) * 2048 + t4
                           : p.VTs + ((size_t)(sb * 8 + h) * 64 + d) * 1152 + 1024 + t4;
          uint2 pk;
          pk.x = pack2(v[0], v[1]);
          pk.y = pack2(v[2], v[3]);
          *(uint2*)vt = pk;
        } else if (cbase < 2560) {
          const int c = col - 1536;
#pragma unroll
          for (int r = 0; r < 4; r++) {
            p.MQK[(size_t)(row4 + r) * 1024 + c] = f2bf(v[r]);
            int t = t4 + r;
            if (t >= L - 3) {
              float* o = isp ? p.out + O_CVP + (size_t)(seq * 3 + (t - (L - 3))) * 1024 + c
                             : p.out + O_CVS + (size_t)(sb * 3 + (t - (L - 3))) * 1024 + c;
              *o = v[r];
            }
          }
        } else if (cbase < 3072) {
          const int c = col - 2560, h = c >> 7, d = c & 127;
          bf16_t* vt = isp ? p.MVTp + ((size_t)(seq * 4 + h) * 128 + d) * 2048 + t4
                           : p.MVTs + ((size_t)(sb * 4 + h) * 128 + d) * 64 + t4;
          uint2 pk;
          pk.x = pack2(v[0], v[1]);
          pk.y = pack2(v[2], v[3]);
          *(uint2*)vt = pk;
        } else if (cbase < 3584) {
          const int c = col - 3072;
#pragma unroll
          for (int r = 0; r < 4; r++) p.SO[(size_t)(row4 + r) * 512 + c] = f2bf(sigm(v[r]));
        } else if (cbase < 4608) {
          const int c = col - 3584;
#pragma unroll
          for (int r = 0; r < 4; r++) p.GA[(size_t)(row4 + r) * 1024 + c] = f2bf(sigm(v[r]));
        } else {
          const int c = col - 4608;
#pragma unroll
          for (int r = 0; r < 4; r++) p.GB[(size_t)(row4 + r) * 1024 + c] = f2bf(sigm(v[r]));
        }
      }
    }
    }
  }
}

__device__ __forceinline__ void lds_barrier() { asm volatile("s_waitcnt lgkmcnt(0)\n\ts_barrier" ::: "memory"); }
__device__ __forceinline__ void attn_task(const Params& p, int seq, int h, int qt, char* smem) {
  const int tid = launder_tid(), lane = tid & 63, w = tid >> 6, fr = lane & 15, fq = lane >> 4;
  const bool isp = seq < 8;
  const int sb = seq - 8;
  const int past = isp ? 0 : 1024;
  const int Tlen = isp ? 2048 : 1152;
  const int row0 = (isp ? seq * 2048 : kNP + sb * 64) + qt * 64;
  const int p0 = past + qt * 64;
  const bf16_t* Kb = isp ? p.Kp + (size_t)(seq * 8 + h) * 2048 * 64 : p.Ks + (size_t)(sb * 8 + h) * 1152 * 64;
  const bf16_t* VT = isp ? p.VTp + (size_t)(seq * 8 + h) * 64 * 2048 : p.VTs + (size_t)(sb * 8 + h) * 64 * 1152;
  bf16_t* sQ = (bf16_t*)smem;
  bf16_t* sK = sQ + 64 * 72;
  bf16_t* sVT = sK + 128 * 72;
  bf16_t* sP = sVT + 64 * 136;
  float* sZ = (float*)(sP + 64 * 136);
  int* sFlag = (int*)(sZ + 64 * 132);

  __syncthreads();
  {
    int r = tid >> 3, chn = tid & 7;
    uint4 q = *(const uint4*)(p.Qb + (size_t)(row0 + r) * 512 + h * 64 + chn * 8);
    *(uint4*)(sQ + r * 72 + chn * 8) = q;
  }
  const int kt_d = (p0 + 62) >> 7;
  const int ki0 = tid, ki1 = tid + 512;
  const bf16_t* kptr0 = Kb + (size_t)(ki0 >> 3) * 64 + (ki0 & 7) * 8;
  const bf16_t* kptr1 = Kb + (size_t)(ki1 >> 3) * 64 + (ki1 & 7) * 8;
  const bf16_t* vptr0 = VT + (size_t)(ki0 >> 4) * Tlen + (ki0 & 15) * 8;
  const bf16_t* vptr1 = VT + (size_t)(ki1 >> 4) * Tlen + (ki1 & 15) * 8;
  uint4 kr0 = *(const uint4*)(kptr0 + (size_t)kt_d * 8192);
  uint4 kr1 = *(const uint4*)(kptr1 + (size_t)kt_d * 8192);
  uint4 vr0 = *(const uint4*)(vptr0 + kt_d * 128);
  uint4 vr1 = *(const uint4*)(vptr1 + kt_d * 128);
  float R = 0.f;
  f32x4 oacc[2];
  oacc[0] = (f32x4){0.f, 0.f, 0.f, 0.f};
  oacc[1] = (f32x4){0.f, 0.f, 0.f, 0.f};
  const int mf = w & 3;
  for (int kt = kt_d; kt >= 0; kt--) {
    lds_barrier();
    *(uint4*)(sK + (ki0 >> 3) * 72 + (ki0 & 7) * 8) = kr0;
    *(uint4*)(sK + (ki1 >> 3) * 72 + (ki1 & 7) * 8) = kr1;
    *(uint4*)(sVT + (ki0 >> 4) * 136 + (ki0 & 15) * 8) = vr0;
    *(uint4*)(sVT + (ki1 >> 4) * 136 + (ki1 & 15) * 8) = vr1;
    if (tid == 0) *sFlag = 0;
    lds_barrier();
    if (kt > 0) {
      kr0 = *(const uint4*)(kptr0 + (size_t)(kt - 1) * 8192);
      kr1 = *(const uint4*)(kptr1 + (size_t)(kt - 1) * 8192);
      vr0 = *(const uint4*)(vptr0 + (kt - 1) * 128);
      vr1 = *(const uint4*)(vptr1 + (kt - 1) * 128);
    }
    {
      const int nf0 = (w >> 2) * 4;
      bf16x8 a0 = lds8(sQ + (mf * 16 + fr) * 72 + fq * 8);
      bf16x8 a1 = lds8(sQ + (mf * 16 + fr) * 72 + 32 + fq * 8);
#pragma unroll
      for (int n = 0; n < 4; n++) {
        bf16x8 b0 = lds8(sK + ((nf0 + n) * 16 + fr) * 72 + fq * 8);
        bf16x8 b1 = lds8(sK + ((nf0 + n) * 16 + fr) * 72 + 32 + fq * 8);
        f32x4 s = (f32x4){0.f, 0.f, 0.f, 0.f};
        s = MFMA(a0, b0, s);
        s = MFMA(a1, b1, s);
#pragma unroll
        for (int r = 0; r < 4; r++) sZ[(mf * 16 + fq * 4 + r) * 132 + (nf0 + n) * 16 + fr] = s[r] * 0.125f;
      }
    }
    lds_barrier();
    {
      const int row = tid >> 3, part = tid & 7;
      const int pos = p0 + row;
      const int j0 = kt * 128 + part * 16;
      float z[16], ls[16];
#pragma unroll
      for (int i4 = 0; i4 < 4; i4++) {
        float4 t4 = *(const float4*)(sZ + row * 132 + part * 16 + i4 * 4);
        z[i4 * 4 + 0] = t4.x;
        z[i4 * 4 + 1] = t4.y;
        z[i4 * 4 + 2] = t4.z;
        z[i4 * 4 + 3] = t4.w;
      }
      float run = 0.f;
      float tl[16];
#pragma unroll
      for (int i = 15; i >= 0; i--) {
        bool valid = (j0 + i) < pos;
        float l = valid ? -(fmaxf(z[i], 0.f) + __logf(1.0f + __expf(-fabsf(z[i])))) : 0.f;
        ls[i] = l;
        tl[i] = run;
        run += l;
      }
      float incl = run;
#pragma unroll
      for (int dlt = 1; dlt < 8; dlt <<= 1) {
        float t = __shfl_down(incl, dlt, 8);
        if (part + dlt < 8) incl += t;
      }
      float excl = incl - run;
      float tot = __shfl(incl, 0, 8);
      float base = R + excl;
      unsigned pk[8];
#pragma unroll
      for (int i = 0; i < 16; i += 2) {
        bool v0 = (j0 + i) < pos, v1 = (j0 + i + 1) < pos;
        float a0 = v0 ? __expf(z[i] + ls[i] + tl[i] + base) : 0.f;
        float a1 = v1 ? __expf(z[i + 1] + ls[i + 1] + tl[i + 1] + base) : 0.f;
        pk[i >> 1] = pack2(a0, a1);
      }
      *(uint4*)(sP + row * 136 + part * 16) = (uint4){pk[0], pk[1], pk[2], pk[3]};
      *(uint4*)(sP + row * 136 + part * 16 + 8) = (uint4){pk[4], pk[5], pk[6], pk[7]};
      R += tot;
      if (R > -110.f) *sFlag = 1;
    }
    lds_barrier();
    const int more = *sFlag;
    {
      const int nf0 = (w >> 2) * 2;
#pragma unroll
      for (int ks = 0; ks < 4; ks++) {
        bf16x8 a = lds8(sP + (mf * 16 + fr) * 136 + ks * 32 + fq * 8);
#pragma unroll
        for (int n = 0; n < 2; n++) {
          bf16x8 b = lds8(sVT + ((nf0 + n) * 16 + fr) * 136 + ks * 32 + fq * 8);
          oacc[n] = MFMA(a, b, oacc[n]);
        }
      }
    }
    if (!more) break;
  }
  {
    const int nf0 = (w >> 2) * 2;
#pragma unroll
    for (int n = 0; n < 2; n++)
#pragma unroll
      for (int r = 0; r < 4; r++)
        p.YA[(size_t)(row0 + mf * 16 + fq * 4 + r) * 512 + h * 64 + (nf0 + n) * 16 + fr] = f2bf(oacc[n][r]);
  }
}


__device__ __forceinline__ void gate_task(const Params& p, int seq, int h, char* smem) {
  const int tid = launder_tid(), lane = tid & 63, w = tid >> 6;
  const bool isp = seq < 8;
  const int sb = seq - 8;
  const int nchunks = isp ? 32 : 1;
  const int grow0 = isp ? seq * 2048 : kNP + sb * 64;
  float* gv = p.GV + (size_t)(isp ? (seq * 4 + h) * 32 : 1024 + sb * 4 + h) * 384;
  float* sBl = (float*)smem;
  float* sG = sBl + 32;
  float* sM = sG + 32;
  __syncthreads();
  float b_[4], as_[4], pm_[4], g_[4];
#pragma unroll
  for (int i = 0; i < 4; i++) {
    const int c = w + i * 8;
    b_[i] = 0.f; as_[i] = 0.f; pm_[i] = 0.f; g_[i] = 0.f;
    if (c < nchunks) {
      const int row = grow0 + c * 64 + lane;
      float li = p.GI[row * 4 + h], lf = p.LF[row * 4 + h];
      float b = lf;
#pragma unroll
      for (int d = 1; d < 64; d <<= 1) {
        float t_ = __shfl_up(b, d);
        if (lane >= d) b += t_;
      }
      float a_s = li - b;
      float pm = a_s;
#pragma unroll
      for (int d = 1; d < 64; d <<= 1) {
        float t_ = __shfl_up(pm, d);
        if (lane >= d) pm = fmaxf(pm, t_);
      }
      float blast = __shfl(b, 63);
      float g = blast - b + li;
      float G = wave_max(g);
      b_[i] = b; as_[i] = a_s; pm_[i] = pm; g_[i] = g;
      if (lane == 0) {
        sBl[c] = blast;
        sG[c] = G;
      }
    }
  }
  __syncthreads();
  if (tid == 0) {
    float m = isp ? 0.f : p.st_m[sb * 4 + h];
    for (int c = 0; c < nchunks; c++) {
      sM[c] = m;
      m = fmaxf(sBl[c] + m, sG[c]);
    }
    sM[nchunks] = m;
    if (isp) p.out[O_MP + seq * 4 + h] = m;
    else p.out[O_MS + sb * 4 + h] = m;
  }
  __syncthreads();
#pragma unroll
  for (int i = 0; i < 4; i++) {
    const int c = w + i * 8;
    if (c < nchunks) {
      const float m_run = sM[c], m_new = sM[c + 1];
      const float mt = b_[i] + fmaxf(m_run, pm_[i]);
      float* o = gv + (size_t)c * 384;
      o[lane] = b_[i] - mt;
      o[64 + lane] = as_[i];
      o[128 + lane] = __expf(b_[i] + m_run - mt);
      o[192 + lane] = __expf(g_[i] - m_new);
      o[256 + lane] = __expf(-mt);
      if (lane == 0) o[320] = __expf(sBl[c] + m_run - m_new);
    }
  }
}

__device__ __forceinline__ void mlpre_task(const Params& p, int seq, int h, int c, char* smem) {
  const bool isp = seq < 8;
  const int sb = seq - 8;
  const int grow0 = isp ? seq * 2048 : kNP + sb * 64;
  const int t0 = c * 64;
  const int cid = isp ? (seq * 4 + h) * 32 + c : 1024 + sb * 4 + h;
  bf16_t* sQ = (bf16_t*)smem;
  bf16_t* sK = sQ + 64 * 136;
  bf16_t* sKT = sK + 64 * 136;
  bf16_t* sSw = sKT + 128 * 72;
  float* sF = (float*)(sSw + 64 * 72);
  float* sV = sF;
  float* sDen = sF + 384;
  float* sCw = sF + 448;
  const float* sBt = sV;
  const float* sAs = sV + 64;
  const float* sWg = sV + 192;
  __syncthreads();
  uint4 xr0, xr1, xr2, xr3, xr4, xr5, xr6;
  {
    const int tid = launder_tid();
    for (int i = tid; i < 1280; i += 512) {
      int j = i >> 8, cc = i & 255;
      int gch = (cc >= 128 ? 512 : 0) + h * 128 + (cc & 127);
      sCw[i] = (j < 4) ? p.w_conv[j * 1024 + gch] : p.b_conv[gch];
    }
    if (tid < 384) sV[tid] = p.GV[(size_t)cid * 384 + tid];
    if (tid < 64) sDen[tid] = 0.f;
    const int rb_ = tid >> 5, cgp_ = tid & 31;
    const int ch_ = (cgp_ >= 16 ? 512 : 0) + h * 128 + (cgp_ & 15) * 8;
    const int tb0 = t0 + rb_ * 4 - 3;
    const bf16_t* xp = p.MQK + (size_t)(grow0 + tb0) * 1024 + ch_;
#define LDX(i, dst)                                                                                           \
  if (tb0 + i >= 0) dst = *(const uint4*)(xp + (size_t)i * 1024);                                             \
  else if (isp) dst = (uint4){0u, 0u, 0u, 0u};                                                                \
  else {                                                                                                      \
    const float* s0 = p.st_conv + (size_t)(sb * 3 + (tb0 + i + 3)) * 1024 + ch_;                              \
    dst = (uint4){pack2(s0[0], s0[1]), pack2(s0[2], s0[3]), pack2(s0[4], s0[5]), pack2(s0[6], s0[7])};        \
  }
    LDX(0, xr0) LDX(1, xr1) LDX(2, xr2)
#undef LDX
    xr3 = *(const uint4*)(xp + (size_t)3 * 1024);
    xr4 = *(const uint4*)(xp + (size_t)4 * 1024);
    xr5 = *(const uint4*)(xp + (size_t)5 * 1024);
    xr6 = *(const uint4*)(xp + (size_t)6 * 1024);
  }
  __syncthreads();
  {
    const int tid = launder_tid();
    const int rb = tid >> 5, cgp = tid & 31;
    const bool isk = cgp >= 16;
    float o0[8], o1[8], o2[8], o3[8];
    {
      const float* cwp = sCw + cgp * 8;
      float4 b0 = *(const float4*)(cwp + 1024), b1 = *(const float4*)(cwp + 1028);
      o0[0] = b0.x; o0[1] = b0.y; o0[2] = b0.z; o0[3] = b0.w; o0[4] = b1.x; o0[5] = b1.y; o0[6] = b1.z; o0[7] = b1.w;
#pragma unroll
      for (int e = 0; e < 8; e++) { o1[e] = o0[e]; o2[e] = o0[e]; o3[e] = o0[e]; }
#define FMAW(j, o, x) { float4 a0 = *(const float4*)(cwp + j * 256), a1 = *(const float4*)(cwp + j * 256 + 4); \
  o[0] += a0.x * x[0]; o[1] += a0.y * x[1]; o[2] += a0.z * x[2]; o[3] += a0.w * x[3];                              \
  o[4] += a1.x * x[4]; o[5] += a1.y * x[5]; o[6] += a1.z * x[6]; o[7] += a1.w * x[7]; }
#define UNP(xv, x) float x[8]; x[0] = __uint_as_float(xv.x << 16); x[1] = __uint_as_float(xv.x & 0xffff0000u); \
  x[2] = __uint_as_float(xv.y << 16); x[3] = __uint_as_float(xv.y & 0xffff0000u);                             \
  x[4] = __uint_as_float(xv.z << 16); x[5] = __uint_as_float(xv.z & 0xffff0000u);                             \
  x[6] = __uint_as_float(xv.w << 16); x[7] = __uint_as_float(xv.w & 0xffff0000u);
      { UNP(xr0, x) FMAW(0, o0, x) }
      { UNP(xr1, x) FMAW(1, o0, x) FMAW(0, o1, x) }
      { UNP(xr2, x) FMAW(2, o0, x) FMAW(1, o1, x) FMAW(0, o2, x) }
      { UNP(xr3, x) FMAW(3, o0, x) FMAW(2, o1, x) FMAW(1, o2, x) FMAW(0, o3, x) }
      { UNP(xr4, x) FMAW(3, o1, x) FMAW(2, o2, x) FMAW(1, o3, x) }
      { UNP(xr5, x) FMAW(3, o2, x) FMAW(2, o3, x) }
      { UNP(xr6, x) FMAW(3, o3, x) }
#undef FMAW
#undef UNP
    }
    const float ksc = isk ? 0.08838834764831845f : 1.0f;
#pragma unroll
    for (int e = 0; e < 8; e++) {
      o0[e] = silu(o0[e]) * ksc; o1[e] = silu(o1[e]) * ksc; o2[e] = silu(o2[e]) * ksc; o3[e] = silu(o3[e]) * ksc;
    }
    bf16_t* dstp = (isk ? sK + (cgp - 16) * 8 : sQ + cgp * 8) + (rb * 4) * 136;
    *(uint4*)(dstp) = (uint4){pack2(o0[0], o0[1]), pack2(o0[2], o0[3]), pack2(o0[4], o0[5]), pack2(o0[6], o0[7])};
    *(uint4*)(dstp + 136) = (uint4){pack2(o1[0], o1[1]), pack2(o1[2], o1[3]), pack2(o1[4], o1[5]), pack2(o1[6], o1[7])};
    *(uint4*)(dstp + 272) = (uint4){pack2(o2[0], o2[1]), pack2(o2[2], o2[3]), pack2(o2[4], o2[5]), pack2(o2[6], o2[7])};
    *(uint4*)(dstp + 408) = (uint4){pack2(o3[0], o3[1]), pack2(o3[2], o3[3]), pack2(o3[4], o3[5]), pack2(o3[6], o3[7])};
    if (isk) {
      float g0 = sWg[rb * 4], g1 = sWg[rb * 4 + 1], g2 = sWg[rb * 4 + 2], g3 = sWg[rb * 4 + 3];
#pragma unroll
      for (int e = 0; e < 8; e++) {
        uint2 pk;
        pk.x = pack2(o0[e] * g0, o1[e] * g1);
        pk.y = pack2(o2[e] * g2, o3[e] * g3);
        *(uint2*)(sKT + ((cgp - 16) * 8 + e) * 72 + rb * 4) = pk;
      }
    }
  }
  __syncthreads();
  {
    const int tid = launder_tid(), lane = tid & 63, w = tid >> 6, fr = lane & 15, fq = lane >> 4;
    const int mf = w >> 1, nf0 = (w & 1) * 2;
    f32x4 sa[2];
    sa[0] = (f32x4){0.f, 0.f, 0.f, 0.f};
    sa[1] = (f32x4){0.f, 0.f, 0.f, 0.f};
#pragma unroll
    for (int ks = 0; ks < 4; ks++) {
      bf16x8 a = lds8(sQ + (mf * 16 + fr) * 136 + ks * 32 + fq * 8);
#pragma unroll
      for (int n = 0; n < 2; n++) {
        bf16x8 b = lds8(sK + ((nf0 + n) * 16 + fr) * 136 + ks * 32 + fq * 8);
        sa[n] = MFMA(a, b, sa[n]);
      }
    }
#pragma unroll
    for (int r = 0; r < 4; r++) {
      const int t = mf * 16 + fq * 4 + r;
      const float bt = sBt[t];
      float rs = 0.f;
#pragma unroll
      for (int n = 0; n < 2; n++) {
        const int s = (nf0 + n) * 16 + fr;
        float wgt = (s <= t) ? __expf(bt + sAs[s]) : 0.f;
        float v = sa[n][r] * wgt;
        rs += v;
        sSw[t * 72 + s] = f2bf(v);
      }
      rs += __shfl_xor(rs, 1);
      rs += __shfl_xor(rs, 2);
      rs += __shfl_xor(rs, 4);
      rs += __shfl_xor(rs, 8);
      if (fr == 0) atomicAdd(&sDen[t], rs);
    }
  }
  __syncthreads();
  {
    const int tid = launder_tid();
    bf16_t* qo = p.Qc + (size_t)cid * 8192;
    bf16_t* ko = p.KTc + (size_t)cid * 8192;
    bf16_t* so = p.SWc + (size_t)cid * 4096;
    *(uint4*)(qo + tid * 8) = *(const uint4*)(sQ + (tid >> 4) * 136 + (tid & 15) * 8);
    *(uint4*)(qo + 4096 + tid * 8) = *(const uint4*)(sQ + (32 + (tid >> 4)) * 136 + (tid & 15) * 8);
    *(uint4*)(ko + tid * 8) = *(const uint4*)(sKT + (tid >> 3) * 72 + (tid & 7) * 8);
    *(uint4*)(ko + 4096 + tid * 8) = *(const uint4*)(sKT + (64 + (tid >> 3)) * 72 + (tid & 7) * 8);
    *(uint4*)(so + tid * 8) = *(const uint4*)(sSw + (tid >> 3) * 72 + (tid & 7) * 8);
    if (tid < 64) p.DENc[(size_t)cid * 64 + tid] = sDen[tid];
  }
}

__device__ __forceinline__ void mlstm_task(const Params& p, int seq, int h, char* smem) {
  const bool isp = seq < 8;
  const int sb = seq - 8;
  const int L = isp ? 2048 : 64;
  const int nchunks = L >> 6;
  const int grow0 = isp ? seq * 2048 : kNP + sb * 64;
  const int cid0 = isp ? (seq * 4 + h) * 32 : 1024 + sb * 4 + h;
  const bf16_t* MVT = isp ? p.MVTp + (size_t)(seq * 4 + h) * 128 * 2048 : p.MVTs + (size_t)(sb * 4 + h) * 128 * 64;
  bf16_t* sQ = (bf16_t*)smem;
  bf16_t* sH = sQ + 64 * 136;
  bf16_t* sKT = sH + 64 * 136;
  bf16_t* sVT = sKT + 128 * 72;
  bf16_t* sCb = sVT + 128 * 72;
  bf16_t* sSw = sCb + 128 * 136;
  float* sF = (float*)(sSw + 64 * 72);
  float* sVec = sF;
  float* sNq = sF + 512;
  float* sSS = sF + 576;
  float* sN = sF + 640;

  __syncthreads();
  f32x4 Cacc[8];
  {
    const int tid = launder_tid(), lane = tid & 63, w = tid >> 6, fr = lane & 15, fq = lane >> 4;
    if (isp) {
#pragma unroll
      for (int n = 0; n < 8; n++) Cacc[n] = (f32x4){0.f, 0.f, 0.f, 0.f};
      if (tid < 128) sN[tid] = 0.f;
    } else {
      const float* C0 = p.st_C + (size_t)(sb * 4 + h) * 16384;
#pragma unroll
      for (int n = 0; n < 8; n++)
#pragma unroll
        for (int r = 0; r < 4; r++) Cacc[n][r] = C0[(w * 16 + fq * 4 + r) * 128 + n * 16 + fr];
      if (tid < 128) sN[tid] = p.st_n[(sb * 4 + h) * 128 + tid];
    }
#pragma unroll
    for (int n = 0; n < 8; n++)
#pragma unroll
      for (int r = 0; r < 4; r++) sCb[(w * 16 + fq * 4 + r) * 136 + n * 16 + fr] = f2bf(Cacc[n][r]);
  }
  float mg0, mg1, mg2, mg3;
  {
    const int tid = launder_tid(), lane = tid & 63, w = tid >> 6, fr = lane & 15;
    const int cidx = h * 128 + (w >> 2) * 64 + fr;
    mg0 = p.ml_norm_g[cidx];
    mg1 = p.ml_norm_g[cidx + 16];
    mg2 = p.ml_norm_g[cidx + 32];
    mg3 = p.ml_norm_g[cidx + 48];
  }
  uint4 q0, q1, k0, k1, v0, v1, sw0;
  float gwi = 0.f, gem = 0.f, gden = 0.f, gdec = 0.f;
#define LOAD_CHUNK(C)                                                                         \
  {                                                                                           \
    const int tid_ = launder_tid();                                                           \
    const size_t cid_ = (size_t)(cid0 + (C));                                                 \
    const bf16_t* qp = p.Qc + cid_ * 8192 + tid_ * 8;                                         \
    const bf16_t* kp = p.KTc + cid_ * 8192 + tid_ * 8;                                        \
    q0 = *(const uint4*)qp;                                                                   \
    q1 = *(const uint4*)(qp + 4096);                                                          \
    k0 = *(const uint4*)kp;                                                                   \
    k1 = *(const uint4*)(kp + 4096);                                                          \
    sw0 = *(const uint4*)(p.SWc + cid_ * 4096 + tid_ * 8);                                    \
    v0 = *(const uint4*)(MVT + (size_t)(tid_ >> 3) * L + (C) * 64 + (tid_ & 7) * 8);          \
    v1 = *(const uint4*)(MVT + (size_t)((tid_ + 512) >> 3) * L + (C) * 64 + (tid_ & 7) * 8);  \
    if (tid_ < 64) {                                                                          \
      gwi = p.GV[cid_ * 384 + 128 + tid_];                                                    \
      gem = p.GV[cid_ * 384 + 256 + tid_];                                                    \
      gden = p.DENc[cid_ * 64 + tid_];                                                        \
      gdec = p.GV[cid_ * 384 + 320];                                                          \
    }                                                                                         \
  }
  LOAD_CHUNK(0)
  lds_barrier();

  for (int c = 0; c < nchunks; c++) {
    const int t0 = c * 64;
    float* sV = sVec + (c & 1) * 256;
    const float* sNo = sN + (c & 1) * 128;
    float* sNn = sN + ((c + 1) & 1) * 128;
    uint4 so0, so1;
    {
      const int tid = launder_tid();
      *(uint4*)(sQ + (tid >> 4) * 136 + (tid & 15) * 8) = q0;
      *(uint4*)(sQ + (32 + (tid >> 4)) * 136 + (tid & 15) * 8) = q1;
      *(uint4*)(sKT + (tid >> 3) * 72 + (tid & 7) * 8) = k0;
      *(uint4*)(sKT + (64 + (tid >> 3)) * 72 + (tid & 7) * 8) = k1;
      *(uint4*)(sVT + (tid >> 3) * 72 + (tid & 7) * 8) = v0;
      *(uint4*)(sVT + (64 + (tid >> 3)) * 72 + (tid & 7) * 8) = v1;
      *(uint4*)(sSw + (tid >> 3) * 72 + (tid & 7) * 8) = sw0;
      float decay = gdec;
      if (tid < 64) {
        sV[tid] = gwi;
        sV[64 + tid] = gem;
        sV[128 + tid] = gden;
        sSS[tid] = 0.f;
        if (tid == 0) sV[192] = gdec;
      }
      decay = __shfl(decay, 0);
#define UNP8(VV, AR) float AR[8]; AR[0] = __uint_as_float(VV.x << 16); AR[1] = __uint_as_float(VV.x & 0xffff0000u); \
  AR[2] = __uint_as_float(VV.y << 16); AR[3] = __uint_as_float(VV.y & 0xffff0000u);                                 \
  AR[4] = __uint_as_float(VV.z << 16); AR[5] = __uint_as_float(VV.z & 0xffff0000u);                                 \
  AR[6] = __uint_as_float(VV.w << 16); AR[7] = __uint_as_float(VV.w & 0xffff0000u);
      {
        const float4 n0 = *(const float4*)(sNo + (tid & 15) * 8), n1 = *(const float4*)(sNo + (tid & 15) * 8 + 4);
        UNP8(q0, a)
        UNP8(q1, b)
        float d0 = a[0] * n0.x + a[1] * n0.y + a[2] * n0.z + a[3] * n0.w + a[4] * n1.x + a[5] * n1.y + a[6] * n1.z + a[7] * n1.w;
        float d1 = b[0] * n0.x + b[1] * n0.y + b[2] * n0.z + b[3] * n0.w + b[4] * n1.x + b[5] * n1.y + b[6] * n1.z + b[7] * n1.w;
#pragma unroll
        for (int o = 1; o < 16; o <<= 1) {
          d0 += __shfl_xor(d0, o);
          d1 += __shfl_xor(d1, o);
        }
        if ((tid & 15) == 0) {
          sNq[tid >> 4] = d0;
          sNq[32 + (tid >> 4)] = d1;
        }
      }
      {
        UNP8(k0, a)
        UNP8(k1, b)
        float d0 = ((a[0] + a[1]) + (a[2] + a[3])) + ((a[4] + a[5]) + (a[6] + a[7]));
        float d1 = ((b[0] + b[1]) + (b[2] + b[3])) + ((b[4] + b[5]) + (b[6] + b[7]));
#pragma unroll
        for (int o = 1; o < 8; o <<= 1) {
          d0 += __shfl_xor(d0, o);
          d1 += __shfl_xor(d1, o);
        }
        if ((tid & 7) == 0) {
          sNn[tid >> 3] = d0;
          sNn[64 + (tid >> 3)] = d1;
        }
      }
#undef UNP8
      {
        const bf16_t* sop = p.SO + (size_t)(grow0 + t0 + (tid >> 4)) * 512 + h * 128 + (tid & 15) * 8;
        so0 = *(const uint4*)sop;
        so1 = *(const uint4*)(sop + (size_t)32 * 512);
      }
    }
    if (c + 1 < nchunks) LOAD_CHUNK(c + 1)
    lds_barrier();
    f32x4 hacc[4];
    {
      const int tid = launder_tid(), lane = tid & 63, w = tid >> 6, fr = lane & 15, fq = lane >> 4;
      const int mf = w & 3, nf0 = (w >> 2) * 4;
      const float* sWi = sV;
      const float* sEm = sV + 64;
      const float* sDn = sV + 128;
#pragma unroll
      for (int n = 0; n < 4; n++) hacc[n] = (f32x4){0.f, 0.f, 0.f, 0.f};
      {
        bf16x8 qa[4], cb[4][4], swa[2], vb[2][4];
#pragma unroll
        for (int ks = 0; ks < 4; ks++) {
          qa[ks] = lds8(sQ + (mf * 16 + fr) * 136 + ks * 32 + fq * 8);
#pragma unroll
          for (int n = 0; n < 4; n++) cb[ks][n] = lds8(sCb + ((nf0 + n) * 16 + fr) * 136 + ks * 32 + fq * 8);
        }
#pragma unroll
        for (int ks = 0; ks < 2; ks++) {
          swa[ks] = lds8(sSw + (mf * 16 + fr) * 72 + ks * 32 + fq * 8);
#pragma unroll
          for (int n = 0; n < 4; n++) vb[ks][n] = lds8(sVT + ((nf0 + n) * 16 + fr) * 72 + ks * 32 + fq * 8);
        }
        float wi4[4];
#pragma unroll
        for (int r = 0; r < 4; r++) wi4[r] = sWi[mf * 16 + fq * 4 + r];
#pragma unroll
        for (int ks = 0; ks < 4; ks++)
#pragma unroll
          for (int n = 0; n < 4; n++) hacc[n] = MFMA(qa[ks], cb[ks][n], hacc[n]);
#pragma unroll
        for (int r = 0; r < 4; r++)
#pragma unroll
          for (int n = 0; n < 4; n++) hacc[n][r] *= wi4[r];
#pragma unroll
        for (int ks = 0; ks < 2; ks++)
#pragma unroll
          for (int n = 0; n < 4; n++) hacc[n] = MFMA(swa[ks], vb[ks][n], hacc[n]);
      }
#pragma unroll
      for (int r = 0; r < 4; r++) {
        const int t = mf * 16 + fq * 4 + r;
        float den = sDn[t] + sWi[t] * sNq[t];
        float dn = fmaxf(fabsf(den), sEm[t]);
        float inv = __builtin_amdgcn_rcpf(dn);
        float ss = 0.f;
#pragma unroll
        for (int n = 0; n < 4; n++) {
          hacc[n][r] *= inv;
          ss += hacc[n][r] * hacc[n][r];
        }
        ss += __shfl_xor(ss, 1);
        ss += __shfl_xor(ss, 2);
        ss += __shfl_xor(ss, 4);
        ss += __shfl_xor(ss, 8);
        if (fr == 0) atomicAdd(&sSS[t], ss);
      }
    }
    lds_barrier();
    {
      const int tid = launder_tid(), lane = tid & 63, w = tid >> 6, fr = lane & 15, fq = lane >> 4;
      const int mf = w & 3, nf0 = (w >> 2) * 4;
#pragma unroll
      for (int r = 0; r < 4; r++) {
        const int t = mf * 16 + fq * 4 + r;
        const float rstd = rsqrtf(sSS[t] * (1.0f / 128.0f) + 1e-6f);
        bf16_t* hp = sH + t * 136 + nf0 * 16 + fr;
        hp[0] = f2bf(hacc[0][r] * rstd * mg0);
        hp[16] = f2bf(hacc[1][r] * rstd * mg1);
        hp[32] = f2bf(hacc[2][r] * rstd * mg2);
        hp[48] = f2bf(hacc[3][r] * rstd * mg3);
      }
      const float decay = sV[192];
#pragma unroll
      for (int n = 0; n < 8; n++) {
        Cacc[n][0] *= decay;
        Cacc[n][1] *= decay;
        Cacc[n][2] *= decay;
        Cacc[n][3] *= decay;
      }
      {
        bf16x8 va[2], kb[2][8];
#pragma unroll
        for (int ks = 0; ks < 2; ks++) {
          va[ks] = lds8(sVT + (w * 16 + fr) * 72 + ks * 32 + fq * 8);
#pragma unroll
          for (int n = 0; n < 8; n++) kb[ks][n] = lds8(sKT + (n * 16 + fr) * 72 + ks * 32 + fq * 8);
        }
#pragma unroll
        for (int ks = 0; ks < 2; ks++)
#pragma unroll
          for (int n = 0; n < 8; n++) Cacc[n] = MFMA(va[ks], kb[ks][n], Cacc[n]);
      }
#pragma unroll
      for (int n = 0; n < 8; n++)
#pragma unroll
        for (int r = 0; r < 4; r++) sCb[(w * 16 + fq * 4 + r) * 136 + n * 16 + fr] = f2bf(Cacc[n][r]);
      if (tid < 128) sNn[tid] = decay * sNo[tid] + sNn[tid];
    }
    lds_barrier();
    {
      const int tid = launder_tid();
      const int row = tid >> 4, c8 = (tid & 15) * 8;
      bf16_t* yp = p.YB + (size_t)(grow0 + t0 + row) * 512 + h * 128 + c8;
      uint4 h0 = *(const uint4*)(sH + row * 136 + c8);
      uint4 h1 = *(const uint4*)(sH + (row + 32) * 136 + c8);
#define MUL2(a, b) pack2(__uint_as_float((a) << 16) * __uint_as_float((b) << 16), \
                         __uint_as_float((a) & 0xffff0000u) * __uint_as_float((b) & 0xffff0000u))
      uint4 y0 = {MUL2(h0.x, so0.x), MUL2(h0.y, so0.y), MUL2(h0.z, so0.z), MUL2(h0.w, so0.w)};
      uint4 y1 = {MUL2(h1.x, so1.x), MUL2(h1.y, so1.y), MUL2(h1.z, so1.z), MUL2(h1.w, so1.w)};
#undef MUL2
      *(uint4*)yp = y0;
      *(uint4*)(yp + (size_t)32 * 512) = y1;
    }
  }
#undef LOAD_CHUNK
  lds_barrier();
  {
    const int tid = launder_tid(), lane = tid & 63, w = tid >> 6, fr = lane & 15, fq = lane >> 4;
    float* Cout = isp ? p.out + O_CP + (size_t)(seq * 4 + h) * 16384 : p.out + O_CS + (size_t)(sb * 4 + h) * 16384;
#pragma unroll
    for (int n = 0; n < 8; n++)
#pragma unroll
      for (int r = 0; r < 4; r++) Cout[(w * 16 + fq * 4 + r) * 128 + n * 16 + fr] = Cacc[n][r];
    float* nout = isp ? p.out + O_NP + (seq * 4 + h) * 128 : p.out + O_NS + (sb * 4 + h) * 128;
    if (tid < 128) nout[tid] = sN[(nchunks & 1) * 128 + tid];
  }
}

constexpr int D_ML_P = 32;
constexpr int D_AT_P = 2048;
constexpr int D_AT_S = 128;
constexpr int D_ML_S = 64;
constexpr int D_TOTAL = D_ML_P + D_AT_P + D_AT_S + D_ML_S;

__device__ __forceinline__ void phase_d0(const Params& p, char* smem) {
  for (int item = blockIdx.x; item < 1088; item += gridDim.x) {
    if (item < 1024) mlpre_task(p, item >> 7, (item >> 5) & 3, item & 31, smem);
    else mlpre_task(p, 8 + ((item - 1024) >> 2), item & 3, 0, smem);
  }
}
__device__ __forceinline__ void phase_d(const Params& p, char* smem, int cidx) {
  int* sTask = (int*)(smem + LDS_BYTES - 16);
  for (;;) {
    __syncthreads();
    if (threadIdx.x == 0) *sTask = (int)atomicAdd(p.counter + cidx, 1u);
    __syncthreads();
    int task = __builtin_amdgcn_readfirstlane(*sTask);
    if (task >= D_TOTAL) break;
    int kind, seq, h, qt = 0;
    if (task < D_ML_P) {
      kind = 0; seq = task >> 2; h = task & 3;
    } else if (task < D_ML_P + D_AT_P) {
      int t2 = task - D_ML_P;
      kind = 1; qt = 31 - (t2 >> 6); seq = (t2 & 63) >> 3; h = t2 & 7;
    } else if (task < D_ML_P + D_AT_P + D_AT_S) {
      int t2 = task - D_ML_P - D_AT_P;
      kind = 1; seq = 8 + (t2 >> 3); h = t2 & 7;
    } else {
      int t2 = task - D_ML_P - D_AT_P - D_AT_S;
      kind = 0; seq = 8 + (t2 >> 2); h = t2 & 3;
    }
    if (kind == 0) mlstm_task(p, seq, h, smem);
    else attn_task(p, seq, h, qt, smem);
  }
}

__device__ __forceinline__ void phase_e(const Params& p, char* smem) {
  const int MT = 68, NT = 8;
  const int tid = launder_tid(), lane = tid & 63, w = tid >> 6, wr = w >> 1, wc = w & 1, fr = lane & 15, fq = lane >> 4;
  int cur = 0;
  {
    int mt0, nt0;
    tile_map(blockIdx.x, MT, NT, mt0, nt0);
    gemm_prologue(p.YA + (size_t)mt0 * 256 * 512, 512, p.Wt_a + (size_t)nt0 * 128 * 512, 512, smem, cur);
  }
  for (int tile = blockIdx.x; tile < MT * NT; tile += gridDim.x) {
    int mt, nt;
    tile_map(tile, MT, NT, mt, nt);
    f32x4 acc[4][4];
    zero_acc(acc);
    const bool hn = tile + (int)gridDim.x < MT * NT;
    int nmt, nnt;
    tile_map(hn ? tile + (int)gridDim.x : tile, MT, NT, nmt, nnt);
    gemm_tile(p.YA + (size_t)mt * 256 * 512, 512, p.Wt_a + (size_t)nt * 128 * 512, 512, 512,
              p.YB + (size_t)mt * 256 * 512, 512, p.Wt_b + (size_t)nt * 128 * 512, 512, true, smem, acc, cur);
#pragma unroll
    for (int m = 0; m < 4; m++)
#pragma unroll
      for (int n = 0; n < 4; n++) {
        const int col = nt * 128 + wc * 64 + n * 16 + fr;
        const int row4 = mt * 256 + wr * 64 + m * 16 + fq * 4;
        const bf16_t* gp = p.GA + (size_t)row4 * 1024 + col;
        bf16_t* mp = p.MER + (size_t)row4 * 1024 + col;
        mp[0] = f2bf(acc[m][n][0] * bf2f(gp[0]));
        mp[1024] = f2bf(acc[m][n][1] * bf2f(gp[1024]));
        mp[2048] = f2bf(acc[m][n][2] * bf2f(gp[2048]));
        mp[3072] = f2bf(acc[m][n][3] * bf2f(gp[3072]));
      }
    zero_acc(acc);
    gemm_tile(p.YB + (size_t)mt * 256 * 512, 512, p.Wt_b + (size_t)nt * 128 * 512, 512, 512,
              p.YA + (size_t)nmt * 256 * 512, 512, p.Wt_a + (size_t)nnt * 128 * 512, 512, hn, smem, acc, cur);
#pragma unroll
    for (int m = 0; m < 4; m++)
#pragma unroll
      for (int n = 0; n < 4; n++) {
        const int col = nt * 128 + wc * 64 + n * 16 + fr;
        const int row4 = mt * 256 + wr * 64 + m * 16 + fq * 4;
        const bf16_t* gp = p.GB + (size_t)row4 * 1024 + col;
        bf16_t* mp = p.MER + (size_t)row4 * 1024 + col;
        mp[0] = f2bf(bf2f(mp[0]) + acc[m][n][0] * bf2f(gp[0]));
        mp[1024] = f2bf(bf2f(mp[1024]) + acc[m][n][1] * bf2f(gp[1024]));
        mp[2048] = f2bf(bf2f(mp[2048]) + acc[m][n][2] * bf2f(gp[2048]));
        mp[3072] = f2bf(bf2f(mp[3072]) + acc[m][n][3] * bf2f(gp[3072]));
      }
  }
}
__device__ __forceinline__ void phase_f(const Params& p, char* smem) {
  const int MT = 68, NT = 8;
  const int tid = launder_tid(), lane = tid & 63, w = tid >> 6, wr = w >> 1, wc = w & 1, fr = lane & 15, fq = lane >> 4;
  int cur = 0;
  {
    int mt0, nt0;
    tile_map(blockIdx.x, MT, NT, mt0, nt0);
    gemm_prologue(p.MER + (size_t)mt0 * 256 * 1024, 1024, p.Wt_out + (size_t)nt0 * 128 * 1024, 1024, smem, cur);
  }
  for (int tile = blockIdx.x; tile < MT * NT; tile += gridDim.x) {
    int mt, nt, nmt, nnt;
    tile_map(tile, MT, NT, mt, nt);
    const bool hn = tile + (int)gridDim.x < MT * NT;
    tile_map(hn ? tile + (int)gridDim.x : tile, MT, NT, nmt, nnt);
    f32x4 acc[4][4];
    zero_acc(acc);
    gemm_tile(p.MER + (size_t)mt * 256 * 1024, 1024, p.Wt_out + (size_t)nt * 128 * 1024, 1024, 1024,
              p.MER + (size_t)nmt * 256 * 1024, 1024, p.Wt_out + (size_t)nnt * 128 * 1024, 1024, hn, smem, acc, cur);
    const int seq = seq_of(mt * 256 + wr * 64);
#pragma unroll
    for (int n = 0; n < 4; n++) {
      const int col = nt * 128 + wc * 64 + n * 16 + fr;
      const float g1 = p.modf[seq * 6144 + 2048 + col];
#pragma unroll
      for (int m = 0; m < 4; m++) {
        const int row4 = mt * 256 + wr * 64 + m * 16 + fq * 4;
#pragma unroll
        for (int r = 0; r < 4; r++) {
          const int row = row4 + r;
          p.X1[(size_t)row * 1024 + col] = xrow(p, row)[col] + g1 * acc[m][n][r];
        }
      }
    }
  }
}
__device__ __forceinline__ void phase_h(const Params& p, char* smem) {
  const int MT = 68, NT = 22;
  const int tid = launder_tid(), lane = tid & 63, w = tid >> 6, wr = w >> 2, wc = w & 3, fr = lane & 15, fq = lane >> 4;
  int cur = 0;
  {
    int mt0, nt0;
    tile_map(blockIdx.x, MT, NT, mt0, nt0);
    gemm256_prologue(p.U + (size_t)mt0 * 256 * 1024, 1024, p.Wt_gu + (size_t)nt0 * 256 * 1024, 1024, smem, cur);
  }
  for (int tile = blockIdx.x; tile < MT * NT; tile += gridDim.x) {
    int mt, nt, nmt, nnt;
    tile_map(tile, MT, NT, mt, nt);
    const bool hn = tile + (int)gridDim.x < MT * NT;
    tile_map(hn ? tile + (int)gridDim.x : tile, MT, NT, nmt, nnt);
    f32x4 acc[8][4];
#pragma unroll
    for (int m = 0; m < 8; m++)
#pragma unroll
      for (int n = 0; n < 4; n++) acc[m][n] = (f32x4){0.f, 0.f, 0.f, 0.f};
    gemm256_tile(p.U + (size_t)mt * 256 * 1024, 1024, p.Wt_gu + (size_t)nt * 256 * 1024, 1024, 1024,
                 p.U + (size_t)nmt * 256 * 1024, 1024, p.Wt_gu + (size_t)nnt * 256 * 1024, 1024, hn, smem, acc, cur);
#pragma unroll
    for (int m = 0; m < 8; m++)
#pragma unroll
      for (int n = 0; n < 2; n++) {
        const int f = (nt * 2 + (wc >> 1)) * 64 + (wc & 1) * 32 + n * 16 + fr;
        const int row4 = mt * 256 + wr * 128 + m * 16 + fq * 4;
#pragma unroll
        for (int r = 0; r < 4; r++)
          p.HFF[(size_t)(row4 + r) * 2816 + f] = f2bf(silu(acc[m][n][r]) * acc[m][n + 2][r]);
      }
  }
}
__device__ __forceinline__ void phase_i(const Params& p, char* smem) {
  const int MT = 68, NT = 8;
  const int tid = launder_tid(), lane = tid & 63, w = tid >> 6, wr = w >> 1, wc = w & 1, fr = lane & 15, fq = lane >> 4;
  int cur = 0;
  {
    int mt0, nt0;
    tile_map(blockIdx.x, MT, NT, mt0, nt0);
    gemm_prologue(p.HFF + (size_t)mt0 * 256 * 2816, 2816, p.Wt_down + (size_t)nt0 * 128 * 2816, 2816, smem, cur);
  }
  for (int tile = blockIdx.x; tile < MT * NT; tile += gridDim.x) {
    int mt, nt, nmt, nnt;
    tile_map(tile, MT, NT, mt, nt);
    const bool hn = tile + (int)gridDim.x < MT * NT;
    tile_map(hn ? tile + (int)gridDim.x : tile, MT, NT, nmt, nnt);
    f32x4 acc[4][4];
    zero_acc(acc);
    gemm_tile(p.HFF + (size_t)mt * 256 * 2816, 2816, p.Wt_down + (size_t)nt * 128 * 2816, 2816, 2816,
              p.HFF + (size_t)nmt * 256 * 2816, 2816, p.Wt_down + (size_t)nnt * 128 * 2816, 2816, hn, smem, acc, cur);
    const int seq = seq_of(mt * 256 + wr * 64);
#pragma unroll
    for (int n = 0; n < 4; n++) {
      const int col = nt * 128 + wc * 64 + n * 16 + fr;
      const float g2 = p.modf[seq * 6144 + 5120 + col];
#pragma unroll
      for (int m = 0; m < 4; m++) {
        const int row4 = mt * 256 + wr * 64 + m * 16 + fq * 4;
#pragma unroll
        for (int r = 0; r < 4; r++) {
          float* px = p.X1 + (size_t)(row4 + r) * 1024 + col;
          *px = *px + g2 * acc[m][n][r];
        }
      }
    }
  }
}
__device__ __forceinline__ void phase_j(const Params& p) {
  const int tid = launder_tid(), lane = tid & 63, w = tid >> 6;
  for (int g = blockIdx.x * 8 + w; g < kT / 4; g += gridDim.x * 8) {
    float4 v[4][4];
#pragma unroll
    for (int i = 0; i < 4; i++)
#pragma unroll
      for (int j = 0; j < 4; j++) v[i][j] = *(const float4*)(p.X1 + (size_t)(g * 4 + i) * 1024 + j * 256 + lane * 4);
#pragma unroll
    for (int i = 0; i < 4; i++) {
      const int row = g * 4 + i;
      float ss = 0.f;
#pragma unroll
      for (int j = 0; j < 4; j++)
        ss += v[i][j].x * v[i][j].x + v[i][j].y * v[i][j].y + v[i][j].z * v[i][j].z + v[i][j].w * v[i][j].w;
      ss = wave_sum(ss);
      float rstd = rsqrtf(ss * (1.0f / 1024.0f) + 1e-6f);
      float* o = p.out + (row < kNP ? O_YP + (size_t)row * 1024 : O_YS + (size_t)(row - kNP) * 1024);
#pragma unroll
      for (int j = 0; j < 4; j++) {
        int c = j * 256 + lane * 4;
        float4 gg = *(const float4*)(p.final_g + c);
        float4 r4;
        r4.x = v[i][j].x * rstd * gg.x;
        r4.y = v[i][j].y * rstd * gg.y;
        r4.z = v[i][j].z * rstd * gg.z;
        r4.w = v[i][j].w * rstd * gg.w;
        *(float4*)(o + c) = r4;
      }
    }
  }
}

#define XB_TMO      128
#define XB_XCNT(j)  (256  + 64 * (j))
#define XB_XSUB(j)  (1280 + 64 * (j))
#define XB_XGEN(j)  (2304 + 64 * (j))
#define XB_TOP      3328
#define XB_TOPGEN   3392
#define XCD_BAR_WORDS 3456
#define XB_SPIN_CAP (1u << 18)
#define LAS __attribute__((address_space(3)))

__device__ __forceinline__ unsigned xb_ld(unsigned* p)              { return __hip_atomic_load(p, __ATOMIC_RELAXED, __HIP_MEMORY_SCOPE_AGENT); }
__device__ __forceinline__ unsigned xb_add(unsigned* p, unsigned v) { return __hip_atomic_fetch_add(p, v, __ATOMIC_RELAXED, __HIP_MEMORY_SCOPE_AGENT); }
__device__ __forceinline__ unsigned xb_xcc_id() { return (unsigned)__builtin_amdgcn_s_getreg((3 << 11) | 20) & 0xFu; }
#define XB_SPIN(cond, bar) do { unsigned _sp = 0; while (cond) { __builtin_amdgcn_s_sleep(1); \
    if ((++_sp & 255u) == 0u) { if (xb_ld(&(bar)[XB_TMO])) break; if (_sp > XB_SPIN_CAP) { atomicAdd(&(bar)[XB_TMO], 1u); break; } } } } while (0)

struct XcdBarrier {
    unsigned* bar; unsigned x;
    volatile LAS unsigned* st;
};

__device__ __forceinline__ XcdBarrier xcd_barrier_post(unsigned* bar, volatile LAS unsigned* st) {
    XcdBarrier b; b.bar = bar; b.x = xb_xcc_id(); b.st = st;
    if (threadIdx.x == 0) (void)xb_add(&bar[XB_XCNT(b.x)], 1u);
    return b;
}
__device__ __forceinline__ void xcd_barrier_complete(unsigned* bar, unsigned x, unsigned& nloc, unsigned& nx) {
    const unsigned G = gridDim.x * gridDim.y * gridDim.z;
    unsigned sum, cnt, mine, sp = 0u;
    for (;;) {
        sum = 0u; cnt = 0u; mine = 0u;
#pragma unroll
        for (unsigned j = 0; j < 16; ++j) { const unsigned c = xb_ld(&bar[XB_XCNT(j)]); sum += c; cnt += (c > 0u) ? 1u : 0u; mine = (j == x) ? c : mine; }
        if (sum == G) break;
        __builtin_amdgcn_s_sleep(1);
        if ((++sp & 255u) == 0u) { if (xb_ld(&bar[XB_TMO])) break; if (sp > XB_SPIN_CAP) { atomicAdd(&bar[XB_TMO], 1u); break; } }
    }
    nloc = mine > 0u ? mine : 1u; nx = cnt > 0u ? cnt : 1u;
}

__device__ __forceinline__ void xcd_barrier(const XcdBarrier& b) {
    asm volatile("s_waitcnt vmcnt(0)" ::: "memory");
    __syncthreads();
    if (threadIdx.x == 0) {
        unsigned* bar = b.bar;
        __builtin_amdgcn_s_waitcnt(0);
        unsigned nloc = b.st[0], nx = b.st[1];
        if (nloc == 0u) { xcd_barrier_complete(bar, b.x, nloc, nx); b.st[0] = nloc; b.st[1] = nx; }
        const unsigned old = xb_add(&bar[XB_XSUB(b.x)], 1u);
        const unsigned gen = old / nloc;
        if (old + 1u == (gen + 1u) * nloc) {
            __builtin_amdgcn_fence(__ATOMIC_RELEASE, "agent");
            asm volatile("s_waitcnt vmcnt(0)" ::: "memory");
            const unsigned og = xb_add(&bar[XB_TOP], 1u);
            const unsigned tg = og / nx;
            if (og + 1u == (tg + 1u) * nx) xb_add(&bar[XB_TOPGEN], 1u);
            else XB_SPIN(xb_ld(&bar[XB_TOPGEN]) == tg, bar);
            __builtin_amdgcn_fence(__ATOMIC_ACQUIRE, "agent");
            xb_add(&bar[XB_XGEN(b.x)], 1u);
            asm volatile("s_waitcnt vmcnt(0)" ::: "memory");
        } else {
            XB_SPIN(xb_ld(&bar[XB_XGEN(b.x)]) == gen, bar);
            __builtin_amdgcn_fence(__ATOMIC_ACQUIRE, "agent");
            asm volatile("s_waitcnt vmcnt(0)" ::: "memory");
        }
    }
    __syncthreads();
}


extern __shared__ __attribute__((aligned(16))) char dyn_smem[];

#ifndef REP_A
#define REP_A 1
#endif
#ifndef REP_C
#define REP_C 1
#endif
#ifndef REP_D
#define REP_D 1
#endif
#ifndef REP_H
#define REP_H 1
#endif
#ifndef REP_E
#define REP_E 1
#endif
__global__ void __launch_bounds__(NTHREADS) mega_kernel(Params p) {
  cg::grid_group grid = cg::this_grid();
  volatile LAS unsigned* xst = (volatile LAS unsigned*)(dyn_smem + LDS_BYTES - 32);
  if (threadIdx.x < 4) xst[threadIdx.x] = 0u;
  __syncthreads();
  XcdBarrier xb = xcd_barrier_post(p.bar, xst);
  if (p.bar == nullptr) grid.sync();
#pragma unroll 1
  for (int r = 0; r < REP_A; r++) {
    phase_a(p, dyn_smem);
    xcd_barrier(xb);
  }
  phase_b(p, dyn_smem);
  xcd_barrier(xb);
#pragma unroll 1
  for (int r = 0; r < REP_C; r++) {
    phase_c(p, dyn_smem);
    xcd_barrier(xb);
  }
  phase_d0(p, dyn_smem);
  xcd_barrier(xb);
#pragma unroll 1
  for (int r = 0; r < REP_D; r++) {
    phase_d(p, dyn_smem, r);
    xcd_barrier(xb);
  }
#pragma unroll 1
  for (int r = 0; r < REP_E; r++) {
    phase_e(p, dyn_smem);
    xcd_barrier(xb);
  }
  phase_f(p, dyn_smem);
  xcd_barrier(xb);
  phase_g(p, dyn_smem);
  xcd_barrier(xb);
#pragma unroll 1
  for (int r = 0; r < REP_H; r++) {
    phase_h(p, dyn_smem);
    xcd_barrier(xb);
  }
  phase_i(p, dyn_smem);
  xcd_barrier(xb);
  phase_j(p);
}
extern "C" void kernel_launch(void* const* d_in, const int* in_sizes, int n_in, void* d_out, int out_size, void* d_ws,
                              size_t ws_size, hipStream_t stream) {
  Params p{};
  const float** pin = (const float**)&p;
  for (int i = 0; i < 26; i++) pin[i] = (const float*)d_in[i];
  p.out = (float*)d_out;
  char* ws = (char*)d_ws;
  size_t off = 0;
  auto alloc = [&](size_t bytes) {
    char* r = ws + off;
    off += (bytes + 255) & ~(size_t)255;
    return r;
  };
  p.Wt_in = (bf16_t*)alloc((size_t)5632 * 1024 * 2);
  p.Wt_a = (bf16_t*)alloc((size_t)1024 * 512 * 2);
  p.Wt_b = (bf16_t*)alloc((size_t)1024 * 512 * 2);
  p.Wt_out = (bf16_t*)alloc((size_t)1024 * 1024 * 2);
  p.Wt_gu = (bf16_t*)alloc((size_t)5632 * 1024 * 2);
  p.Wt_down = (bf16_t*)alloc((size_t)1024 * 2816 * 2);
  p.wg = (float*)alloc(8192 * 4);
  p.modp = (float*)alloc((size_t)8 * 24 * 6144 * 4);
  p.modf = (float*)alloc((size_t)24 * 6144 * 4);
  p.U = (bf16_t*)alloc((size_t)kT * 1024 * 2);
  char* r1 = ws + off;
  p.Qb = (bf16_t*)alloc((size_t)kT * 512 * 2);
  p.Kp = (bf16_t*)alloc((size_t)64 * 2048 * 64 * 2);
  p.Ks = (bf16_t*)alloc((size_t)128 * 1152 * 64 * 2);
  p.VTp = (bf16_t*)alloc((size_t)64 * 64 * 2048 * 2);
  p.VTs = (bf16_t*)alloc((size_t)128 * 64 * 1152 * 2);
  p.MQK = (bf16_t*)alloc((size_t)kT * 1024 * 2);
  const size_t r1_bytes = (size_t)(ws + off - r1);
  char* r2 = ws + off;
  p.MVTp = (bf16_t*)alloc((size_t)32 * 128 * 2048 * 2);
  p.MVTs = (bf16_t*)alloc((size_t)64 * 128 * 64 * 2);
  p.SO = (bf16_t*)alloc((size_t)kT * 512 * 2);
  const size_t r2_bytes = (size_t)(ws + off - r2);
  char* r3 = ws + off;
  p.GA = (bf16_t*)alloc((size_t)kT * 1024 * 2);
  p.GB = (bf16_t*)alloc((size_t)kT * 1024 * 2);
  const size_t r3_bytes = (size_t)(ws + off - r3);
  p.GI = (float*)alloc((size_t)kT * 4 * 4);
  p.LF = (float*)alloc((size_t)kT * 4 * 4);
  p.GV = (float*)alloc((size_t)1088 * 384 * 4);
  p.DENc = (float*)alloc((size_t)1088 * 64 * 4);
  char* r4 = ws + off;
  p.Qc = (bf16_t*)alloc((size_t)1088 * 8192 * 2);
  p.KTc = (bf16_t*)alloc((size_t)1088 * 8192 * 2);
  p.SWc = (bf16_t*)alloc((size_t)1088 * 4096 * 2);
  p.YA = (bf16_t*)alloc((size_t)kT * 512 * 2);
  p.YB = (bf16_t*)alloc((size_t)kT * 512 * 2);
  const size_t r4_bytes = (size_t)(ws + off - r4);
  p.counter = (unsigned*)alloc(256);
  p.bar = (unsigned*)alloc(XCD_BAR_WORDS * 4);
  p.HFF = (bf16_t*)r1;
  p.MER = (bf16_t*)r2;
  p.X1 = (float*)r4;
  if (r1_bytes < (size_t)kT * 2816 * 2 || r2_bytes < (size_t)kT * 1024 * 2 ||
      r4_bytes < (size_t)kT * 1024 * 4 || off > ws_size) {
    fprintf(stderr, "workspace layout error: need %zu bytes, have %zu\n", off, ws_size);
    return;
  }

#if ONE_LAUNCH
  static int grid_blocks = 0;
  if (!grid_blocks) {
    int dev = 0, cus = 0, per_cu = 0;
    hipGetDevice(&dev);
    hipDeviceGetAttribute(&cus, hipDeviceAttributeMultiprocessorCount, dev);
    hipFuncSetAttribute((const void*)mega_kernel, hipFuncAttributeMaxDynamicSharedMemorySize, LDS_BYTES);
    hipOccupancyMaxActiveBlocksPerMultiprocessor(&per_cu, mega_kernel, NTHREADS, LDS_BYTES);
    if (per_cu < 1) per_cu = 1;
    grid_blocks = cus * per_cu;
  }
  (void)hipMemsetAsync(p.bar, 0, XCD_BAR_WORDS * 4, stream);
  void* args[] = {&p};
  hipError_t e = hipLaunchCooperativeKernel((void*)mega_kernel, dim3(grid_blocks), dim3(NTHREADS), args, LDS_BYTES, stream);
  if (e != hipSuccess) fprintf(stderr, "cooperative launch failed: %s (grid %d)\n", hipGetErrorString(e), grid_blocks);
#endif
}
```

```cpp
#include <hip/hip_runtime.h>
#include <hip/hip_cooperative_groups.h>
#include <stdint.h>
#include <stdio.h>
namespace cg = cooperative_groups;

#ifndef ONE_LAUNCH
#define ONE_LAUNCH 1
#endif

typedef unsigned short bf16_t;
using bf16x8 = __attribute__((ext_vector_type(8))) short;
using f32x4 = __attribute__((ext_vector_type(4))) float;

#define NTHREADS 512
#define LDS_BYTES 155648
constexpr int kNP = 16384;
constexpr int kT = 17408;
constexpr int kINW = 5640;

struct Params {
  const float *x_prompt, *x_sample, *c_prompt, *c_sample, *cache_k, *cache_v, *st_C, *st_n, *st_m, *st_conv;
  const float *norm1_g, *norm2_g, *w_ada, *b_ada, *w_in, *b_if, *w_conv, *b_conv, *ml_norm_g, *w_a, *w_b, *w_out,
      *w_gate, *w_up, *w_down, *final_g;
  float* out;
  bf16_t *Wt_in, *Wt_a, *Wt_b, *Wt_out, *Wt_gu, *Wt_down;
  float *wg, *modp, *modf;
  bf16_t *U, *Qb, *Kp, *Ks, *VTp, *VTs, *MQK, *MVTp, *MVTs, *SO, *GA, *GB;
  float *GI, *LF, *GV, *DENc;
  bf16_t *Qc, *KTc, *SWc;
  bf16_t *YA, *YB, *MER;
  float* X1;
  bf16_t* HFF;
  unsigned* counter;
  unsigned* bar;
};

constexpr size_t O_YP = 0;
constexpr size_t O_YS = O_YP + 16777216;
constexpr size_t O_KP = O_YS + 1048576;
constexpr size_t O_VP = O_KP + 8388608;
constexpr size_t O_CP = O_VP + 8388608;
constexpr size_t O_NP = O_CP + 524288;
constexpr size_t O_MP = O_NP + 4096;
constexpr size_t O_CVP = O_MP + 32;
constexpr size_t O_KS = O_CVP + 24576;
constexpr size_t O_VS = O_KS + 524288;
constexpr size_t O_CS = O_VS + 524288;
constexpr size_t O_NS = O_CS + 1048576;
constexpr size_t O_MS = O_NS + 8192;
constexpr size_t O_CVS = O_MS + 64;

typedef __bf16 hwbf16x2_t __attribute__((ext_vector_type(2)));
typedef float hwf32x2_t __attribute__((ext_vector_type(2)));
__device__ __forceinline__ bf16_t f2bf(float f) {
  __bf16 r = (__bf16)f;
  return __builtin_bit_cast(unsigned short, r);
}
__device__ __forceinline__ float bf2f(bf16_t h) { return __uint_as_float(((unsigned)h) << 16); }
__device__ __forceinline__ unsigned pack2(float a, float b) {
  hwf32x2_t v = {a, b};
  hwbf16x2_t r = __builtin_convertvector(v, hwbf16x2_t);
  return __builtin_bit_cast(unsigned, r);
}
__device__ __forceinline__ float sigm(float x) { return __builtin_amdgcn_rcpf(1.0f + __expf(-x)); }
__device__ __forceinline__ float silu(float x) { return x * __builtin_amdgcn_rcpf(1.0f + __expf(-x)); }
__device__ __forceinline__ float logsig(float x) { return fminf(x, 0.f) - __logf(1.0f + __expf(-fabsf(x))); }
__device__ __forceinline__ float wave_sum(float v) {
#pragma unroll
  for (int o = 32; o > 0; o >>= 1) v += __shfl_xor(v, o);
  return v;
}
__device__ __forceinline__ float wave_max(float v) {
#pragma unroll
  for (int o = 32; o > 0; o >>= 1) v = fmaxf(v, __shfl_xor(v, o));
  return v;
}
__device__ __forceinline__ int seq_of(int row) { return row < kNP ? (row >> 11) : 8 + ((row - kNP) >> 6); }
__device__ __forceinline__ const float* xrow(const Params& p, int row) {
  return row < kNP ? p.x_prompt + (size_t)row * 1024 : p.x_sample + (size_t)(row - kNP) * 1024;
}
__device__ __forceinline__ int launder_tid() {
  int t = threadIdx.x;
  asm volatile("" : "+v"(t));
  return t;
}
__device__ __forceinline__ bf16x8 lds8(const void* p) { return *(const bf16x8*)p; }
#define MFMA(a, b, c) __builtin_amdgcn_mfma_f32_16x16x32_bf16(a, b, c, 0, 0, 0)

__device__ __forceinline__ void glds16(const void* g, void* l) {
  __builtin_amdgcn_global_load_lds((const unsigned*)g, (unsigned*)l, 16, 0, 0);
}
__device__ __forceinline__ void gemm_stage(const bf16_t* __restrict__ A, int lda, const bf16_t* __restrict__ B, int ldb,
                                           int k0, char* st) {
  const int tid = launder_tid();
#pragma unroll
  for (int i = 0; i < 4; i++) {
    int b = tid + i * 512;
    int row = b >> 3;
    int ch = (b & 7) ^ ((row >> 1) & 7);
    glds16(A + (size_t)row * lda + k0 + ch * 8, st + b * 16);
  }
#pragma unroll
  for (int i = 0; i < 2; i++) {
    int b = tid + i * 512;
    int row = b >> 3;
    int ch = (b & 7) ^ ((row >> 1) & 7);
    glds16(B + (size_t)row * ldb + k0 + ch * 8, st + 32768 + b * 16);
  }
}
__device__ __forceinline__ void gemm_prologue(const bf16_t* __restrict__ A, int lda, const bf16_t* __restrict__ B, int ldb,
                                              char* smem, int& cur) {
  __syncthreads();
  cur = 0;
  gemm_stage(A, lda, B, ldb, 0, smem);
  gemm_stage(A, lda, B, ldb, 64, smem + 49152);
}
template <bool BATCH = true>
__device__ __forceinline__ void gemm_tile(const bf16_t* __restrict__ A, int lda, const bf16_t* __restrict__ B, int ldb,
                                          int K, const bf16_t* __restrict__ nA, int nlda, const bf16_t* __restrict__ nB,
                                          int nldb, bool has_next, char* smem, f32x4 (&acc)[4][4], int& cur) {
  const int tid = launder_tid(), lane = tid & 63, w = tid >> 6, wr = w >> 1, wc = w & 1;
  const int fr = lane & 15, fq = lane >> 4;
  const int nt = K >> 6;
  for (int t = 0; t < nt; t++) {
    if (t == 0) asm volatile("s_waitcnt vmcnt(0)" ::: "memory");
    else if (t + 1 < nt || has_next) asm volatile("s_waitcnt vmcnt(6)" ::: "memory");
    else asm volatile("s_waitcnt vmcnt(0)" ::: "memory");
    __builtin_amdgcn_s_barrier();
    asm volatile("" ::: "memory");
    {
      int nxt = cur + 2;
      if (nxt >= 3) nxt -= 3;
      if (t + 2 < nt) gemm_stage(A, lda, B, ldb, (t + 2) << 6, smem + nxt * 49152);
      else if (has_next) gemm_stage(nA, nlda, nB, nldb, (t + 2 - nt) << 6, smem + nxt * 49152);
    }
    const char* sa = smem + cur * 49152;
    cur = (cur == 2) ? 0 : cur + 1;
    const char* sb = sa + 32768;
    if (BATCH) {
      bf16x8 af[2][4], bfr[2][4];
#pragma unroll
      for (int ks = 0; ks < 2; ks++) {
        const int ch = ((ks * 4 + fq) ^ ((fr >> 1) & 7)) * 16;
#pragma unroll
        for (int m = 0; m < 4; m++) af[ks][m] = lds8(sa + (wr * 64 + m * 16 + fr) * 128 + ch);
#pragma unroll
        for (int n = 0; n < 4; n++) bfr[ks][n] = lds8(sb + (wc * 64 + n * 16 + fr) * 128 + ch);
      }
      __builtin_amdgcn_s_setprio(1);
#pragma unroll
      for (int ks = 0; ks < 2; ks++) {
#pragma unroll
        for (int m = 0; m < 4; m++)
#pragma unroll
          for (int n = 0; n < 4; n++) acc[m][n] = MFMA(af[ks][m], bfr[ks][n], acc[m][n]);
      }
      __builtin_amdgcn_s_setprio(0);
    } else {
#pragma unroll
      for (int ks = 0; ks < 2; ks++) {
        bf16x8 af[4], bfr[4];
        const int ch = ((ks * 4 + fq) ^ ((fr >> 1) & 7)) * 16;
#pragma unroll
        for (int m = 0; m < 4; m++) af[m] = lds8(sa + (wr * 64 + m * 16 + fr) * 128 + ch);
#pragma unroll
        for (int n = 0; n < 4; n++) bfr[n] = lds8(sb + (wc * 64 + n * 16 + fr) * 128 + ch);
#pragma unroll
        for (int m = 0; m < 4; m++)
#pragma unroll
          for (int n = 0; n < 4; n++) acc[m][n] = MFMA(af[m], bfr[n], acc[m][n]);
      }
    }
  }
}
__device__ __forceinline__ void gemm256_stage(const bf16_t* __restrict__ A, int lda, const bf16_t* __restrict__ B, int ldb,
                                              int k0, char* st) {
  const int tid = threadIdx.x;
#pragma unroll
  for (int i = 0; i < 4; i++) {
    int b = tid + i * 512;
    int row = b >> 3;
    int ch = (b & 7) ^ ((row >> 1) & 7);
    glds16(A + (size_t)row * lda + k0 + ch * 8, st + b * 16);
  }
#pragma unroll
  for (int i = 0; i < 4; i++) {
    int b = tid + i * 512;
    int row = b >> 3;
    int ch = (b & 7) ^ ((row >> 1) & 7);
    glds16(B + (size_t)row * ldb + k0 + ch * 8, st + 32768 + b * 16);
  }
}
__device__ __forceinline__ void gemm256_prologue(const bf16_t* __restrict__ A, int lda, const bf16_t* __restrict__ B,
                                                 int ldb, char* smem, int& cur) {
  __syncthreads();
  cur = 0;
  gemm256_stage(A, lda, B, ldb, 0, smem);
}
__device__ __forceinline__ void gemm256_tile(const bf16_t* __restrict__ A, int lda, const bf16_t* __restrict__ B, int ldb,
                                             int K, const bf16_t* __restrict__ nA, int nlda,
                                             const bf16_t* __restrict__ nB, int nldb, bool has_next, char* smem,
                                             f32x4 (&acc)[8][4], int& cur) {
  const int tid = launder_tid(), lane = tid & 63, w = tid >> 6, wr = w >> 2, wc = w & 3;
  const int fr = lane & 15, fq = lane >> 4;
  const int nt = K >> 6;
  asm volatile("" : "+s"(A), "+s"(B), "+s"(nA), "+s"(nB), "+s"(lda), "+s"(ldb), "+s"(nlda), "+s"(nldb));
  for (int t = 0; t < nt; t++) {
    asm volatile("s_waitcnt vmcnt(0)" ::: "memory");
    __builtin_amdgcn_s_barrier();
    asm volatile("" ::: "memory");
    {
      char* nb = smem + (cur ^ 1) * 65536;
      if (t + 1 < nt) gemm256_stage(A, lda, B, ldb, (t + 1) << 6, nb);
      else if (has_next) gemm256_stage(nA, nlda, nB, nldb, 0, nb);
    }
    const char* sa = smem + cur * 65536;
    const char* sb = sa + 32768;
    cur ^= 1;
#pragma unroll
    for (int ks = 0; ks < 2; ks++) {
      bf16x8 bfr[4];
      const int ch = ((ks * 4 + fq) ^ ((fr >> 1) & 7)) * 16;
#pragma unroll
      for (int n = 0; n < 4; n++) bfr[n] = lds8(sb + (wc * 64 + n * 16 + fr) * 128 + ch);
#pragma unroll
      for (int mh = 0; mh < 2; mh++) {
        bf16x8 af[4];
#pragma unroll
        for (int m = 0; m < 4; m++) af[m] = lds8(sa + (wr * 128 + mh * 64 + m * 16 + fr) * 128 + ch);
#pragma unroll
        for (int m = 0; m < 4; m++)
#pragma unroll
          for (int n = 0; n < 4; n++) acc[mh * 4 + m][n] = MFMA(af[m], bfr[n], acc[mh * 4 + m][n]);
      }
    }
  }
}
__device__ __forceinline__ void tile_map(int tile, int MT, int NT, int& mt, int& nt) {
  int per = 8 * NT;
  int g = tile / per, r = tile - g * per;
  int gsz = min(8, MT - g * 8);
  mt = g * 8 + r % gsz;
  nt = r / gsz;
}
__device__ __forceinline__ void zero_acc(f32x4 (&acc)[4][4]) {
#pragma unroll
  for (int m = 0; m < 4; m++)
#pragma unroll
    for (int n = 0; n < 4; n++) acc[m][n] = (f32x4){0.f, 0.f, 0.f, 0.f};
}

namespace pg8 {
#define PG8_LAS __attribute__((address_space(3)))
typedef unsigned short bf16_t;
typedef short bf16x8 __attribute__((ext_vector_type(8)));
typedef float f32x4 __attribute__((ext_vector_type(4)));
typedef unsigned u32x4 __attribute__((ext_vector_type(4)));
constexpr int BM = 256, BK = 64, HALF = 128, HTB = HALF * BK * 2  , STAGE_BYTES = 8 * HTB, NXCD = 8, WGM = 8;

__host__ __device__ __forceinline__ int lds_byte(int r, int c) { const int st = (r >> 4) * 2 + (c >> 5), rr = r & 15, cc = c & 31, ob = rr * 64 + cc * 2; return st * 1024 + (ob ^ (((ob >> 9) & 1) << 5)); }
__host__ __device__ __forceinline__ void stage_rc(int b, int& R, int& C) { const int st = b / 1024, sb = b % 1024, swz = sb ^ (((sb >> 9) & 1) << 5); R = (st >> 1) * 16 + swz / 64; C = (st & 1) * 32 + (swz % 64) / 2; }
__host__ __device__ __forceinline__ int perm32(int rho) { const int n = rho >> 4, i = rho & 15; return 8 * (i >> 2) + 4 * n + (i & 3); }

struct Unit { int pm, pn; };
struct Gemm { const bf16_t* A; const bf16_t* Bt; int M, N, K; };

struct StaticOrder {
    int nM, nN, nwg, G, c;
    __host__ __device__ void init(int M, int N, int G_, int c_) { nM = M / BM; nN = N / BM; nwg = nM * nN; G = G_; c = c_; }
    __host__ __device__ bool next(int i, Unit& u) const {
        const long L = (long)i * G + c; if (L >= nwg) return false;
        int wgid = (int)L; { const int q = nwg / NXCD, r = nwg % NXCD, xcd = wgid % NXCD, off = wgid / NXCD; wgid = (xcd < r ? xcd * (q + 1) : r * (q + 1) + (xcd - r) * q) + off; }
        const int nig = WGM * nN, gid = wgid / nig, fm = gid * WGM, gsz = (nM - fm) < WGM ? (nM - fm) : WGM;
        u.pm = fm + ((wgid % nig) % gsz); u.pn = (wgid % nig) / gsz; return true;
    }
    __device__ __forceinline__ void a_ready(const Unit&) const {}
    __device__ __forceinline__ void done(const Unit&) const {}
};
__device__ __forceinline__ unsigned cvt_pk_bf16(float lo, float hi) { unsigned r; asm volatile("v_cvt_pk_bf16_f32 %0, %1, %2" : "=v"(r) : "v"(lo), "v"(hi)); return r; }
template <class Epi, class Sched, bool STAMP = false>
__device__ __forceinline__ void gemm_phase(PG8_LAS unsigned char* lds, const Gemm g, const Sched& S, const Epi& E, unsigned long long* stamps) {
    const int tid = threadIdx.x, wid = __builtin_amdgcn_readfirstlane(tid >> 6), lane = tid & 63, wr = wid >> 2, wc = wid & 3, fr = lane & 15, fq = lane >> 4;
    const int K = g.K, nt = K / BK;
    int ts_lo = 0, ts_hi = 0, nts = 0; const unsigned long long rt_entry = STAMP ? (unsigned long long)wall_clock64() : 0ull;
#define PG8_STAMP() do { if (STAMP && wid == 0 && nts < 64) { const unsigned long long _c = (unsigned long long)clock64(); \
        ts_lo = (lane == nts) ? (int)(unsigned)_c : ts_lo; ts_hi = (lane == nts) ? (int)(unsigned)(_c >> 32) : ts_hi; ++nts; } } while (0)
    PG8_STAMP();
    unsigned voffA[2], voffB[2];
#pragma unroll
    for (int i = 0; i < 2; ++i) { int R, C; stage_rc(tid * 16 + i * 8192, R, C); const int Rb = Epi::PERM ? ((R & ~31) + perm32(R & 31)) : R;
        voffA[i] = (unsigned)(R * K + C) * 2u; voffB[i] = (unsigned)(Rb * K + C) * 2u; }
    const size_t kstep = (size_t)(BK * 2);
    const size_t hstep = (size_t)HALF * K * 2;
    const size_t tstep = 2 * hstep;
    const unsigned ldsw = (unsigned)wid * 1024u;
    const int aoff = lds_byte(wr * 64 + fr, fq * 8), boff = lds_byte(wc * 32 + fr, fq * 8);
#define PG8_SA(b, h) (((b) * 2 + (h)) * HTB)
#define PG8_SB(b, h) ((4 + (b) * 2 + (h)) * HTB)
#define PG8_STAGE(bufoff, gbase, voff) do { _Pragma("unroll") for (int _i = 0; _i < 2; ++_i) \
        __builtin_amdgcn_global_load_lds((const unsigned*)((const char*)(gbase) + (voff)[_i]), (PG8_LAS unsigned*)(lds + (bufoff) + ldsw + _i * 8192), 16, 0, 0); } while (0)
#define PG8_LDA(dst, b, h) do { _Pragma("unroll") for (int m = 0; m < 4; ++m) _Pragma("unroll") for (int k = 0; k < 2; ++k) dst[m][k] = *(const PG8_LAS bf16x8*)(lds + PG8_SA(b, h) + aoff + m * 2048 + k * 1024); } while (0)
#define PG8_LDB(dst, b, h) do { _Pragma("unroll") for (int n = 0; n < 2; ++n) _Pragma("unroll") for (int k = 0; k < 2; ++k) dst[n][k] = *(const PG8_LAS bf16x8*)(lds + PG8_SB(b, h) + boff + n * 2048 + k * 1024); } while (0)
#define PG8_MMA(ai, bj, At, Bt) do { __builtin_amdgcn_s_setprio(1); _Pragma("unroll") for (int m = 0; m < 4; ++m) _Pragma("unroll") for (int n = 0; n < 2; ++n) _Pragma("unroll") for (int k = 0; k < 2; ++k) \
        acc[ai][bj][m][n] = __builtin_amdgcn_mfma_f32_16x16x32_bf16(Bt[n][k], At[m][k], acc[ai][bj][m][n], 0, 0, 0); __builtin_amdgcn_s_setprio(0); } while (0)
#define PG8_WAIT_V(n) asm volatile("s_waitcnt vmcnt(" #n ")" ::: "memory")
#define PG8_WAIT_L(n) asm volatile("s_waitcnt lgkmcnt(" #n ")" ::: "memory")
#define PG8_BAR __builtin_amdgcn_s_barrier()
#define PG8_SCHED __builtin_amdgcn_sched_barrier(0)
    Unit cur, nxt; int ui = 0;
    if (!S.next(0, cur)) return;
    f32x4 acc[2][2][4][2];
#pragma unroll
    for (int a = 0; a < 2; ++a)
#pragma unroll
        for (int b = 0; b < 2; ++b)
#pragma unroll
            for (int m = 0; m < 4; ++m)
#pragma unroll
                for (int n = 0; n < 2; ++n) acc[a][b][m][n] = (f32x4){0.f, 0.f, 0.f, 0.f};
    bf16x8 At[4][2], B0[2][2], B1[2][2];
    const char* cA = (const char*)g.A + (size_t)cur.pm * tstep; const char* cB = (const char*)g.Bt + (size_t)cur.pn * tstep;
    S.a_ready(cur);
    PG8_STAGE(PG8_SB(0, 0), cB, voffB); PG8_STAGE(PG8_SA(0, 0), cA, voffA); PG8_STAGE(PG8_SB(0, 1), cB + hstep, voffB); PG8_STAGE(PG8_SA(0, 1), cA + hstep, voffA);
    if (wr == 1) PG8_BAR;
    PG8_WAIT_V(4); PG8_BAR;
    PG8_STAGE(PG8_SB(1, 0), cB + kstep, voffB); PG8_STAGE(PG8_SA(1, 0), cA + kstep, voffA); PG8_STAGE(PG8_SB(1, 1), cB + hstep + kstep, voffB);
    PG8_WAIT_V(6); PG8_BAR;
    PG8_STAMP();
    for (;;) {
        const bool has_next = S.next(ui + 1, nxt);
        const char* nA = has_next ? (const char*)g.A + (size_t)nxt.pm * tstep : cA; const char* nB = has_next ? (const char*)g.Bt + (size_t)nxt.pn * tstep : cB;
        for (int t = 0; t < nt; t += 2) {
            const bool last = (t == nt - 2);
            const char* a1 = cA + (size_t)(t + 1) * kstep;
            const char* a2 = last ? nA : cA + (size_t)(t + 2) * kstep; const char* b2 = last ? nB : cB + (size_t)(t + 2) * kstep;
            const char* a3 = a2 + kstep; const char* b3 = b2 + kstep;
            if (last && has_next) S.a_ready(nxt);
            PG8_LDB(B0, 0, 0); PG8_SCHED; PG8_LDA(At, 0, 0); PG8_STAGE(PG8_SA(1, 1), a1 + hstep, voffA);
            PG8_WAIT_L(8); PG8_BAR; PG8_WAIT_L(0); PG8_MMA(0, 0, At, B0); PG8_BAR; PG8_SCHED;
            PG8_LDB(B1, 0, 1); PG8_STAGE(PG8_SB(0, 0), b2, voffB);
            PG8_BAR; PG8_WAIT_L(0); PG8_MMA(0, 1, At, B1); PG8_BAR;
            PG8_LDA(At, 0, 1); PG8_STAGE(PG8_SA(0, 0), a2, voffA);
            PG8_BAR; PG8_WAIT_L(0); PG8_MMA(1, 0, At, B0); PG8_BAR; PG8_SCHED;
            PG8_STAGE(PG8_SB(0, 1), b2 + hstep, voffB);
            PG8_WAIT_V(6); PG8_BAR; PG8_MMA(1, 1, At, B1); PG8_BAR;
            PG8_LDB(B0, 1, 0); PG8_SCHED; PG8_LDA(At, 1, 0); PG8_STAGE(PG8_SA(0, 1), a2 + hstep, voffA);
            PG8_WAIT_L(8); PG8_BAR; PG8_WAIT_L(0); PG8_MMA(0, 0, At, B0); PG8_BAR; PG8_SCHED;
            PG8_LDB(B1, 1, 1); PG8_STAGE(PG8_SB(1, 0), b3, voffB);
            PG8_BAR; PG8_WAIT_L(0); PG8_MMA(0, 1, At, B1); PG8_BAR;
            PG8_LDA(At, 1, 1); PG8_STAGE(PG8_SA(1, 0), a3, voffA);
            PG8_BAR; PG8_WAIT_L(0); PG8_MMA(1, 0, At, B0); PG8_BAR; PG8_SCHED;
            PG8_STAGE(PG8_SB(1, 1), b3 + hstep, voffB);
            PG8_WAIT_V(6); PG8_BAR; PG8_MMA(1, 1, At, B1); PG8_BAR;
        }
        PG8_STAMP();
        if constexpr (!Epi::AFTER_DRAIN) { E(acc, cur, wr, wc, fr, fq); S.done(cur); }
        PG8_STAMP();
        if (!has_next) break;
#pragma unroll
        for (int a = 0; a < 2; ++a)
#pragma unroll
            for (int b = 0; b < 2; ++b)
#pragma unroll
                for (int m = 0; m < 4; ++m)
#pragma unroll
                    for (int n = 0; n < 2; ++n) acc[a][b][m][n] = (f32x4){0.f, 0.f, 0.f, 0.f};
        cur = nxt; cA = nA; cB = nB; ++ui;
    }
    PG8_WAIT_V(0);
    if (wr == 0) PG8_BAR;
    PG8_BAR;
    if constexpr (Epi::AFTER_DRAIN) { E.fused(acc, cur, wr, wc, fr, fq, lds, wid, lane); S.done(cur); }
    PG8_STAMP();
    if (STAMP && wid == 0) { stamps[lane] = lane < nts ? (((unsigned long long)(unsigned)ts_hi << 32) | (unsigned)ts_lo) : 0ull;
        if (lane == 62) stamps[62] = rt_entry; if (lane == 63) stamps[63] = (unsigned long long)wall_clock64(); }
#undef PG8_STAMP
#undef PG8_SA
#undef PG8_SB
#undef PG8_STAGE
#undef PG8_LDA
#undef PG8_LDB
#undef PG8_MMA
#undef PG8_WAIT_V
#undef PG8_WAIT_L
#undef PG8_BAR
#undef PG8_SCHED
}
}

__device__ __forceinline__ void transpose_quad(const float* __restrict__ src, int lds_, size_t sstep, bf16_t* __restrict__ dst, int ldd,
                               int k0, int kstep, int nbase, int nstep, int mode, char* smem) {
  float* tl = (float*)smem;
  const int tid = launder_tid();
  float4 v[4][2];
#pragma unroll
  for (int q = 0; q < 4; q++)
#pragma unroll
    for (int i = 0; i < 2; i++) {
      int idx = tid + i * 512;
      int k = idx >> 4, n4 = (idx & 15) * 4;
      v[q][i] = *(const float4*)(src + q * sstep + (size_t)k * lds_ + n4);
    }
  __syncthreads();
#pragma unroll
  for (int q = 0; q < 4; q++)
#pragma unroll
    for (int i = 0; i < 2; i++) {
      int idx = tid + i * 512;
      int k = idx >> 4, n4 = (idx & 15) * 4;
      float* t = tl + q * 4160 + k * 65 + n4;
      t[0] = v[q][i].x;
      t[1] = v[q][i].y;
      t[2] = v[q][i].z;
      t[3] = v[q][i].w;
    }
  __syncthreads();
  const int n = tid >> 3, kc = (tid & 7) * 8;
#pragma unroll
  for (int q = 0; q < 4; q++) {
    float o[8];
#pragma unroll
    for (int e = 0; e < 8; e++) o[e] = tl[q * 4160 + (kc + e) * 65 + n];
    const int nb = (mode == 2) ? nbase + (q >> 1) * 256 + (q & 1) * 64 : nbase + q * nstep;
    const int nrow = (mode != 1) ? (nb + n) : (nb + (n >> 5) * 64 + (n & 31));
    uint4 pk = {pack2(o[0], o[1]), pack2(o[2], o[3]), pack2(o[4], o[5]), pack2(o[6], o[7])};
    *(uint4*)(dst + (size_t)nrow * ldd + k0 + q * kstep + kc) = pk;
  }
}

constexpr int A_MOD = 96;
constexpr int A_WT = 1008;
constexpr int A_VC = 512;
constexpr int A_KC = 256;
constexpr int A_PAD = 128;
constexpr int A_MISC = 1;
constexpr int A_TOTAL = A_MOD + A_WT + A_VC + A_KC + A_PAD + A_MISC;

__device__ __forceinline__ void phase_a(const Params& p, char* smem) {
  const int tid = launder_tid();
  for (int task = blockIdx.x; task < A_TOTAL; task += gridDim.x) {
    int id = task;
    if (id < A_MOD) {
      int cgp = id % 12, ks = id / 12;
      float* sc = (float*)smem;
      __syncthreads();
      for (int i = tid; i < 24 * 128; i += 512) {
        int s = i >> 7, kk = i & 127, k = ks * 128 + kk;
        float cv = s < 8 ? p.c_prompt[s * 1024 + k] : p.c_sample[(s - 8) * 1024 + k];
        sc[i] = silu(cv);
      }
      __syncthreads();
      int col = cgp * 512 + tid;
      float acc[24];
#pragma unroll
      for (int s = 0; s < 24; s++) acc[s] = 0.f;
      const float* wp = p.w_ada + (size_t)(ks * 128) * 6144 + col;
#pragma unroll 1
      for (int kb = 0; kb < 128; kb += 32) {
        float wv[32];
#pragma unroll
        for (int j = 0; j < 32; j++) wv[j] = wp[(size_t)(kb + j) * 6144];
#pragma unroll
        for (int j = 0; j < 32; j++)
#pragma unroll
          for (int s = 0; s < 24; s++) acc[s] += sc[s * 128 + kb + j] * wv[j];
      }
#pragma unroll
      for (int s = 0; s < 24; s++) p.modp[(size_t)(ks * 24 + s) * 6144 + col] = acc[s];
      continue;
    }
    id -= A_MOD;
    if (id < A_WT) {
      if (id < 352) {
        int kt = id / 22, nq = id % 22;
        int scol = nq < 14 ? nq * 256 : 3592 + (nq - 14) * 256;
        int drow = nq < 14 ? nq * 256 : 3584 + (nq - 14) * 256;
        transpose_quad(p.w_in + (size_t)kt * 64 * kINW + scol, kINW, 64, p.Wt_in, 1024, kt * 64, 0, drow, 64, 0, smem);
      } else if (id < 384) {
        int i2 = id - 352, kt = i2 / 4, nq = i2 % 4;
        transpose_quad(p.w_a + (size_t)kt * 64 * 1024 + nq * 256, 1024, 64, p.Wt_a, 512, kt * 64, 0, nq * 256, 64, 0, smem);
      } else if (id < 416) {
        int i2 = id - 384, kt = i2 / 4, nq = i2 % 4;
        transpose_quad(p.w_b + (size_t)kt * 64 * 1024 + nq * 256, 1024, 64, p.Wt_b, 512, kt * 64, 0, nq * 256, 64, 0, smem);
      } else if (id < 480) {
        int i2 = id - 416, kt = i2 / 4, nq = i2 % 4;
        transpose_quad(p.w_out + (size_t)kt * 64 * 1024 + nq * 256, 1024, 64, p.Wt_out, 1024, kt * 64, 0, nq * 256, 64, 0, smem);
      } else if (id < 656) {
        int i2 = id - 480, kt = i2 / 11, nq = i2 % 11;
        transpose_quad(p.w_gate + (size_t)kt * 64 * 2816 + nq * 256, 2816, 64, p.Wt_gu, 1024, kt * 64, 0, nq * 512, 0, 2, smem);
      } else if (id < 832) {
        int i2 = id - 656, kt = i2 / 11, nq = i2 % 11;
        transpose_quad(p.w_up + (size_t)kt * 64 * 2816 + nq * 256, 2816, 64, p.Wt_gu, 1024, kt * 64, 0, nq * 512 + 128, 0, 2, smem);
      } else {
        int i2 = id - 832, kt = i2 / 4, nq = i2 % 4;
        transpose_quad(p.w_down + (size_t)kt * 64 * 1024 + nq * 256, 1024, 64, p.Wt_down, 2816, kt * 64, 0, nq * 256, 64, 0, smem);
      }
      continue;
    }
    id -= A_WT;
    if (id < A_VC) {
      int bh = id >> 2, jq = id & 3;
      int b = bh >> 3, h = bh & 7;
      transpose_quad(p.cache_v + ((size_t)(b * 1024 + jq * 256) * 8 + h) * 64, 512, (size_t)64 * 512,
                     p.VTs + (size_t)bh * 64 * 1152, 1152, jq * 256, 64, 0, 0, 0, smem);
      continue;
    }
    id -= A_VC;
    if (id < A_KC) {
      int b = id >> 4, jb = id & 15;
#pragma unroll
      for (int it = 0; it < 8; it++) {
        int g = tid + it * 512;
        int j = g >> 6, col = (g & 63) * 8;
        int h = col >> 6, d = col & 63;
        const float* src = p.cache_k + ((size_t)(b * 1024 + jb * 64 + j)) * 512 + col;
        float4 v0 = *(const float4*)src, v1 = *(const float4*)(src + 4);
        uint4 o;
        o.x = pack2(v0.x, v0.y);
        o.y = pack2(v0.z, v0.w);
        o.z = pack2(v1.x, v1.y);
        o.w = pack2(v1.z, v1.w);
        *(uint4*)(p.Ks + ((size_t)((b * 8 + h) * 1152 + jb * 64 + j)) * 64 + d) = o;
      }
      continue;
    }
    id -= A_KC;
    if (id < A_PAD) {
      int bh = id;
      uint4 z = {0u, 0u, 0u, 0u};
      *(uint4*)(p.Ks + ((size_t)bh * 1152 + 1088) * 64 + tid * 8) = z;
      int d = tid >> 3, chn = tid & 7;
      *(uint4*)(p.VTs + ((size_t)bh * 64 + d) * 1152 + 1088 + chn * 8) = z;
      continue;
    }
    for (int i = tid; i < 8192; i += 512) {
      int g = i >> 10, k = i & 1023;
      p.wg[i] = p.w_in[(size_t)k * kINW + 3584 + g];
    }
    if (tid < 8) p.counter[tid] = 0u;
  }
}

__device__ __forceinline__ void norm_task(const Params& p, int task, int which, char* smem) {
  float* sm_scale = (float*)smem;
  float* sm_shift = sm_scale + 1024;
  const float* sm_wg = sm_shift + 1024;
  const int tid = launder_tid(), lane = tid & 63, w = tid >> 6;
  const int row0 = task * 32;
  const int seq = seq_of(row0);
  const float* g = which ? p.norm2_g : p.norm1_g;
  const int sh_off = which ? 3072 : 0, sc_off = which ? 4096 : 1024;
  __syncthreads();
  for (int c = tid; c < 1024; c += 512) {
    float sh, sc;
    if (which == 0) {
      sh = p.b_ada[sh_off + c];
      sc = p.b_ada[sc_off + c];
#pragma unroll
      for (int ks = 0; ks < 8; ks++) {
        sh += p.modp[(size_t)(ks * 24 + seq) * 6144 + sh_off + c];
        sc += p.modp[(size_t)(ks * 24 + seq) * 6144 + sc_off + c];
      }
    } else {
      sh = p.modf[seq * 6144 + sh_off + c];
      sc = p.modf[seq * 6144 + sc_off + c];
    }
    sm_scale[c] = g[c] * (1.0f + sc);
    sm_shift[c] = sh;
  }
  __syncthreads();
  float4 v[4][4];
#pragma unroll
  for (int i = 0; i < 4; i++) {
    const int row = row0 + w * 4 + i;
    const float* xr = which ? (p.X1 + (size_t)row * 1024) : xrow(p, row);
#pragma unroll
    for (int j = 0; j < 4; j++) v[i][j] = *(const float4*)(xr + j * 256 + lane * 4);
  }
#pragma unroll
  for (int i = 0; i < 4; i++) {
    const int row = row0 + w * 4 + i;
    float ss = 0.f;
#pragma unroll
    for (int j = 0; j < 4; j++)
      ss += v[i][j].x * v[i][j].x + v[i][j].y * v[i][j].y + v[i][j].z * v[i][j].z + v[i][j].w * v[i][j].w;
    ss = wave_sum(ss);
    float rstd = rsqrtf(ss * (1.0f / 1024.0f) + 1e-6f);
#pragma unroll
    for (int j = 0; j < 4; j++) {
      int c = j * 256 + lane * 4;
      float4 sc = *(const float4*)(sm_scale + c), sh = *(const float4*)(sm_shift + c);
      v[i][j].x = v[i][j].x * rstd * sc.x + sh.x;
      v[i][j].y = v[i][j].y * rstd * sc.y + sh.y;
      v[i][j].z = v[i][j].z * rstd * sc.z + sh.z;
      v[i][j].w = v[i][j].w * rstd * sc.w + sh.w;
      uint2 o;
      o.x = pack2(v[i][j].x, v[i][j].y);
      o.y = pack2(v[i][j].z, v[i][j].w);
      *(uint2*)(p.U + (size_t)row * 1024 + c) = o;
    }
    if (which == 0) {
      float gv[8];
#pragma unroll
      for (int gi = 0; gi < 8; gi++) {
        float a = 0.f;
#pragma unroll
        for (int j = 0; j < 4; j++) {
          float4 wv = *(const float4*)(sm_wg + gi * 1024 + j * 256 + lane * 4);
          a += v[i][j].x * wv.x + v[i][j].y * wv.y + v[i][j].z * wv.z + v[i][j].w * wv.w;
        }
        gv[gi] = wave_sum(a);
      }
      if (lane == 0) {
#pragma unroll
        for (int h = 0; h < 4; h++) {
          p.GI[row * 4 + h] = gv[h] + p.b_if[h];
          p.LF[row * 4 + h] = logsig(gv[4 + h] + p.b_if[4 + h]);
        }
      }
    }
  }
}
__device__ __forceinline__ void phase_b(const Params& p, char* smem) {
  const int NTASK = kT / 32;
  {
    float* swg = (float*)smem + 2048;
    for (int i = threadIdx.x; i < 8192; i += 512) swg[i] = p.w_in[(size_t)(i & 1023) * kINW + 3584 + (i >> 10)];
  }
  for (int task = blockIdx.x; task < NTASK + 288; task += gridDim.x) {
    if (task < NTASK) {
      norm_task(p, task, 0, smem);
    } else {
      int i = (task - NTASK) * 512 + threadIdx.x;
      int s = i / 6144, c = i - s * 6144;
      float a = p.b_ada[c];
#pragma unroll
      for (int ks = 0; ks < 8; ks++) a += p.modp[(size_t)(ks * 24 + s) * 6144 + c];
      p.modf[i] = a;
    }
  }
}
__device__ __forceinline__ void phase_g(const Params& p, char* smem) {
  for (int task = blockIdx.x; task < kT / 32; task += gridDim.x) norm_task(p, task, 1, smem);
}

__device__ __forceinline__ uint4 pack8(const f32x4& a, const f32x4& b) {
  return (uint4){pack2(a[0], a[1]), pack2(a[2], a[3]), pack2(b[0], b[1]), pack2(b[2], b[3])};
}
struct EpiC {
  static constexpr bool PERM = true, AFTER_DRAIN = false;
  Params p;
  __device__ __forceinline__ void operator()(const f32x4 (&acc)[2][2][4][2], const pg8::Unit& u, int wr, int wc, int fr, int fq) const {
#pragma unroll
    for (int ai = 0; ai < 2; ++ai) {
      const int rb = u.pm * 256 + ai * 128 + wr * 64;
      const int seq = seq_of(rb);
      const bool isp = seq < 8;
      const int sb = seq - 8;
      const int srow0 = isp ? seq * 2048 : kNP + sb * 64;
      const int L = isp ? 2048 : 64;
#pragma unroll
      for (int bj = 0; bj < 2; ++bj) {
        const int cb = u.pn * 256 + bj * 128;
        const int c0 = cb + wc * 32 + fq * 8;
#pragma unroll
        for (int m = 0; m < 4; ++m) {
          const int row = rb + m * 16 + fr;
          const int t = row - srow0;
          const f32x4 v0 = acc[ai][bj][m][0], v1 = acc[ai][bj][m][1];
          if (cb < 512) {
            *(uint4*)(p.Qb + (size_t)row * 512 + c0) = pack8(v0, v1);
          } else if (cb < 1024) {
            const int c = c0 - 512, h = c >> 6, d = c & 63;
            float* o = (isp ? p.out + O_KP + (size_t)row * 512 : p.out + O_KS + (size_t)(row - kNP) * 512) + c;
            *(f32x4*)o = v0;
            *(f32x4*)(o + 4) = v1;
            bf16_t* kb = isp ? p.Kp + ((size_t)(seq * 8 + h) * 2048 + t) * 64 + d
                             : p.Ks + ((size_t)(sb * 8 + h) * 1152 + 1024 + t) * 64 + d;
            *(uint4*)kb = pack8(v0, v1);
          } else if (cb < 1536) {
            const int c = c0 - 1024, h = c >> 6, d = c & 63;
            float* o = (isp ? p.out + O_VP + (size_t)row * 512 : p.out + O_VS + (size_t)(row - kNP) * 512) + c;
            *(f32x4*)o = v0;
            *(f32x4*)(o + 4) = v1;
            bf16_t* vt = isp ? p.VTp + ((size_t)(seq * 8 + h) * 64 + d) * 2048 + t
                             : p.VTs + ((size_t)(sb * 8 + h) * 64 + d) * 1152 + 1024 + t;
            const size_t tl = isp ? 2048 : 1152;
#pragma unroll
            for (int e = 0; e < 4; ++e) {
              vt[(size_t)e * tl] = f2bf(v0[e]);
              vt[(size_t)(e + 4) * tl] = f2bf(v1[e]);
            }
          } else if (cb < 2560) {
            const int c = c0 - 1536;
            *(uint4*)(p.MQK + (size_t)row * 1024 + c) = pack8(v0, v1);
            if (t >= L - 3) {
              float* o = (isp ? p.out + O_CVP + (size_t)(seq * 3 + (t - (L - 3))) * 1024
                              : p.out + O_CVS + (size_t)(sb * 3 + (t - (L - 3))) * 1024) + c;
              *(f32x4*)o = v0;
              *(f32x4*)(o + 4) = v1;
            }
          } else if (cb < 3072) {
            const int c = c0 - 2560, h = c >> 7, d = c & 127;
            bf16_t* vt = isp ? p.MVTp + ((size_t)(seq * 4 + h) * 128 + d) * 2048 + t
                             : p.MVTs + ((size_t)(sb * 4 + h) * 128 + d) * 64 + t;
            const size_t tl = isp ? 2048 : 64;
#pragma unroll
            for (int e = 0; e < 4; ++e) {
              vt[(size_t)e * tl] = f2bf(v0[e]);
              vt[(size_t)(e + 4) * tl] = f2bf(v1[e]);
            }
          } else {
            f32x4 s0, s1;
#pragma unroll
            for (int e = 0; e < 4; ++e) {
              s0[e] = sigm(v0[e]);
              s1[e] = sigm(v1[e]);
            }
            bf16_t* dst = (cb < 3584)   ? p.SO + (size_t)row * 512 + (c0 - 3072)
                          : (cb < 4608) ? p.GA + (size_t)row * 1024 + (c0 - 3584)
                                        : p.GB + (size_t)row * 1024 + (c0 - 4608);
            *(uint4*)dst = pack8(s0, s1);
          }
        }
      }
    }
  }
};
struct EpiH {
  static constexpr bool PERM = true, AFTER_DRAIN = false;
  bf16_t* HFF;
  __device__ __forceinline__ void operator()(const f32x4 (&acc)[2][2][4][2], const pg8::Unit& u, int wr, int wc, int fr, int fq) const {
    const int f0 = u.pn * 128 + wc * 32 + fq * 8;
#pragma unroll
    for (int ai = 0; ai < 2; ++ai)
#pragma unroll
      for (int m = 0; m < 4; ++m) {
        const int row = u.pm * 256 + ai * 128 + wr * 64 + m * 16 + fr;
        f32x4 o0, o1;
#pragma unroll
        for (int e = 0; e < 4; ++e) {
          o0[e] = silu(acc[ai][0][m][0][e]) * acc[ai][1][m][0][e];
          o1[e] = silu(acc[ai][0][m][1][e]) * acc[ai][1][m][1][e];
        }
        *(uint4*)(HFF + (size_t)row * 2816 + f0) = pack8(o0, o1);
      }
  }
};
__device__ __forceinline__ void gate_task(const Params& p, int seq, int h, char* smem);
__device__ __forceinline__ void phase_c(const Params& p, char* smem) {
  for (int item = blockIdx.x; item < 96; item += gridDim.x) {
    if (item < 32) gate_task(p, item >> 2, item & 3, smem);
    else gate_task(p, 8 + ((item - 32) >> 2), item & 3, smem);
  }
  __syncthreads();
  pg8::Gemm g{p.U, p.Wt_in, kT, 5632, 1024};
  pg8::StaticOrder S;
  S.init(kT, 5632, gridDim.x, blockIdx.x);
  EpiC E{p};
  pg8::gemm_phase<EpiC, pg8::StaticOrder, false>((PG8_LAS unsigned char*)smem, g, S, E, nullptr);
}

__device__ __forceinline__ void lds_barrier() { asm volatile("s_waitcnt lgkmcnt(0)\n\ts_barrier" ::: "memory"); }
__device__ __forceinline__ void attn_task(const Params& p, int seq, int h, int qt, char* smem) {
  const int tid = launder_tid(), lane = tid & 63, w = tid >> 6, fr = lane & 15, fq = lane >> 4;
  const bool isp = seq < 8;
  const int sb = seq - 8;
  const int past = isp ? 0 : 1024;
  const int Tlen = isp ? 2048 : 1152;
  const int row0 = (isp ? seq * 2048 : kNP + sb * 64) + qt * 64;
  const int p0 = past + qt * 64;
  const bf16_t* Kb = isp ? p.Kp + (size_t)(seq * 8 + h) * 2048 * 64 : p.Ks + (size_t)(sb * 8 + h) * 1152 * 64;
  const bf16_t* VT = isp ? p.VTp + (size_t)(seq * 8 + h) * 64 * 2048 : p.VTs + (size_t)(sb * 8 + h) * 64 * 1152;
  bf16_t* sQ = (bf16_t*)smem;
  bf16_t* sK = sQ + 64 * 72;
  bf16_t* sVT = sK + 128 * 72;
  bf16_t* sP = sVT + 64 * 136;
  float* sZ = (float*)(sP + 64 * 136);
  int* sFlag = (int*)(sZ + 64 * 132);

  __syncthreads();
  {
    int r = tid >> 3, chn = tid & 7;
    uint4 q = *(const uint4*)(p.Qb + (size_t)(row0 + r) * 512 + h * 64 + chn * 8);
    *(uint4*)(sQ + r * 72 + chn * 8) = q;
  }
  const int kt_d = (p0 + 62) >> 7;
  const int ki0 = tid, ki1 = tid + 512;
  const bf16_t* kptr0 = Kb + (size_t)(ki0 >> 3) * 64 + (ki0 & 7) * 8;
  const bf16_t* kptr1 = Kb + (size_t)(ki1 >> 3) * 64 + (ki1 & 7) * 8;
  const bf16_t* vptr0 = VT + (size_t)(ki0 >> 4) * Tlen + (ki0 & 15) * 8;
  const bf16_t* vptr1 = VT + (size_t)(ki1 >> 4) * Tlen + (ki1 & 15) * 8;
  uint4 kr0 = *(const uint4*)(kptr0 + (size_t)kt_d * 8192);
  uint4 kr1 = *(const uint4*)(kptr1 + (size_t)kt_d * 8192);
  uint4 vr0 = *(const uint4*)(vptr0 + kt_d * 128);
  uint4 vr1 = *(const uint4*)(vptr1 + kt_d * 128);
  float R = 0.f;
  f32x4 oacc[2];
  oacc[0] = (f32x4){0.f, 0.f, 0.f, 0.f};
  oacc[1] = (f32x4){0.f, 0.f, 0.f, 0.f};
  const int mf = w & 3;
  for (int kt = kt_d; kt >= 0; kt--) {
    lds_barrier();
    *(uint4*)(sK + (ki0 >> 3) * 72 + (ki0 & 7) * 8) = kr0;
    *(uint4*)(sK + (ki1 >> 3) * 72 + (ki1 & 7) * 8) = kr1;
    *(uint4*)(sVT + (ki0 >> 4) * 136 + (ki0 & 15) * 8) = vr0;
    *(uint4*)(sVT + (ki1 >> 4) * 136 + (ki1 & 15) * 8) = vr1;
    if (tid == 0) *sFlag = 0;
    lds_barrier();
    if (kt > 0) {
      kr0 = *(const uint4*)(kptr0 + (size_t)(kt - 1) * 8192);
      kr1 = *(const uint4*)(kptr1 + (size_t)(kt - 1) * 8192);
      vr0 = *(const uint4*)(vptr0 + (kt - 1) * 128);
      vr1 = *(const uint4*)(vptr1 + (kt - 1) * 128);
    }
    {
      const int nf0 = (w >> 2) * 4;
      bf16x8 a0 = lds8(sQ + (mf * 16 + fr) * 72 + fq * 8);
      bf16x8 a1 = lds8(sQ + (mf * 16 + fr) * 72 + 32 + fq * 8);
#pragma unroll
      for (int n = 0; n < 4; n++) {
        bf16x8 b0 = lds8(sK + ((nf0 + n) * 16 + fr) * 72 + fq * 8);
        bf16x8 b1 = lds8(sK + ((nf0 + n) * 16 + fr) * 72 + 32 + fq * 8);
        f32x4 s = (f32x4){0.f, 0.f, 0.f, 0.f};
        s = MFMA(a0, b0, s);
        s = MFMA(a1, b1, s);
#pragma unroll
        for (int r = 0; r < 4; r++) sZ[(mf * 16 + fq * 4 + r) * 132 + (nf0 + n) * 16 + fr] = s[r] * 0.125f;
      }
    }
    lds_barrier();
    {
      const int row = tid >> 3, part = tid & 7;
      const int pos = p0 + row;
      const int j0 = kt * 128 + part * 16;
      float z[16], ls[16];
#pragma unroll
      for (int i4 = 0; i4 < 4; i4++) {
        float4 t4 = *(const float4*)(sZ + row * 132 + part * 16 + i4 * 4);
        z[i4 * 4 + 0] = t4.x;
        z[i4 * 4 + 1] = t4.y;
        z[i4 * 4 + 2] = t4.z;
        z[i4 * 4 + 3] = t4.w;
      }
      float run = 0.f;
      float tl[16];
#pragma unroll
      for (int i = 15; i >= 0; i--) {
        bool valid = (j0 + i) < pos;
        float l = valid ? -(fmaxf(z[i], 0.f) + __logf(1.0f + __expf(-fabsf(z[i])))) : 0.f;
        ls[i] = l;
        tl[i] = run;
        run += l;
      }
      float incl = run;
#pragma unroll
      for (int dlt = 1; dlt < 8; dlt <<= 1) {
        float t = __shfl_down(incl, dlt, 8);
        if (part + dlt < 8) incl += t;
      }
      float excl = incl - run;
      float tot = __shfl(incl, 0, 8);
      float base = R + excl;
      unsigned pk[8];
#pragma unroll
      for (int i = 0; i < 16; i += 2) {
        bool v0 = (j0 + i) < pos, v1 = (j0 + i + 1) < pos;
        float a0 = v0 ? __expf(z[i] + ls[i] + tl[i] + base) : 0.f;
        float a1 = v1 ? __expf(z[i + 1] + ls[i + 1] + tl[i + 1] + base) : 0.f;
        pk[i >> 1] = pack2(a0, a1);
      }
      *(uint4*)(sP + row * 136 + part * 16) = (uint4){pk[0], pk[1], pk[2], pk[3]};
      *(uint4*)(sP + row * 136 + part * 16 + 8) = (uint4){pk[4], pk[5], pk[6], pk[7]};
      R += tot;
      if (R > -110.f) *sFlag = 1;
    }
    lds_barrier();
    const int more = *sFlag;
    {
      const int nf0 = (w >> 2) * 2;
#pragma unroll
      for (int ks = 0; ks < 4; ks++) {
        bf16x8 a = lds8(sP + (mf * 16 + fr) * 136 + ks * 32 + fq * 8);
#pragma unroll
        for (int n = 0; n < 2; n++) {
          bf16x8 b = lds8(sVT + ((nf0 + n) * 16 + fr) * 136 + ks * 32 + fq * 8);
          oacc[n] = MFMA(a, b, oacc[n]);
        }
      }
    }
    if (!more) break;
  }
  {
    const int nf0 = (w >> 2) * 2;
#pragma unroll
    for (int n = 0; n < 2; n++)
#pragma unroll
      for (int r = 0; r < 4; r++)
        p.YA[(size_t)(row0 + mf * 16 + fq * 4 + r) * 512 + h * 64 + (nf0 + n) * 16 + fr] = f2bf(oacc[n][r]);
  }
}


__device__ __forceinline__ void gate_task(const Params& p, int seq, int h, char* smem) {
  const int tid = launder_tid(), lane = tid & 63, w = tid >> 6;
  const bool isp = seq < 8;
  const int sb = seq - 8;
  const int nchunks = isp ? 32 : 1;
  const int grow0 = isp ? seq * 2048 : kNP + sb * 64;
  float* gv = p.GV + (size_t)(isp ? (seq * 4 + h) * 32 : 1024 + sb * 4 + h) * 384;
  float* sBl = (float*)smem;
  float* sG = sBl + 32;
  float* sM = sG + 32;
  __syncthreads();
  float b_[4], as_[4], pm_[4], g_[4];
#pragma unroll
  for (int i = 0; i < 4; i++) {
    const int c = w + i * 8;
    b_[i] = 0.f; as_[i] = 0.f; pm_[i] = 0.f; g_[i] = 0.f;
    if (c < nchunks) {
      const int row = grow0 + c * 64 + lane;
      float li = p.GI[row * 4 + h], lf = p.LF[row * 4 + h];
      float b = lf;
#pragma unroll
      for (int d = 1; d < 64; d <<= 1) {
        float t_ = __shfl_up(b, d);
        if (lane >= d) b += t_;
      }
      float a_s = li - b;
      float pm = a_s;
#pragma unroll
      for (int d = 1; d < 64; d <<= 1) {
        float t_ = __shfl_up(pm, d);
        if (lane >= d) pm = fmaxf(pm, t_);
      }
      float blast = __shfl(b, 63);
      float g = blast - b + li;
      float G = wave_max(g);
      b_[i] = b; as_[i] = a_s; pm_[i] = pm; g_[i] = g;
      if (lane == 0) {
        sBl[c] = blast;
        sG[c] = G;
      }
    }
  }
  __syncthreads();
  if (tid == 0) {
    float m = isp ? 0.f : p.st_m[sb * 4 + h];
    for (int c = 0; c < nchunks; c++) {
      sM[c] = m;
      m = fmaxf(sBl[c] + m, sG[c]);
    }
    sM[nchunks] = m;
    if (isp) p.out[O_MP + seq * 4 + h] = m;
    else p.out[O_MS + sb * 4 + h] = m;
  }
  __syncthreads();
#pragma unroll
  for (int i = 0; i < 4; i++) {
    const int c = w + i * 8;
    if (c < nchunks) {
      const float m_run = sM[c], m_new = sM[c + 1];
      const float mt = b_[i] + fmaxf(m_run, pm_[i]);
      float* o = gv + (size_t)c * 384;
      o[lane] = b_[i] - mt;
      o[64 + lane] = as_[i];
      o[128 + lane] = __expf(b_[i] + m_run - mt);
      o[192 + lane] = __expf(g_[i] - m_new);
      o[256 + lane] = __expf(-mt);
      if (lane == 0) o[320] = __expf(sBl[c] + m_run - m_new);
    }
  }
}

__device__ __forceinline__ void mlpre_task(const Params& p, int seq, int h, int c, char* smem) {
  const bool isp = seq < 8;
  const int sb = seq - 8;
  const int grow0 = isp ? seq * 2048 : kNP + sb * 64;
  const int t0 = c * 64;
  const int cid = isp ? (seq * 4 + h) * 32 + c : 1024 + sb * 4 + h;
  bf16_t* sQ = (bf16_t*)smem;
  bf16_t* sK = sQ + 64 * 136;
  bf16_t* sKT = sK + 64 * 136;
  bf16_t* sSw = sKT + 128 * 72;
  float* sF = (float*)(sSw + 64 * 72);
  float* sV = sF;
  float* sDen = sF + 384;
  float* sCw = sF + 448;
  const float* sBt = sV;
  const float* sAs = sV + 64;
  const float* sWg = sV + 192;
  __syncthreads();
  uint4 xr0, xr1, xr2, xr3, xr4, xr5, xr6;
  {
    const int tid = launder_tid();
    for (int i = tid; i < 1280; i += 512) {
      int j = i >> 8, cc = i & 255;
      int gch = (cc >= 128 ? 512 : 0) + h * 128 + (cc & 127);
      sCw[i] = (j < 4) ? p.w_conv[j * 1024 + gch] : p.b_conv[gch];
    }
    if (tid < 384) sV[tid] = p.GV[(size_t)cid * 384 + tid];
    if (tid < 64) sDen[tid] = 0.f;
    const int rb_ = tid >> 5, cgp_ = tid & 31;
    const int ch_ = (cgp_ >= 16 ? 512 : 0) + h * 128 + (cgp_ & 15) * 8;
    const int tb0 = t0 + rb_ * 4 - 3;
    const bf16_t* xp = p.MQK + (size_t)(grow0 + tb0) * 1024 + ch_;
#define LDX(i, dst)                                                                                           \
  if (tb0 + i >= 0) dst = *(const uint4*)(xp + (size_t)i * 1024);                                             \
  else if (isp) dst = (uint4){0u, 0u, 0u, 0u};                                                                \
  else {                                                                                                      \
    const float* s0 = p.st_conv + (size_t)(sb * 3 + (tb0 + i + 3)) * 1024 + ch_;                              \
    dst = (uint4){pack2(s0[0], s0[1]), pack2(s0[2], s0[3]), pack2(s0[4], s0[5]), pack2(s0[6], s0[7])};        \
  }
    LDX(0, xr0) LDX(1, xr1) LDX(2, xr2)
#undef LDX
    xr3 = *(const uint4*)(xp + (size_t)3 * 1024);
    xr4 = *(const uint4*)(xp + (size_t)4 * 1024);
    xr5 = *(const uint4*)(xp + (size_t)5 * 1024);
    xr6 = *(const uint4*)(xp + (size_t)6 * 1024);
  }
  __syncthreads();
  {
    const int tid = launder_tid();
    const int rb = tid >> 5, cgp = tid & 31;
    const bool isk = cgp >= 16;
    float o0[8], o1[8], o2[8], o3[8];
    {
      const float* cwp = sCw + cgp * 8;
      float4 b0 = *(const float4*)(cwp + 1024), b1 = *(const float4*)(cwp + 1028);
      o0[0] = b0.x; o0[1] = b0.y; o0[2] = b0.z; o0[3] = b0.w; o0[4] = b1.x; o0[5] = b1.y; o0[6] = b1.z; o0[7] = b1.w;
#pragma unroll
      for (int e = 0; e < 8; e++) { o1[e] = o0[e]; o2[e] = o0[e]; o3[e] = o0[e]; }
#define FMAW(j, o, x) { float4 a0 = *(const float4*)(cwp + j * 256), a1 = *(const float4*)(cwp + j * 256 + 4); \
  o[0] += a0.x * x[0]; o[1] += a0.y * x[1]; o[2] += a0.z * x[2]; o[3] += a0.w * x[3];                              \
  o[4] += a1.x * x[4]; o[5] += a1.y * x[5]; o[6] += a1.z * x[6]; o[7] += a1.w * x[7]; }
#define UNP(xv, x) float x[8]; x[0] = __uint_as_float(xv.x << 16); x[1] = __uint_as_float(xv.x & 0xffff0000u); \
  x[2] = __uint_as_float(xv.y << 16); x[3] = __uint_as_float(xv.y & 0xffff0000u);                             \
  x[4] = __uint_as_float(xv.z << 16); x[5] = __uint_as_float(xv.z & 0xffff0000u);                             \
  x[6] = __uint_as_float(xv.w << 16); x[7] = __uint_as_float(xv.w & 0xffff0000u);
      { UNP(xr0, x) FMAW(0, o0, x) }
      { UNP(xr1, x) FMAW(1, o0, x) FMAW(0, o1, x) }
      { UNP(xr2, x) FMAW(2, o0, x) FMAW(1, o1, x) FMAW(0, o2, x) }
      { UNP(xr3, x) FMAW(3, o0, x) FMAW(2, o1, x) FMAW(1, o2, x) FMAW(0, o3, x) }
      { UNP(xr4, x) FMAW(3, o1, x) FMAW(2, o2, x) FMAW(1, o3, x) }
      { UNP(xr5, x) FMAW(3, o2, x) FMAW(2, o3, x) }
      { UNP(xr6, x) FMAW(3, o3, x) }
#undef FMAW
#undef UNP
    }
    const float ksc = isk ? 0.08838834764831845f : 1.0f;
#pragma unroll
    for (int e = 0; e < 8; e++) {
      o0[e] = silu(o0[e]) * ksc; o1[e] = silu(o1[e]) * ksc; o2[e] = silu(o2[e]) * ksc; o3[e] = silu(o3[e]) * ksc;
    }
    bf16_t* dstp = (isk ? sK + (cgp - 16) * 8 : sQ + cgp * 8) + (rb * 4) * 136;
    *(uint4*)(dstp) = (uint4){pack2(o0[0], o0[1]), pack2(o0[2], o0[3]), pack2(o0[4], o0[5]), pack2(o0[6], o0[7])};
    *(uint4*)(dstp + 136) = (uint4){pack2(o1[0], o1[1]), pack2(o1[2], o1[3]), pack2(o1[4], o1[5]), pack2(o1[6], o1[7])};
    *(uint4*)(dstp + 272) = (uint4){pack2(o2[0], o2[1]), pack2(o2[2], o2[3]), pack2(o2[4], o2[5]), pack2(o2[6], o2[7])};
    *(uint4*)(dstp + 408) = (uint4){pack2(o3[0], o3[1]), pack2(o3[2], o3[3]), pack2(o3[4], o3[5]), pack2(o3[6], o3[7])};
    if (isk) {
      float g0 = sWg[rb * 4], g1 = sWg[rb * 4 + 1], g2 = sWg[rb * 4 + 2], g3 = sWg[rb * 4 + 3];
#pragma unroll
      for (int e = 0; e < 8; e++) {
        uint2 pk;
        pk.x = pack2(o0[e] * g0, o1[e] * g1);
        pk.y = pack2(o2[e] * g2, o3[e] * g3);
        *(uint2*)(sKT + ((cgp - 16) * 8 + e) * 72 + rb * 4) = pk;
      }
    }
  }
  __syncthreads();
  {
    const int tid = launder_tid(), lane = tid & 63, w = tid >> 6, fr = lane & 15, fq = lane >> 4;
    const int mf = w >> 1, nf0 = (w & 1) * 2;
    f32x4 sa[2];
    sa[0] = (f32x4){0.f, 0.f, 0.f, 0.f};
    sa[1] = (f32x4){0.f, 0.f, 0.f, 0.f};
#pragma unroll
    for (int ks = 0; ks < 4; ks++) {
      bf16x8 a = lds8(sQ + (mf * 16 + fr) * 136 + ks * 32 + fq * 8);
#pragma unroll
      for (int n = 0; n < 2; n++) {
        bf16x8 b = lds8(sK + ((nf0 + n) * 16 + fr) * 136 + ks * 32 + fq * 8);
        sa[n] = MFMA(a, b, sa[n]);
      }
    }
#pragma unroll
    for (int r = 0; r < 4; r++) {
      const int t = mf * 16 + fq * 4 + r;
      const float bt = sBt[t];
      float rs = 0.f;
#pragma unroll
      for (int n = 0; n < 2; n++) {
        const int s = (nf0 + n) * 16 + fr;
        float wgt = (s <= t) ? __expf(bt + sAs[s]) : 0.f;
        float v = sa[n][r] * wgt;
        rs += v;
        sSw[t * 72 + s] = f2bf(v);
      }
      rs += __shfl_xor(rs, 1);
      rs += __shfl_xor(rs, 2);
      rs += __shfl_xor(rs, 4);
      rs += __shfl_xor(rs, 8);
      if (fr == 0) atomicAdd(&sDen[t], rs);
    }
  }
  __syncthreads();
  {
    const int tid = launder_tid();
    bf16_t* qo = p.Qc + (size_t)cid * 8192;
    bf16_t* ko = p.KTc + (size_t)cid * 8192;
    bf16_t* so = p.SWc + (size_t)cid * 4096;
    *(uint4*)(qo + tid * 8) = *(const uint4*)(sQ + (tid >> 4) * 136 + (tid & 15) * 8);
    *(uint4*)(qo + 4096 + tid * 8) = *(const uint4*)(sQ + (32 + (tid >> 4)) * 136 + (tid & 15) * 8);
    *(uint4*)(ko + tid * 8) = *(const uint4*)(sKT + (tid >> 3) * 72 + (tid & 7) * 8);
    *(uint4*)(ko + 4096 + tid * 8) = *(const uint4*)(sKT + (64 + (tid >> 3)) * 72 + (tid & 7) * 8);
    *(uint4*)(so + tid * 8) = *(const uint4*)(sSw + (tid >> 3) * 72 + (tid & 7) * 8);
    if (tid < 64) p.DENc[(size_t)cid * 64 + tid] = sDen[tid];
  }
}

__device__ __forceinline__ void mlstm_task(const Params& p, int seq, int h, char* smem) {
  const bool isp = seq < 8;
  const int sb = seq - 8;
  const int L = isp ? 2048 : 64;
  const int nchunks = L >> 6;
  const int grow0 = isp ? seq * 2048 : kNP + sb * 64;
  const int cid0 = isp ? (seq * 4 + h) * 32 : 1024 + sb * 4 + h;
  const bf16_t* MVT = isp ? p.MVTp + (size_t)(seq * 4 + h) * 128 * 2048 : p.MVTs + (size_t)(sb * 4 + h) * 128 * 64;
  bf16_t* sQ = (bf16_t*)smem;
  bf16_t* sH = sQ + 64 * 136;
  bf16_t* sKT = sH + 64 * 136;
  bf16_t* sVT = sKT + 128 * 72;
  bf16_t* sCb = sVT + 128 * 72;
  bf16_t* sSw = sCb + 128 * 136;
  float* sF = (float*)(sSw + 64 * 72);
  float* sVec = sF;
  float* sNq = sF + 512;
  float* sSS = sF + 576;
  float* sN = sF + 640;

  __syncthreads();
  f32x4 Cacc[8];
  {
    const int tid = launder_tid(), lane = tid & 63, w = tid >> 6, fr = lane & 15, fq = lane >> 4;
    if (isp) {
#pragma unroll
      for (int n = 0; n < 8; n++) Cacc[n] = (f32x4){0.f, 0.f, 0.f, 0.f};
      if (tid < 128) sN[tid] = 0.f;
    } else {
      const float* C0 = p.st_C + (size_t)(sb * 4 + h) * 16384;
#pragma unroll
      for (int n = 0; n < 8; n++)
#pragma unroll
        for (int r = 0; r < 4; r++) Cacc[n][r] = C0[(w * 16 + fq * 4 + r) * 128 + n * 16 + fr];
      if (tid < 128) sN[tid] = p.st_n[(sb * 4 + h) * 128 + tid];
    }
#pragma unroll
    for (int n = 0; n < 8; n++)
#pragma unroll
      for (int r = 0; r < 4; r++) sCb[(w * 16 + fq * 4 + r) * 136 + n * 16 + fr] = f2bf(Cacc[n][r]);
  }
  float mg0, mg1, mg2, mg3;
  {
    const int tid = launder_tid(), lane = tid & 63, w = tid >> 6, fr = lane & 15;
    const int cidx = h * 128 + (w >> 2) * 64 + fr;
    mg0 = p.ml_norm_g[cidx];
    mg1 = p.ml_norm_g[cidx + 16];
    mg2 = p.ml_norm_g[cidx + 32];
    mg3 = p.ml_norm_g[cidx + 48];
  }
  uint4 q0, q1, k0, k1, v0, v1, sw0;
  float gwi = 0.f, gem = 0.f, gden = 0.f, gdec = 0.f;
#define LOAD_CHUNK(C)                                                                         \
  {                                                                                           \
    const int tid_ = launder_tid();                                                           \
    const size_t cid_ = (size_t)(cid0 + (C));                                                 \
    const bf16_t* qp = p.Qc + cid_ * 8192 + tid_ * 8;                                         \
    const bf16_t* kp = p.KTc + cid_ * 8192 + tid_ * 8;                                        \
    q0 = *(const uint4*)qp;                                                                   \
    q1 = *(const uint4*)(qp + 4096);                                                          \
    k0 = *(const uint4*)kp;                                                                   \
    k1 = *(const uint4*)(kp + 4096);                                                          \
    sw0 = *(const uint4*)(p.SWc + cid_ * 4096 + tid_ * 8);                                    \
    v0 = *(const uint4*)(MVT + (size_t)(tid_ >> 3) * L + (C) * 64 + (tid_ & 7) * 8);          \
    v1 = *(const uint4*)(MVT + (size_t)((tid_ + 512) >> 3) * L + (C) * 64 + (tid_ & 7) * 8);  \
    if (tid_ < 64) {                                                                          \
      gwi = p.GV[cid_ * 384 + 128 + tid_];                                                    \
      gem = p.GV[cid_ * 384 + 256 + tid_];                                                    \
      gden = p.DENc[cid_ * 64 + tid_];                                                        \
      gdec = p.GV[cid_ * 384 + 320];                                                          \
    }                                                                                         \
  }
  LOAD_CHUNK(0)
  lds_barrier();

  for (int c = 0; c < nchunks; c++) {
    const int t0 = c * 64;
    float* sV = sVec + (c & 1) * 256;
    const float* sNo = sN + (c & 1) * 128;
    float* sNn = sN + ((c + 1) & 1) * 128;
    uint4 so0, so1;
    {
      const int tid = launder_tid();
      *(uint4*)(sQ + (tid >> 4) * 136 + (tid & 15) * 8) = q0;
      *(uint4*)(sQ + (32 + (tid >> 4)) * 136 + (tid & 15) * 8) = q1;
      *(uint4*)(sKT + (tid >> 3) * 72 + (tid & 7) * 8) = k0;
      *(uint4*)(sKT + (64 + (tid >> 3)) * 72 + (tid & 7) * 8) = k1;
      *(uint4*)(sVT + (tid >> 3) * 72 + (tid & 7) * 8) = v0;
      *(uint4*)(sVT + (64 + (tid >> 3)) * 72 + (tid & 7) * 8) = v1;
      *(uint4*)(sSw + (tid >> 3) * 72 + (tid & 7) * 8) = sw0;
      float decay = gdec;
      if (tid < 64) {
        sV[tid] = gwi;
        sV[64 + tid] = gem;
        sV[128 + tid] = gden;
        sSS[tid] = 0.f;
        if (tid == 0) sV[192] = gdec;
      }
      decay = __shfl(decay, 0);
#define UNP8(VV, AR) float AR[8]; AR[0] = __uint_as_float(VV.x << 16); AR[1] = __uint_as_float(VV.x & 0xffff0000u); \
  AR[2] = __uint_as_float(VV.y << 16); AR[3] = __uint_as_float(VV.y & 0xffff0000u);                                 \
  AR[4] = __uint_as_float(VV.z << 16); AR[5] = __uint_as_float(VV.z & 0xffff0000u);                                 \
  AR[6] = __uint_as_float(VV.w << 16); AR[7] = __uint_as_float(VV.w & 0xffff0000u);
      {
        const float4 n0 = *(const float4*)(sNo + (tid & 15) * 8), n1 = *(const float4*)(sNo + (tid & 15) * 8 + 4);
        UNP8(q0, a)
        UNP8(q1, b)
        float d0 = a[0] * n0.x + a[1] * n0.y + a[2] * n0.z + a[3] * n0.w + a[4] * n1.x + a[5] * n1.y + a[6] * n1.z + a[7] * n1.w;
        float d1 = b[0] * n0.x + b[1] * n0.y + b[2] * n0.z + b[3] * n0.w + b[4] * n1.x + b[5] * n1.y + b[6] * n1.z + b[7] * n1.w;
#pragma unroll
        for (int o = 1; o < 16; o <<= 1) {
          d0 += __shfl_xor(d0, o);
          d1 += __shfl_xor(d1, o);
        }
        if ((tid & 15) == 0) {
          sNq[tid >> 4] = d0;
          sNq[32 + (tid >> 4)] = d1;
        }
      }
      {
        UNP8(k0, a)
        UNP8(k1, b)
        float d0 = ((a[0] + a[1]) + (a[2] + a[3])) + ((a[4] + a[5]) + (a[6] + a[7]));
        float d1 = ((b[0] + b[1]) + (b[2] + b[3])) + ((b[4] + b[5]) + (b[6] + b[7]));
#pragma unroll
        for (int o = 1; o < 8; o <<= 1) {
          d0 += __shfl_xor(d0, o);
          d1 += __shfl_xor(d1, o);
        }
        if ((tid & 7) == 0) {
          sNn[tid >> 3] = d0;
          sNn[64 + (tid >> 3)] = d1;
        }
      }
#undef UNP8
      {
        const bf16_t* sop = p.SO + (size_t)(grow0 + t0 + (tid >> 4)) * 512 + h * 128 + (tid & 15) * 8;
        so0 = *(const uint4*)sop;
        so1 = *(const uint4*)(sop + (size_t)32 * 512);
      }
    }
    if (c + 1 < nchunks) LOAD_CHUNK(c + 1)
    lds_barrier();
    f32x4 hacc[4];
    {
      const int tid = launder_tid(), lane = tid & 63, w = tid >> 6, fr = lane & 15, fq = lane >> 4;
      const int mf = w & 3, nf0 = (w >> 2) * 4;
      const float* sWi = sV;
      const float* sEm = sV + 64;
      const float* sDn = sV + 128;
#pragma unroll
      for (int n = 0; n < 4; n++) hacc[n] = (f32x4){0.f, 0.f, 0.f, 0.f};
      {
        bf16x8 qa[4], cb[4][4], swa[2], vb[2][4];
#pragma unroll
        for (int ks = 0; ks < 4; ks++) {
          qa[ks] = lds8(sQ + (mf * 16 + fr) * 136 + ks * 32 + fq * 8);
#pragma unroll
          for (int n = 0; n < 4; n++) cb[ks][n] = lds8(sCb + ((nf0 + n) * 16 + fr) * 136 + ks * 32 + fq * 8);
        }
#pragma unroll
        for (int ks = 0; ks < 2; ks++) {
          swa[ks] = lds8(sSw + (mf * 16 + fr) * 72 + ks * 32 + fq * 8);
#pragma unroll
          for (int n = 0; n < 4; n++) vb[ks][n] = lds8(sVT + ((nf0 + n) * 16 + fr) * 72 + ks * 32 + fq * 8);
        }
        float wi4[4];
#pragma unroll
        for (int r = 0; r < 4; r++) wi4[r] = sWi[mf * 16 + fq * 4 + r];
#pragma unroll
        for (int ks = 0; ks < 4; ks++)
#pragma unroll
          for (int n = 0; n < 4; n++) hacc[n] = MFMA(qa[ks], cb[ks][n], hacc[n]);
#pragma unroll
        for (int r = 0; r < 4; r++)
#pragma unroll
          for (int n = 0; n < 4; n++) hacc[n][r] *= wi4[r];
#pragma unroll
        for (int ks = 0; ks < 2; ks++)
#pragma unroll
          for (int n = 0; n < 4; n++) hacc[n] = MFMA(swa[ks], vb[ks][n], hacc[n]);
      }
#pragma unroll
      for (int r = 0; r < 4; r++) {
        const int t = mf * 16 + fq * 4 + r;
        float den = sDn[t] + sWi[t] * sNq[t];
        float dn = fmaxf(fabsf(den), sEm[t]);
        float inv = __builtin_amdgcn_rcpf(dn);
        float ss = 0.f;
#pragma unroll
        for (int n = 0; n < 4; n++) {
          hacc[n][r] *= inv;
          ss += hacc[n][r] * hacc[n][r];
        }
        ss += __shfl_xor(ss, 1);
        ss += __shfl_xor(ss, 2);
        ss += __shfl_xor(ss, 4);
        ss += __shfl_xor(ss, 8);
        if (fr == 0) atomicAdd(&sSS[t], ss);
      }
    }
    lds_barrier();
    {
      const int tid = launder_tid(), lane = tid & 63, w = tid >> 6, fr = lane & 15, fq = lane >> 4;
      const int mf = w & 3, nf0 = (w >> 2) * 4;
#pragma unroll
      for (int r = 0; r < 4; r++) {
        const int t = mf * 16 + fq * 4 + r;
        const float rstd = rsqrtf(sSS[t] * (1.0f / 128.0f) + 1e-6f);
        bf16_t* hp = sH + t * 136 + nf0 * 16 + fr;
        hp[0] = f2bf(hacc[0][r] * rstd * mg0);
        hp[16] = f2bf(hacc[1][r] * rstd * mg1);
        hp[32] = f2bf(hacc[2][r] * rstd * mg2);
        hp[48] = f2bf(hacc[3][r] * rstd * mg3);
      }
      const float decay = sV[192];
#pragma unroll
      for (int n = 0; n < 8; n++) {
        Cacc[n][0] *= decay;
        Cacc[n][1] *= decay;
        Cacc[n][2] *= decay;
        Cacc[n][3] *= decay;
      }
      {
        bf16x8 va[2], kb[2][8];
#pragma unroll
        for (int ks = 0; ks < 2; ks++) {
          va[ks] = lds8(sVT + (w * 16 + fr) * 72 + ks * 32 + fq * 8);
#pragma unroll
          for (int n = 0; n < 8; n++) kb[ks][n] = lds8(sKT + (n * 16 + fr) * 72 + ks * 32 + fq * 8);
        }
#pragma unroll
        for (int ks = 0; ks < 2; ks++)
#pragma unroll
          for (int n = 0; n < 8; n++) Cacc[n] = MFMA(va[ks], kb[ks][n], Cacc[n]);
      }
#pragma unroll
      for (int n = 0; n < 8; n++)
#pragma unroll
        for (int r = 0; r < 4; r++) sCb[(w * 16 + fq * 4 + r) * 136 + n * 16 + fr] = f2bf(Cacc[n][r]);
      if (tid < 128) sNn[tid] = decay * sNo[tid] + sNn[tid];
    }
    lds_barrier();
    {
      const int tid = launder_tid();
      const int row = tid >> 4, c8 = (tid & 15) * 8;
      bf16_t* yp = p.YB + (size_t)(grow0 + t0 + row) * 512 + h * 128 + c8;
      uint4 h0 = *(const uint4*)(sH + row * 136 + c8);
      uint4 h1 = *(const uint4*)(sH + (row + 32) * 136 + c8);
#define MUL2(a, b) pack2(__uint_as_float((a) << 16) * __uint_as_float((b) << 16), \
                         __uint_as_float((a) & 0xffff0000u) * __uint_as_float((b) & 0xffff0000u))
      uint4 y0 = {MUL2(h0.x, so0.x), MUL2(h0.y, so0.y), MUL2(h0.z, so0.z), MUL2(h0.w, so0.w)};
      uint4 y1 = {MUL2(h1.x, so1.x), MUL2(h1.y, so1.y), MUL2(h1.z, so1.z), MUL2(h1.w, so1.w)};
#undef MUL2
      *(uint4*)yp = y0;
      *(uint4*)(yp + (size_t)32 * 512) = y1;
    }
  }
#undef LOAD_CHUNK
  lds_barrier();
  {
    const int tid = launder_tid(), lane = tid & 63, w = tid >> 6, fr = lane & 15, fq = lane >> 4;
    float* Cout = isp ? p.out + O_CP + (size_t)(seq * 4 + h) * 16384 : p.out + O_CS + (size_t)(sb * 4 + h) * 16384;
#pragma unroll
    for (int n = 0; n < 8; n++)
#pragma unroll
      for (int r = 0; r < 4; r++) Cout[(w * 16 + fq * 4 + r) * 128 + n * 16 + fr] = Cacc[n][r];
    float* nout = isp ? p.out + O_NP + (seq * 4 + h) * 128 : p.out + O_NS + (sb * 4 + h) * 128;
    if (tid < 128) nout[tid] = sN[(nchunks & 1) * 128 + tid];
  }
}

constexpr int D_ML_P = 32;
constexpr int D_AT_P = 2048;
constexpr int D_AT_S = 128;
constexpr int D_ML_S = 64;
constexpr int D_TOTAL = D_ML_P + D_AT_P + D_AT_S + D_ML_S;

__device__ __forceinline__ void phase_d0(const Params& p, char* smem) {
  for (int item = blockIdx.x; item < 1088; item += gridDim.x) {
    if (item < 1024) mlpre_task(p, item >> 7, (item >> 5) & 3, item & 31, smem);
    else mlpre_task(p, 8 + ((item - 1024) >> 2), item & 3, 0, smem);
  }
}
__device__ __forceinline__ void phase_d(const Params& p, char* smem, int cidx) {
  int* sTask = (int*)(smem + LDS_BYTES - 16);
  for (;;) {
    __syncthreads();
    if (threadIdx.x == 0) *sTask = (int)atomicAdd(p.counter + cidx, 1u);
    __syncthreads();
    int task = __builtin_amdgcn_readfirstlane(*sTask);
    if (task >= D_TOTAL) break;
    int kind, seq, h, qt = 0;
    if (task < D_ML_P) {
      kind = 0; seq = task >> 2; h = task & 3;
    } else if (task < D_ML_P + D_AT_P) {
      int t2 = task - D_ML_P;
      kind = 1; qt = 31 - (t2 >> 6); seq = (t2 & 63) >> 3; h = t2 & 7;
    } else if (task < D_ML_P + D_AT_P + D_AT_S) {
      int t2 = task - D_ML_P - D_AT_P;
      kind = 1; seq = 8 + (t2 >> 3); h = t2 & 7;
    } else {
      int t2 = task - D_ML_P - D_AT_P - D_AT_S;
      kind = 0; seq = 8 + (t2 >> 2); h = t2 & 3;
    }
    if (kind == 0) mlstm_task(p, seq, h, smem);
    else attn_task(p, seq, h, qt, smem);
  }
}

__device__ __forceinline__ void phase_e(const Params& p, char* smem) {
  const int MT = 68, NT = 8;
  const int tid = launder_tid(), lane = tid & 63, w = tid >> 6, wr = w >> 1, wc = w & 1, fr = lane & 15, fq = lane >> 4;
  int cur = 0;
  {
    int mt0, nt0;
    tile_map(blockIdx.x, MT, NT, mt0, nt0);
    gemm_prologue(p.YA + (size_t)mt0 * 256 * 512, 512, p.Wt_a + (size_t)nt0 * 128 * 512, 512, smem, cur);
  }
  for (int tile = blockIdx.x; tile < MT * NT; tile += gridDim.x) {
    int mt, nt;
    tile_map(tile, MT, NT, mt, nt);
    f32x4 acc[4][4];
    zero_acc(acc);
    const bool hn = tile + (int)gridDim.x < MT * NT;
    int nmt, nnt;
    tile_map(hn ? tile + (int)gridDim.x : tile, MT, NT, nmt, nnt);
    gemm_tile(p.YA + (size_t)mt * 256 * 512, 512, p.Wt_a + (size_t)nt * 128 * 512, 512, 512,
              p.YB + (size_t)mt * 256 * 512, 512, p.Wt_b + (size_t)nt * 128 * 512, 512, true, smem, acc, cur);
#pragma unroll
    for (int m = 0; m < 4; m++)
#pragma unroll
      for (int n = 0; n < 4; n++) {
        const int col = nt * 128 + wc * 64 + n * 16 + fr;
        const int row4 = mt * 256 + wr * 64 + m * 16 + fq * 4;
        const bf16_t* gp = p.GA + (size_t)row4 * 1024 + col;
        bf16_t* mp = p.MER + (size_t)row4 * 1024 + col;
        mp[0] = f2bf(acc[m][n][0] * bf2f(gp[0]));
        mp[1024] = f2bf(acc[m][n][1] * bf2f(gp[1024]));
        mp[2048] = f2bf(acc[m][n][2] * bf2f(gp[2048]));
        mp[3072] = f2bf(acc[m][n][3] * bf2f(gp[3072]));
      }
    zero_acc(acc);
    gemm_tile(p.YB + (size_t)mt * 256 * 512, 512, p.Wt_b + (size_t)nt * 128 * 512, 512, 512,
              p.YA + (size_t)nmt * 256 * 512, 512, p.Wt_a + (size_t)nnt * 128 * 512, 512, hn, smem, acc, cur);
#pragma unroll
    for (int m = 0; m < 4; m++)
#pragma unroll
      for (int n = 0; n < 4; n++) {
        const int col = nt * 128 + wc * 64 + n * 16 + fr;
        const int row4 = mt * 256 + wr * 64 + m * 16 + fq * 4;
        const bf16_t* gp = p.GB + (size_t)row4 * 1024 + col;
        bf16_t* mp = p.MER + (size_t)row4 * 1024 + col;
        mp[0] = f2bf(bf2f(mp[0]) + acc[m][n][0] * bf2f(gp[0]));
        mp[1024] = f2bf(bf2f(mp[1024]) + acc[m][n][1] * bf2f(gp[1024]));
        mp[2048] = f2bf(bf2f(mp[2048]) + acc[m][n][2] * bf2f(gp[2048]));
        mp[3072] = f2bf(bf2f(mp[3072]) + acc[m][n][3] * bf2f(gp[3072]));
      }
  }
}
__device__ __forceinline__ void phase_f(const Params& p, char* smem) {
  const int MT = 68, NT = 8;
  const int tid = launder_tid(), lane = tid & 63, w = tid >> 6, wr = w >> 1, wc = w & 1, fr = lane & 15, fq = lane >> 4;
  int cur = 0;
  {
    int mt0, nt0;
    tile_map(blockIdx.x, MT, NT, mt0, nt0);
    gemm_prologue(p.MER + (size_t)mt0 * 256 * 1024, 1024, p.Wt_out + (size_t)nt0 * 128 * 1024, 1024, smem, cur);
  }
  for (int tile = blockIdx.x; tile < MT * NT; tile += gridDim.x) {
    int mt, nt, nmt, nnt;
    tile_map(tile, MT, NT, mt, nt);
    const bool hn = tile + (int)gridDim.x < MT * NT;
    tile_map(hn ? tile + (int)gridDim.x : tile, MT, NT, nmt, nnt);
    f32x4 acc[4][4];
    zero_acc(acc);
    gemm_tile(p.MER + (size_t)mt * 256 * 1024, 1024, p.Wt_out + (size_t)nt * 128 * 1024, 1024, 1024,
              p.MER + (size_t)nmt * 256 * 1024, 1024, p.Wt_out + (size_t)nnt * 128 * 1024, 1024, hn, smem, acc, cur);
    const int seq = seq_of(mt * 256 + wr * 64);
#pragma unroll
    for (int n = 0; n < 4; n++) {
      const int col = nt * 128 + wc * 64 + n * 16 + fr;
      const float g1 = p.modf[seq * 6144 + 2048 + col];
#pragma unroll
      for (int m = 0; m < 4; m++) {
        const int row4 = mt * 256 + wr * 64 + m * 16 + fq * 4;
#pragma unroll
        for (int r = 0; r < 4; r++) {
          const int row = row4 + r;
          p.X1[(size_t)row * 1024 + col] = xrow(p, row)[col] + g1 * acc[m][n][r];
        }
      }
    }
  }
}
__device__ __forceinline__ void phase_h(const Params& p, char* smem) {
  __syncthreads();
  pg8::Gemm g{p.U, p.Wt_gu, kT, 5632, 1024};
  pg8::StaticOrder S;
  S.init(kT, 5632, gridDim.x, blockIdx.x);
  EpiH E{p.HFF};
  pg8::gemm_phase<EpiH, pg8::StaticOrder, false>((PG8_LAS unsigned char*)smem, g, S, E, nullptr);
}
__device__ __forceinline__ void phase_i(const Params& p, char* smem) {
  const int MT = 68, NT = 8;
  const int tid = launder_tid(), lane = tid & 63, w = tid >> 6, wr = w >> 1, wc = w & 1, fr = lane & 15, fq = lane >> 4;
  int cur = 0;
  {
    int mt0, nt0;
    tile_map(blockIdx.x, MT, NT, mt0, nt0);
    gemm_prologue(p.HFF + (size_t)mt0 * 256 * 2816, 2816, p.Wt_down + (size_t)nt0 * 128 * 2816, 2816, smem, cur);
  }
  for (int tile = blockIdx.x; tile < MT * NT; tile += gridDim.x) {
    int mt, nt, nmt, nnt;
    tile_map(tile, MT, NT, mt, nt);
    const bool hn = tile + (int)gridDim.x < MT * NT;
    tile_map(hn ? tile + (int)gridDim.x : tile, MT, NT, nmt, nnt);
    f32x4 acc[4][4];
    zero_acc(acc);
    gemm_tile(p.HFF + (size_t)mt * 256 * 2816, 2816, p.Wt_down + (size_t)nt * 128 * 2816, 2816, 2816,
              p.HFF + (size_t)nmt * 256 * 2816, 2816, p.Wt_down + (size_t)nnt * 128 * 2816, 2816, hn, smem, acc, cur);
    const int seq = seq_of(mt * 256 + wr * 64);
#pragma unroll
    for (int n = 0; n < 4; n++) {
      const int col = nt * 128 + wc * 64 + n * 16 + fr;
      const float g2 = p.modf[seq * 6144 + 5120 + col];
#pragma unroll
      for (int m = 0; m < 4; m++) {
        const int row4 = mt * 256 + wr * 64 + m * 16 + fq * 4;
#pragma unroll
        for (int r = 0; r < 4; r++) {
          float* px = p.X1 + (size_t)(row4 + r) * 1024 + col;
          *px = *px + g2 * acc[m][n][r];
        }
      }
    }
  }
}
__device__ __forceinline__ void phase_j(const Params& p) {
  const int tid = launder_tid(), lane = tid & 63, w = tid >> 6;
  for (int g = blockIdx.x * 8 + w; g < kT / 4; g += gridDim.x * 8) {
    float4 v[4][4];
#pragma unroll
    for (int i = 0; i < 4; i++)
#pragma unroll
      for (int j = 0; j < 4; j++) v[i][j] = *(const float4*)(p.X1 + (size_t)(g * 4 + i) * 1024 + j * 256 + lane * 4);
#pragma unroll
    for (int i = 0; i < 4; i++) {
      const int row = g * 4 + i;
      float ss = 0.f;
#pragma unroll
      for (int j = 0; j < 4; j++)
        ss += v[i][j].x * v[i][j].x + v[i][j].y * v[i][j].y + v[i][j].z * v[i][j].z + v[i][j].w * v[i][j].w;
      ss = wave_sum(ss);
      float rstd = rsqrtf(ss * (1.0f / 1024.0f) + 1e-6f);
      float* o = p.out + (row < kNP ? O_YP + (size_t)row * 1024 : O_YS + (size_t)(row - kNP) * 1024);
#pragma unroll
      for (int j = 0; j < 4; j++) {
        int c = j * 256 + lane * 4;
        float4 gg = *(const float4*)(p.final_g + c);
        float4 r4;
        r4.x = v[i][j].x * rstd * gg.x;
        r4.y = v[i][j].y * rstd * gg.y;
        r4.z = v[i][j].z * rstd * gg.z;
        r4.w = v[i][j].w * rstd * gg.w;
        *(float4*)(o + c) = r4;
      }
    }
  }
}

#define XB_TMO      128
#define XB_XCNT(j)  (256  + 64 * (j))
#define XB_XSUB(j)  (1280 + 64 * (j))
#define XB_XGEN(j)  (2304 + 64 * (j))
#define XB_TOP      3328
#define XB_TOPGEN   3392
#define XCD_BAR_WORDS 3456
#define XB_SPIN_CAP (1u << 18)
#define LAS __attribute__((address_space(3)))

__device__ __forceinline__ unsigned xb_ld(unsigned* p)              { return __hip_atomic_load(p, __ATOMIC_RELAXED, __HIP_MEMORY_SCOPE_AGENT); }
__device__ __forceinline__ unsigned xb_add(unsigned* p, unsigned v) { return __hip_atomic_fetch_add(p, v, __ATOMIC_RELAXED, __HIP_MEMORY_SCOPE_AGENT); }
__device__ __forceinline__ unsigned xb_xcc_id() { return (unsigned)__builtin_amdgcn_s_getreg((3 << 11) | 20) & 0xFu; }
#define XB_SPIN(cond, bar) do { unsigned _sp = 0; while (cond) { __builtin_amdgcn_s_sleep(1); \
    if ((++_sp & 255u) == 0u) { if (xb_ld(&(bar)[XB_TMO])) break; if (_sp > XB_SPIN_CAP) { atomicAdd(&(bar)[XB_TMO], 1u); break; } } } } while (0)

struct XcdBarrier {
    unsigned* bar; unsigned x;
    volatile LAS unsigned* st;
};

__device__ __forceinline__ XcdBarrier xcd_barrier_post(unsigned* bar, volatile LAS unsigned* st) {
    XcdBarrier b; b.bar = bar; b.x = xb_xcc_id(); b.st = st;
    if (threadIdx.x == 0) (void)xb_add(&bar[XB_XCNT(b.x)], 1u);
    return b;
}
__device__ __forceinline__ void xcd_barrier_complete(unsigned* bar, unsigned x, unsigned& nloc, unsigned& nx) {
    const unsigned G = gridDim.x * gridDim.y * gridDim.z;
    unsigned sum, cnt, mine, sp = 0u;
    for (;;) {
        sum = 0u; cnt = 0u; mine = 0u;
#pragma unroll
        for (unsigned j = 0; j < 16; ++j) { const unsigned c = xb_ld(&bar[XB_XCNT(j)]); sum += c; cnt += (c > 0u) ? 1u : 0u; mine = (j == x) ? c : mine; }
        if (sum == G) break;
        __builtin_amdgcn_s_sleep(1);
        if ((++sp & 255u) == 0u) { if (xb_ld(&bar[XB_TMO])) break; if (sp > XB_SPIN_CAP) { atomicAdd(&bar[XB_TMO], 1u); break; } }
    }
    nloc = mine > 0u ? mine : 1u; nx = cnt > 0u ? cnt : 1u;
}

__device__ __forceinline__ void xcd_barrier(const XcdBarrier& b) {
    asm volatile("s_waitcnt vmcnt(0)" ::: "memory");
    __syncthreads();
    if (threadIdx.x == 0) {
        unsigned* bar = b.bar;
        __builtin_amdgcn_s_waitcnt(0);
        unsigned nloc = b.st[0], nx = b.st[1];
        if (nloc == 0u) { xcd_barrier_complete(bar, b.x, nloc, nx); b.st[0] = nloc; b.st[1] = nx; }
        const unsigned old = xb_add(&bar[XB_XSUB(b.x)], 1u);
        const unsigned gen = old / nloc;
        if (old + 1u == (gen + 1u) * nloc) {
            __builtin_amdgcn_fence(__ATOMIC_RELEASE, "agent");
            asm volatile("s_waitcnt vmcnt(0)" ::: "memory");
            const unsigned og = xb_add(&bar[XB_TOP], 1u);
            const unsigned tg = og / nx;
            if (og + 1u == (tg + 1u) * nx) xb_add(&bar[XB_TOPGEN], 1u);
            else XB_SPIN(xb_ld(&bar[XB_TOPGEN]) == tg, bar);
            __builtin_amdgcn_fence(__ATOMIC_ACQUIRE, "agent");
            xb_add(&bar[XB_XGEN(b.x)], 1u);
            asm volatile("s_waitcnt vmcnt(0)" ::: "memory");
        } else {
            XB_SPIN(xb_ld(&bar[XB_XGEN(b.x)]) == gen, bar);
            __builtin_amdgcn_fence(__ATOMIC_ACQUIRE, "agent");
            asm volatile("s_waitcnt vmcnt(0)" ::: "memory");
        }
    }
    __syncthreads();
}


extern __shared__ __attribute__((aligned(16))) char dyn_smem[];

#ifndef REP_A
#define REP_A 1
#endif
#ifndef REP_C
#define REP_C 1
#endif
#ifndef REP_D
#define REP_D 1
#endif
#ifndef REP_H
#define REP_H 1
#endif
#ifndef REP_E
#define REP_E 1
#endif
__global__ void __launch_bounds__(NTHREADS) mega_kernel(Params p) {
  cg::grid_group grid = cg::this_grid();
  volatile LAS unsigned* xst = (volatile LAS unsigned*)(dyn_smem + LDS_BYTES - 32);
  if (threadIdx.x < 4) xst[threadIdx.x] = 0u;
  __syncthreads();
  XcdBarrier xb = xcd_barrier_post(p.bar, xst);
  if (p.bar == nullptr) grid.sync();
#pragma unroll 1
  for (int r = 0; r < REP_A; r++) {
    phase_a(p, dyn_smem);
    xcd_barrier(xb);
  }
  phase_b(p, dyn_smem);
  xcd_barrier(xb);
#pragma unroll 1
  for (int r = 0; r < REP_C; r++) {
    phase_c(p, dyn_smem);
    xcd_barrier(xb);
  }
  phase_d0(p, dyn_smem);
  xcd_barrier(xb);
#pragma unroll 1
  for (int r = 0; r < REP_D; r++) {
    phase_d(p, dyn_smem, r);
    xcd_barrier(xb);
  }
#pragma unroll 1
  for (int r = 0; r < REP_E; r++) {
    phase_e(p, dyn_smem);
    xcd_barrier(xb);
  }
  phase_f(p, dyn_smem);
  xcd_barrier(xb);
  phase_g(p, dyn_smem);
  xcd_barrier(xb);
#pragma unroll 1
  for (int r = 0; r < REP_H; r++) {
    phase_h(p, dyn_smem);
    xcd_barrier(xb);
  }
  phase_i(p, dyn_smem);
  xcd_barrier(xb);
  phase_j(p);
}
extern "C" void kernel_launch(void* const* d_in, const int* in_sizes, int n_in, void* d_out, int out_size, void* d_ws,
                              size_t ws_size, hipStream_t stream) {
  Params p{};
  const float** pin = (const float**)&p;
  for (int i = 0; i < 26; i++) pin[i] = (const float*)d_in[i];
  p.out = (float*)d_out;
  char* ws = (char*)d_ws;
  size_t off = 0;
  auto alloc = [&](size_t bytes) {
    char* r = ws + off;
    off += (bytes + 255) & ~(size_t)255;
    return r;
  };
  p.Wt_in = (bf16_t*)alloc((size_t)5632 * 1024 * 2);
  p.Wt_a = (bf16_t*)alloc((size_t)1024 * 512 * 2);
  p.Wt_b = (bf16_t*)alloc((size_t)1024 * 512 * 2);
  p.Wt_out = (bf16_t*)alloc((size_t)1024 * 1024 * 2);
  p.Wt_gu = (bf16_t*)alloc((size_t)5632 * 1024 * 2);
  p.Wt_down = (bf16_t*)alloc((size_t)1024 * 2816 * 2);
  p.wg = (float*)alloc(8192 * 4);
  p.modp = (float*)alloc((size_t)8 * 24 * 6144 * 4);
  p.modf = (float*)alloc((size_t)24 * 6144 * 4);
  p.U = (bf16_t*)alloc((size_t)kT * 1024 * 2);
  char* r1 = ws + off;
  p.Qb = (bf16_t*)alloc((size_t)kT * 512 * 2);
  p.Kp = (bf16_t*)alloc((size_t)64 * 2048 * 64 * 2);
  p.Ks = (bf16_t*)alloc((size_t)128 * 1152 * 64 * 2);
  p.VTp = (bf16_t*)alloc((size_t)64 * 64 * 2048 * 2);
  p.VTs = (bf16_t*)alloc((size_t)128 * 64 * 1152 * 2);
  p.MQK = (bf16_t*)alloc((size_t)kT * 1024 * 2);
  const size_t r1_bytes = (size_t)(ws + off - r1);
  char* r2 = ws + off;
  p.MVTp = (bf16_t*)alloc((size_t)32 * 128 * 2048 * 2);
  p.MVTs = (bf16_t*)alloc((size_t)64 * 128 * 64 * 2);
  p.SO = (bf16_t*)alloc((size_t)kT * 512 * 2);
  const size_t r2_bytes = (size_t)(ws + off - r2);
  char* r3 = ws + off;
  p.GA = (bf16_t*)alloc((size_t)kT * 1024 * 2);
  p.GB = (bf16_t*)alloc((size_t)kT * 1024 * 2);
  const size_t r3_bytes = (size_t)(ws + off - r3);
  p.GI = (float*)alloc((size_t)kT * 4 * 4);
  p.LF = (float*)alloc((size_t)kT * 4 * 4);
  p.GV = (float*)alloc((size_t)1088 * 384 * 4);
  p.DENc = (float*)alloc((size_t)1088 * 64 * 4);
  char* r4 = ws + off;
  p.Qc = (bf16_t*)alloc((size_t)1088 * 8192 * 2);
  p.KTc = (bf16_t*)alloc((size_t)1088 * 8192 * 2);
  p.SWc = (bf16_t*)alloc((size_t)1088 * 4096 * 2);
  p.YA = (bf16_t*)alloc((size_t)kT * 512 * 2);
  p.YB = (bf16_t*)alloc((size_t)kT * 512 * 2);
  const size_t r4_bytes = (size_t)(ws + off - r4);
  p.counter = (unsigned*)alloc(256);
  p.bar = (unsigned*)alloc(XCD_BAR_WORDS * 4);
  p.HFF = (bf16_t*)r1;
  p.MER = (bf16_t*)r2;
  p.X1 = (float*)r4;
  if (r1_bytes < (size_t)kT * 2816 * 2 || r2_bytes < (size_t)kT * 1024 * 2 ||
      r4_bytes < (size_t)kT * 1024 * 4 || off > ws_size) {
    fprintf(stderr, "workspace layout error: need %zu bytes, have %zu\n", off, ws_size);
    return;
  }

#if ONE_LAUNCH
  static int grid_blocks = 0;
  if (!grid_blocks) {
    int dev = 0, cus = 0, per_cu = 0;
    hipGetDevice(&dev);
    hipDeviceGetAttribute(&cus, hipDeviceAttributeMultiprocessorCount, dev);
    hipFuncSetAttribute((const void*)mega_kernel, hipFuncAttributeMaxDynamicSharedMemorySize, LDS_BYTES);
    hipOccupancyMaxActiveBlocksPerMultiprocessor(&per_cu, mega_kernel, NTHREADS, LDS_BYTES);
    if (per_cu < 1) per_cu = 1;
    grid_blocks = cus * per_cu;
  }
  (void)hipMemsetAsync(p.bar, 0, XCD_BAR_WORDS * 4, stream);
  void* args[] = {&p};
  hipError_t e = hipLaunchCooperativeKernel((void*)mega_kernel, dim3(grid_blocks), dim3(NTHREADS), args, LDS_BYTES, stream);
  if (e != hipSuccess) fprintf(stderr, "cooperative launch failed: %s (grid %d)\n", hipGetErrorString(e), grid_blocks);
#endif
}
```

```cpp
#include <hip/hip_runtime.h>
#include <hip/hip_cooperative_groups.h>
#include <stdint.h>
#include <stdio.h>
namespace cg = cooperative_groups;

#ifndef ONE_LAUNCH
#define ONE_LAUNCH 1
#endif

typedef unsigned short bf16_t;
using bf16x8 = __attribute__((ext_vector_type(8))) short;
using f32x4 = __attribute__((ext_vector_type(4))) float;

#define NTHREADS 512
#define LDS_BYTES 155648
constexpr int kNP = 16384;
constexpr int kT = 17408;
constexpr int kINW = 5640;

struct Params {
  const float *x_prompt, *x_sample, *c_prompt, *c_sample, *cache_k, *cache_v, *st_C, *st_n, *st_m, *st_conv;
  const float *norm1_g, *norm2_g, *w_ada, *b_ada, *w_in, *b_if, *w_conv, *b_conv, *ml_norm_g, *w_a, *w_b, *w_out,
      *w_gate, *w_up, *w_down, *final_g;
  float* out;
  bf16_t *Wt_in, *Wt_a, *Wt_b, *Wt_out, *Wt_gu, *Wt_down;
  float *wg, *modp, *modf;
  bf16_t *U, *Qb, *Kp, *Ks, *VTp, *VTs, *MQK, *MVTp, *MVTs, *SO, *GA, *GB;
  float *GI, *LF, *GV, *DENc;
  bf16_t *Qc, *KTc, *SWc;
  bf16_t *YA, *YB, *MER;
  float* X1;
  float* SLAB;
  bf16_t* HFF;
  unsigned* counter;
  unsigned* bar;
};

constexpr size_t O_YP = 0;
constexpr size_t O_YS = O_YP + 16777216;
constexpr size_t O_KP = O_YS + 1048576;
constexpr size_t O_VP = O_KP + 8388608;
constexpr size_t O_CP = O_VP + 8388608;
constexpr size_t O_NP = O_CP + 524288;
constexpr size_t O_MP = O_NP + 4096;
constexpr size_t O_CVP = O_MP + 32;
constexpr size_t O_KS = O_CVP + 24576;
constexpr size_t O_VS = O_KS + 524288;
constexpr size_t O_CS = O_VS + 524288;
constexpr size_t O_NS = O_CS + 1048576;
constexpr size_t O_MS = O_NS + 8192;
constexpr size_t O_CVS = O_MS + 64;

typedef __bf16 hwbf16x2_t __attribute__((ext_vector_type(2)));
typedef float hwf32x2_t __attribute__((ext_vector_type(2)));
__device__ __forceinline__ bf16_t f2bf(float f) {
  __bf16 r = (__bf16)f;
  return __builtin_bit_cast(unsigned short, r);
}
__device__ __forceinline__ float bf2f(bf16_t h) { return __uint_as_float(((unsigned)h) << 16); }
__device__ __forceinline__ unsigned pack2(float a, float b) {
  hwf32x2_t v = {a, b};
  hwbf16x2_t r = __builtin_convertvector(v, hwbf16x2_t);
  return __builtin_bit_cast(unsigned, r);
}
__device__ __forceinline__ float sigm(float x) { return __builtin_amdgcn_rcpf(1.0f + __expf(-x)); }
__device__ __forceinline__ float silu(float x) { return x * __builtin_amdgcn_rcpf(1.0f + __expf(-x)); }
__device__ __forceinline__ float logsig(float x) { return fminf(x, 0.f) - __logf(1.0f + __expf(-fabsf(x))); }
__device__ __forceinline__ float wave_sum(float v) {
#pragma unroll
  for (int o = 32; o > 0; o >>= 1) v += __shfl_xor(v, o);
  return v;
}
__device__ __forceinline__ float wave_max(float v) {
#pragma unroll
  for (int o = 32; o > 0; o >>= 1) v = fmaxf(v, __shfl_xor(v, o));
  return v;
}
__device__ __forceinline__ int seq_of(int row) { return row < kNP ? (row >> 11) : 8 + ((row - kNP) >> 6); }
__device__ __forceinline__ const float* xrow(const Params& p, int row) {
  return row < kNP ? p.x_prompt + (size_t)row * 1024 : p.x_sample + (size_t)(row - kNP) * 1024;
}
__device__ __forceinline__ int launder_tid() {
  int t = threadIdx.x;
  asm volatile("" : "+v"(t));
  return t;
}
__device__ __forceinline__ bf16x8 lds8(const void* p) { return *(const bf16x8*)p; }
#define MFMA(a, b, c) __builtin_amdgcn_mfma_f32_16x16x32_bf16(a, b, c, 0, 0, 0)

__device__ __forceinline__ void glds16(const void* g, void* l) {
  __builtin_amdgcn_global_load_lds((const unsigned*)g, (unsigned*)l, 16, 0, 0);
}
__device__ __forceinline__ void gemm_stage(const bf16_t* __restrict__ A, int lda, const bf16_t* __restrict__ B, int ldb,
                                           int k0, char* st) {
  const int tid = launder_tid();
#pragma unroll
  for (int i = 0; i < 4; i++) {
    int b = tid + i * 512;
    int row = b >> 3;
    int ch = (b & 7) ^ ((row >> 1) & 7);
    glds16(A + (size_t)row * lda + k0 + ch * 8, st + b * 16);
  }
#pragma unroll
  for (int i = 0; i < 2; i++) {
    int b = tid + i * 512;
    int row = b >> 3;
    int ch = (b & 7) ^ ((row >> 1) & 7);
    glds16(B + (size_t)row * ldb + k0 + ch * 8, st + 32768 + b * 16);
  }
}
__device__ __forceinline__ void gemm_prologue(const bf16_t* __restrict__ A, int lda, const bf16_t* __restrict__ B, int ldb,
                                              char* smem, int& cur) {
  __syncthreads();
  cur = 0;
  gemm_stage(A, lda, B, ldb, 0, smem);
  gemm_stage(A, lda, B, ldb, 64, smem + 49152);
}
template <bool BATCH = true>
__device__ __forceinline__ void gemm_tile(const bf16_t* __restrict__ A, int lda, const bf16_t* __restrict__ B, int ldb,
                                          int K, const bf16_t* __restrict__ nA, int nlda, const bf16_t* __restrict__ nB,
                                          int nldb, bool has_next, char* smem, f32x4 (&acc)[4][4], int& cur) {
  const int tid = launder_tid(), lane = tid & 63, w = tid >> 6, wr = w >> 1, wc = w & 1;
  const int fr = lane & 15, fq = lane >> 4;
  const int nt = K >> 6;
  for (int t = 0; t < nt; t++) {
    if (t == 0) asm volatile("s_waitcnt vmcnt(0)" ::: "memory");
    else if (t + 1 < nt || has_next) asm volatile("s_waitcnt vmcnt(6)" ::: "memory");
    else asm volatile("s_waitcnt vmcnt(0)" ::: "memory");
    __builtin_amdgcn_s_barrier();
    asm volatile("" ::: "memory");
    {
      int nxt = cur + 2;
      if (nxt >= 3) nxt -= 3;
      if (t + 2 < nt) gemm_stage(A, lda, B, ldb, (t + 2) << 6, smem + nxt * 49152);
      else if (has_next) gemm_stage(nA, nlda, nB, nldb, (t + 2 - nt) << 6, smem + nxt * 49152);
    }
    const char* sa = smem + cur * 49152;
    cur = (cur == 2) ? 0 : cur + 1;
    const char* sb = sa + 32768;
    if (BATCH) {
      bf16x8 af[2][4], bfr[2][4];
#pragma unroll
      for (int ks = 0; ks < 2; ks++) {
        const int ch = ((ks * 4 + fq) ^ ((fr >> 1) & 7)) * 16;
#pragma unroll
        for (int m = 0; m < 4; m++) af[ks][m] = lds8(sa + (wr * 64 + m * 16 + fr) * 128 + ch);
#pragma unroll
        for (int n = 0; n < 4; n++) bfr[ks][n] = lds8(sb + (wc * 64 + n * 16 + fr) * 128 + ch);
      }
      __builtin_amdgcn_s_setprio(1);
#pragma unroll
      for (int ks = 0; ks < 2; ks++) {
#pragma unroll
        for (int m = 0; m < 4; m++)
#pragma unroll
          for (int n = 0; n < 4; n++) acc[m][n] = MFMA(af[ks][m], bfr[ks][n], acc[m][n]);
      }
      __builtin_amdgcn_s_setprio(0);
    } else {
#pragma unroll
      for (int ks = 0; ks < 2; ks++) {
        bf16x8 af[4], bfr[4];
        const int ch = ((ks * 4 + fq) ^ ((fr >> 1) & 7)) * 16;
#pragma unroll
        for (int m = 0; m < 4; m++) af[m] = lds8(sa + (wr * 64 + m * 16 + fr) * 128 + ch);
#pragma unroll
        for (int n = 0; n < 4; n++) bfr[n] = lds8(sb + (wc * 64 + n * 16 + fr) * 128 + ch);
#pragma unroll
        for (int m = 0; m < 4; m++)
#pragma unroll
          for (int n = 0; n < 4; n++) acc[m][n] = MFMA(af[m], bfr[n], acc[m][n]);
      }
    }
  }
}
__device__ __forceinline__ void gemm256_stage(const bf16_t* __restrict__ A, int lda, const bf16_t* __restrict__ B, int ldb,
                                              int k0, char* st) {
  const int tid = threadIdx.x;
#pragma unroll
  for (int i = 0; i < 4; i++) {
    int b = tid + i * 512;
    int row = b >> 3;
    int ch = (b & 7) ^ ((row >> 1) & 7);
    glds16(A + (size_t)row * lda + k0 + ch * 8, st + b * 16);
  }
#pragma unroll
  for (int i = 0; i < 4; i++) {
    int b = tid + i * 512;
    int row = b >> 3;
    int ch = (b & 7) ^ ((row >> 1) & 7);
    glds16(B + (size_t)row * ldb + k0 + ch * 8, st + 32768 + b * 16);
  }
}
__device__ __forceinline__ void gemm256_prologue(const bf16_t* __restrict__ A, int lda, const bf16_t* __restrict__ B,
                                                 int ldb, char* smem, int& cur) {
  __syncthreads();
  cur = 0;
  gemm256_stage(A, lda, B, ldb, 0, smem);
}
__device__ __forceinline__ void gemm256_tile(const bf16_t* __restrict__ A, int lda, const bf16_t* __restrict__ B, int ldb,
                                             int K, const bf16_t* __restrict__ nA, int nlda,
                                             const bf16_t* __restrict__ nB, int nldb, bool has_next, char* smem,
                                             f32x4 (&acc)[8][4], int& cur) {
  const int tid = launder_tid(), lane = tid & 63, w = tid >> 6, wr = w >> 2, wc = w & 3;
  const int fr = lane & 15, fq = lane >> 4;
  const int nt = K >> 6;
  asm volatile("" : "+s"(A), "+s"(B), "+s"(nA), "+s"(nB), "+s"(lda), "+s"(ldb), "+s"(nlda), "+s"(nldb));
  for (int t = 0; t < nt; t++) {
    asm volatile("s_waitcnt vmcnt(0)" ::: "memory");
    __builtin_amdgcn_s_barrier();
    asm volatile("" ::: "memory");
    {
      char* nb = smem + (cur ^ 1) * 65536;
      if (t + 1 < nt) gemm256_stage(A, lda, B, ldb, (t + 1) << 6, nb);
      else if (has_next) gemm256_stage(nA, nlda, nB, nldb, 0, nb);
    }
    const char* sa = smem + cur * 65536;
    const char* sb = sa + 32768;
    cur ^= 1;
#pragma unroll
    for (int ks = 0; ks < 2; ks++) {
      bf16x8 bfr[4];
      const int ch = ((ks * 4 + fq) ^ ((fr >> 1) & 7)) * 16;
#pragma unroll
      for (int n = 0; n < 4; n++) bfr[n] = lds8(sb + (wc * 64 + n * 16 + fr) * 128 + ch);
#pragma unroll
      for (int mh = 0; mh < 2; mh++) {
        bf16x8 af[4];
#pragma unroll
        for (int m = 0; m < 4; m++) af[m] = lds8(sa + (wr * 128 + mh * 64 + m * 16 + fr) * 128 + ch);
#pragma unroll
        for (int m = 0; m < 4; m++)
#pragma unroll
          for (int n = 0; n < 4; n++) acc[mh * 4 + m][n] = MFMA(af[m], bfr[n], acc[mh * 4 + m][n]);
      }
    }
  }
}
__device__ __forceinline__ void tile_map(int tile, int MT, int NT, int& mt, int& nt) {
  int per = 8 * NT;
  int g = tile / per, r = tile - g * per;
  int gsz = min(8, MT - g * 8);
  mt = g * 8 + r % gsz;
  nt = r / gsz;
}
__device__ __forceinline__ void zero_acc(f32x4 (&acc)[4][4]) {
#pragma unroll
  for (int m = 0; m < 4; m++)
#pragma unroll
    for (int n = 0; n < 4; n++) acc[m][n] = (f32x4){0.f, 0.f, 0.f, 0.f};
}

namespace pg8 {
#define PG8_LAS __attribute__((address_space(3)))
typedef unsigned short bf16_t;
typedef short bf16x8 __attribute__((ext_vector_type(8)));
typedef float f32x4 __attribute__((ext_vector_type(4)));
typedef unsigned u32x4 __attribute__((ext_vector_type(4)));
constexpr int BM = 256, BK = 64, HALF = 128, HTB = HALF * BK * 2  , STAGE_BYTES = 8 * HTB, NXCD = 8, WGM = 8;

__host__ __device__ __forceinline__ int lds_byte(int r, int c) { const int st = (r >> 4) * 2 + (c >> 5), rr = r & 15, cc = c & 31, ob = rr * 64 + cc * 2; return st * 1024 + (ob ^ (((ob >> 9) & 1) << 5)); }
__host__ __device__ __forceinline__ void stage_rc(int b, int& R, int& C) { const int st = b / 1024, sb = b % 1024, swz = sb ^ (((sb >> 9) & 1) << 5); R = (st >> 1) * 16 + swz / 64; C = (st & 1) * 32 + (swz % 64) / 2; }
__host__ __device__ __forceinline__ int perm32(int rho) { const int n = rho >> 4, i = rho & 15; return 8 * (i >> 2) + 4 * n + (i & 3); }

struct Unit { int pm, pn; int ko = 0, nt = 0; };
struct Gemm { const bf16_t* A; const bf16_t* Bt; int M, N, K; int ld = 0; };

struct StaticOrder {
    int nM, nN, nwg, G, c;
    __host__ __device__ void init(int M, int N, int G_, int c_) { nM = M / BM; nN = N / BM; nwg = nM * nN; G = G_; c = c_; }
    __host__ __device__ bool next(int i, Unit& u) const {
        const long L = (long)i * G + c; if (L >= nwg) return false;
        int wgid = (int)L; { const int q = nwg / NXCD, r = nwg % NXCD, xcd = wgid % NXCD, off = wgid / NXCD; wgid = (xcd < r ? xcd * (q + 1) : r * (q + 1) + (xcd - r) * q) + off; }
        const int nig = WGM * nN, gid = wgid / nig, fm = gid * WGM, gsz = (nM - fm) < WGM ? (nM - fm) : WGM;
        u.pm = fm + ((wgid % nig) % gsz); u.pn = (wgid % nig) / gsz; return true;
    }
    __device__ __forceinline__ void a_ready(const Unit&) const {}
    __device__ __forceinline__ void done(const Unit&) const {}
};
__device__ __forceinline__ unsigned cvt_pk_bf16(float lo, float hi) { unsigned r; asm volatile("v_cvt_pk_bf16_f32 %0, %1, %2" : "=v"(r) : "v"(lo), "v"(hi)); return r; }
template <class Epi, class Sched, bool STAMP = false>
__device__ __forceinline__ void gemm_phase(PG8_LAS unsigned char* lds, const Gemm g, const Sched& S, const Epi& E, unsigned long long* stamps) {
    const int tid = launder_tid(), wid = __builtin_amdgcn_readfirstlane(tid >> 6), lane = tid & 63, wr = wid >> 2, wc = wid & 3, fr = lane & 15, fq = lane >> 4;
    const int K = g.K, nt = K / BK, ld = g.ld ? g.ld : K;
    int ts_lo = 0, ts_hi = 0, nts = 0; const unsigned long long rt_entry = STAMP ? (unsigned long long)wall_clock64() : 0ull;
#define PG8_STAMP() do { if (STAMP && wid == 0 && nts < 64) { const unsigned long long _c = (unsigned long long)clock64(); \
        ts_lo = (lane == nts) ? (int)(unsigned)_c : ts_lo; ts_hi = (lane == nts) ? (int)(unsigned)(_c >> 32) : ts_hi; ++nts; } } while (0)
    PG8_STAMP();
    unsigned voffA[2], voffB[2];
#pragma unroll
    for (int i = 0; i < 2; ++i) { int R, C; stage_rc(tid * 16 + i * 8192, R, C); const int Rb = Epi::PERM ? ((R & ~31) + perm32(R & 31)) : R;
        voffA[i] = (unsigned)(R * ld + C) * 2u; voffB[i] = (unsigned)(Rb * ld + C) * 2u; }
    const size_t kstep = (size_t)(BK * 2);
    const size_t hstep = (size_t)HALF * ld * 2;
    const size_t tstep = 2 * hstep;
    const unsigned ldsw = (unsigned)wid * 1024u;
    const int aoff = lds_byte(wr * 64 + fr, fq * 8), boff = lds_byte(wc * 32 + fr, fq * 8);
#define PG8_SA(b, h) (((b) * 2 + (h)) * HTB)
#define PG8_SB(b, h) ((4 + (b) * 2 + (h)) * HTB)
#define PG8_STAGE(bufoff, gbase, voff) do { _Pragma("unroll") for (int _i = 0; _i < 2; ++_i) \
        __builtin_amdgcn_global_load_lds((const unsigned*)((const char*)(gbase) + (voff)[_i]), (PG8_LAS unsigned*)(lds + (bufoff) + ldsw + _i * 8192), 16, 0, 0); } while (0)
#define PG8_LDA(dst, b, h) do { _Pragma("unroll") for (int m = 0; m < 4; ++m) _Pragma("unroll") for (int k = 0; k < 2; ++k) dst[m][k] = *(const PG8_LAS bf16x8*)(lds + PG8_SA(b, h) + aoff + m * 2048 + k * 1024); } while (0)
#define PG8_LDB(dst, b, h) do { _Pragma("unroll") for (int n = 0; n < 2; ++n) _Pragma("unroll") for (int k = 0; k < 2; ++k) dst[n][k] = *(const PG8_LAS bf16x8*)(lds + PG8_SB(b, h) + boff + n * 2048 + k * 1024); } while (0)
#define PG8_MMA(ai, bj, At, Bt) do { __builtin_amdgcn_s_setprio(1); _Pragma("unroll") for (int m = 0; m < 4; ++m) _Pragma("unroll") for (int n = 0; n < 2; ++n) _Pragma("unroll") for (int k = 0; k < 2; ++k) \
        acc[ai][bj][m][n] = __builtin_amdgcn_mfma_f32_16x16x32_bf16(Bt[n][k], At[m][k], acc[ai][bj][m][n], 0, 0, 0); __builtin_amdgcn_s_setprio(0); } while (0)
#define PG8_WAIT_V(n) asm volatile("s_waitcnt vmcnt(" #n ")" ::: "memory")
#define PG8_WAIT_L(n) asm volatile("s_waitcnt lgkmcnt(" #n ")" ::: "memory")
#define PG8_BAR __builtin_amdgcn_s_barrier()
#define PG8_SCHED __builtin_amdgcn_sched_barrier(0)
    Unit cur, nxt; int ui = 0;
    if (!S.next(0, cur)) return;
    f32x4 acc[2][2][4][2];
#pragma unroll
    for (int a = 0; a < 2; ++a)
#pragma unroll
        for (int b = 0; b < 2; ++b)
#pragma unroll
            for (int m = 0; m < 4; ++m)
#pragma unroll
                for (int n = 0; n < 2; ++n) acc[a][b][m][n] = (f32x4){0.f, 0.f, 0.f, 0.f};
    bf16x8 At[4][2], B0[2][2], B1[2][2];
    const char* cA = (const char*)g.A + (size_t)cur.pm * tstep + (size_t)cur.ko * 2; const char* cB = (const char*)g.Bt + (size_t)cur.pn * tstep + (size_t)cur.ko * 2;
    S.a_ready(cur);
    PG8_STAGE(PG8_SB(0, 0), cB, voffB); PG8_STAGE(PG8_SA(0, 0), cA, voffA); PG8_STAGE(PG8_SB(0, 1), cB + hstep, voffB); PG8_STAGE(PG8_SA(0, 1), cA + hstep, voffA);
    if (wr == 1) PG8_BAR;
    PG8_WAIT_V(4); PG8_BAR;
    PG8_STAGE(PG8_SB(1, 0), cB + kstep, voffB); PG8_STAGE(PG8_SA(1, 0), cA + kstep, voffA); PG8_STAGE(PG8_SB(1, 1), cB + hstep + kstep, voffB);
    PG8_WAIT_V(6); PG8_BAR;
    PG8_STAMP();
    for (;;) {
        const bool has_next = S.next(ui + 1, nxt);
        const char* nA = has_next ? (const char*)g.A + (size_t)nxt.pm * tstep + (size_t)nxt.ko * 2 : cA; const char* nB = has_next ? (const char*)g.Bt + (size_t)nxt.pn * tstep + (size_t)nxt.ko * 2 : cB;
        const int unt = cur.nt ? cur.nt : nt;
        for (int t = 0; t < unt; t += 2) {
            const bool last = (t == unt - 2);
            const char* a1 = cA + (size_t)(t + 1) * kstep;
            const char* a2 = last ? nA : cA + (size_t)(t + 2) * kstep; const char* b2 = last ? nB : cB + (size_t)(t + 2) * kstep;
            const char* a3 = a2 + kstep; const char* b3 = b2 + kstep;
            if (last && has_next) S.a_ready(nxt);
            PG8_LDB(B0, 0, 0); PG8_SCHED; PG8_LDA(At, 0, 0); PG8_STAGE(PG8_SA(1, 1), a1 + hstep, voffA);
            PG8_WAIT_L(8); PG8_BAR; PG8_WAIT_L(0); PG8_MMA(0, 0, At, B0); PG8_BAR; PG8_SCHED;
            PG8_LDB(B1, 0, 1); PG8_STAGE(PG8_SB(0, 0), b2, voffB);
            PG8_BAR; PG8_WAIT_L(0); PG8_MMA(0, 1, At, B1); PG8_BAR;
            PG8_LDA(At, 0, 1); PG8_STAGE(PG8_SA(0, 0), a2, voffA);
            PG8_BAR; PG8_WAIT_L(0); PG8_MMA(1, 0, At, B0); PG8_BAR; PG8_SCHED;
            PG8_STAGE(PG8_SB(0, 1), b2 + hstep, voffB);
            PG8_WAIT_V(6); PG8_BAR; PG8_MMA(1, 1, At, B1); PG8_BAR;
            PG8_LDB(B0, 1, 0); PG8_SCHED; PG8_LDA(At, 1, 0); PG8_STAGE(PG8_SA(0, 1), a2 + hstep, voffA);
            PG8_WAIT_L(8); PG8_BAR; PG8_WAIT_L(0); PG8_MMA(0, 0, At, B0); PG8_BAR; PG8_SCHED;
            PG8_LDB(B1, 1, 1); PG8_STAGE(PG8_SB(1, 0), b3, voffB);
            PG8_BAR; PG8_WAIT_L(0); PG8_MMA(0, 1, At, B1); PG8_BAR;
            PG8_LDA(At, 1, 1); PG8_STAGE(PG8_SA(1, 0), a3, voffA);
            PG8_BAR; PG8_WAIT_L(0); PG8_MMA(1, 0, At, B0); PG8_BAR; PG8_SCHED;
            PG8_STAGE(PG8_SB(1, 1), b3 + hstep, voffB);
            PG8_WAIT_V(6); PG8_BAR; PG8_MMA(1, 1, At, B1); PG8_BAR;
        }
        PG8_STAMP();
        if constexpr (!Epi::AFTER_DRAIN) { E(acc, cur, wr, wc, fr, fq); S.done(cur); }
        PG8_STAMP();
        if (!has_next) break;
#pragma unroll
        for (int a = 0; a < 2; ++a)
#pragma unroll
            for (int b = 0; b < 2; ++b)
#pragma unroll
                for (int m = 0; m < 4; ++m)
#pragma unroll
                    for (int n = 0; n < 2; ++n) acc[a][b][m][n] = (f32x4){0.f, 0.f, 0.f, 0.f};
        cur = nxt; cA = nA; cB = nB; ++ui;
    }
    PG8_WAIT_V(0);
    if (wr == 0) PG8_BAR;
    PG8_BAR;
    if constexpr (Epi::AFTER_DRAIN) { E.fused(acc, cur, wr, wc, fr, fq, lds, wid, lane); S.done(cur); }
    PG8_STAMP();
    if (STAMP && wid == 0) { stamps[lane] = lane < nts ? (((unsigned long long)(unsigned)ts_hi << 32) | (unsigned)ts_lo) : 0ull;
        if (lane == 62) stamps[62] = rt_entry; if (lane == 63) stamps[63] = (unsigned long long)wall_clock64(); }
#undef PG8_STAMP
#undef PG8_SA
#undef PG8_SB
#undef PG8_STAGE
#undef PG8_LDA
#undef PG8_LDB
#undef PG8_MMA
#undef PG8_WAIT_V
#undef PG8_WAIT_L
#undef PG8_BAR
#undef PG8_SCHED
}
}

__device__ __forceinline__ void transpose_quad(const float* __restrict__ src, int lds_, size_t sstep, bf16_t* __restrict__ dst, int ldd,
                               int k0, int kstep, int nbase, int nstep, int mode, char* smem) {
  float* tl = (float*)smem;
  const int tid = launder_tid();
  float4 v[4][2];
#pragma unroll
  for (int q = 0; q < 4; q++)
#pragma unroll
    for (int i = 0; i < 2; i++) {
      int idx = tid + i * 512;
      int k = idx >> 4, n4 = (idx & 15) * 4;
      v[q][i] = *(const float4*)(src + q * sstep + (size_t)k * lds_ + n4);
    }
  __syncthreads();
#pragma unroll
  for (int q = 0; q < 4; q++)
#pragma unroll
    for (int i = 0; i < 2; i++) {
      int idx = tid + i * 512;
      int k = idx >> 4, n4 = (idx & 15) * 4;
      float* t = tl + q * 4160 + k * 65 + n4;
      t[0] = v[q][i].x;
      t[1] = v[q][i].y;
      t[2] = v[q][i].z;
      t[3] = v[q][i].w;
    }
  __syncthreads();
  const int n = tid >> 3, kc = (tid & 7) * 8;
#pragma unroll
  for (int q = 0; q < 4; q++) {
    float o[8];
#pragma unroll
    for (int e = 0; e < 8; e++) o[e] = tl[q * 4160 + (kc + e) * 65 + n];
    const int nb = (mode == 2) ? nbase + (q >> 1) * 256 + (q & 1) * 64 : nbase + q * nstep;
    const int nrow = (mode != 1) ? (nb + n) : (nb + (n >> 5) * 64 + (n & 31));
    uint4 pk = {pack2(o[0], o[1]), pack2(o[2], o[3]), pack2(o[4], o[5]), pack2(o[6], o[7])};
    *(uint4*)(dst + (size_t)nrow * ldd + k0 + q * kstep + kc) = pk;
  }
}

constexpr int A_MOD = 96;
constexpr int A_WT = 1008;
constexpr int A_VC = 512;
constexpr int A_KC = 256;
constexpr int A_PAD = 128;
constexpr int A_MISC = 1;
constexpr int A_TOTAL = A_MOD + A_WT + A_VC + A_KC + A_PAD + A_MISC;

__device__ __forceinline__ void phase_a(const Params& p, char* smem) {
  const int tid = launder_tid();
  for (int task = blockIdx.x; task < A_TOTAL; task += gridDim.x) {
    int id = task;
    if (id < A_MOD) {
      int cgp = id % 12, ks = id / 12;
      float* sc = (float*)smem;
      __syncthreads();
      for (int i = tid; i < 24 * 128; i += 512) {
        int s = i >> 7, kk = i & 127, k = ks * 128 + kk;
        float cv = s < 8 ? p.c_prompt[s * 1024 + k] : p.c_sample[(s - 8) * 1024 + k];
        sc[i] = silu(cv);
      }
      __syncthreads();
      int col = cgp * 512 + tid;
      float acc[24];
#pragma unroll
      for (int s = 0; s < 24; s++) acc[s] = 0.f;
      const float* wp = p.w_ada + (size_t)(ks * 128) * 6144 + col;
#pragma unroll 1
      for (int kb = 0; kb < 128; kb += 32) {
        float wv[32];
#pragma unroll
        for (int j = 0; j < 32; j++) wv[j] = wp[(size_t)(kb + j) * 6144];
#pragma unroll
        for (int j = 0; j < 32; j++)
#pragma unroll
          for (int s = 0; s < 24; s++) acc[s] += sc[s * 128 + kb + j] * wv[j];
      }
#pragma unroll
      for (int s = 0; s < 24; s++) p.modp[(size_t)(ks * 24 + s) * 6144 + col] = acc[s];
      continue;
    }
    id -= A_MOD;
    if (id < A_WT) {
      if (id < 352) {
        int kt = id / 22, nq = id % 22;
        int scol = nq < 14 ? nq * 256 : 3592 + (nq - 14) * 256;
        int drow = nq < 14 ? nq * 256 : 3584 + (nq - 14) * 256;
        transpose_quad(p.w_in + (size_t)kt * 64 * kINW + scol, kINW, 64, p.Wt_in, 1024, kt * 64, 0, drow, 64, 0, smem);
      } else if (id < 384) {
        int i2 = id - 352, kt = i2 / 4, nq = i2 % 4;
        transpose_quad(p.w_a + (size_t)kt * 64 * 1024 + nq * 256, 1024, 64, p.Wt_a, 1024, kt * 64, 0, nq * 256, 64, 0, smem);
      } else if (id < 416) {
        int i2 = id - 384, kt = i2 / 4, nq = i2 % 4;
        transpose_quad(p.w_b + (size_t)kt * 64 * 1024 + nq * 256, 1024, 64, p.Wt_a, 1024, 512 + kt * 64, 0, nq * 256, 64, 0, smem);
      } else if (id < 480) {
        int i2 = id - 416, kt = i2 / 4, nq = i2 % 4;
        transpose_quad(p.w_out + (size_t)kt * 64 * 1024 + nq * 256, 1024, 64, p.Wt_out, 1024, kt * 64, 0, nq * 256, 64, 0, smem);
      } else if (id < 656) {
        int i2 = id - 480, kt = i2 / 11, nq = i2 % 11;
        transpose_quad(p.w_gate + (size_t)kt * 64 * 2816 + nq * 256, 2816, 64, p.Wt_gu, 1024, kt * 64, 0, nq * 512, 0, 2, smem);
      } else if (id < 832) {
        int i2 = id - 656, kt = i2 / 11, nq = i2 % 11;
        transpose_quad(p.w_up + (size_t)kt * 64 * 2816 + nq * 256, 2816, 64, p.Wt_gu, 1024, kt * 64, 0, nq * 512 + 128, 0, 2, smem);
      } else {
        int i2 = id - 832, kt = i2 / 4, nq = i2 % 4;
        transpose_quad(p.w_down + (size_t)kt * 64 * 1024 + nq * 256, 1024, 64, p.Wt_down, 2816, kt * 64, 0, nq * 256, 64, 0, smem);
      }
      continue;
    }
    id -= A_WT;
    if (id < A_VC) {
      int bh = id >> 2, jq = id & 3;
      int b = bh >> 3, h = bh & 7;
      transpose_quad(p.cache_v + ((size_t)(b * 1024 + jq * 256) * 8 + h) * 64, 512, (size_t)64 * 512,
                     p.VTs + (size_t)bh * 64 * 1152, 1152, jq * 256, 64, 0, 0, 0, smem);
      continue;
    }
    id -= A_VC;
    if (id < A_KC) {
      int b = id >> 4, jb = id & 15;
#pragma unroll
      for (int it = 0; it < 8; it++) {
        int g = tid + it * 512;
        int j = g >> 6, col = (g & 63) * 8;
        int h = col >> 6, d = col & 63;
        const float* src = p.cache_k + ((size_t)(b * 1024 + jb * 64 + j)) * 512 + col;
        float4 v0 = *(const float4*)src, v1 = *(const float4*)(src + 4);
        uint4 o;
        o.x = pack2(v0.x, v0.y);
        o.y = pack2(v0.z, v0.w);
        o.z = pack2(v1.x, v1.y);
        o.w = pack2(v1.z, v1.w);
        *(uint4*)(p.Ks + ((size_t)((b * 8 + h) * 1152 + jb * 64 + j)) * 64 + d) = o;
      }
      continue;
    }
    id -= A_KC;
    if (id < A_PAD) {
      int bh = id;
      uint4 z = {0u, 0u, 0u, 0u};
      *(uint4*)(p.Ks + ((size_t)bh * 1152 + 1088) * 64 + tid * 8) = z;
      int d = tid >> 3, chn = tid & 7;
      *(uint4*)(p.VTs + ((size_t)bh * 64 + d) * 1152 + 1088 + chn * 8) = z;
      continue;
    }
    for (int i = tid; i < 8192; i += 512) {
      int g = i >> 10, k = i & 1023;
      p.wg[i] = p.w_in[(size_t)k * kINW + 3584 + g];
    }
    if (tid < 8) p.counter[tid] = 0u;
  }
}

__device__ __forceinline__ void norm_task(const Params& p, int task, int which, char* smem) {
  float* sm_scale = (float*)smem;
  float* sm_shift = sm_scale + 1024;
  const float* sm_wg = sm_shift + 1024;
  const int tid = launder_tid(), lane = tid & 63, w = tid >> 6;
  const int row0 = task * 32;
  const int seq = seq_of(row0);
  const float* g = which ? p.norm2_g : p.norm1_g;
  const int sh_off = which ? 3072 : 0, sc_off = which ? 4096 : 1024;
  __syncthreads();
  for (int c = tid; c < 1024; c += 512) {
    float sh, sc;
    if (which == 0) {
      sh = p.b_ada[sh_off + c];
      sc = p.b_ada[sc_off + c];
#pragma unroll
      for (int ks = 0; ks < 8; ks++) {
        sh += p.modp[(size_t)(ks * 24 + seq) * 6144 + sh_off + c];
        sc += p.modp[(size_t)(ks * 24 + seq) * 6144 + sc_off + c];
      }
    } else {
      sh = p.modf[seq * 6144 + sh_off + c];
      sc = p.modf[seq * 6144 + sc_off + c];
    }
    sm_scale[c] = g[c] * (1.0f + sc);
    sm_shift[c] = sh;
  }
  __syncthreads();
  float4 v[4][4];
#pragma unroll
  for (int i = 0; i < 4; i++) {
    const int row = row0 + w * 4 + i;
    const float* xr = which ? (p.X1 + (size_t)row * 1024) : xrow(p, row);
#pragma unroll
    for (int j = 0; j < 4; j++) {
      v[i][j] = *(const float4*)(xr + j * 256 + lane * 4);
      if (which && row >= kNP) {
        const float* sl = p.SLAB + (size_t)((((row - kNP) >> 8) * 4 + j) * 3) * 65536 + (row & 255) * 256 + lane * 4;
#pragma unroll
        for (int kp = 0; kp < 3; kp++) {
          const float4 e = *(const float4*)(sl + (size_t)kp * 65536);
          v[i][j].x += e.x;
          v[i][j].y += e.y;
          v[i][j].z += e.z;
          v[i][j].w += e.w;
        }
        *(float4*)(p.X1 + (size_t)row * 1024 + j * 256 + lane * 4) = v[i][j];
      }
    }
  }
#pragma unroll
  for (int i = 0; i < 4; i++) {
    const int row = row0 + w * 4 + i;
    float ss = 0.f;
#pragma unroll
    for (int j = 0; j < 4; j++)
      ss += v[i][j].x * v[i][j].x + v[i][j].y * v[i][j].y + v[i][j].z * v[i][j].z + v[i][j].w * v[i][j].w;
    ss = wave_sum(ss);
    float rstd = rsqrtf(ss * (1.0f / 1024.0f) + 1e-6f);
#pragma unroll
    for (int j = 0; j < 4; j++) {
      int c = j * 256 + lane * 4;
      float4 sc = *(const float4*)(sm_scale + c), sh = *(const float4*)(sm_shift + c);
      v[i][j].x = v[i][j].x * rstd * sc.x + sh.x;
      v[i][j].y = v[i][j].y * rstd * sc.y + sh.y;
      v[i][j].z = v[i][j].z * rstd * sc.z + sh.z;
      v[i][j].w = v[i][j].w * rstd * sc.w + sh.w;
      uint2 o;
      o.x = pack2(v[i][j].x, v[i][j].y);
      o.y = pack2(v[i][j].z, v[i][j].w);
      *(uint2*)(p.U + (size_t)row * 1024 + c) = o;
    }
    if (which == 0) {
      float gv[8];
#pragma unroll
      for (int gi = 0; gi < 8; gi++) {
        float a = 0.f;
#pragma unroll
        for (int j = 0; j < 4; j++) {
          float4 wv = *(const float4*)(sm_wg + gi * 1024 + j * 256 + lane * 4);
          a += v[i][j].x * wv.x + v[i][j].y * wv.y + v[i][j].z * wv.z + v[i][j].w * wv.w;
        }
        gv[gi] = wave_sum(a);
      }
      if (lane == 0) {
#pragma unroll
        for (int h = 0; h < 4; h++) {
          p.GI[row * 4 + h] = gv[h] + p.b_if[h];
          p.LF[row * 4 + h] = logsig(gv[4 + h] + p.b_if[4 + h]);
        }
      }
    }
  }
}
__device__ __forceinline__ void phase_b(const Params& p, char* smem) {
  const int NTASK = kT / 32;
  {
    float* swg = (float*)smem + 2048;
    for (int i = threadIdx.x; i < 8192; i += 512) swg[i] = p.w_in[(size_t)(i & 1023) * kINW + 3584 + (i >> 10)];
  }
  for (int task = blockIdx.x; task < NTASK + 288; task += gridDim.x) {
    if (task < NTASK) {
      norm_task(p, task, 0, smem);
    } else {
      int i = (task - NTASK) * 512 + threadIdx.x;
      int s = i / 6144, c = i - s * 6144;
      float a = p.b_ada[c];
#pragma unroll
      for (int ks = 0; ks < 8; ks++) a += p.modp[(size_t)(ks * 24 + s) * 6144 + c];
      p.modf[i] = a;
    }
  }
}
__device__ __forceinline__ void phase_g(const Params& p, char* smem) {
  for (int task = blockIdx.x; task < kT / 32; task += gridDim.x) norm_task(p, task, 1, smem);
}

__device__ __forceinline__ uint4 pack8(const f32x4& a, const f32x4& b) {
  return (uint4){pack2(a[0], a[1]), pack2(a[2], a[3]), pack2(b[0], b[1]), pack2(b[2], b[3])};
}
struct EpiC {
  static constexpr bool PERM = true, AFTER_DRAIN = false;
  Params p;
  __device__ __forceinline__ void operator()(const f32x4 (&acc)[2][2][4][2], const pg8::Unit& u, int wr, int wc, int fr, int fq) const {
#pragma unroll
    for (int ai = 0; ai < 2; ++ai) {
      const int rb = u.pm * 256 + ai * 128 + wr * 64;
      const int seq = seq_of(rb);
      const bool isp = seq < 8;
      const int sb = seq - 8;
      const int srow0 = isp ? seq * 2048 : kNP + sb * 64;
      const int L = isp ? 2048 : 64;
#pragma unroll
      for (int bj = 0; bj < 2; ++bj) {
        const int cb = u.pn * 256 + bj * 128;
        const int c0 = cb + wc * 32 + fq * 8;
#pragma unroll
        for (int m = 0; m < 4; ++m) {
          const int row = rb + m * 16 + fr;
          const int t = row - srow0;
          const f32x4 v0 = acc[ai][bj][m][0], v1 = acc[ai][bj][m][1];
          if (cb < 512) {
            *(uint4*)(p.Qb + (size_t)row * 512 + c0) = pack8(v0, v1);
          } else if (cb < 1024) {
            const int c = c0 - 512, h = c >> 6, d = c & 63;
            float* o = (isp ? p.out + O_KP + (size_t)row * 512 : p.out + O_KS + (size_t)(row - kNP) * 512) + c;
            *(f32x4*)o = v0;
            *(f32x4*)(o + 4) = v1;
            bf16_t* kb = isp ? p.Kp + ((size_t)(seq * 8 + h) * 2048 + t) * 64 + d
                             : p.Ks + ((size_t)(sb * 8 + h) * 1152 + 1024 + t) * 64 + d;
            *(uint4*)kb = pack8(v0, v1);
          } else if (cb < 1536) {
            const int c = c0 - 1024, h = c >> 6, d = c & 63;
            float* o = (isp ? p.out + O_VP + (size_t)row * 512 : p.out + O_VS + (size_t)(row - kNP) * 512) + c;
            *(f32x4*)o = v0;
            *(f32x4*)(o + 4) = v1;
            bf16_t* vt = isp ? p.VTp + ((size_t)(seq * 8 + h) * 64 + d) * 2048 + t
                             : p.VTs + ((size_t)(sb * 8 + h) * 64 + d) * 1152 + 1024 + t;
            const size_t tl = isp ? 2048 : 1152;
#pragma unroll
            for (int e = 0; e < 4; ++e) {
              vt[(size_t)e * tl] = f2bf(v0[e]);
              vt[(size_t)(e + 4) * tl] = f2bf(v1[e]);
            }
          } else if (cb < 2560) {
            const int c = c0 - 1536;
            *(uint4*)(p.MQK + (size_t)row * 1024 + c) = pack8(v0, v1);
            if (t >= L - 3) {
              float* o = (isp ? p.out + O_CVP + (size_t)(seq * 3 + (t - (L - 3))) * 1024
                              : p.out + O_CVS + (size_t)(sb * 3 + (t - (L - 3))) * 1024) + c;
              *(f32x4*)o = v0;
              *(f32x4*)(o + 4) = v1;
            }
          } else if (cb < 3072) {
            const int c = c0 - 2560, h = c >> 7, d = c & 127;
            bf16_t* vt = isp ? p.MVTp + ((size_t)(seq * 4 + h) * 128 + d) * 2048 + t
                             : p.MVTs + ((size_t)(sb * 4 + h) * 128 + d) * 64 + t;
            const size_t tl = isp ? 2048 : 64;
#pragma unroll
            for (int e = 0; e < 4; ++e) {
              vt[(size_t)e * tl] = f2bf(v0[e]);
              vt[(size_t)(e + 4) * tl] = f2bf(v1[e]);
            }
          } else {
            f32x4 s0, s1;
#pragma unroll
            for (int e = 0; e < 4; ++e) {
              s0[e] = sigm(v0[e]);
              s1[e] = sigm(v1[e]);
            }
            bf16_t* dst = (cb < 3584)   ? p.SO + (size_t)row * 512 + (c0 - 3072)
                          : (cb < 4608) ? p.GA + (size_t)row * 1024 + (c0 - 3584)
                                        : p.GB + (size_t)row * 1024 + (c0 - 4608);
            *(uint4*)dst = pack8(s0, s1);
          }
        }
      }
    }
  }
};
struct EpiH {
  static constexpr bool PERM = true, AFTER_DRAIN = false;
  bf16_t* HFF;
  __device__ __forceinline__ void operator()(const f32x4 (&acc)[2][2][4][2], const pg8::Unit& u, int wr, int wc, int fr, int fq) const {
    const int f0 = u.pn * 128 + wc * 32 + fq * 8;
#pragma unroll
    for (int ai = 0; ai < 2; ++ai)
#pragma unroll
      for (int m = 0; m < 4; ++m) {
        const int row = u.pm * 256 + ai * 128 + wr * 64 + m * 16 + fr;
        f32x4 o0, o1;
#pragma unroll
        for (int e = 0; e < 4; ++e) {
          o0[e] = silu(acc[ai][0][m][0][e]) * acc[ai][1][m][0][e];
          o1[e] = silu(acc[ai][0][m][1][e]) * acc[ai][1][m][1][e];
        }
        *(uint4*)(HFF + (size_t)row * 2816 + f0) = pack8(o0, o1);
      }
  }
};
__device__ __forceinline__ void gate_task(const Params& p, int seq, int h, char* smem);
__device__ __forceinline__ void phase_c(const Params& p, char* smem) {
  for (int item = blockIdx.x; item < 96; item += gridDim.x) {
    if (item < 32) gate_task(p, item >> 2, item & 3, smem);
    else gate_task(p, 8 + ((item - 32) >> 2), item & 3, smem);
  }
  __syncthreads();
  pg8::Gemm g{p.U, p.Wt_in, kT, 5632, 1024};
  pg8::StaticOrder S;
  S.init(kT, 5632, gridDim.x, blockIdx.x);
  EpiC E{p};
  pg8::gemm_phase<EpiC, pg8::StaticOrder, false>((PG8_LAS unsigned char*)smem, g, S, E, nullptr);
}

__device__ __forceinline__ void lds_barrier() { asm volatile("s_waitcnt lgkmcnt(0)\n\ts_barrier" ::: "memory"); }
__device__ __forceinline__ void attn_task(const Params& p, int seq, int h, int qt, char* smem) {
  const int tid = launder_tid(), lane = tid & 63, w = tid >> 6, fr = lane & 15, fq = lane >> 4;
  const bool isp = seq < 8;
  const int sb = seq - 8;
  const int past = isp ? 0 : 1024;
  const int Tlen = isp ? 2048 : 1152;
  const int row0 = (isp ? seq * 2048 : kNP + sb * 64) + qt * 64;
  const int p0 = past + qt * 64;
  const bf16_t* Kb = isp ? p.Kp + (size_t)(seq * 8 + h) * 2048 * 64 : p.Ks + (size_t)(sb * 8 + h) * 1152 * 64;
  const bf16_t* VT = isp ? p.VTp + (size_t)(seq * 8 + h) * 64 * 2048 : p.VTs + (size_t)(sb * 8 + h) * 64 * 1152;
  bf16_t* sQ = (bf16_t*)smem;
  bf16_t* sK = sQ + 64 * 72;
  bf16_t* sVT = sK + 128 * 72;
  bf16_t* sP = sVT + 64 * 136;
  float* sZ = (float*)(sP + 64 * 136);
  int* sFlag = (int*)(sZ + 64 * 132);

  __syncthreads();
  {
    int r = tid >> 3, chn = tid & 7;
    uint4 q = *(const uint4*)(p.Qb + (size_t)(row0 + r) * 512 + h * 64 + chn * 8);
    *(uint4*)(sQ + r * 72 + chn * 8) = q;
  }
  const int kt_d = (p0 + 62) >> 7;
  const int ki0 = tid, ki1 = tid + 512;
  const bf16_t* kptr0 = Kb + (size_t)(ki0 >> 3) * 64 + (ki0 & 7) * 8;
  const bf16_t* kptr1 = Kb + (size_t)(ki1 >> 3) * 64 + (ki1 & 7) * 8;
  const bf16_t* vptr0 = VT + (size_t)(ki0 >> 4) * Tlen + (ki0 & 15) * 8;
  const bf16_t* vptr1 = VT + (size_t)(ki1 >> 4) * Tlen + (ki1 & 15) * 8;
  uint4 kr0 = *(const uint4*)(kptr0 + (size_t)kt_d * 8192);
  uint4 kr1 = *(const uint4*)(kptr1 + (size_t)kt_d * 8192);
  uint4 vr0 = *(const uint4*)(vptr0 + kt_d * 128);
  uint4 vr1 = *(const uint4*)(vptr1 + kt_d * 128);
  float R = 0.f;
  f32x4 oacc[2];
  oacc[0] = (f32x4){0.f, 0.f, 0.f, 0.f};
  oacc[1] = (f32x4){0.f, 0.f, 0.f, 0.f};
  const int mf = w & 3;
  for (int kt = kt_d; kt >= 0; kt--) {
    lds_barrier();
    *(uint4*)(sK + (ki0 >> 3) * 72 + (ki0 & 7) * 8) = kr0;
    *(uint4*)(sK + (ki1 >> 3) * 72 + (ki1 & 7) * 8) = kr1;
    *(uint4*)(sVT + (ki0 >> 4) * 136 + (ki0 & 15) * 8) = vr0;
    *(uint4*)(sVT + (ki1 >> 4) * 136 + (ki1 & 15) * 8) = vr1;
    if (tid == 0) *sFlag = 0;
    lds_barrier();
    if (kt > 0) {
      kr0 = *(const uint4*)(kptr0 + (size_t)(kt - 1) * 8192);
      kr1 = *(const uint4*)(kptr1 + (size_t)(kt - 1) * 8192);
      vr0 = *(const uint4*)(vptr0 + (kt - 1) * 128);
      vr1 = *(const uint4*)(vptr1 + (kt - 1) * 128);
    }
    {
      const int nf0 = (w >> 2) * 4;
      bf16x8 a0 = lds8(sQ + (mf * 16 + fr) * 72 + fq * 8);
      bf16x8 a1 = lds8(sQ + (mf * 16 + fr) * 72 + 32 + fq * 8);
#pragma unroll
      for (int n = 0; n < 4; n++) {
        bf16x8 b0 = lds8(sK + ((nf0 + n) * 16 + fr) * 72 + fq * 8);
        bf16x8 b1 = lds8(sK + ((nf0 + n) * 16 + fr) * 72 + 32 + fq * 8);
        f32x4 s = (f32x4){0.f, 0.f, 0.f, 0.f};
        s = MFMA(a0, b0, s);
        s = MFMA(a1, b1, s);
#pragma unroll
        for (int r = 0; r < 4; r++) sZ[(mf * 16 + fq * 4 + r) * 132 + (nf0 + n) * 16 + fr] = s[r] * 0.125f;
      }
    }
    lds_barrier();
    {
      const int row = tid >> 3, part = tid & 7;
      const int pos = p0 + row;
      const int j0 = kt * 128 + part * 16;
      float z[16], ls[16];
#pragma unroll
      for (int i4 = 0; i4 < 4; i4++) {
        float4 t4 = *(const float4*)(sZ + row * 132 + part * 16 + i4 * 4);
        z[i4 * 4 + 0] = t4.x;
        z[i4 * 4 + 1] = t4.y;
        z[i4 * 4 + 2] = t4.z;
        z[i4 * 4 + 3] = t4.w;
      }
      float run = 0.f;
      float tl[16];
#pragma unroll
      for (int i = 15; i >= 0; i--) {
        bool valid = (j0 + i) < pos;
        float l = valid ? -(fmaxf(z[i], 0.f) + __logf(1.0f + __expf(-fabsf(z[i])))) : 0.f;
        ls[i] = l;
        tl[i] = run;
        run += l;
      }
      float incl = run;
#pragma unroll
      for (int dlt = 1; dlt < 8; dlt <<= 1) {
        float t = __shfl_down(incl, dlt, 8);
        if (part + dlt < 8) incl += t;
      }
      float excl = incl - run;
      float tot = __shfl(incl, 0, 8);
      float base = R + excl;
      unsigned pk[8];
#pragma unroll
      for (int i = 0; i < 16; i += 2) {
        bool v0 = (j0 + i) < pos, v1 = (j0 + i + 1) < pos;
        float a0 = v0 ? __expf(z[i] + ls[i] + tl[i] + base) : 0.f;
        float a1 = v1 ? __expf(z[i + 1] + ls[i + 1] + tl[i + 1] + base) : 0.f;
        pk[i >> 1] = pack2(a0, a1);
      }
      *(uint4*)(sP + row * 136 + part * 16) = (uint4){pk[0], pk[1], pk[2], pk[3]};
      *(uint4*)(sP + row * 136 + part * 16 + 8) = (uint4){pk[4], pk[5], pk[6], pk[7]};
      R += tot;
      if (R > -110.f) *sFlag = 1;
    }
    lds_barrier();
    const int more = *sFlag;
    {
      const int nf0 = (w >> 2) * 2;
#pragma unroll
      for (int ks = 0; ks < 4; ks++) {
        bf16x8 a = lds8(sP + (mf * 16 + fr) * 136 + ks * 32 + fq * 8);
#pragma unroll
        for (int n = 0; n < 2; n++) {
          bf16x8 b = lds8(sVT + ((nf0 + n) * 16 + fr) * 136 + ks * 32 + fq * 8);
          oacc[n] = MFMA(a, b, oacc[n]);
        }
      }
    }
    if (!more) break;
  }
  {
    const int nf0 = (w >> 2) * 2;
#pragma unroll
    for (int n = 0; n < 2; n++)
#pragma unroll
      for (int r = 0; r < 4; r++)
        p.YA[(size_t)(row0 + mf * 16 + fq * 4 + r) * 1024 + h * 64 + (nf0 + n) * 16 + fr] = f2bf(oacc[n][r]);
  }
}


__device__ __forceinline__ void gate_task(const Params& p, int seq, int h, char* smem) {
  const int tid = launder_tid(), lane = tid & 63, w = tid >> 6;
  const bool isp = seq < 8;
  const int sb = seq - 8;
  const int nchunks = isp ? 32 : 1;
  const int grow0 = isp ? seq * 2048 : kNP + sb * 64;
  float* gv = p.GV + (size_t)(isp ? (seq * 4 + h) * 32 : 1024 + sb * 4 + h) * 384;
  float* sBl = (float*)smem;
  float* sG = sBl + 32;
  float* sM = sG + 32;
  __syncthreads();
  float b_[4], as_[4], pm_[4], g_[4];
#pragma unroll
  for (int i = 0; i < 4; i++) {
    const int c = w + i * 8;
    b_[i] = 0.f; as_[i] = 0.f; pm_[i] = 0.f; g_[i] = 0.f;
    if (c < nchunks) {
      const int row = grow0 + c * 64 + lane;
      float li = p.GI[row * 4 + h], lf = p.LF[row * 4 + h];
      float b = lf;
#pragma unroll
      for (int d = 1; d < 64; d <<= 1) {
        float t_ = __shfl_up(b, d);
        if (lane >= d) b += t_;
      }
      float a_s = li - b;
      float pm = a_s;
#pragma unroll
      for (int d = 1; d < 64; d <<= 1) {
        float t_ = __shfl_up(pm, d);
        if (lane >= d) pm = fmaxf(pm, t_);
      }
      float blast = __shfl(b, 63);
      float g = blast - b + li;
      float G = wave_max(g);
      b_[i] = b; as_[i] = a_s; pm_[i] = pm; g_[i] = g;
      if (lane == 0) {
        sBl[c] = blast;
        sG[c] = G;
      }
    }
  }
  __syncthreads();
  if (tid == 0) {
    float m = isp ? 0.f : p.st_m[sb * 4 + h];
    for (int c = 0; c < nchunks; c++) {
      sM[c] = m;
      m = fmaxf(sBl[c] + m, sG[c]);
    }
    sM[nchunks] = m;
    if (isp) p.out[O_MP + seq * 4 + h] = m;
    else p.out[O_MS + sb * 4 + h] = m;
  }
  __syncthreads();
#pragma unroll
  for (int i = 0; i < 4; i++) {
    const int c = w + i * 8;
    if (c < nchunks) {
      const float m_run = sM[c], m_new = sM[c + 1];
      const float mt = b_[i] + fmaxf(m_run, pm_[i]);
      float* o = gv + (size_t)c * 384;
      o[lane] = b_[i] - mt;
      o[64 + lane] = as_[i];
      o[128 + lane] = __expf(b_[i] + m_run - mt);
      o[192 + lane] = __expf(g_[i] - m_new);
      o[256 + lane] = __expf(-mt);
      if (lane == 0) o[320] = __expf(sBl[c] + m_run - m_new);
    }
  }
}

__device__ __forceinline__ void mlpre_task(const Params& p, int seq, int h, int c, char* smem) {
  const bool isp = seq < 8;
  const int sb = seq - 8;
  const int grow0 = isp ? seq * 2048 : kNP + sb * 64;
  const int t0 = c * 64;
  const int cid = isp ? (seq * 4 + h) * 32 + c : 1024 + sb * 4 + h;
  bf16_t* sQ = (bf16_t*)smem;
  bf16_t* sK = sQ + 64 * 136;
  bf16_t* sKT = sK + 64 * 136;
  bf16_t* sSw = sKT + 128 * 72;
  float* sF = (float*)(sSw + 64 * 72);
  float* sV = sF;
  float* sDen = sF + 384;
  float* sCw = sF + 448;
  const float* sBt = sV;
  const float* sAs = sV + 64;
  const float* sWg = sV + 192;
  __syncthreads();
  uint4 xr0, xr1, xr2, xr3, xr4, xr5, xr6;
  {
    const int tid = launder_tid();
    for (int i = tid; i < 1280; i += 512) {
      int j = i >> 8, cc = i & 255;
      int gch = (cc >= 128 ? 512 : 0) + h * 128 + (cc & 127);
      sCw[i] = (j < 4) ? p.w_conv[j * 1024 + gch] : p.b_conv[gch];
    }
    if (tid < 384) sV[tid] = p.GV[(size_t)cid * 384 + tid];
    if (tid < 64) sDen[tid] = 0.f;
    const int rb_ = tid >> 5, cgp_ = tid & 31;
    const int ch_ = (cgp_ >= 16 ? 512 : 0) + h * 128 + (cgp_ & 15) * 8;
    const int tb0 = t0 + rb_ * 4 - 3;
    const bf16_t* xp = p.MQK + (size_t)(grow0 + tb0) * 1024 + ch_;
#define LDX(i, dst)                                                                                           \
  if (tb0 + i >= 0) dst = *(const uint4*)(xp + (size_t)i * 1024);                                             \
  else if (isp) dst = (uint4){0u, 0u, 0u, 0u};                                                                \
  else {                                                                                                      \
    const float* s0 = p.st_conv + (size_t)(sb * 3 + (tb0 + i + 3)) * 1024 + ch_;                              \
    dst = (uint4){pack2(s0[0], s0[1]), pack2(s0[2], s0[3]), pack2(s0[4], s0[5]), pack2(s0[6], s0[7])};        \
  }
    LDX(0, xr0) LDX(1, xr1) LDX(2, xr2)
#undef LDX
    xr3 = *(const uint4*)(xp + (size_t)3 * 1024);
    xr4 = *(const uint4*)(xp + (size_t)4 * 1024);
    xr5 = *(const uint4*)(xp + (size_t)5 * 1024);
    xr6 = *(const uint4*)(xp + (size_t)6 * 1024);
  }
  __syncthreads();
  {
    const int tid = launder_tid();
    const int rb = tid >> 5, cgp = tid & 31;
    const bool isk = cgp >= 16;
    float o0[8], o1[8], o2[8], o3[8];
    {
      const float* cwp = sCw + cgp * 8;
      float4 b0 = *(const float4*)(cwp + 1024), b1 = *(const float4*)(cwp + 1028);
      o0[0] = b0.x; o0[1] = b0.y; o0[2] = b0.z; o0[3] = b0.w; o0[4] = b1.x; o0[5] = b1.y; o0[6] = b1.z; o0[7] = b1.w;
#pragma unroll
      for (int e = 0; e < 8; e++) { o1[e] = o0[e]; o2[e] = o0[e]; o3[e] = o0[e]; }
#define FMAW(j, o, x) { float4 a0 = *(const float4*)(cwp + j * 256), a1 = *(const float4*)(cwp + j * 256 + 4); \
  o[0] += a0.x * x[0]; o[1] += a0.y * x[1]; o[2] += a0.z * x[2]; o[3] += a0.w * x[3];                              \
  o[4] += a1.x * x[4]; o[5] += a1.y * x[5]; o[6] += a1.z * x[6]; o[7] += a1.w * x[7]; }
#define UNP(xv, x) float x[8]; x[0] = __uint_as_float(xv.x << 16); x[1] = __uint_as_float(xv.x & 0xffff0000u); \
  x[2] = __uint_as_float(xv.y << 16); x[3] = __uint_as_float(xv.y & 0xffff0000u);                             \
  x[4] = __uint_as_float(xv.z << 16); x[5] = __uint_as_float(xv.z & 0xffff0000u);                             \
  x[6] = __uint_as_float(xv.w << 16); x[7] = __uint_as_float(xv.w & 0xffff0000u);
      { UNP(xr0, x) FMAW(0, o0, x) }
      { UNP(xr1, x) FMAW(1, o0, x) FMAW(0, o1, x) }
      { UNP(xr2, x) FMAW(2, o0, x) FMAW(1, o1, x) FMAW(0, o2, x) }
      { UNP(xr3, x) FMAW(3, o0, x) FMAW(2, o1, x) FMAW(1, o2, x) FMAW(0, o3, x) }
      { UNP(xr4, x) FMAW(3, o1, x) FMAW(2, o2, x) FMAW(1, o3, x) }
      { UNP(xr5, x) FMAW(3, o2, x) FMAW(2, o3, x) }
      { UNP(xr6, x) FMAW(3, o3, x) }
#undef FMAW
#undef UNP
    }
    const float ksc = isk ? 0.08838834764831845f : 1.0f;
#pragma unroll
    for (int e = 0; e < 8; e++) {
      o0[e] = silu(o0[e]) * ksc; o1[e] = silu(o1[e]) * ksc; o2[e] = silu(o2[e]) * ksc; o3[e] = silu(o3[e]) * ksc;
    }
    bf16_t* dstp = (isk ? sK + (cgp - 16) * 8 : sQ + cgp * 8) + (rb * 4) * 136;
    *(uint4*)(dstp) = (uint4){pack2(o0[0], o0[1]), pack2(o0[2], o0[3]), pack2(o0[4], o0[5]), pack2(o0[6], o0[7])};
    *(uint4*)(dstp + 136) = (uint4){pack2(o1[0], o1[1]), pack2(o1[2], o1[3]), pack2(o1[4], o1[5]), pack2(o1[6], o1[7])};
    *(uint4*)(dstp + 272) = (uint4){pack2(o2[0], o2[1]), pack2(o2[2], o2[3]), pack2(o2[4], o2[5]), pack2(o2[6], o2[7])};
    *(uint4*)(dstp + 408) = (uint4){pack2(o3[0], o3[1]), pack2(o3[2], o3[3]), pack2(o3[4], o3[5]), pack2(o3[6], o3[7])};
    if (isk) {
      float g0 = sWg[rb * 4], g1 = sWg[rb * 4 + 1], g2 = sWg[rb * 4 + 2], g3 = sWg[rb * 4 + 3];
#pragma unroll
      for (int e = 0; e < 8; e++) {
        uint2 pk;
        pk.x = pack2(o0[e] * g0, o1[e] * g1);
        pk.y = pack2(o2[e] * g2, o3[e] * g3);
        *(uint2*)(sKT + ((cgp - 16) * 8 + e) * 72 + rb * 4) = pk;
      }
    }
  }
  __syncthreads();
  {
    const int tid = launder_tid(), lane = tid & 63, w = tid >> 6, fr = lane & 15, fq = lane >> 4;
    const int mf = w >> 1, nf0 = (w & 1) * 2;
    f32x4 sa[2];
    sa[0] = (f32x4){0.f, 0.f, 0.f, 0.f};
    sa[1] = (f32x4){0.f, 0.f, 0.f, 0.f};
#pragma unroll
    for (int ks = 0; ks < 4; ks++) {
      bf16x8 a = lds8(sQ + (mf * 16 + fr) * 136 + ks * 32 + fq * 8);
#pragma unroll
      for (int n = 0; n < 2; n++) {
        bf16x8 b = lds8(sK + ((nf0 + n) * 16 + fr) * 136 + ks * 32 + fq * 8);
        sa[n] = MFMA(a, b, sa[n]);
      }
    }
#pragma unroll
    for (int r = 0; r < 4; r++) {
      const int t = mf * 16 + fq * 4 + r;
      const float bt = sBt[t];
      float rs = 0.f;
#pragma unroll
      for (int n = 0; n < 2; n++) {
        const int s = (nf0 + n) * 16 + fr;
        float wgt = (s <= t) ? __expf(bt + sAs[s]) : 0.f;
        float v = sa[n][r] * wgt;
        rs += v;
        sSw[t * 72 + s] = f2bf(v);
      }
      rs += __shfl_xor(rs, 1);
      rs += __shfl_xor(rs, 2);
      rs += __shfl_xor(rs, 4);
      rs += __shfl_xor(rs, 8);
      if (fr == 0) atomicAdd(&sDen[t], rs);
    }
  }
  __syncthreads();
  {
    const int tid = launder_tid();
    bf16_t* qo = p.Qc + (size_t)cid * 8192;
    bf16_t* ko = p.KTc + (size_t)cid * 8192;
    bf16_t* so = p.SWc + (size_t)cid * 4096;
    *(uint4*)(qo + tid * 8) = *(const uint4*)(sQ + (tid >> 4) * 136 + (tid & 15) * 8);
    *(uint4*)(qo + 4096 + tid * 8) = *(const uint4*)(sQ + (32 + (tid >> 4)) * 136 + (tid & 15) * 8);
    *(uint4*)(ko + tid * 8) = *(const uint4*)(sKT + (tid >> 3) * 72 + (tid & 7) * 8);
    *(uint4*)(ko + 4096 + tid * 8) = *(const uint4*)(sKT + (64 + (tid >> 3)) * 72 + (tid & 7) * 8);
    *(uint4*)(so + tid * 8) = *(const uint4*)(sSw + (tid >> 3) * 72 + (tid & 7) * 8);
    if (tid < 64) p.DENc[(size_t)cid * 64 + tid] = sDen[tid];
  }
}

__device__ __forceinline__ void mlstm_task(const Params& p, int seq, int h, char* smem) {
  const bool isp = seq < 8;
  const int sb = seq - 8;
  const int L = isp ? 2048 : 64;
  const int nchunks = L >> 6;
  const int grow0 = isp ? seq * 2048 : kNP + sb * 64;
  const int cid0 = isp ? (seq * 4 + h) * 32 : 1024 + sb * 4 + h;
  const bf16_t* MVT = isp ? p.MVTp + (size_t)(seq * 4 + h) * 128 * 2048 : p.MVTs + (size_t)(sb * 4 + h) * 128 * 64;
  bf16_t* sQ = (bf16_t*)smem;
  bf16_t* sH = sQ + 64 * 136;
  bf16_t* sKT = sH + 64 * 136;
  bf16_t* sVT = sKT + 128 * 72;
  bf16_t* sCb = sVT + 128 * 72;
  bf16_t* sSw = sCb + 128 * 136;
  float* sF = (float*)(sSw + 64 * 72);
  float* sVec = sF;
  float* sNq = sF + 512;
  float* sSS = sF + 576;
  float* sN = sF + 640;

  __syncthreads();
  f32x4 Cacc[8];
  {
    const int tid = launder_tid(), lane = tid & 63, w = tid >> 6, fr = lane & 15, fq = lane >> 4;
    if (isp) {
#pragma unroll
      for (int n = 0; n < 8; n++) Cacc[n] = (f32x4){0.f, 0.f, 0.f, 0.f};
      if (tid < 128) sN[tid] = 0.f;
    } else {
      const float* C0 = p.st_C + (size_t)(sb * 4 + h) * 16384;
#pragma unroll
      for (int n = 0; n < 8; n++)
#pragma unroll
        for (int r = 0; r < 4; r++) Cacc[n][r] = C0[(w * 16 + fq * 4 + r) * 128 + n * 16 + fr];
      if (tid < 128) sN[tid] = p.st_n[(sb * 4 + h) * 128 + tid];
    }
#pragma unroll
    for (int n = 0; n < 8; n++)
#pragma unroll
      for (int r = 0; r < 4; r++) sCb[(w * 16 + fq * 4 + r) * 136 + n * 16 + fr] = f2bf(Cacc[n][r]);
  }
  float mg0, mg1, mg2, mg3;
  {
    const int tid = launder_tid(), lane = tid & 63, w = tid >> 6, fr = lane & 15;
    const int cidx = h * 128 + (w >> 2) * 64 + fr;
    mg0 = p.ml_norm_g[cidx];
    mg1 = p.ml_norm_g[cidx + 16];
    mg2 = p.ml_norm_g[cidx + 32];
    mg3 = p.ml_norm_g[cidx + 48];
  }
  uint4 q0, q1, k0, k1, v0, v1, sw0;
  float gwi = 0.f, gem = 0.f, gden = 0.f, gdec = 0.f;
#define LOAD_CHUNK(C)                                                                         \
  {                                                                                           \
    const int tid_ = launder_tid();                                                           \
    const size_t cid_ = (size_t)(cid0 + (C));                                                 \
    const bf16_t* qp = p.Qc + cid_ * 8192 + tid_ * 8;                                         \
    const bf16_t* kp = p.KTc + cid_ * 8192 + tid_ * 8;                                        \
    q0 = *(const uint4*)qp;                                                                   \
    q1 = *(const uint4*)(qp + 4096);                                                          \
    k0 = *(const uint4*)kp;                                                                   \
    k1 = *(const uint4*)(kp + 4096);                                                          \
    sw0 = *(const uint4*)(p.SWc + cid_ * 4096 + tid_ * 8);                                    \
    v0 = *(const uint4*)(MVT + (size_t)(tid_ >> 3) * L + (C) * 64 + (tid_ & 7) * 8);          \
    v1 = *(const uint4*)(MVT + (size_t)((tid_ + 512) >> 3) * L + (C) * 64 + (tid_ & 7) * 8);  \
    if (tid_ < 64) {                                                                          \
      gwi = p.GV[cid_ * 384 + 128 + tid_];                                                    \
      gem = p.GV[cid_ * 384 + 256 + tid_];                                                    \
      gden = p.DENc[cid_ * 64 + tid_];                                                        \
      gdec = p.GV[cid_ * 384 + 320];                                                          \
    }                                                                                         \
  }
  LOAD_CHUNK(0)
  lds_barrier();

  for (int c = 0; c < nchunks; c++) {
    const int t0 = c * 64;
    float* sV = sVec + (c & 1) * 256;
    const float* sNo = sN + (c & 1) * 128;
    float* sNn = sN + ((c + 1) & 1) * 128;
    uint4 so0, so1;
    {
      const int tid = launder_tid();
      *(uint4*)(sQ + (tid >> 4) * 136 + (tid & 15) * 8) = q0;
      *(uint4*)(sQ + (32 + (tid >> 4)) * 136 + (tid & 15) * 8) = q1;
      *(uint4*)(sKT + (tid >> 3) * 72 + (tid & 7) * 8) = k0;
      *(uint4*)(sKT + (64 + (tid >> 3)) * 72 + (tid & 7) * 8) = k1;
      *(uint4*)(sVT + (tid >> 3) * 72 + (tid & 7) * 8) = v0;
      *(uint4*)(sVT + (64 + (tid >> 3)) * 72 + (tid & 7) * 8) = v1;
      *(uint4*)(sSw + (tid >> 3) * 72 + (tid & 7) * 8) = sw0;
      float decay = gdec;
      if (tid < 64) {
        sV[tid] = gwi;
        sV[64 + tid] = gem;
        sV[128 + tid] = gden;
        sSS[tid] = 0.f;
        if (tid == 0) sV[192] = gdec;
      }
      decay = __shfl(decay, 0);
#define UNP8(VV, AR) float AR[8]; AR[0] = __uint_as_float(VV.x << 16); AR[1] = __uint_as_float(VV.x & 0xffff0000u); \
  AR[2] = __uint_as_float(VV.y << 16); AR[3] = __uint_as_float(VV.y & 0xffff0000u);                                 \
  AR[4] = __uint_as_float(VV.z << 16); AR[5] = __uint_as_float(VV.z & 0xffff0000u);                                 \
  AR[6] = __uint_as_float(VV.w << 16); AR[7] = __uint_as_float(VV.w & 0xffff0000u);
      {
        const float4 n0 = *(const float4*)(sNo + (tid & 15) * 8), n1 = *(const float4*)(sNo + (tid & 15) * 8 + 4);
        UNP8(q0, a)
        UNP8(q1, b)
        float d0 = a[0] * n0.x + a[1] * n0.y + a[2] * n0.z + a[3] * n0.w + a[4] * n1.x + a[5] * n1.y + a[6] * n1.z + a[7] * n1.w;
        float d1 = b[0] * n0.x + b[1] * n0.y + b[2] * n0.z + b[3] * n0.w + b[4] * n1.x + b[5] * n1.y + b[6] * n1.z + b[7] * n1.w;
#pragma unroll
        for (int o = 1; o < 16; o <<= 1) {
          d0 += __shfl_xor(d0, o);
          d1 += __shfl_xor(d1, o);
        }
        if ((tid & 15) == 0) {
          sNq[tid >> 4] = d0;
          sNq[32 + (tid >> 4)] = d1;
        }
      }
      {
        UNP8(k0, a)
        UNP8(k1, b)
        float d0 = ((a[0] + a[1]) + (a[2] + a[3])) + ((a[4] + a[5]) + (a[6] + a[7]));
        float d1 = ((b[0] + b[1]) + (b[2] + b[3])) + ((b[4] + b[5]) + (b[6] + b[7]));
#pragma unroll
        for (int o = 1; o < 8; o <<= 1) {
          d0 += __shfl_xor(d0, o);
          d1 += __shfl_xor(d1, o);
        }
        if ((tid & 7) == 0) {
          sNn[tid >> 3] = d0;
          sNn[64 + (tid >> 3)] = d1;
        }
      }
#undef UNP8
      {
        const bf16_t* sop = p.SO + (size_t)(grow0 + t0 + (tid >> 4)) * 512 + h * 128 + (tid & 15) * 8;
        so0 = *(const uint4*)sop;
        so1 = *(const uint4*)(sop + (size_t)32 * 512);
      }
    }
    if (c + 1 < nchunks) LOAD_CHUNK(c + 1)
    lds_barrier();
    f32x4 hacc[4];
    {
      const int tid = launder_tid(), lane = tid & 63, w = tid >> 6, fr = lane & 15, fq = lane >> 4;
      const int mf = w & 3, nf0 = (w >> 2) * 4;
      const float* sWi = sV;
      const float* sEm = sV + 64;
      const float* sDn = sV + 128;
#pragma unroll
      for (int n = 0; n < 4; n++) hacc[n] = (f32x4){0.f, 0.f, 0.f, 0.f};
      {
        bf16x8 qa[4], cb[4][4], swa[2], vb[2][4];
#pragma unroll
        for (int ks = 0; ks < 4; ks++) {
          qa[ks] = lds8(sQ + (mf * 16 + fr) * 136 + ks * 32 + fq * 8);
#pragma unroll
          for (int n = 0; n < 4; n++) cb[ks][n] = lds8(sCb + ((nf0 + n) * 16 + fr) * 136 + ks * 32 + fq * 8);
        }
#pragma unroll
        for (int ks = 0; ks < 2; ks++) {
          swa[ks] = lds8(sSw + (mf * 16 + fr) * 72 + ks * 32 + fq * 8);
#pragma unroll
          for (int n = 0; n < 4; n++) vb[ks][n] = lds8(sVT + ((nf0 + n) * 16 + fr) * 72 + ks * 32 + fq * 8);
        }
        float wi4[4];
#pragma unroll
        for (int r = 0; r < 4; r++) wi4[r] = sWi[mf * 16 + fq * 4 + r];
#pragma unroll
        for (int ks = 0; ks < 4; ks++)
#pragma unroll
          for (int n = 0; n < 4; n++) hacc[n] = MFMA(qa[ks], cb[ks][n], hacc[n]);
#pragma unroll
        for (int r = 0; r < 4; r++)
#pragma unroll
          for (int n = 0; n < 4; n++) hacc[n][r] *= wi4[r];
#pragma unroll
        for (int ks = 0; ks < 2; ks++)
#pragma unroll
          for (int n = 0; n < 4; n++) hacc[n] = MFMA(swa[ks], vb[ks][n], hacc[n]);
      }
#pragma unroll
      for (int r = 0; r < 4; r++) {
        const int t = mf * 16 + fq * 4 + r;
        float den = sDn[t] + sWi[t] * sNq[t];
        float dn = fmaxf(fabsf(den), sEm[t]);
        float inv = __builtin_amdgcn_rcpf(dn);
        float ss = 0.f;
#pragma unroll
        for (int n = 0; n < 4; n++) {
          hacc[n][r] *= inv;
          ss += hacc[n][r] * hacc[n][r];
        }
        ss += __shfl_xor(ss, 1);
        ss += __shfl_xor(ss, 2);
        ss += __shfl_xor(ss, 4);
        ss += __shfl_xor(ss, 8);
        if (fr == 0) atomicAdd(&sSS[t], ss);
      }
    }
    lds_barrier();
    {
      const int tid = launder_tid(), lane = tid & 63, w = tid >> 6, fr = lane & 15, fq = lane >> 4;
      const int mf = w & 3, nf0 = (w >> 2) * 4;
#pragma unroll
      for (int r = 0; r < 4; r++) {
        const int t = mf * 16 + fq * 4 + r;
        const float rstd = rsqrtf(sSS[t] * (1.0f / 128.0f) + 1e-6f);
        bf16_t* hp = sH + t * 136 + nf0 * 16 + fr;
        hp[0] = f2bf(hacc[0][r] * rstd * mg0);
        hp[16] = f2bf(hacc[1][r] * rstd * mg1);
        hp[32] = f2bf(hacc[2][r] * rstd * mg2);
        hp[48] = f2bf(hacc[3][r] * rstd * mg3);
      }
      const float decay = sV[192];
#pragma unroll
      for (int n = 0; n < 8; n++) {
        Cacc[n][0] *= decay;
        Cacc[n][1] *= decay;
        Cacc[n][2] *= decay;
        Cacc[n][3] *= decay;
      }
      {
        bf16x8 va[2], kb[2][8];
#pragma unroll
        for (int ks = 0; ks < 2; ks++) {
          va[ks] = lds8(sVT + (w * 16 + fr) * 72 + ks * 32 + fq * 8);
#pragma unroll
          for (int n = 0; n < 8; n++) kb[ks][n] = lds8(sKT + (n * 16 + fr) * 72 + ks * 32 + fq * 8);
        }
#pragma unroll
        for (int ks = 0; ks < 2; ks++)
#pragma unroll
          for (int n = 0; n < 8; n++) Cacc[n] = MFMA(va[ks], kb[ks][n], Cacc[n]);
      }
#pragma unroll
      for (int n = 0; n < 8; n++)
#pragma unroll
        for (int r = 0; r < 4; r++) sCb[(w * 16 + fq * 4 + r) * 136 + n * 16 + fr] = f2bf(Cacc[n][r]);
      if (tid < 128) sNn[tid] = decay * sNo[tid] + sNn[tid];
    }
    lds_barrier();
    {
      const int tid = launder_tid();
      const int row = tid >> 4, c8 = (tid & 15) * 8;
      bf16_t* yp = p.YA + (size_t)(grow0 + t0 + row) * 1024 + 512 + h * 128 + c8;
      uint4 h0 = *(const uint4*)(sH + row * 136 + c8);
      uint4 h1 = *(const uint4*)(sH + (row + 32) * 136 + c8);
#define MUL2(a, b) pack2(__uint_as_float((a) << 16) * __uint_as_float((b) << 16), \
                         __uint_as_float((a) & 0xffff0000u) * __uint_as_float((b) & 0xffff0000u))
      uint4 y0 = {MUL2(h0.x, so0.x), MUL2(h0.y, so0.y), MUL2(h0.z, so0.z), MUL2(h0.w, so0.w)};
      uint4 y1 = {MUL2(h1.x, so1.x), MUL2(h1.y, so1.y), MUL2(h1.z, so1.z), MUL2(h1.w, so1.w)};
#undef MUL2
      *(uint4*)yp = y0;
      *(uint4*)(yp + (size_t)32 * 1024) = y1;
    }
  }
#undef LOAD_CHUNK
  lds_barrier();
  {
    const int tid = launder_tid(), lane = tid & 63, w = tid >> 6, fr = lane & 15, fq = lane >> 4;
    float* Cout = isp ? p.out + O_CP + (size_t)(seq * 4 + h) * 16384 : p.out + O_CS + (size_t)(sb * 4 + h) * 16384;
#pragma unroll
    for (int n = 0; n < 8; n++)
#pragma unroll
      for (int r = 0; r < 4; r++) Cout[(w * 16 + fq * 4 + r) * 128 + n * 16 + fr] = Cacc[n][r];
    float* nout = isp ? p.out + O_NP + (seq * 4 + h) * 128 : p.out + O_NS + (sb * 4 + h) * 128;
    if (tid < 128) nout[tid] = sN[(nchunks & 1) * 128 + tid];
  }
}

constexpr int D_ML_P = 32;
constexpr int D_AT_P = 2048;
constexpr int D_AT_S = 128;
constexpr int D_ML_S = 64;
constexpr int D_TOTAL = D_ML_P + D_AT_P + D_AT_S + D_ML_S;

__device__ __forceinline__ void phase_d0(const Params& p, char* smem) {
  for (int item = blockIdx.x; item < 1088; item += gridDim.x) {
    if (item < 1024) mlpre_task(p, item >> 7, (item >> 5) & 3, item & 31, smem);
    else mlpre_task(p, 8 + ((item - 1024) >> 2), item & 3, 0, smem);
  }
}
__device__ __forceinline__ void phase_d(const Params& p, char* smem, int cidx) {
  int* sTask = (int*)(smem + LDS_BYTES - 16);
  for (;;) {
    __syncthreads();
    if (threadIdx.x == 0) *sTask = (int)atomicAdd(p.counter + cidx, 1u);
    __syncthreads();
    int task = __builtin_amdgcn_readfirstlane(*sTask);
    if (task >= D_TOTAL) break;
    int kind, seq, h, qt = 0;
    if (task < D_ML_P) {
      kind = 0; seq = task >> 2; h = task & 3;
    } else if (task < D_ML_P + D_AT_P) {
      int t2 = task - D_ML_P;
      kind = 1; qt = 31 - (t2 >> 6); seq = (t2 & 63) >> 3; h = t2 & 7;
    } else if (task < D_ML_P + D_AT_P + D_AT_S) {
      int t2 = task - D_ML_P - D_AT_P;
      kind = 1; seq = 8 + (t2 >> 3); h = t2 & 7;
    } else {
      int t2 = task - D_ML_P - D_AT_P - D_AT_S;
      kind = 0; seq = 8 + (t2 >> 2); h = t2 & 3;
    }
    if (kind == 0) mlstm_task(p, seq, h, smem);
    else attn_task(p, seq, h, qt, smem);
  }
}

struct OrderE {
  __device__ __forceinline__ bool next(int i, pg8::Unit& u) const {
    const int b = blockIdx.x;
    if (i < 2) {
      const int xcd = b & 7, l = b >> 3;
      u.pm = xcd * 8 + (l >> 2);
      u.pn = l & 3;
    } else if (i < 4 && b < 16) {
      u.pm = 64 + (b >> 2);
      u.pn = b & 3;
    } else {
      return false;
    }
    u.ko = (i & 1) * 512;
    u.nt = 8;
    return true;
  }
  __device__ __forceinline__ void a_ready(const pg8::Unit&) const {}
  __device__ __forceinline__ void done(const pg8::Unit&) const {}
};
struct EpiE {
  static constexpr bool PERM = true, AFTER_DRAIN = false;
  const bf16_t* GA;
  const bf16_t* GB;
  bf16_t* MER;
  __device__ __forceinline__ void operator()(const f32x4 (&acc)[2][2][4][2], const pg8::Unit& u, int wr, int wc, int fr, int fq) const {
    const bool second = (u.ko != 0);
    const bf16_t* G = second ? GB : GA;
#pragma unroll
    for (int ai = 0; ai < 2; ++ai)
#pragma unroll
      for (int bj = 0; bj < 2; ++bj)
#pragma unroll
        for (int m = 0; m < 4; ++m) {
          const int row = u.pm * 256 + ai * 128 + wr * 64 + m * 16 + fr;
          const int c0 = u.pn * 256 + bj * 128 + wc * 32 + fq * 8;
          const uint4 gv = *(const uint4*)(G + (size_t)row * 1024 + c0);
          const unsigned gw[4] = {gv.x, gv.y, gv.z, gv.w};
          f32x4 o0 = acc[ai][bj][m][0], o1 = acc[ai][bj][m][1];
          o0[0] *= __uint_as_float(gw[0] << 16);
          o0[1] *= __uint_as_float(gw[0] & 0xffff0000u);
          o0[2] *= __uint_as_float(gw[1] << 16);
          o0[3] *= __uint_as_float(gw[1] & 0xffff0000u);
          o1[0] *= __uint_as_float(gw[2] << 16);
          o1[1] *= __uint_as_float(gw[2] & 0xffff0000u);
          o1[2] *= __uint_as_float(gw[3] << 16);
          o1[3] *= __uint_as_float(gw[3] & 0xffff0000u);
          bf16_t* mp = MER + (size_t)row * 1024 + c0;
          if (second) {
            const uint4 pv = *(const uint4*)mp;
            o0[0] += __uint_as_float(pv.x << 16);
            o0[1] += __uint_as_float(pv.x & 0xffff0000u);
            o0[2] += __uint_as_float(pv.y << 16);
            o0[3] += __uint_as_float(pv.y & 0xffff0000u);
            o1[0] += __uint_as_float(pv.z << 16);
            o1[1] += __uint_as_float(pv.z & 0xffff0000u);
            o1[2] += __uint_as_float(pv.w << 16);
            o1[3] += __uint_as_float(pv.w & 0xffff0000u);
          }
          *(uint4*)mp = pack8(o0, o1);
          if (m == 3) asm volatile("" ::: "memory");
        }
  }
};
__device__ __forceinline__ void phase_e(const Params& p, char* smem) {
  __syncthreads();
  pg8::Gemm g{p.YA, p.Wt_a, kT, 1024, 1024, 1024};
  OrderE S;
  EpiE E{p.GA, p.GB, p.MER};
  pg8::gemm_phase<EpiE, OrderE, false>((PG8_LAS unsigned char*)smem, g, S, E, nullptr);
}
struct OrderF {
  __device__ __forceinline__ bool next(int i, pg8::Unit& u) const {
    const int b = blockIdx.x;
    if (i == 0) {
      const int xcd = b & 7, l = b >> 3;
      u.pm = xcd * 8 + (l >> 2);
      u.pn = l & 3;
      u.ko = 0;
      u.nt = 16;
      return true;
    }
    if (i == 1 && b < 64) {
      const int t2 = b >> 2, kp = b & 3;
      u.pm = 64 + (t2 >> 2);
      u.pn = t2 & 3;
      u.ko = kp * 256;
      u.nt = 4;
      return true;
    }
    return false;
  }
  __device__ __forceinline__ void a_ready(const pg8::Unit&) const {}
  __device__ __forceinline__ void done(const pg8::Unit&) const {}
};
struct EpiF {
  static constexpr bool PERM = false, AFTER_DRAIN = false;
  const float* x_prompt;
  const float* x_sample;
  float* X1;
  float* SLAB;
  const float* modf;
  __device__ __forceinline__ void operator()(const f32x4 (&acc)[2][2][4][2], const pg8::Unit& u, int wr, int wc, int fr, int fq) const {
    const bool primary = (u.ko == 0);
    float* slab = SLAB + (size_t)(((u.pm - 64) * 4 + u.pn) * 3 + ((u.ko >> 8) - 1)) * 65536;
#pragma unroll
    for (int ai = 0; ai < 2; ++ai) {
      const int lr0 = ai * 128 + wr * 64 + fr;
      const int seq = seq_of(u.pm * 256 + ai * 128 + wr * 64);
#pragma unroll
      for (int bj = 0; bj < 2; ++bj)
#pragma unroll
        for (int n = 0; n < 2; ++n) {
          const int lc = bj * 128 + wc * 32 + n * 16 + fq * 4;
          const f32x4 g1 = *(const f32x4*)(modf + seq * 6144 + 2048 + u.pn * 256 + lc);
#pragma unroll
          for (int m = 0; m < 4; ++m) {
            const int lr = lr0 + m * 16;
            const f32x4 v = g1 * acc[ai][bj][m][n];
            if (primary) {
              const int row = u.pm * 256 + lr;
              const float* xr = (row < kNP ? x_prompt + (size_t)row * 1024 : x_sample + (size_t)(row - kNP) * 1024) + u.pn * 256 + lc;
              *(f32x4*)(X1 + (size_t)row * 1024 + u.pn * 256 + lc) = *(const f32x4*)xr + v;
            } else {
              *(f32x4*)(slab + lr * 256 + lc) = v;
            }
          }
          asm volatile("" ::: "memory");
        }
    }
  }
};
__device__ __forceinline__ void phase_f(const Params& p, char* smem) {
  __syncthreads();
  pg8::Gemm g{p.MER, p.Wt_out, kT, 1024, 1024};
  OrderF S;
  EpiF E{p.x_prompt, p.x_sample, p.X1, p.SLAB, p.modf};
  pg8::gemm_phase<EpiF, OrderF, false>((PG8_LAS unsigned char*)smem, g, S, E, nullptr);
}
__device__ __forceinline__ void phase_h(const Params& p, char* smem) {
  __syncthreads();
  pg8::Gemm g{p.U, p.Wt_gu, kT, 5632, 1024};
  pg8::StaticOrder S;
  S.init(kT, 5632, gridDim.x, blockIdx.x);
  EpiH E{p.HFF};
  pg8::gemm_phase<EpiH, pg8::StaticOrder, false>((PG8_LAS unsigned char*)smem, g, S, E, nullptr);
}
struct OrderI {
  __device__ __forceinline__ bool next(int i, pg8::Unit& u) const {
    const int b = blockIdx.x;
    if (i == 0) {
      const int xcd = b & 7, l = b >> 3;
      u.pm = xcd * 8 + (l >> 2);
      u.pn = l & 3;
      u.ko = 0;
      u.nt = 44;
      return true;
    }
    if (i == 1 && b < 176) {
      const int t2 = b / 11, kp = b - t2 * 11;
      u.pm = 64 + (t2 >> 2);
      u.pn = t2 & 3;
      u.ko = kp * 256;
      u.nt = 4;
      return true;
    }
    return false;
  }
  __device__ __forceinline__ void a_ready(const pg8::Unit&) const {}
  __device__ __forceinline__ void done(const pg8::Unit&) const {}
};
struct EpiI {
  static constexpr bool PERM = false, AFTER_DRAIN = false;
  float* X1;
  float* SLAB;
  const float* modf;
  __device__ __forceinline__ void operator()(const f32x4 (&acc)[2][2][4][2], const pg8::Unit& u, int wr, int wc, int fr, int fq) const {
    const bool primary = (u.nt == 44);
    float* slab = SLAB + (size_t)(((u.pm - 64) * 4 + u.pn) * 11 + (u.ko >> 8)) * 65536;
#pragma unroll
    for (int ai = 0; ai < 2; ++ai) {
      const int lr0 = ai * 128 + wr * 64 + fr;
      const int seq = seq_of(u.pm * 256 + ai * 128 + wr * 64);
#pragma unroll
      for (int bj = 0; bj < 2; ++bj)
#pragma unroll
        for (int n = 0; n < 2; ++n) {
          const int lc = bj * 128 + wc * 32 + n * 16 + fq * 4;
          const f32x4 g2 = *(const f32x4*)(modf + seq * 6144 + 5120 + u.pn * 256 + lc);
#pragma unroll
          for (int m = 0; m < 4; ++m) {
            const int lr = lr0 + m * 16;
            const f32x4 v = g2 * acc[ai][bj][m][n];
            if (primary) {
              float* px = X1 + (size_t)(u.pm * 256 + lr) * 1024 + u.pn * 256 + lc;
              *(f32x4*)px = *(const f32x4*)px + v;
            } else {
              *(f32x4*)(slab + lr * 256 + lc) = v;
            }
          }
          asm volatile("" ::: "memory");
        }
    }
  }
};
__device__ __forceinline__ void phase_i(const Params& p, char* smem) {
  __syncthreads();
  pg8::Gemm g{p.HFF, p.Wt_down, kT, 1024, 2816, 2816};
  OrderI S;
  EpiI E{p.X1, p.SLAB, p.modf};
  pg8::gemm_phase<EpiI, OrderI, false>((PG8_LAS unsigned char*)smem, g, S, E, nullptr);
}
__device__ __forceinline__ void phase_j(const Params& p) {
  const int tid = launder_tid(), lane = tid & 63, w = tid >> 6;
  for (int g = blockIdx.x * 8 + w; g < kT / 4; g += gridDim.x * 8) {
    float4 v[4][4];
#pragma unroll
    for (int i = 0; i < 4; i++)
#pragma unroll
      for (int j = 0; j < 4; j++) {
        const int row = g * 4 + i;
        v[i][j] = *(const float4*)(p.X1 + (size_t)row * 1024 + j * 256 + lane * 4);
        if (row >= kNP) {
          const float* sl = p.SLAB + (size_t)((((row - kNP) >> 8) * 4 + j) * 11) * 65536 + (row & 255) * 256 + lane * 4;
#pragma unroll
          for (int kp = 0; kp < 11; kp++) {
            const float4 e = *(const float4*)(sl + (size_t)kp * 65536);
            v[i][j].x += e.x;
            v[i][j].y += e.y;
            v[i][j].z += e.z;
            v[i][j].w += e.w;
          }
        }
      }
#pragma unroll
    for (int i = 0; i < 4; i++) {
      const int row = g * 4 + i;
      float ss = 0.f;
#pragma unroll
      for (int j = 0; j < 4; j++)
        ss += v[i][j].x * v[i][j].x + v[i][j].y * v[i][j].y + v[i][j].z * v[i][j].z + v[i][j].w * v[i][j].w;
      ss = wave_sum(ss);
      float rstd = rsqrtf(ss * (1.0f / 1024.0f) + 1e-6f);
      float* o = p.out + (row < kNP ? O_YP + (size_t)row * 1024 : O_YS + (size_t)(row - kNP) * 1024);
#pragma unroll
      for (int j = 0; j < 4; j++) {
        int c = j * 256 + lane * 4;
        float4 gg = *(const float4*)(p.final_g + c);
        float4 r4;
        r4.x = v[i][j].x * rstd * gg.x;
        r4.y = v[i][j].y * rstd * gg.y;
        r4.z = v[i][j].z * rstd * gg.z;
        r4.w = v[i][j].w * rstd * gg.w;
        *(float4*)(o + c) = r4;
      }
    }
  }
}

#define XB_TMO      128
#define XB_XCNT(j)  (256  + 64 * (j))
#define XB_XSUB(j)  (1280 + 64 * (j))
#define XB_XGEN(j)  (2304 + 64 * (j))
#define XB_TOP      3328
#define XB_TOPGEN   3392
#define XCD_BAR_WORDS 3456
#define XB_SPIN_CAP (1u << 18)
#define LAS __attribute__((address_space(3)))

__device__ __forceinline__ unsigned xb_ld(unsigned* p)              { return __hip_atomic_load(p, __ATOMIC_RELAXED, __HIP_MEMORY_SCOPE_AGENT); }
__device__ __forceinline__ unsigned xb_add(unsigned* p, unsigned v) { return __hip_atomic_fetch_add(p, v, __ATOMIC_RELAXED, __HIP_MEMORY_SCOPE_AGENT); }
__device__ __forceinline__ unsigned xb_xcc_id() { return (unsigned)__builtin_amdgcn_s_getreg((3 << 11) | 20) & 0xFu; }
#define XB_SPIN(cond, bar) do { unsigned _sp = 0; while (cond) { __builtin_amdgcn_s_sleep(1); \
    if ((++_sp & 255u) == 0u) { if (xb_ld(&(bar)[XB_TMO])) break; if (_sp > XB_SPIN_CAP) { atomicAdd(&(bar)[XB_TMO], 1u); break; } } } } while (0)

struct XcdBarrier {
    unsigned* bar; unsigned x;
    volatile LAS unsigned* st;
};

__device__ __forceinline__ XcdBarrier xcd_barrier_post(unsigned* bar, volatile LAS unsigned* st) {
    XcdBarrier b; b.bar = bar; b.x = xb_xcc_id(); b.st = st;
    if (threadIdx.x == 0) (void)xb_add(&bar[XB_XCNT(b.x)], 1u);
    return b;
}
__device__ __forceinline__ void xcd_barrier_complete(unsigned* bar, unsigned x, unsigned& nloc, unsigned& nx) {
    const unsigned G = gridDim.x * gridDim.y * gridDim.z;
    unsigned sum, cnt, mine, sp = 0u;
    for (;;) {
        sum = 0u; cnt = 0u; mine = 0u;
#pragma unroll
        for (unsigned j = 0; j < 16; ++j) { const unsigned c = xb_ld(&bar[XB_XCNT(j)]); sum += c; cnt += (c > 0u) ? 1u : 0u; mine = (j == x) ? c : mine; }
        if (sum == G) break;
        __builtin_amdgcn_s_sleep(1);
        if ((++sp & 255u) == 0u) { if (xb_ld(&bar[XB_TMO])) break; if (sp > XB_SPIN_CAP) { atomicAdd(&bar[XB_TMO], 1u); break; } }
    }
    nloc = mine > 0u ? mine : 1u; nx = cnt > 0u ? cnt : 1u;
}

__device__ __forceinline__ void xcd_barrier(const XcdBarrier& b) {
    asm volatile("s_waitcnt vmcnt(0)" ::: "memory");
    __syncthreads();
    if (threadIdx.x == 0) {
        unsigned* bar = b.bar;
        __builtin_amdgcn_s_waitcnt(0);
        unsigned nloc = b.st[0], nx = b.st[1];
        if (nloc == 0u) { xcd_barrier_complete(bar, b.x, nloc, nx); b.st[0] = nloc; b.st[1] = nx; }
        const unsigned old = xb_add(&bar[XB_XSUB(b.x)], 1u);
        const unsigned gen = old / nloc;
        if (old + 1u == (gen + 1u) * nloc) {
            __builtin_amdgcn_fence(__ATOMIC_RELEASE, "agent");
            asm volatile("s_waitcnt vmcnt(0)" ::: "memory");
            const unsigned og = xb_add(&bar[XB_TOP], 1u);
            const unsigned tg = og / nx;
            if (og + 1u == (tg + 1u) * nx) xb_add(&bar[XB_TOPGEN], 1u);
            else XB_SPIN(xb_ld(&bar[XB_TOPGEN]) == tg, bar);
            __builtin_amdgcn_fence(__ATOMIC_ACQUIRE, "agent");
            xb_add(&bar[XB_XGEN(b.x)], 1u);
            asm volatile("s_waitcnt vmcnt(0)" ::: "memory");
        } else {
            XB_SPIN(xb_ld(&bar[XB_XGEN(b.x)]) == gen, bar);
            __builtin_amdgcn_fence(__ATOMIC_ACQUIRE, "agent");
            asm volatile("s_waitcnt vmcnt(0)" ::: "memory");
        }
    }
    __syncthreads();
}


extern __shared__ __attribute__((aligned(16))) char dyn_smem[];

#ifndef REP_A
#define REP_A 1
#endif
#ifndef REP_C
#define REP_C 1
#endif
#ifndef REP_D
#define REP_D 1
#endif
#ifndef REP_H
#define REP_H 1
#endif
#ifndef REP_E
#define REP_E 1
#endif
__global__ void __launch_bounds__(NTHREADS) mega_kernel(Params p) {
  cg::grid_group grid = cg::this_grid();
  volatile LAS unsigned* xst = (volatile LAS unsigned*)(dyn_smem + LDS_BYTES - 32);
  if (threadIdx.x < 4) xst[threadIdx.x] = 0u;
  __syncthreads();
  XcdBarrier xb = xcd_barrier_post(p.bar, xst);
  if (p.bar == nullptr) grid.sync();
#pragma unroll 1
  for (int r = 0; r < REP_A; r++) {
    phase_a(p, dyn_smem);
    xcd_barrier(xb);
  }
  phase_b(p, dyn_smem);
  xcd_barrier(xb);
#pragma unroll 1
  for (int r = 0; r < REP_C; r++) {
    phase_c(p, dyn_smem);
    xcd_barrier(xb);
  }
  phase_d0(p, dyn_smem);
  xcd_barrier(xb);
#pragma unroll 1
  for (int r = 0; r < REP_D; r++) {
    phase_d(p, dyn_smem, r);
    xcd_barrier(xb);
  }
#pragma unroll 1
  for (int r = 0; r < REP_E; r++) {
    phase_e(p, dyn_smem);
    xcd_barrier(xb);
  }
  phase_f(p, dyn_smem);
  xcd_barrier(xb);
  phase_g(p, dyn_smem);
  xcd_barrier(xb);
#pragma unroll 1
  for (int r = 0; r < REP_H; r++) {
    phase_h(p, dyn_smem);
    xcd_barrier(xb);
  }
  phase_i(p, dyn_smem);
  xcd_barrier(xb);
  phase_j(p);
}
extern "C" void kernel_launch(void* const* d_in, const int* in_sizes, int n_in, void* d_out, int out_size, void* d_ws,
                              size_t ws_size, hipStream_t stream) {
  Params p{};
  const float** pin = (const float**)&p;
  for (int i = 0; i < 26; i++) pin[i] = (const float*)d_in[i];
  p.out = (float*)d_out;
  char* ws = (char*)d_ws;
  size_t off = 0;
  auto alloc = [&](size_t bytes) {
    char* r = ws + off;
    off += (bytes + 255) & ~(size_t)255;
    return r;
  };
  p.Wt_in = (bf16_t*)alloc((size_t)5632 * 1024 * 2);
  p.Wt_a = (bf16_t*)alloc((size_t)1024 * 1024 * 2);
  p.Wt_b = p.Wt_a;
  p.Wt_out = (bf16_t*)alloc((size_t)1024 * 1024 * 2);
  p.Wt_gu = (bf16_t*)alloc((size_t)5632 * 1024 * 2);
  p.Wt_down = (bf16_t*)alloc((size_t)1024 * 2816 * 2);
  p.wg = (float*)alloc(8192 * 4);
  p.modp = (float*)alloc((size_t)8 * 24 * 6144 * 4);
  p.modf = (float*)alloc((size_t)24 * 6144 * 4);
  p.U = (bf16_t*)alloc((size_t)kT * 1024 * 2);
  char* r1 = ws + off;
  p.Qb = (bf16_t*)alloc((size_t)kT * 512 * 2);
  p.Kp = (bf16_t*)alloc((size_t)64 * 2048 * 64 * 2);
  p.Ks = (bf16_t*)alloc((size_t)128 * 1152 * 64 * 2);
  p.VTp = (bf16_t*)alloc((size_t)64 * 64 * 2048 * 2);
  p.VTs = (bf16_t*)alloc((size_t)128 * 64 * 1152 * 2);
  p.MQK = (bf16_t*)alloc((size_t)kT * 1024 * 2);
  const size_t r1_bytes = (size_t)(ws + off - r1);
  char* r2 = ws + off;
  p.MVTp = (bf16_t*)alloc((size_t)32 * 128 * 2048 * 2);
  p.MVTs = (bf16_t*)alloc((size_t)64 * 128 * 64 * 2);
  p.SO = (bf16_t*)alloc((size_t)kT * 512 * 2);
  const size_t r2_bytes = (size_t)(ws + off - r2);
  char* r3 = ws + off;
  p.GA = (bf16_t*)alloc((size_t)kT * 1024 * 2);
  p.GB = (bf16_t*)alloc((size_t)kT * 1024 * 2);
  const size_t r3_bytes = (size_t)(ws + off - r3);
  p.GI = (float*)alloc((size_t)kT * 4 * 4);
  p.LF = (float*)alloc((size_t)kT * 4 * 4);
  p.GV = (float*)alloc((size_t)1088 * 384 * 4);
  p.DENc = (float*)alloc((size_t)1088 * 64 * 4);
  char* r4 = ws + off;
  p.Qc = (bf16_t*)alloc((size_t)1088 * 8192 * 2);
  p.KTc = (bf16_t*)alloc((size_t)1088 * 8192 * 2);
  p.SWc = (bf16_t*)alloc((size_t)1088 * 4096 * 2);
  p.YA = (bf16_t*)alloc((size_t)kT * 1024 * 2);
  p.YB = p.YA;
  const size_t r4_bytes = (size_t)(ws + off - r4);
  p.counter = (unsigned*)alloc(256);
  p.bar = (unsigned*)alloc(XCD_BAR_WORDS * 4);
  p.HFF = (bf16_t*)r1;
  p.MER = (bf16_t*)r2;
  p.X1 = (float*)r4;
  p.SLAB = (float*)r3;
  if (r1_bytes < (size_t)kT * 2816 * 2 || r2_bytes < (size_t)kT * 1024 * 2 ||
      r4_bytes < (size_t)kT * 1024 * 4 || r3_bytes < (size_t)176 * 65536 * 4 || off > ws_size) {
    fprintf(stderr, "workspace layout error: need %zu bytes, have %zu\n", off, ws_size);
    return;
  }

#if ONE_LAUNCH
  static int grid_blocks = 0;
  if (!grid_blocks) {
    int dev = 0, cus = 0, per_cu = 0;
    hipGetDevice(&dev);
    hipDeviceGetAttribute(&cus, hipDeviceAttributeMultiprocessorCount, dev);
    hipFuncSetAttribute((const void*)mega_kernel, hipFuncAttributeMaxDynamicSharedMemorySize, LDS_BYTES);
    hipOccupancyMaxActiveBlocksPerMultiprocessor(&per_cu, mega_kernel, NTHREADS, LDS_BYTES);
    if (per_cu < 1) per_cu = 1;
    grid_blocks = cus * per_cu;
    if (grid_blocks > 256) grid_blocks = 256;
  }
  (void)hipMemsetAsync(p.bar, 0, XCD_BAR_WORDS * 4, stream);
  if (grid_blocks != 256) {
    fprintf(stderr, "unexpected co-resident grid %d (phase I is laid out for 256 workgroups)\n", grid_blocks);
    return;
  }
  void* args[] = {&p};
  hipError_t e = hipLaunchCooperativeKernel((void*)mega_kernel, dim3(grid_blocks), dim3(NTHREADS), args, LDS_BYTES, stream);
  if (e != hipSuccess) fprintf(stderr, "cooperative launch failed: %s (grid %d)\n", hipGetErrorString(e), grid_blocks);
#endif
}
```

```cpp
#include <hip/hip_runtime.h>
#include <hip/hip_cooperative_groups.h>
#include <stdint.h>
#include <stdio.h>
namespace cg = cooperative_groups;

#ifndef ONE_LAUNCH
#define ONE_LAUNCH 1
#endif

typedef unsigned short bf16_t;
using bf16x8 = __attribute__((ext_vector_type(8))) short;
using f32x4 = __attribute__((ext_vector_type(4))) float;

#define NTHREADS 512
#define LDS_BYTES 155648
constexpr int kNP = 16384;
constexpr int kT = 17408;
constexpr int kINW = 5640;

struct Params {
  const float *x_prompt, *x_sample, *c_prompt, *c_sample, *cache_k, *cache_v, *st_C, *st_n, *st_m, *st_conv;
  const float *norm1_g, *norm2_g, *w_ada, *b_ada, *w_in, *b_if, *w_conv, *b_conv, *ml_norm_g, *w_a, *w_b, *w_out,
      *w_gate, *w_up, *w_down, *final_g;
  float* out;
  bf16_t *Wt_in, *Wt_a, *Wt_b, *Wt_out, *Wt_gu, *Wt_down;
  float *modp, *modf;
  bf16_t *U, *Qb, *Kp, *Ks, *VTp, *VTs, *MQK, *MVTp, *MVTs, *SO, *GA, *GB;
  float *GI, *LF, *GV, *DENc;
  bf16_t *Qc, *KTc, *SWc;
  bf16_t *YA, *YB, *MER;
  float* X1;
  float* SLAB;
  bf16_t* HFF;
  unsigned* counter;
  unsigned* bar;
};

constexpr size_t O_YP = 0;
constexpr size_t O_YS = O_YP + 16777216;
constexpr size_t O_KP = O_YS + 1048576;
constexpr size_t O_VP = O_KP + 8388608;
constexpr size_t O_CP = O_VP + 8388608;
constexpr size_t O_NP = O_CP + 524288;
constexpr size_t O_MP = O_NP + 4096;
constexpr size_t O_CVP = O_MP + 32;
constexpr size_t O_KS = O_CVP + 24576;
constexpr size_t O_VS = O_KS + 524288;
constexpr size_t O_CS = O_VS + 524288;
constexpr size_t O_NS = O_CS + 1048576;
constexpr size_t O_MS = O_NS + 8192;
constexpr size_t O_CVS = O_MS + 64;

typedef __bf16 hwbf16x2_t __attribute__((ext_vector_type(2)));
typedef float hwf32x2_t __attribute__((ext_vector_type(2)));
__device__ __forceinline__ bf16_t f2bf(float f) {
  __bf16 r = (__bf16)f;
  return __builtin_bit_cast(unsigned short, r);
}
__device__ __forceinline__ float bf2f(bf16_t h) { return __uint_as_float(((unsigned)h) << 16); }
__device__ __forceinline__ unsigned pack2(float a, float b) {
  hwf32x2_t v = {a, b};
  hwbf16x2_t r = __builtin_convertvector(v, hwbf16x2_t);
  return __builtin_bit_cast(unsigned, r);
}
__device__ __forceinline__ float sigm(float x) { return __builtin_amdgcn_rcpf(1.0f + __expf(-x)); }
__device__ __forceinline__ float silu(float x) { return x * __builtin_amdgcn_rcpf(1.0f + __expf(-x)); }
__device__ __forceinline__ float logsig(float x) { return fminf(x, 0.f) - __logf(1.0f + __expf(-fabsf(x))); }
__device__ __forceinline__ float wave_max(float v) {
#pragma unroll
  for (int o = 32; o > 0; o >>= 1) v = fmaxf(v, __shfl_xor(v, o));
  return v;
}
#define DPP_ADD(v, ctrl) v += __int_as_float(__builtin_amdgcn_update_dpp(0, __float_as_int(v), ctrl, 0xF, 0xF, true))
__device__ __forceinline__ float row16_sum(float v) {
  DPP_ADD(v, 0xB1);
  DPP_ADD(v, 0x4E);
  DPP_ADD(v, 0x124);
  DPP_ADD(v, 0x128);
  return v;
}
__device__ __forceinline__ float half8_sum(float v) {
  DPP_ADD(v, 0xB1);
  DPP_ADD(v, 0x4E);
  DPP_ADD(v, 0x141);
  return v;
}
__device__ __forceinline__ float wave_sum(float v) {
  v = row16_sum(v);
  v += __shfl_xor(v, 16);
  v += __shfl_xor(v, 32);
  return v;
}
__device__ __forceinline__ int seq_of(int row) { return row < kNP ? (row >> 11) : 8 + ((row - kNP) >> 6); }
__device__ __forceinline__ const float* xrow(const Params& p, int row) {
  return row < kNP ? p.x_prompt + (size_t)row * 1024 : p.x_sample + (size_t)(row - kNP) * 1024;
}
__device__ __forceinline__ int launder_tid() {
  int t = threadIdx.x;
  asm volatile("" : "+v"(t));
  return t;
}
__device__ __forceinline__ bf16x8 lds8(const void* p) { return *(const bf16x8*)p; }
#define MFMA(a, b, c) __builtin_amdgcn_mfma_f32_16x16x32_bf16(a, b, c, 0, 0, 0)

namespace pg8 {
#define PG8_LAS __attribute__((address_space(3)))
typedef unsigned short bf16_t;
typedef short bf16x8 __attribute__((ext_vector_type(8)));
typedef float f32x4 __attribute__((ext_vector_type(4)));
typedef unsigned u32x4 __attribute__((ext_vector_type(4)));
constexpr int BM = 256, BK = 64, HALF = 128, HTB = HALF * BK * 2  , STAGE_BYTES = 8 * HTB, NXCD = 8, WGM = 8;

__host__ __device__ __forceinline__ int lds_byte(int r, int c) { const int st = (r >> 4) * 2 + (c >> 5), rr = r & 15, cc = c & 31, ob = rr * 64 + cc * 2; return st * 1024 + (ob ^ (((ob >> 9) & 1) << 5)); }
__host__ __device__ __forceinline__ void stage_rc(int b, int& R, int& C) { const int st = b / 1024, sb = b % 1024, swz = sb ^ (((sb >> 9) & 1) << 5); R = (st >> 1) * 16 + swz / 64; C = (st & 1) * 32 + (swz % 64) / 2; }
__host__ __device__ __forceinline__ int perm32(int rho) { const int n = rho >> 4, i = rho & 15; return 8 * (i >> 2) + 4 * n + (i & 3); }

struct Unit { int pm, pn; int ko = 0, nt = 0; };
struct Gemm { const bf16_t* A; const bf16_t* Bt; int M, N, K; int ld = 0; };

struct StaticOrder {
    int nM, nN, nwg, G, c;
    __host__ __device__ void init(int M, int N, int G_, int c_) { nM = M / BM; nN = N / BM; nwg = nM * nN; G = G_; c = c_; }
    __host__ __device__ bool next(int i, Unit& u) const {
        const long L = (long)i * G + c; if (L >= nwg) return false;
        int wgid = (int)L; { const int q = nwg / NXCD, r = nwg % NXCD, xcd = wgid % NXCD, off = wgid / NXCD; wgid = (xcd < r ? xcd * (q + 1) : r * (q + 1) + (xcd - r) * q) + off; }
        const int nig = WGM * nN, gid = wgid / nig, fm = gid * WGM, gsz = (nM - fm) < WGM ? (nM - fm) : WGM;
        u.pm = fm + ((wgid % nig) % gsz); u.pn = (wgid % nig) / gsz; return true;
    }
    __device__ __forceinline__ void a_ready(const Unit&) const {}
    __device__ __forceinline__ void done(const Unit&) const {}
};
__device__ __forceinline__ unsigned cvt_pk_bf16(float lo, float hi) { unsigned r; asm volatile("v_cvt_pk_bf16_f32 %0, %1, %2" : "=v"(r) : "v"(lo), "v"(hi)); return r; }
template <class Epi, class Sched, bool STAMP = false>
__device__ __forceinline__ void gemm_phase(PG8_LAS unsigned char* lds, const Gemm g, const Sched& S, const Epi& E, unsigned long long* stamps) {
    const int tid = launder_tid(), wid = __builtin_amdgcn_readfirstlane(tid >> 6), lane = tid & 63, wr = wid >> 2, wc = wid & 3, fr = lane & 15, fq = lane >> 4;
    const int K = g.K, nt = K / BK, ld = g.ld ? g.ld : K;
    int ts_lo = 0, ts_hi = 0, nts = 0; const unsigned long long rt_entry = STAMP ? (unsigned long long)wall_clock64() : 0ull;
#define PG8_STAMP() do { if (STAMP && wid == 0 && nts < 64) { const unsigned long long _c = (unsigned long long)clock64(); \
        ts_lo = (lane == nts) ? (int)(unsigned)_c : ts_lo; ts_hi = (lane == nts) ? (int)(unsigned)(_c >> 32) : ts_hi; ++nts; } } while (0)
    PG8_STAMP();
    unsigned voffA[2], voffB[2];
#pragma unroll
    for (int i = 0; i < 2; ++i) { int R, C; stage_rc(tid * 16 + i * 8192, R, C); const int Rb = Epi::PERM ? ((R & ~31) + perm32(R & 31)) : R;
        voffA[i] = (unsigned)(R * ld + C) * 2u; voffB[i] = (unsigned)(Rb * ld + C) * 2u; }
    const size_t kstep = (size_t)(BK * 2);
    const size_t hstep = (size_t)HALF * ld * 2;
    const size_t tstep = 2 * hstep;
    const unsigned ldsw = (unsigned)wid * 1024u;
    const int aoff = lds_byte(wr * 64 + fr, fq * 8), boff = lds_byte(wc * 32 + fr, fq * 8);
#define PG8_SA(b, h) (((b) * 2 + (h)) * HTB)
#define PG8_SB(b, h) ((4 + (b) * 2 + (h)) * HTB)
#define PG8_STAGE(bufoff, gbase, voff) do { _Pragma("unroll") for (int _i = 0; _i < 2; ++_i) \
        __builtin_amdgcn_global_load_lds((const unsigned*)((const char*)(gbase) + (voff)[_i]), (PG8_LAS unsigned*)(lds + (bufoff) + ldsw + _i * 8192), 16, 0, 0); } while (0)
#define PG8_LDA(dst, b, h) do { _Pragma("unroll") for (int m = 0; m < 4; ++m) _Pragma("unroll") for (int k = 0; k < 2; ++k) dst[m][k] = *(const PG8_LAS bf16x8*)(lds + PG8_SA(b, h) + aoff + m * 2048 + k * 1024); } while (0)
#define PG8_LDB(dst, b, h) do { _Pragma("unroll") for (int n = 0; n < 2; ++n) _Pragma("unroll") for (int k = 0; k < 2; ++k) dst[n][k] = *(const PG8_LAS bf16x8*)(lds + PG8_SB(b, h) + boff + n * 2048 + k * 1024); } while (0)
#define PG8_MMA(ai, bj, At, Bt) do { __builtin_amdgcn_s_setprio(1); _Pragma("unroll") for (int m = 0; m < 4; ++m) _Pragma("unroll") for (int n = 0; n < 2; ++n) _Pragma("unroll") for (int k = 0; k < 2; ++k) \
        acc[ai][bj][m][n] = __builtin_amdgcn_mfma_f32_16x16x32_bf16(Bt[n][k], At[m][k], acc[ai][bj][m][n], 0, 0, 0); __builtin_amdgcn_s_setprio(0); } while (0)
#define PG8_WAIT_V(n) asm volatile("s_waitcnt vmcnt(" #n ")" ::: "memory")
#define PG8_WAIT_L(n) asm volatile("s_waitcnt lgkmcnt(" #n ")" ::: "memory")
#define PG8_BAR __builtin_amdgcn_s_barrier()
#define PG8_SCHED __builtin_amdgcn_sched_barrier(0)
    Unit cur, nxt; int ui = 0;
    if (!S.next(0, cur)) return;
    f32x4 acc[2][2][4][2];
#pragma unroll
    for (int a = 0; a < 2; ++a)
#pragma unroll
        for (int b = 0; b < 2; ++b)
#pragma unroll
            for (int m = 0; m < 4; ++m)
#pragma unroll
                for (int n = 0; n < 2; ++n) acc[a][b][m][n] = (f32x4){0.f, 0.f, 0.f, 0.f};
    bf16x8 At[4][2], B0[2][2], B1[2][2];
    const char* cA = (const char*)g.A + (size_t)cur.pm * tstep + (size_t)cur.ko * 2; const char* cB = (const char*)g.Bt + (size_t)cur.pn * tstep + (size_t)cur.ko * 2;
    S.a_ready(cur);
    PG8_STAGE(PG8_SB(0, 0), cB, voffB); PG8_STAGE(PG8_SA(0, 0), cA, voffA); PG8_STAGE(PG8_SB(0, 1), cB + hstep, voffB); PG8_STAGE(PG8_SA(0, 1), cA + hstep, voffA);
    if (wr == 1) PG8_BAR;
    PG8_WAIT_V(4); PG8_BAR;
    PG8_STAGE(PG8_SB(1, 0), cB + kstep, voffB); PG8_STAGE(PG8_SA(1, 0), cA + kstep, voffA); PG8_STAGE(PG8_SB(1, 1), cB + hstep + kstep, voffB);
    PG8_WAIT_V(6); PG8_BAR;
    PG8_STAMP();
    for (;;) {
        const bool has_next = S.next(ui + 1, nxt);
        const char* nA = has_next ? (const char*)g.A + (size_t)nxt.pm * tstep + (size_t)nxt.ko * 2 : cA; const char* nB = has_next ? (const char*)g.Bt + (size_t)nxt.pn * tstep + (size_t)nxt.ko * 2 : cB;
        const int unt = cur.nt ? cur.nt : nt;
        for (int t = 0; t < unt; t += 2) {
            const bool last = (t == unt - 2);
            const char* a1 = cA + (size_t)(t + 1) * kstep;
            const char* a2 = last ? nA : cA + (size_t)(t + 2) * kstep; const char* b2 = last ? nB : cB + (size_t)(t + 2) * kstep;
            const char* a3 = a2 + kstep; const char* b3 = b2 + kstep;
            if (last && has_next) S.a_ready(nxt);
            PG8_LDB(B0, 0, 0); PG8_SCHED; PG8_LDA(At, 0, 0); PG8_STAGE(PG8_SA(1, 1), a1 + hstep, voffA);
            PG8_WAIT_L(8); PG8_BAR; PG8_WAIT_L(0); PG8_MMA(0, 0, At, B0); PG8_BAR; PG8_SCHED;
            PG8_LDB(B1, 0, 1); PG8_STAGE(PG8_SB(0, 0), b2, voffB);
            PG8_BAR; PG8_WAIT_L(0); PG8_MMA(0, 1, At, B1); PG8_BAR;
            PG8_LDA(At, 0, 1); PG8_STAGE(PG8_SA(0, 0), a2, voffA);
            PG8_BAR; PG8_WAIT_L(0); PG8_MMA(1, 0, At, B0); PG8_BAR; PG8_SCHED;
            PG8_STAGE(PG8_SB(0, 1), b2 + hstep, voffB);
            PG8_WAIT_V(6); PG8_BAR; PG8_MMA(1, 1, At, B1); PG8_BAR;
            PG8_LDB(B0, 1, 0); PG8_SCHED; PG8_LDA(At, 1, 0); PG8_STAGE(PG8_SA(0, 1), a2 + hstep, voffA);
            PG8_WAIT_L(8); PG8_BAR; PG8_WAIT_L(0); PG8_MMA(0, 0, At, B0); PG8_BAR; PG8_SCHED;
            PG8_LDB(B1, 1, 1); PG8_STAGE(PG8_SB(1, 0), b3, voffB);
            PG8_BAR; PG8_WAIT_L(0); PG8_MMA(0, 1, At, B1); PG8_BAR;
            PG8_LDA(At, 1, 1); PG8_STAGE(PG8_SA(1, 0), a3, voffA);
            PG8_BAR; PG8_WAIT_L(0); PG8_MMA(1, 0, At, B0); PG8_BAR; PG8_SCHED;
            PG8_STAGE(PG8_SB(1, 1), b3 + hstep, voffB);
            PG8_WAIT_V(6); PG8_BAR; PG8_MMA(1, 1, At, B1); PG8_BAR;
        }
        PG8_STAMP();
        if constexpr (!Epi::AFTER_DRAIN) { E(acc, cur, wr, wc, fr, fq); S.done(cur); }
        PG8_STAMP();
        if (!has_next) break;
#pragma unroll
        for (int a = 0; a < 2; ++a)
#pragma unroll
            for (int b = 0; b < 2; ++b)
#pragma unroll
                for (int m = 0; m < 4; ++m)
#pragma unroll
                    for (int n = 0; n < 2; ++n) acc[a][b][m][n] = (f32x4){0.f, 0.f, 0.f, 0.f};
        cur = nxt; cA = nA; cB = nB; ++ui;
    }
    PG8_WAIT_V(0);
    if (wr == 0) PG8_BAR;
    PG8_BAR;
    if constexpr (Epi::AFTER_DRAIN) { E.fused(acc, cur, wr, wc, fr, fq, lds, wid, lane); S.done(cur); }
    PG8_STAMP();
    if (STAMP && wid == 0) { stamps[lane] = lane < nts ? (((unsigned long long)(unsigned)ts_hi << 32) | (unsigned)ts_lo) : 0ull;
        if (lane == 62) stamps[62] = rt_entry; if (lane == 63) stamps[63] = (unsigned long long)wall_clock64(); }
#undef PG8_STAMP
#undef PG8_SA
#undef PG8_SB
#undef PG8_STAGE
#undef PG8_LDA
#undef PG8_LDB
#undef PG8_MMA
#undef PG8_WAIT_V
#undef PG8_WAIT_L
#undef PG8_BAR
#undef PG8_SCHED
}
}

__device__ __forceinline__ void transpose_quad(const float* __restrict__ src, int lds_, size_t sstep, bf16_t* __restrict__ dst, int ldd,
                               int k0, int kstep, int nbase, int nstep, int mode, char* smem) {
  float* tl = (float*)smem;
  const int tid = launder_tid();
  float4 v[4][2];
#pragma unroll
  for (int q = 0; q < 4; q++)
#pragma unroll
    for (int i = 0; i < 2; i++) {
      int idx = tid + i * 512;
      int k = idx >> 4, n4 = (idx & 15) * 4;
      v[q][i] = *(const float4*)(src + q * sstep + (size_t)k * lds_ + n4);
    }
  __syncthreads();
#pragma unroll
  for (int q = 0; q < 4; q++)
#pragma unroll
    for (int i = 0; i < 2; i++) {
      int idx = tid + i * 512;
      int k = idx >> 4, n4 = (idx & 15) * 4;
      float* t = tl + q * 4160 + k * 65 + n4;
      t[0] = v[q][i].x;
      t[1] = v[q][i].y;
      t[2] = v[q][i].z;
      t[3] = v[q][i].w;
    }
  __syncthreads();
  const int n = tid >> 3, kc = (tid & 7) * 8;
#pragma unroll
  for (int q = 0; q < 4; q++) {
    float o[8];
#pragma unroll
    for (int e = 0; e < 8; e++) o[e] = tl[q * 4160 + (kc + e) * 65 + n];
    const int nb = (mode == 2) ? nbase + (q >> 1) * 256 + (q & 1) * 64 : nbase + q * nstep;
    const int nrow = (mode != 1) ? (nb + n) : (nb + (n >> 5) * 64 + (n & 31));
    uint4 pk = {pack2(o[0], o[1]), pack2(o[2], o[3]), pack2(o[4], o[5]), pack2(o[6], o[7])};
    *(uint4*)(dst + (size_t)nrow * ldd + k0 + q * kstep + kc) = pk;
  }
}

constexpr int A_MOD = 96;
constexpr int A_WT = 1008;
constexpr int A_VC = 512;
constexpr int A_KC = 256;
constexpr int A_PAD = 128;
constexpr int A_MISC = 1;
constexpr int A_TOTAL = A_MOD + A_WT + A_VC + A_KC + A_PAD + A_MISC;

__device__ __forceinline__ void phase_a(const Params& p, char* smem) {
  const int tid = launder_tid();
  for (int task = blockIdx.x; task < A_TOTAL; task += gridDim.x) {
    int id = task;
    if (id < A_MOD) {
      int cgp = id % 12, ks = id / 12;
      float* sc = (float*)smem;
      __syncthreads();
      for (int i = tid; i < 24 * 128; i += 512) {
        int s = i >> 7, kk = i & 127, k = ks * 128 + kk;
        float cv = s < 8 ? p.c_prompt[s * 1024 + k] : p.c_sample[(s - 8) * 1024 + k];
        sc[i] = silu(cv);
      }
      __syncthreads();
      int col = cgp * 512 + tid;
      float acc[24];
#pragma unroll
      for (int s = 0; s < 24; s++) acc[s] = 0.f;
      const float* wp = p.w_ada + (size_t)(ks * 128) * 6144 + col;
#pragma unroll 1
      for (int kb = 0; kb < 128; kb += 32) {
        float wv[32];
#pragma unroll
        for (int j = 0; j < 32; j++) wv[j] = wp[(size_t)(kb + j) * 6144];
#pragma unroll
        for (int j = 0; j < 32; j++)
#pragma unroll
          for (int s = 0; s < 24; s++) acc[s] += sc[s * 128 + kb + j] * wv[j];
      }
#pragma unroll
      for (int s = 0; s < 24; s++) p.modp[(size_t)(ks * 24 + s) * 6144 + col] = acc[s];
      continue;
    }
    id -= A_MOD;
    if (id < A_WT) {
      if (id < 352) {
        int kt = id / 22, nq = id % 22;
        int scol = nq < 14 ? nq * 256 : 3592 + (nq - 14) * 256;
        int drow = nq < 14 ? nq * 256 : 3584 + (nq - 14) * 256;
        transpose_quad(p.w_in + (size_t)kt * 64 * kINW + scol, kINW, 64, p.Wt_in, 1024, kt * 64, 0, drow, 64, 0, smem);
      } else if (id < 384) {
        int i2 = id - 352, kt = i2 / 4, nq = i2 % 4;
        transpose_quad(p.w_a + (size_t)kt * 64 * 1024 + nq * 256, 1024, 64, p.Wt_a, 1024, kt * 64, 0, nq * 256, 64, 0, smem);
      } else if (id < 416) {
        int i2 = id - 384, kt = i2 / 4, nq = i2 % 4;
        transpose_quad(p.w_b + (size_t)kt * 64 * 1024 + nq * 256, 1024, 64, p.Wt_a, 1024, 512 + kt * 64, 0, nq * 256, 64, 0, smem);
      } else if (id < 480) {
        int i2 = id - 416, kt = i2 / 4, nq = i2 % 4;
        transpose_quad(p.w_out + (size_t)kt * 64 * 1024 + nq * 256, 1024, 64, p.Wt_out, 1024, kt * 64, 0, nq * 256, 64, 0, smem);
      } else if (id < 656) {
        int i2 = id - 480, kt = i2 / 11, nq = i2 % 11;
        transpose_quad(p.w_gate + (size_t)kt * 64 * 2816 + nq * 256, 2816, 64, p.Wt_gu, 1024, kt * 64, 0, nq * 512, 0, 2, smem);
      } else if (id < 832) {
        int i2 = id - 656, kt = i2 / 11, nq = i2 % 11;
        transpose_quad(p.w_up + (size_t)kt * 64 * 2816 + nq * 256, 2816, 64, p.Wt_gu, 1024, kt * 64, 0, nq * 512 + 128, 0, 2, smem);
      } else {
        int i2 = id - 832, kt = i2 / 4, nq = i2 % 4;
        transpose_quad(p.w_down + (size_t)kt * 64 * 1024 + nq * 256, 1024, 64, p.Wt_down, 2816, kt * 64, 0, nq * 256, 64, 0, smem);
      }
      continue;
    }
    id -= A_WT;
    if (id < A_VC) {
      int bh = id >> 2, jq = id & 3;
      int b = bh >> 3, h = bh & 7;
      transpose_quad(p.cache_v + ((size_t)(b * 1024 + jq * 256) * 8 + h) * 64, 512, (size_t)64 * 512,
                     p.VTs + (size_t)bh * 64 * 1152, 1152, jq * 256, 64, 0, 0, 0, smem);
      continue;
    }
    id -= A_VC;
    if (id < A_KC) {
      int b = id >> 4, jb = id & 15;
#pragma unroll
      for (int it = 0; it < 8; it++) {
        int g = tid + it * 512;
        int j = g >> 6, col = (g & 63) * 8;
        int h = col >> 6, d = col & 63;
        const float* src = p.cache_k + ((size_t)(b * 1024 + jb * 64 + j)) * 512 + col;
        float4 v0 = *(const float4*)src, v1 = *(const float4*)(src + 4);
        uint4 o;
        o.x = pack2(v0.x, v0.y);
        o.y = pack2(v0.z, v0.w);
        o.z = pack2(v1.x, v1.y);
        o.w = pack2(v1.z, v1.w);
        *(uint4*)(p.Ks + ((size_t)((b * 8 + h) * 1152 + jb * 64 + j)) * 64 + d) = o;
      }
      continue;
    }
    id -= A_KC;
    if (id < A_PAD) {
      int bh = id;
      uint4 z = {0u, 0u, 0u, 0u};
      *(uint4*)(p.Ks + ((size_t)bh * 1152 + 1088) * 64 + tid * 8) = z;
      int d = tid >> 3, chn = tid & 7;
      *(uint4*)(p.VTs + ((size_t)bh * 64 + d) * 1152 + 1088 + chn * 8) = z;
      continue;
    }
    if (tid < 8) p.counter[tid] = 0u;
  }
}

__device__ __forceinline__ void norm_task(const Params& p, int task, int which, char* smem) {
  float* sm_scale = (float*)smem;
  float* sm_shift = sm_scale + 1024;
  const float* sm_wg = sm_shift + 1024;
  const int tid = launder_tid(), lane = tid & 63, w = tid >> 6;
  const int row0 = task * 32;
  const int seq = seq_of(row0);
  const float* g = which ? p.norm2_g : p.norm1_g;
  const int sh_off = which ? 3072 : 0, sc_off = which ? 4096 : 1024;
  __syncthreads();
  for (int c = tid; c < 1024; c += 512) {
    float sh, sc;
    if (which == 0) {
      sh = p.b_ada[sh_off + c];
      sc = p.b_ada[sc_off + c];
#pragma unroll
      for (int ks = 0; ks < 8; ks++) {
        sh += p.modp[(size_t)(ks * 24 + seq) * 6144 + sh_off + c];
        sc += p.modp[(size_t)(ks * 24 + seq) * 6144 + sc_off + c];
      }
    } else {
      sh = p.modf[seq * 6144 + sh_off + c];
      sc = p.modf[seq * 6144 + sc_off + c];
    }
    sm_scale[c] = g[c] * (1.0f + sc);
    sm_shift[c] = sh;
  }
  __syncthreads();
  float4 v[4][4];
#pragma unroll
  for (int i = 0; i < 4; i++) {
    const int row = row0 + w * 4 + i;
    const float* xr = which ? (p.X1 + (size_t)row * 1024) : xrow(p, row);
#pragma unroll
    for (int j = 0; j < 4; j++) {
      v[i][j] = *(const float4*)(xr + j * 256 + lane * 4);
      if (which && row >= kNP) {
        const float* sl = p.SLAB + (size_t)((((row - kNP) >> 8) * 4 + j) * 3) * 65536 + (row & 255) * 256 + lane * 4;
#pragma unroll
        for (int kp = 0; kp < 3; kp++) {
          const float4 e = *(const float4*)(sl + (size_t)kp * 65536);
          v[i][j].x += e.x;
          v[i][j].y += e.y;
          v[i][j].z += e.z;
          v[i][j].w += e.w;
        }
        *(float4*)(p.X1 + (size_t)row * 1024 + j * 256 + lane * 4) = v[i][j];
      }
    }
  }
#pragma unroll
  for (int i = 0; i < 4; i++) {
    const int row = row0 + w * 4 + i;
    float ss = 0.f;
#pragma unroll
    for (int j = 0; j < 4; j++)
      ss += v[i][j].x * v[i][j].x + v[i][j].y * v[i][j].y + v[i][j].z * v[i][j].z + v[i][j].w * v[i][j].w;
    ss = wave_sum(ss);
    float rstd = rsqrtf(ss * (1.0f / 1024.0f) + 1e-6f);
#pragma unroll
    for (int j = 0; j < 4; j++) {
      int c = j * 256 + lane * 4;
      float4 sc = *(const float4*)(sm_scale + c), sh = *(const float4*)(sm_shift + c);
      v[i][j].x = v[i][j].x * rstd * sc.x + sh.x;
      v[i][j].y = v[i][j].y * rstd * sc.y + sh.y;
      v[i][j].z = v[i][j].z * rstd * sc.z + sh.z;
      v[i][j].w = v[i][j].w * rstd * sc.w + sh.w;
      uint2 o;
      o.x = pack2(v[i][j].x, v[i][j].y);
      o.y = pack2(v[i][j].z, v[i][j].w);
      *(uint2*)(p.U + (size_t)row * 1024 + c) = o;
    }
    if (which == 0) {
      float gv[8];
#pragma unroll
      for (int gi = 0; gi < 8; gi++) {
        float a = 0.f;
#pragma unroll
        for (int j = 0; j < 4; j++) {
          float4 wv = *(const float4*)(sm_wg + gi * 1024 + j * 256 + lane * 4);
          a += v[i][j].x * wv.x + v[i][j].y * wv.y + v[i][j].z * wv.z + v[i][j].w * wv.w;
        }
        gv[gi] = wave_sum(a);
      }
      if (lane == 0) {
#pragma unroll
        for (int h = 0; h < 4; h++) {
          p.GI[row * 4 + h] = gv[h] + p.b_if[h];
          p.LF[row * 4 + h] = logsig(gv[4 + h] + p.b_if[4 + h]);
        }
      }
    }
  }
}
__device__ __forceinline__ void phase_b(const Params& p, char* smem) {
  const int NTASK = kT / 32;
  {
    float* swg = (float*)smem + 2048;
    for (int i = threadIdx.x; i < 8192; i += 512) swg[i] = p.w_in[(size_t)(i & 1023) * kINW + 3584 + (i >> 10)];
  }
  for (int task = blockIdx.x; task < NTASK + 288; task += gridDim.x) {
    if (task < NTASK) {
      norm_task(p, task, 0, smem);
    } else {
      int i = (task - NTASK) * 512 + threadIdx.x;
      int s = i / 6144, c = i - s * 6144;
      float a = p.b_ada[c];
#pragma unroll
      for (int ks = 0; ks < 8; ks++) a += p.modp[(size_t)(ks * 24 + s) * 6144 + c];
      p.modf[i] = a;
    }
  }
}
__device__ __forceinline__ void phase_g(const Params& p, char* smem) {
  for (int task = blockIdx.x; task < kT / 32; task += gridDim.x) norm_task(p, task, 1, smem);
}

__device__ __forceinline__ uint4 pack8(const f32x4& a, const f32x4& b) {
  return (uint4){pack2(a[0], a[1]), pack2(a[2], a[3]), pack2(b[0], b[1]), pack2(b[2], b[3])};
}
struct EpiC {
  static constexpr bool PERM = true, AFTER_DRAIN = false;
  Params p;
  __device__ __forceinline__ void operator()(const f32x4 (&acc)[2][2][4][2], const pg8::Unit& u, int wr, int wc, int fr, int fq) const {
#pragma unroll
    for (int ai = 0; ai < 2; ++ai) {
      const int rb = u.pm * 256 + ai * 128 + wr * 64;
      const int seq = seq_of(rb);
      const bool isp = seq < 8;
      const int sb = seq - 8;
      const int srow0 = isp ? seq * 2048 : kNP + sb * 64;
      const int L = isp ? 2048 : 64;
#pragma unroll
      for (int bj = 0; bj < 2; ++bj) {
        const int cb = u.pn * 256 + bj * 128;
        const int c0 = cb + wc * 32 + fq * 8;
#pragma unroll
        for (int m = 0; m < 4; ++m) {
          const int row = rb + m * 16 + fr;
          const int t = row - srow0;
          const f32x4 v0 = acc[ai][bj][m][0], v1 = acc[ai][bj][m][1];
          if (cb < 512) {
            *(uint4*)(p.Qb + (size_t)row * 512 + c0) = pack8(v0, v1);
          } else if (cb < 1024) {
            const int c = c0 - 512, h = c >> 6, d = c & 63;
            float* o = (isp ? p.out + O_KP + (size_t)row * 512 : p.out + O_KS + (size_t)(row - kNP) * 512) + c;
            *(f32x4*)o = v0;
            *(f32x4*)(o + 4) = v1;
            bf16_t* kb = isp ? p.Kp + ((size_t)(seq * 8 + h) * 2048 + t) * 64 + d
                             : p.Ks + ((size_t)(sb * 8 + h) * 1152 + 1024 + t) * 64 + d;
            *(uint4*)kb = pack8(v0, v1);
          } else if (cb < 1536) {
            const int c = c0 - 1024, h = c >> 6, d = c & 63;
            float* o = (isp ? p.out + O_VP + (size_t)row * 512 : p.out + O_VS + (size_t)(row - kNP) * 512) + c;
            *(f32x4*)o = v0;
            *(f32x4*)(o + 4) = v1;
            bf16_t* vt = isp ? p.VTp + ((size_t)(seq * 8 + h) * 64 + d) * 2048 + t
                             : p.VTs + ((size_t)(sb * 8 + h) * 64 + d) * 1152 + 1024 + t;
            const size_t tl = isp ? 2048 : 1152;
#pragma unroll
            for (int e = 0; e < 4; ++e) {
              vt[(size_t)e * tl] = f2bf(v0[e]);
              vt[(size_t)(e + 4) * tl] = f2bf(v1[e]);
            }
          } else if (cb < 2560) {
            const int c = c0 - 1536;
            *(uint4*)(p.MQK + (size_t)row * 1024 + c) = pack8(v0, v1);
            if (t >= L - 3) {
              float* o = (isp ? p.out + O_CVP + (size_t)(seq * 3 + (t - (L - 3))) * 1024
                              : p.out + O_CVS + (size_t)(sb * 3 + (t - (L - 3))) * 1024) + c;
              *(f32x4*)o = v0;
              *(f32x4*)(o + 4) = v1;
            }
          } else if (cb < 3072) {
            const int c = c0 - 2560, h = c >> 7, d = c & 127;
            bf16_t* vt = isp ? p.MVTp + ((size_t)(seq * 4 + h) * 128 + d) * 2048 + t
                             : p.MVTs + ((size_t)(sb * 4 + h) * 128 + d) * 64 + t;
            const size_t tl = isp ? 2048 : 64;
#pragma unroll
            for (int e = 0; e < 4; ++e) {
              vt[(size_t)e * tl] = f2bf(v0[e]);
              vt[(size_t)(e + 4) * tl] = f2bf(v1[e]);
            }
          } else {
            f32x4 s0, s1;
#pragma unroll
            for (int e = 0; e < 4; ++e) {
              s0[e] = sigm(v0[e]);
              s1[e] = sigm(v1[e]);
            }
            bf16_t* dst = (cb < 3584)   ? p.SO + (size_t)row * 512 + (c0 - 3072)
                          : (cb < 4608) ? p.GA + (size_t)row * 1024 + (c0 - 3584)
                                        : p.GB + (size_t)row * 1024 + (c0 - 4608);
            *(uint4*)dst = pack8(s0, s1);
          }
        }
      }
    }
  }
};
struct EpiH {
  static constexpr bool PERM = true, AFTER_DRAIN = false;
  bf16_t* HFF;
  __device__ __forceinline__ void operator()(const f32x4 (&acc)[2][2][4][2], const pg8::Unit& u, int wr, int wc, int fr, int fq) const {
    const int f0 = u.pn * 128 + wc * 32 + fq * 8;
#pragma unroll
    for (int ai = 0; ai < 2; ++ai)
#pragma unroll
      for (int m = 0; m < 4; ++m) {
        const int row = u.pm * 256 + ai * 128 + wr * 64 + m * 16 + fr;
        f32x4 o0, o1;
#pragma unroll
        for (int e = 0; e < 4; ++e) {
          o0[e] = silu(acc[ai][0][m][0][e]) * acc[ai][1][m][0][e];
          o1[e] = silu(acc[ai][0][m][1][e]) * acc[ai][1][m][1][e];
        }
        *(uint4*)(HFF + (size_t)row * 2816 + f0) = pack8(o0, o1);
      }
  }
};
__device__ __forceinline__ void gate_task(const Params& p, int seq, int h, char* smem);
__device__ __forceinline__ void phase_c(const Params& p, char* smem) {
  for (int item = blockIdx.x; item < 96; item += gridDim.x) {
    if (item < 32) gate_task(p, item >> 2, item & 3, smem);
    else gate_task(p, 8 + ((item - 32) >> 2), item & 3, smem);
  }
  __syncthreads();
  pg8::Gemm g{p.U, p.Wt_in, kT, 5632, 1024};
  pg8::StaticOrder S;
  S.init(kT, 5632, gridDim.x, blockIdx.x);
  EpiC E{p};
  pg8::gemm_phase<EpiC, pg8::StaticOrder, false>((PG8_LAS unsigned char*)smem, g, S, E, nullptr);
}

__device__ __forceinline__ void lds_barrier() { asm volatile("s_waitcnt lgkmcnt(0)\n\ts_barrier" ::: "memory"); }
__device__ __forceinline__ void attn_task(const Params& p, int seq, int h, int qt, char* smem) {
  const int tid = launder_tid(), lane = tid & 63, w = tid >> 6, fr = lane & 15, fq = lane >> 4;
  const bool isp = seq < 8;
  const int sb = seq - 8;
  const int past = isp ? 0 : 1024;
  const int Tlen = isp ? 2048 : 1152;
  const int row0 = (isp ? seq * 2048 : kNP + sb * 64) + qt * 64;
  const int p0 = past + qt * 64;
  const bf16_t* Kb = isp ? p.Kp + (size_t)(seq * 8 + h) * 2048 * 64 : p.Ks + (size_t)(sb * 8 + h) * 1152 * 64;
  const bf16_t* VT = isp ? p.VTp + (size_t)(seq * 8 + h) * 64 * 2048 : p.VTs + (size_t)(sb * 8 + h) * 64 * 1152;
  bf16_t* sQ = (bf16_t*)smem;
  bf16_t* sK = sQ + 64 * 72;
  bf16_t* sVT = sK + 128 * 72;
  bf16_t* sP = sVT + 64 * 136;
  float* sZ = (float*)(sP + 64 * 136);
  int* sFlag = (int*)(sZ + 64 * 132);

  __syncthreads();
  {
    int r = tid >> 3, chn = tid & 7;
    uint4 q = *(const uint4*)(p.Qb + (size_t)(row0 + r) * 512 + h * 64 + chn * 8);
    *(uint4*)(sQ + r * 72 + chn * 8) = q;
  }
  const int kt_d = (p0 + 62) >> 7;
  const int ki0 = tid, ki1 = tid + 512;
  const bf16_t* kptr0 = Kb + (size_t)(ki0 >> 3) * 64 + (ki0 & 7) * 8;
  const bf16_t* kptr1 = Kb + (size_t)(ki1 >> 3) * 64 + (ki1 & 7) * 8;
  const bf16_t* vptr0 = VT + (size_t)(ki0 >> 4) * Tlen + (ki0 & 15) * 8;
  const bf16_t* vptr1 = VT + (size_t)(ki1 >> 4) * Tlen + (ki1 & 15) * 8;
  uint4 kr0 = *(const uint4*)(kptr0 + (size_t)kt_d * 8192);
  uint4 kr1 = *(const uint4*)(kptr1 + (size_t)kt_d * 8192);
  uint4 vr0 = *(const uint4*)(vptr0 + kt_d * 128);
  uint4 vr1 = *(const uint4*)(vptr1 + kt_d * 128);
  float R = 0.f;
  f32x4 oacc[2];
  oacc[0] = (f32x4){0.f, 0.f, 0.f, 0.f};
  oacc[1] = (f32x4){0.f, 0.f, 0.f, 0.f};
  const int mf = w & 3;
  for (int kt = kt_d; kt >= 0; kt--) {
    lds_barrier();
    *(uint4*)(sK + (ki0 >> 3) * 72 + (ki0 & 7) * 8) = kr0;
    *(uint4*)(sK + (ki1 >> 3) * 72 + (ki1 & 7) * 8) = kr1;
    *(uint4*)(sVT + (ki0 >> 4) * 136 + (ki0 & 15) * 8) = vr0;
    *(uint4*)(sVT + (ki1 >> 4) * 136 + (ki1 & 15) * 8) = vr1;
    if (tid == 0) *sFlag = 0;
    lds_barrier();
    if (kt > 0) {
      kr0 = *(const uint4*)(kptr0 + (size_t)(kt - 1) * 8192);
      kr1 = *(const uint4*)(kptr1 + (size_t)(kt - 1) * 8192);
      vr0 = *(const uint4*)(vptr0 + (kt - 1) * 128);
      vr1 = *(const uint4*)(vptr1 + (kt - 1) * 128);
    }
    {
      const int nf0 = (w >> 2) * 4;
      bf16x8 a0 = lds8(sQ + (mf * 16 + fr) * 72 + fq * 8);
      bf16x8 a1 = lds8(sQ + (mf * 16 + fr) * 72 + 32 + fq * 8);
#pragma unroll
      for (int n = 0; n < 4; n++) {
        bf16x8 b0 = lds8(sK + ((nf0 + n) * 16 + fr) * 72 + fq * 8);
        bf16x8 b1 = lds8(sK + ((nf0 + n) * 16 + fr) * 72 + 32 + fq * 8);
        f32x4 s = (f32x4){0.f, 0.f, 0.f, 0.f};
        s = MFMA(a0, b0, s);
        s = MFMA(a1, b1, s);
#pragma unroll
        for (int r = 0; r < 4; r++) sZ[(mf * 16 + fq * 4 + r) * 132 + (nf0 + n) * 16 + fr] = s[r] * 0.125f;
      }
    }
    lds_barrier();
    {
      const int row = tid >> 3, part = tid & 7;
      const int pos = p0 + row;
      const int j0 = kt * 128 + part * 16;
      float z[16], ls[16];
#pragma unroll
      for (int i4 = 0; i4 < 4; i4++) {
        float4 t4 = *(const float4*)(sZ + row * 132 + part * 16 + i4 * 4);
        z[i4 * 4 + 0] = t4.x;
        z[i4 * 4 + 1] = t4.y;
        z[i4 * 4 + 2] = t4.z;
        z[i4 * 4 + 3] = t4.w;
      }
      float run = 0.f;
      float tl[16];
#pragma unroll
      for (int i = 15; i >= 0; i--) {
        bool valid = (j0 + i) < pos;
        float l = valid ? -(fmaxf(z[i], 0.f) + __logf(1.0f + __expf(-fabsf(z[i])))) : 0.f;
        ls[i] = l;
        tl[i] = run;
        run += l;
      }
      float incl = run;
#pragma unroll
      for (int dlt = 1; dlt < 8; dlt <<= 1) {
        float t = __shfl_down(incl, dlt, 8);
        if (part + dlt < 8) incl += t;
      }
      float excl = incl - run;
      float tot = __shfl(incl, 0, 8);
      float base = R + excl;
      unsigned pk[8];
#pragma unroll
      for (int i = 0; i < 16; i += 2) {
        bool v0 = (j0 + i) < pos, v1 = (j0 + i + 1) < pos;
        float a0 = v0 ? __expf(z[i] + ls[i] + tl[i] + base) : 0.f;
        float a1 = v1 ? __expf(z[i + 1] + ls[i + 1] + tl[i + 1] + base) : 0.f;
        pk[i >> 1] = pack2(a0, a1);
      }
      *(uint4*)(sP + row * 136 + part * 16) = (uint4){pk[0], pk[1], pk[2], pk[3]};
      *(uint4*)(sP + row * 136 + part * 16 + 8) = (uint4){pk[4], pk[5], pk[6], pk[7]};
      R += tot;
      if (R > -110.f) *sFlag = 1;
    }
    lds_barrier();
    const int more = *sFlag;
    {
      const int nf0 = (w >> 2) * 2;
#pragma unroll
      for (int ks = 0; ks < 4; ks++) {
        bf16x8 a = lds8(sP + (mf * 16 + fr) * 136 + ks * 32 + fq * 8);
#pragma unroll
        for (int n = 0; n < 2; n++) {
          bf16x8 b = lds8(sVT + ((nf0 + n) * 16 + fr) * 136 + ks * 32 + fq * 8);
          oacc[n] = MFMA(a, b, oacc[n]);
        }
      }
    }
    if (!more) break;
  }
  {
    const int nf0 = (w >> 2) * 2;
#pragma unroll
    for (int n = 0; n < 2; n++)
#pragma unroll
      for (int r = 0; r < 4; r++)
        p.YA[(size_t)(row0 + mf * 16 + fq * 4 + r) * 1024 + h * 64 + (nf0 + n) * 16 + fr] = f2bf(oacc[n][r]);
  }
}


__device__ __forceinline__ void gate_task(const Params& p, int seq, int h, char* smem) {
  const int tid = launder_tid(), lane = tid & 63, w = tid >> 6;
  const bool isp = seq < 8;
  const int sb = seq - 8;
  const int nchunks = isp ? 32 : 1;
  const int grow0 = isp ? seq * 2048 : kNP + sb * 64;
  float* gv = p.GV + (size_t)(isp ? (seq * 4 + h) * 32 : 1024 + sb * 4 + h) * 384;
  float* sBl = (float*)smem;
  float* sG = sBl + 32;
  float* sM = sG + 32;
  __syncthreads();
  float b_[4], as_[4], pm_[4], g_[4];
#pragma unroll
  for (int i = 0; i < 4; i++) {
    const int c = w + i * 8;
    b_[i] = 0.f; as_[i] = 0.f; pm_[i] = 0.f; g_[i] = 0.f;
    if (c < nchunks) {
      const int row = grow0 + c * 64 + lane;
      float li = p.GI[row * 4 + h], lf = p.LF[row * 4 + h];
      float b = lf;
#pragma unroll
      for (int d = 1; d < 64; d <<= 1) {
        float t_ = __shfl_up(b, d);
        if (lane >= d) b += t_;
      }
      float a_s = li - b;
      float pm = a_s;
#pragma unroll
      for (int d = 1; d < 64; d <<= 1) {
        float t_ = __shfl_up(pm, d);
        if (lane >= d) pm = fmaxf(pm, t_);
      }
      float blast = __shfl(b, 63);
      float g = blast - b + li;
      float G = wave_max(g);
      b_[i] = b; as_[i] = a_s; pm_[i] = pm; g_[i] = g;
      if (lane == 0) {
        sBl[c] = blast;
        sG[c] = G;
      }
    }
  }
  __syncthreads();
  if (tid == 0) {
    float m = isp ? 0.f : p.st_m[sb * 4 + h];
    for (int c = 0; c < nchunks; c++) {
      sM[c] = m;
      m = fmaxf(sBl[c] + m, sG[c]);
    }
    sM[nchunks] = m;
    if (isp) p.out[O_MP + seq * 4 + h] = m;
    else p.out[O_MS + sb * 4 + h] = m;
  }
  __syncthreads();
#pragma unroll
  for (int i = 0; i < 4; i++) {
    const int c = w + i * 8;
    if (c < nchunks) {
      const float m_run = sM[c], m_new = sM[c + 1];
      const float mt = b_[i] + fmaxf(m_run, pm_[i]);
      float* o = gv + (size_t)c * 384;
      o[lane] = b_[i] - mt;
      o[64 + lane] = as_[i];
      o[128 + lane] = __expf(b_[i] + m_run - mt);
      o[192 + lane] = __expf(g_[i] - m_new);
      o[256 + lane] = __expf(-mt);
      if (lane == 0) o[320] = __expf(sBl[c] + m_run - m_new);
    }
  }
}

__device__ __forceinline__ void mlpre_task(const Params& p, int seq, int h, int c, char* smem) {
  const bool isp = seq < 8;
  const int sb = seq - 8;
  const int grow0 = isp ? seq * 2048 : kNP + sb * 64;
  const int t0 = c * 64;
  const int cid = isp ? (seq * 4 + h) * 32 + c : 1024 + sb * 4 + h;
  bf16_t* sQ = (bf16_t*)smem;
  bf16_t* sK = sQ + 64 * 136;
  bf16_t* sKT = sK + 64 * 136;
  bf16_t* sSw = sKT + 128 * 72;
  float* sF = (float*)(sSw + 64 * 72);
  float* sV = sF;
  float* sDen = sF + 384;
  float* sCw = sF + 448;
  const float* sBt = sV;
  const float* sAs = sV + 64;
  const float* sWg = sV + 192;
  __syncthreads();
  uint4 xr0, xr1, xr2, xr3, xr4, xr5, xr6;
  {
    const int tid = launder_tid();
    for (int i = tid; i < 1280; i += 512) {
      int j = i >> 8, cc = i & 255;
      int gch = (cc >= 128 ? 512 : 0) + h * 128 + (cc & 127);
      sCw[i] = (j < 4) ? p.w_conv[j * 1024 + gch] : p.b_conv[gch];
    }
    if (tid < 384) sV[tid] = p.GV[(size_t)cid * 384 + tid];
    if (tid < 64) sDen[tid] = 0.f;
    const int rb_ = tid >> 5, cgp_ = tid & 31;
    const int ch_ = (cgp_ >= 16 ? 512 : 0) + h * 128 + (cgp_ & 15) * 8;
    const int tb0 = t0 + rb_ * 4 - 3;
    const bf16_t* xp = p.MQK + (size_t)(grow0 + tb0) * 1024 + ch_;
#define LDX(i, dst)                                                                                           \
  if (tb0 + i >= 0) dst = *(const uint4*)(xp + (size_t)i * 1024);                                             \
  else if (isp) dst = (uint4){0u, 0u, 0u, 0u};                                                                \
  else {                                                                                                      \
    const float* s0 = p.st_conv + (size_t)(sb * 3 + (tb0 + i + 3)) * 1024 + ch_;                              \
    dst = (uint4){pack2(s0[0], s0[1]), pack2(s0[2], s0[3]), pack2(s0[4], s0[5]), pack2(s0[6], s0[7])};        \
  }
    LDX(0, xr0) LDX(1, xr1) LDX(2, xr2)
#undef LDX
    xr3 = *(const uint4*)(xp + (size_t)3 * 1024);
    xr4 = *(const uint4*)(xp + (size_t)4 * 1024);
    xr5 = *(const uint4*)(xp + (size_t)5 * 1024);
    xr6 = *(const uint4*)(xp + (size_t)6 * 1024);
  }
  __syncthreads();
  {
    const int tid = launder_tid();
    const int rb = tid >> 5, cgp = tid & 31;
    const bool isk = cgp >= 16;
    float o0[8], o1[8], o2[8], o3[8];
    {
      const float* cwp = sCw + cgp * 8;
      float4 b0 = *(const float4*)(cwp + 1024), b1 = *(const float4*)(cwp + 1028);
      o0[0] = b0.x; o0[1] = b0.y; o0[2] = b0.z; o0[3] = b0.w; o0[4] = b1.x; o0[5] = b1.y; o0[6] = b1.z; o0[7] = b1.w;
#pragma unroll
      for (int e = 0; e < 8; e++) { o1[e] = o0[e]; o2[e] = o0[e]; o3[e] = o0[e]; }
#define FMAW(j, o, x) { float4 a0 = *(const float4*)(cwp + j * 256), a1 = *(const float4*)(cwp + j * 256 + 4); \
  o[0] += a0.x * x[0]; o[1] += a0.y * x[1]; o[2] += a0.z * x[2]; o[3] += a0.w * x[3];                              \
  o[4] += a1.x * x[4]; o[5] += a1.y * x[5]; o[6] += a1.z * x[6]; o[7] += a1.w * x[7]; }
#define UNP(xv, x) float x[8]; x[0] = __uint_as_float(xv.x << 16); x[1] = __uint_as_float(xv.x & 0xffff0000u); \
  x[2] = __uint_as_float(xv.y << 16); x[3] = __uint_as_float(xv.y & 0xffff0000u);                             \
  x[4] = __uint_as_float(xv.z << 16); x[5] = __uint_as_float(xv.z & 0xffff0000u);                             \
  x[6] = __uint_as_float(xv.w << 16); x[7] = __uint_as_float(xv.w & 0xffff0000u);
      { UNP(xr0, x) FMAW(0, o0, x) }
      { UNP(xr1, x) FMAW(1, o0, x) FMAW(0, o1, x) }
      { UNP(xr2, x) FMAW(2, o0, x) FMAW(1, o1, x) FMAW(0, o2, x) }
      { UNP(xr3, x) FMAW(3, o0, x) FMAW(2, o1, x) FMAW(1, o2, x) FMAW(0, o3, x) }
      { UNP(xr4, x) FMAW(3, o1, x) FMAW(2, o2, x) FMAW(1, o3, x) }
      { UNP(xr5, x) FMAW(3, o2, x) FMAW(2, o3, x) }
      { UNP(xr6, x) FMAW(3, o3, x) }
#undef FMAW
#undef UNP
    }
    const float ksc = isk ? 0.08838834764831845f : 1.0f;
#pragma unroll
    for (int e = 0; e < 8; e++) {
      o0[e] = silu(o0[e]) * ksc; o1[e] = silu(o1[e]) * ksc; o2[e] = silu(o2[e]) * ksc; o3[e] = silu(o3[e]) * ksc;
    }
    bf16_t* dstp = (isk ? sK + (cgp - 16) * 8 : sQ + cgp * 8) + (rb * 4) * 136;
    *(uint4*)(dstp) = (uint4){pack2(o0[0], o0[1]), pack2(o0[2], o0[3]), pack2(o0[4], o0[5]), pack2(o0[6], o0[7])};
    *(uint4*)(dstp + 136) = (uint4){pack2(o1[0], o1[1]), pack2(o1[2], o1[3]), pack2(o1[4], o1[5]), pack2(o1[6], o1[7])};
    *(uint4*)(dstp + 272) = (uint4){pack2(o2[0], o2[1]), pack2(o2[2], o2[3]), pack2(o2[4], o2[5]), pack2(o2[6], o2[7])};
    *(uint4*)(dstp + 408) = (uint4){pack2(o3[0], o3[1]), pack2(o3[2], o3[3]), pack2(o3[4], o3[5]), pack2(o3[6], o3[7])};
    if (isk) {
      float g0 = sWg[rb * 4], g1 = sWg[rb * 4 + 1], g2 = sWg[rb * 4 + 2], g3 = sWg[rb * 4 + 3];
#pragma unroll
      for (int e = 0; e < 8; e++) {
        uint2 pk;
        pk.x = pack2(o0[e] * g0, o1[e] * g1);
        pk.y = pack2(o2[e] * g2, o3[e] * g3);
        *(uint2*)(sKT + ((cgp - 16) * 8 + e) * 72 + rb * 4) = pk;
      }
    }
  }
  __syncthreads();
  {
    const int tid = launder_tid(), lane = tid & 63, w = tid >> 6, fr = lane & 15, fq = lane >> 4;
    const int mf = w >> 1, nf0 = (w & 1) * 2;
    f32x4 sa[2];
    sa[0] = (f32x4){0.f, 0.f, 0.f, 0.f};
    sa[1] = (f32x4){0.f, 0.f, 0.f, 0.f};
#pragma unroll
    for (int ks = 0; ks < 4; ks++) {
      bf16x8 a = lds8(sQ + (mf * 16 + fr) * 136 + ks * 32 + fq * 8);
#pragma unroll
      for (int n = 0; n < 2; n++) {
        bf16x8 b = lds8(sK + ((nf0 + n) * 16 + fr) * 136 + ks * 32 + fq * 8);
        sa[n] = MFMA(a, b, sa[n]);
      }
    }
#pragma unroll
    for (int r = 0; r < 4; r++) {
      const int t = mf * 16 + fq * 4 + r;
      const float bt = sBt[t];
      float rs = 0.f;
#pragma unroll
      for (int n = 0; n < 2; n++) {
        const int s = (nf0 + n) * 16 + fr;
        float wgt = (s <= t) ? __expf(bt + sAs[s]) : 0.f;
        float v = sa[n][r] * wgt;
        rs += v;
        sSw[t * 72 + s] = f2bf(v);
      }
      rs = row16_sum(rs);
      if (fr == 0) atomicAdd(&sDen[t], rs);
    }
  }
  __syncthreads();
  {
    const int tid = launder_tid();
    bf16_t* qo = p.Qc + (size_t)cid * 8192;
    bf16_t* ko = p.KTc + (size_t)cid * 8192;
    bf16_t* so = p.SWc + (size_t)cid * 4096;
    *(uint4*)(qo + tid * 8) = *(const uint4*)(sQ + (tid >> 4) * 136 + (tid & 15) * 8);
    *(uint4*)(qo + 4096 + tid * 8) = *(const uint4*)(sQ + (32 + (tid >> 4)) * 136 + (tid & 15) * 8);
    *(uint4*)(ko + tid * 8) = *(const uint4*)(sKT + (tid >> 3) * 72 + (tid & 7) * 8);
    *(uint4*)(ko + 4096 + tid * 8) = *(const uint4*)(sKT + (64 + (tid >> 3)) * 72 + (tid & 7) * 8);
    *(uint4*)(so + tid * 8) = *(const uint4*)(sSw + (tid >> 3) * 72 + (tid & 7) * 8);
    if (tid < 64) p.DENc[(size_t)cid * 64 + tid] = sDen[tid];
  }
}

__device__ __forceinline__ void mlstm_task(const Params& p, int seq, int h, char* smem) {
  const bool isp = seq < 8;
  const int sb = seq - 8;
  const int L = isp ? 2048 : 64;
  const int nchunks = L >> 6;
  const int grow0 = isp ? seq * 2048 : kNP + sb * 64;
  const int cid0 = isp ? (seq * 4 + h) * 32 : 1024 + sb * 4 + h;
  const bf16_t* MVT = isp ? p.MVTp + (size_t)(seq * 4 + h) * 128 * 2048 : p.MVTs + (size_t)(sb * 4 + h) * 128 * 64;
  bf16_t* sQ = (bf16_t*)smem;
  bf16_t* sH = sQ + 64 * 136;
  bf16_t* sKT = sH + 64 * 136;
  bf16_t* sVT = sKT + 128 * 72;
  bf16_t* sCb = sVT + 128 * 72;
  bf16_t* sSw = sCb + 128 * 136;
  float* sF = (float*)(sSw + 64 * 72);
  float* sVec = sF;
  float* sNq = sF + 512;
  float* sSS = sF + 576;
  float* sN = sF + 640;

  __syncthreads();
  f32x4 Cacc[8];
  {
    const int tid = launder_tid(), lane = tid & 63, w = tid >> 6, fr = lane & 15, fq = lane >> 4;
    if (isp) {
#pragma unroll
      for (int n = 0; n < 8; n++) Cacc[n] = (f32x4){0.f, 0.f, 0.f, 0.f};
      if (tid < 128) sN[tid] = 0.f;
    } else {
      const float* C0 = p.st_C + (size_t)(sb * 4 + h) * 16384;
#pragma unroll
      for (int n = 0; n < 8; n++)
#pragma unroll
        for (int r = 0; r < 4; r++) Cacc[n][r] = C0[(w * 16 + fq * 4 + r) * 128 + n * 16 + fr];
      if (tid < 128) sN[tid] = p.st_n[(sb * 4 + h) * 128 + tid];
    }
#pragma unroll
    for (int n = 0; n < 8; n++)
#pragma unroll
      for (int r = 0; r < 4; r++) sCb[(w * 16 + fq * 4 + r) * 136 + n * 16 + fr] = f2bf(Cacc[n][r]);
  }
  float mg0, mg1, mg2, mg3;
  {
    const int tid = launder_tid(), lane = tid & 63, w = tid >> 6, fr = lane & 15;
    const int cidx = h * 128 + (w >> 2) * 64 + fr;
    mg0 = p.ml_norm_g[cidx];
    mg1 = p.ml_norm_g[cidx + 16];
    mg2 = p.ml_norm_g[cidx + 32];
    mg3 = p.ml_norm_g[cidx + 48];
  }
  uint4 q0, q1, k0, k1, v0, v1, sw0;
  float gwi = 0.f, gem = 0.f, gden = 0.f, gdec = 0.f;
#define LOAD_CHUNK(C)                                                                         \
  {                                                                                           \
    const int tid_ = launder_tid();                                                           \
    const size_t cid_ = (size_t)(cid0 + (C));                                                 \
    const bf16_t* qp = p.Qc + cid_ * 8192 + tid_ * 8;                                         \
    const bf16_t* kp = p.KTc + cid_ * 8192 + tid_ * 8;                                        \
    q0 = *(const uint4*)qp;                                                                   \
    q1 = *(const uint4*)(qp + 4096);                                                          \
    k0 = *(const uint4*)kp;                                                                   \
    k1 = *(const uint4*)(kp + 4096);                                                          \
    sw0 = *(const uint4*)(p.SWc + cid_ * 4096 + tid_ * 8);                                    \
    v0 = *(const uint4*)(MVT + (size_t)(tid_ >> 3) * L + (C) * 64 + (tid_ & 7) * 8);          \
    v1 = *(const uint4*)(MVT + (size_t)((tid_ + 512) >> 3) * L + (C) * 64 + (tid_ & 7) * 8);  \
    if (tid_ < 64) {                                                                          \
      gwi = p.GV[cid_ * 384 + 128 + tid_];                                                    \
      gem = p.GV[cid_ * 384 + 256 + tid_];                                                    \
      gden = p.DENc[cid_ * 64 + tid_];                                                        \
      gdec = p.GV[cid_ * 384 + 320];                                                          \
    }                                                                                         \
  }
  LOAD_CHUNK(0)
  lds_barrier();

  for (int c = 0; c < nchunks; c++) {
    const int t0 = c * 64;
    float* sV = sVec + (c & 1) * 256;
    const float* sNo = sN + (c & 1) * 128;
    float* sNn = sN + ((c + 1) & 1) * 128;
    uint4 so0, so1;
    {
      const int tid = launder_tid();
      *(uint4*)(sQ + (tid >> 4) * 136 + (tid & 15) * 8) = q0;
      *(uint4*)(sQ + (32 + (tid >> 4)) * 136 + (tid & 15) * 8) = q1;
      *(uint4*)(sKT + (tid >> 3) * 72 + (tid & 7) * 8) = k0;
      *(uint4*)(sKT + (64 + (tid >> 3)) * 72 + (tid & 7) * 8) = k1;
      *(uint4*)(sVT + (tid >> 3) * 72 + (tid & 7) * 8) = v0;
      *(uint4*)(sVT + (64 + (tid >> 3)) * 72 + (tid & 7) * 8) = v1;
      *(uint4*)(sSw + (tid >> 3) * 72 + (tid & 7) * 8) = sw0;
      float decay = gdec;
      if (tid < 64) {
        sV[tid] = gwi;
        sV[64 + tid] = gem;
        sV[128 + tid] = gden;
        sSS[tid] = 0.f;
        if (tid == 0) sV[192] = gdec;
      }
      decay = __shfl(decay, 0);
#define UNP8(VV, AR) float AR[8]; AR[0] = __uint_as_float(VV.x << 16); AR[1] = __uint_as_float(VV.x & 0xffff0000u); \
  AR[2] = __uint_as_float(VV.y << 16); AR[3] = __uint_as_float(VV.y & 0xffff0000u);                                 \
  AR[4] = __uint_as_float(VV.z << 16); AR[5] = __uint_as_float(VV.z & 0xffff0000u);                                 \
  AR[6] = __uint_as_float(VV.w << 16); AR[7] = __uint_as_float(VV.w & 0xffff0000u);
      {
        const float4 n0 = *(const float4*)(sNo + (tid & 15) * 8), n1 = *(const float4*)(sNo + (tid & 15) * 8 + 4);
        UNP8(q0, a)
        UNP8(q1, b)
        float d0 = a[0] * n0.x + a[1] * n0.y + a[2] * n0.z + a[3] * n0.w + a[4] * n1.x + a[5] * n1.y + a[6] * n1.z + a[7] * n1.w;
        float d1 = b[0] * n0.x + b[1] * n0.y + b[2] * n0.z + b[3] * n0.w + b[4] * n1.x + b[5] * n1.y + b[6] * n1.z + b[7] * n1.w;
        d0 = row16_sum(d0);
        d1 = row16_sum(d1);
        if ((tid & 15) == 0) {
          sNq[tid >> 4] = d0;
          sNq[32 + (tid >> 4)] = d1;
        }
      }
      {
        UNP8(k0, a)
        UNP8(k1, b)
        float d0 = ((a[0] + a[1]) + (a[2] + a[3])) + ((a[4] + a[5]) + (a[6] + a[7]));
        float d1 = ((b[0] + b[1]) + (b[2] + b[3])) + ((b[4] + b[5]) + (b[6] + b[7]));
        d0 = half8_sum(d0);
        d1 = half8_sum(d1);
        if ((tid & 7) == 0) {
          sNn[tid >> 3] = d0;
          sNn[64 + (tid >> 3)] = d1;
        }
      }
#undef UNP8
      {
        const bf16_t* sop = p.SO + (size_t)(grow0 + t0 + (tid >> 4)) * 512 + h * 128 + (tid & 15) * 8;
        so0 = *(const uint4*)sop;
        so1 = *(const uint4*)(sop + (size_t)32 * 512);
      }
    }
    if (c + 1 < nchunks) LOAD_CHUNK(c + 1)
    lds_barrier();
    f32x4 hacc[4];
    {
      const int tid = launder_tid(), lane = tid & 63, w = tid >> 6, fr = lane & 15, fq = lane >> 4;
      const int mf = w & 3, nf0 = (w >> 2) * 4;
      const float* sWi = sV;
      const float* sEm = sV + 64;
      const float* sDn = sV + 128;
#pragma unroll
      for (int n = 0; n < 4; n++) hacc[n] = (f32x4){0.f, 0.f, 0.f, 0.f};
      {
        bf16x8 qa[4], cb[4][4], swa[2], vb[2][4];
#pragma unroll
        for (int ks = 0; ks < 4; ks++) {
          qa[ks] = lds8(sQ + (mf * 16 + fr) * 136 + ks * 32 + fq * 8);
#pragma unroll
          for (int n = 0; n < 4; n++) cb[ks][n] = lds8(sCb + ((nf0 + n) * 16 + fr) * 136 + ks * 32 + fq * 8);
        }
#pragma unroll
        for (int ks = 0; ks < 2; ks++) {
          swa[ks] = lds8(sSw + (mf * 16 + fr) * 72 + ks * 32 + fq * 8);
#pragma unroll
          for (int n = 0; n < 4; n++) vb[ks][n] = lds8(sVT + ((nf0 + n) * 16 + fr) * 72 + ks * 32 + fq * 8);
        }
        float wi4[4];
#pragma unroll
        for (int r = 0; r < 4; r++) wi4[r] = sWi[mf * 16 + fq * 4 + r];
#pragma unroll
        for (int ks = 0; ks < 4; ks++)
#pragma unroll
          for (int n = 0; n < 4; n++) hacc[n] = MFMA(qa[ks], cb[ks][n], hacc[n]);
#pragma unroll
        for (int r = 0; r < 4; r++)
#pragma unroll
          for (int n = 0; n < 4; n++) hacc[n][r] *= wi4[r];
#pragma unroll
        for (int ks = 0; ks < 2; ks++)
#pragma unroll
          for (int n = 0; n < 4; n++) hacc[n] = MFMA(swa[ks], vb[ks][n], hacc[n]);
      }
#pragma unroll
      for (int r = 0; r < 4; r++) {
        const int t = mf * 16 + fq * 4 + r;
        float den = sDn[t] + sWi[t] * sNq[t];
        float dn = fmaxf(fabsf(den), sEm[t]);
        float inv = __builtin_amdgcn_rcpf(dn);
        float ss = 0.f;
#pragma unroll
        for (int n = 0; n < 4; n++) {
          hacc[n][r] *= inv;
          ss += hacc[n][r] * hacc[n][r];
        }
        ss = row16_sum(ss);
        if (fr == 0) atomicAdd(&sSS[t], ss);
      }
    }
    lds_barrier();
    {
      const int tid = launder_tid(), lane = tid & 63, w = tid >> 6, fr = lane & 15, fq = lane >> 4;
      const int mf = w & 3, nf0 = (w >> 2) * 4;
#pragma unroll
      for (int r = 0; r < 4; r++) {
        const int t = mf * 16 + fq * 4 + r;
        const float rstd = rsqrtf(sSS[t] * (1.0f / 128.0f) + 1e-6f);
        bf16_t* hp = sH + t * 136 + nf0 * 16 + fr;
        hp[0] = f2bf(hacc[0][r] * rstd * mg0);
        hp[16] = f2bf(hacc[1][r] * rstd * mg1);
        hp[32] = f2bf(hacc[2][r] * rstd * mg2);
        hp[48] = f2bf(hacc[3][r] * rstd * mg3);
      }
      const float decay = sV[192];
#pragma unroll
      for (int n = 0; n < 8; n++) {
        Cacc[n][0] *= decay;
        Cacc[n][1] *= decay;
        Cacc[n][2] *= decay;
        Cacc[n][3] *= decay;
      }
      {
        bf16x8 va[2], kb[2][8];
#pragma unroll
        for (int ks = 0; ks < 2; ks++) {
          va[ks] = lds8(sVT + (w * 16 + fr) * 72 + ks * 32 + fq * 8);
#pragma unroll
          for (int n = 0; n < 8; n++) kb[ks][n] = lds8(sKT + (n * 16 + fr) * 72 + ks * 32 + fq * 8);
        }
#pragma unroll
        for (int ks = 0; ks < 2; ks++)
#pragma unroll
          for (int n = 0; n < 8; n++) Cacc[n] = MFMA(va[ks], kb[ks][n], Cacc[n]);
      }
#pragma unroll
      for (int n = 0; n < 8; n++)
#pragma unroll
        for (int r = 0; r < 4; r++) sCb[(w * 16 + fq * 4 + r) * 136 + n * 16 + fr] = f2bf(Cacc[n][r]);
      if (tid < 128) sNn[tid] = decay * sNo[tid] + sNn[tid];
    }
    lds_barrier();
    {
      const int tid = launder_tid();
      const int row = tid >> 4, c8 = (tid & 15) * 8;
      bf16_t* yp = p.YA + (size_t)(grow0 + t0 + row) * 1024 + 512 + h * 128 + c8;
      uint4 h0 = *(const uint4*)(sH + row * 136 + c8);
      uint4 h1 = *(const uint4*)(sH + (row + 32) * 136 + c8);
#define MUL2(a, b) pack2(__uint_as_float((a) << 16) * __uint_as_float((b) << 16), \
                         __uint_as_float((a) & 0xffff0000u) * __uint_as_float((b) & 0xffff0000u))
      uint4 y0 = {MUL2(h0.x, so0.x), MUL2(h0.y, so0.y), MUL2(h0.z, so0.z), MUL2(h0.w, so0.w)};
      uint4 y1 = {MUL2(h1.x, so1.x), MUL2(h1.y, so1.y), MUL2(h1.z, so1.z), MUL2(h1.w, so1.w)};
#undef MUL2
      *(uint4*)yp = y0;
      *(uint4*)(yp + (size_t)32 * 1024) = y1;
    }
  }
#undef LOAD_CHUNK
  lds_barrier();
  {
    const int tid = launder_tid(), lane = tid & 63, w = tid >> 6, fr = lane & 15, fq = lane >> 4;
    float* Cout = isp ? p.out + O_CP + (size_t)(seq * 4 + h) * 16384 : p.out + O_CS + (size_t)(sb * 4 + h) * 16384;
#pragma unroll
    for (int n = 0; n < 8; n++)
#pragma unroll
      for (int r = 0; r < 4; r++) Cout[(w * 16 + fq * 4 + r) * 128 + n * 16 + fr] = Cacc[n][r];
    float* nout = isp ? p.out + O_NP + (seq * 4 + h) * 128 : p.out + O_NS + (sb * 4 + h) * 128;
    if (tid < 128) nout[tid] = sN[(nchunks & 1) * 128 + tid];
  }
}

constexpr int D_ML_P = 32;
constexpr int D_AT_P = 2048;
constexpr int D_AT_S = 128;
constexpr int D_ML_S = 64;
constexpr int D_TOTAL = D_ML_P + D_AT_P + D_AT_S + D_ML_S;

__device__ __forceinline__ void phase_d0(const Params& p, char* smem) {
  for (int item = blockIdx.x; item < 1088; item += gridDim.x) {
    if (item < 1024) mlpre_task(p, item >> 7, (item >> 5) & 3, item & 31, smem);
    else mlpre_task(p, 8 + ((item - 1024) >> 2), item & 3, 0, smem);
  }
}
__device__ __forceinline__ void phase_d(const Params& p, char* smem, int cidx) {
  int* sTask = (int*)(smem + LDS_BYTES - 16);
  for (;;) {
    __syncthreads();
    if (threadIdx.x == 0) *sTask = (int)atomicAdd(p.counter + cidx, 1u);
    __syncthreads();
    int task = __builtin_amdgcn_readfirstlane(*sTask);
    if (task >= D_TOTAL) break;
    int kind, seq, h, qt = 0;
    if (task < D_ML_P) {
      kind = 0; seq = task >> 2; h = task & 3;
    } else if (task < D_ML_P + D_AT_P) {
      int t2 = task - D_ML_P;
      kind = 1; qt = 31 - (t2 >> 6); seq = (t2 & 63) >> 3; h = t2 & 7;
    } else if (task < D_ML_P + D_AT_P + D_AT_S) {
      int t2 = task - D_ML_P - D_AT_P;
      kind = 1; seq = 8 + (t2 >> 3); h = t2 & 7;
    } else {
      int t2 = task - D_ML_P - D_AT_P - D_AT_S;
      kind = 0; seq = 8 + (t2 >> 2); h = t2 & 3;
    }
    if (kind == 0) mlstm_task(p, seq, h, smem);
    else attn_task(p, seq, h, qt, smem);
  }
}

struct OrderE {
  __device__ __forceinline__ bool next(int i, pg8::Unit& u) const {
    const int b = blockIdx.x;
    if (i < 2) {
      const int xcd = b & 7, l = b >> 3;
      u.pm = xcd * 8 + (l >> 2);
      u.pn = l & 3;
    } else if (i < 4 && b < 16) {
      u.pm = 64 + (b >> 2);
      u.pn = b & 3;
    } else {
      return false;
    }
    u.ko = (i & 1) * 512;
    u.nt = 8;
    return true;
  }
  __device__ __forceinline__ void a_ready(const pg8::Unit&) const {}
  __device__ __forceinline__ void done(const pg8::Unit&) const {}
};
struct EpiE {
  static constexpr bool PERM = true, AFTER_DRAIN = false;
  const bf16_t* GA;
  const bf16_t* GB;
  bf16_t* MER;
  __device__ __forceinline__ void operator()(const f32x4 (&acc)[2][2][4][2], const pg8::Unit& u, int wr, int wc, int fr, int fq) const {
    const bool second = (u.ko != 0);
    const bf16_t* G = second ? GB : GA;
#pragma unroll
    for (int ai = 0; ai < 2; ++ai)
#pragma unroll
      for (int bj = 0; bj < 2; ++bj)
#pragma unroll
        for (int m = 0; m < 4; ++m) {
          const int row = u.pm * 256 + ai * 128 + wr * 64 + m * 16 + fr;
          const int c0 = u.pn * 256 + bj * 128 + wc * 32 + fq * 8;
          const uint4 gv = *(const uint4*)(G + (size_t)row * 1024 + c0);
          const unsigned gw[4] = {gv.x, gv.y, gv.z, gv.w};
          f32x4 o0 = acc[ai][bj][m][0], o1 = acc[ai][bj][m][1];
          o0[0] *= __uint_as_float(gw[0] << 16);
          o0[1] *= __uint_as_float(gw[0] & 0xffff0000u);
          o0[2] *= __uint_as_float(gw[1] << 16);
          o0[3] *= __uint_as_float(gw[1] & 0xffff0000u);
          o1[0] *= __uint_as_float(gw[2] << 16);
          o1[1] *= __uint_as_float(gw[2] & 0xffff0000u);
          o1[2] *= __uint_as_float(gw[3] << 16);
          o1[3] *= __uint_as_float(gw[3] & 0xffff0000u);
          bf16_t* mp = MER + (size_t)row * 1024 + c0;
          if (second) {
            const uint4 pv = *(const uint4*)mp;
            o0[0] += __uint_as_float(pv.x << 16);
            o0[1] += __uint_as_float(pv.x & 0xffff0000u);
            o0[2] += __uint_as_float(pv.y << 16);
            o0[3] += __uint_as_float(pv.y & 0xffff0000u);
            o1[0] += __uint_as_float(pv.z << 16);
            o1[1] += __uint_as_float(pv.z & 0xffff0000u);
            o1[2] += __uint_as_float(pv.w << 16);
            o1[3] += __uint_as_float(pv.w & 0xffff0000u);
          }
          *(uint4*)mp = pack8(o0, o1);
          if (m == 3) asm volatile("" ::: "memory");
        }
  }
};
__device__ __forceinline__ void phase_e(const Params& p, char* smem) {
  __syncthreads();
  pg8::Gemm g{p.YA, p.Wt_a, kT, 1024, 1024, 1024};
  OrderE S;
  EpiE E{p.GA, p.GB, p.MER};
  pg8::gemm_phase<EpiE, OrderE, false>((PG8_LAS unsigned char*)smem, g, S, E, nullptr);
}
struct OrderF {
  __device__ __forceinline__ bool next(int i, pg8::Unit& u) const {
    const int b = blockIdx.x;
    if (i == 0) {
      const int xcd = b & 7, l = b >> 3;
      u.pm = xcd * 8 + (l >> 2);
      u.pn = l & 3;
      u.ko = 0;
      u.nt = 16;
      return true;
    }
    if (i == 1 && b < 64) {
      const int t2 = b >> 2, kp = b & 3;
      u.pm = 64 + (t2 >> 2);
      u.pn = t2 & 3;
      u.ko = kp * 256;
      u.nt = 4;
      return true;
    }
    return false;
  }
  __device__ __forceinline__ void a_ready(const pg8::Unit&) const {}
  __device__ __forceinline__ void done(const pg8::Unit&) const {}
};
struct EpiF {
  static constexpr bool PERM = false, AFTER_DRAIN = false;
  const float* x_prompt;
  const float* x_sample;
  float* X1;
  float* SLAB;
  const float* modf;
  __device__ __forceinline__ void operator()(const f32x4 (&acc)[2][2][4][2], const pg8::Unit& u, int wr, int wc, int fr, int fq) const {
    const bool primary = (u.ko == 0);
    float* slab = SLAB + (size_t)(((u.pm - 64) * 4 + u.pn) * 3 + ((u.ko >> 8) - 1)) * 65536;
#pragma unroll
    for (int ai = 0; ai < 2; ++ai) {
      const int lr0 = ai * 128 + wr * 64 + fr;
      const int seq = seq_of(u.pm * 256 + ai * 128 + wr * 64);
#pragma unroll
      for (int bj = 0; bj < 2; ++bj)
#pragma unroll
        for (int n = 0; n < 2; ++n) {
          const int lc = bj * 128 + wc * 32 + n * 16 + fq * 4;
          const f32x4 g1 = *(const f32x4*)(modf + seq * 6144 + 2048 + u.pn * 256 + lc);
#pragma unroll
          for (int m = 0; m < 4; ++m) {
            const int lr = lr0 + m * 16;
            const f32x4 v = g1 * acc[ai][bj][m][n];
            if (primary) {
              const int row = u.pm * 256 + lr;
              const float* xr = (row < kNP ? x_prompt + (size_t)row * 1024 : x_sample + (size_t)(row - kNP) * 1024) + u.pn * 256 + lc;
              *(f32x4*)(X1 + (size_t)row * 1024 + u.pn * 256 + lc) = *(const f32x4*)xr + v;
            } else {
              *(f32x4*)(slab + lr * 256 + lc) = v;
            }
          }
          asm volatile("" ::: "memory");
        }
    }
  }
};
__device__ __forceinline__ void phase_f(const Params& p, char* smem) {
  __syncthreads();
  pg8::Gemm g{p.MER, p.Wt_out, kT, 1024, 1024};
  OrderF S;
  EpiF E{p.x_prompt, p.x_sample, p.X1, p.SLAB, p.modf};
  pg8::gemm_phase<EpiF, OrderF, false>((PG8_LAS unsigned char*)smem, g, S, E, nullptr);
}
__device__ __forceinline__ void phase_h(const Params& p, char* smem) {
  __syncthreads();
  pg8::Gemm g{p.U, p.Wt_gu, kT, 5632, 1024};
  pg8::StaticOrder S;
  S.init(kT, 5632, gridDim.x, blockIdx.x);
  EpiH E{p.HFF};
  pg8::gemm_phase<EpiH, pg8::StaticOrder, false>((PG8_LAS unsigned char*)smem, g, S, E, nullptr);
}
struct OrderI {
  __device__ __forceinline__ bool next(int i, pg8::Unit& u) const {
    const int b = blockIdx.x;
    if (i == 0) {
      const int xcd = b & 7, l = b >> 3;
      u.pm = xcd * 8 + (l >> 2);
      u.pn = l & 3;
      u.ko = 0;
      u.nt = 44;
      return true;
    }
    if (i == 1 && b < 176) {
      const int t2 = b / 11, kp = b - t2 * 11;
      u.pm = 64 + (t2 >> 2);
      u.pn = t2 & 3;
      u.ko = kp * 256;
      u.nt = 4;
      return true;
    }
    return false;
  }
  __device__ __forceinline__ void a_ready(const pg8::Unit&) const {}
  __device__ __forceinline__ void done(const pg8::Unit&) const {}
};
struct EpiI {
  static constexpr bool PERM = false, AFTER_DRAIN = false;
  float* X1;
  float* SLAB;
  const float* modf;
  __device__ __forceinline__ void operator()(const f32x4 (&acc)[2][2][4][2], const pg8::Unit& u, int wr, int wc, int fr, int fq) const {
    const bool primary = (u.nt == 44);
    float* slab = SLAB + (size_t)(((u.pm - 64) * 4 + u.pn) * 11 + (u.ko >> 8)) * 65536;
#pragma unroll
    for (int ai = 0; ai < 2; ++ai) {
      const int lr0 = ai * 128 + wr * 64 + fr;
      const int seq = seq_of(u.pm * 256 + ai * 128 + wr * 64);
#pragma unroll
      for (int bj = 0; bj < 2; ++bj)
#pragma unroll
        for (int n = 0; n < 2; ++n) {
          const int lc = bj * 128 + wc * 32 + n * 16 + fq * 4;
          const f32x4 g2 = *(const f32x4*)(modf + seq * 6144 + 5120 + u.pn * 256 + lc);
#pragma unroll
          for (int m = 0; m < 4; ++m) {
            const int lr = lr0 + m * 16;
            const f32x4 v = g2 * acc[ai][bj][m][n];
            if (primary) {
              float* px = X1 + (size_t)(u.pm * 256 + lr) * 1024 + u.pn * 256 + lc;
              *(f32x4*)px = *(const f32x4*)px + v;
            } else {
              *(f32x4*)(slab + lr * 256 + lc) = v;
            }
          }
          asm volatile("" ::: "memory");
        }
    }
  }
};
__device__ __forceinline__ void phase_i(const Params& p, char* smem) {
  __syncthreads();
  pg8::Gemm g{p.HFF, p.Wt_down, kT, 1024, 2816, 2816};
  OrderI S;
  EpiI E{p.X1, p.SLAB, p.modf};
  pg8::gemm_phase<EpiI, OrderI, false>((PG8_LAS unsigned char*)smem, g, S, E, nullptr);
}
__device__ __forceinline__ void phase_j(const Params& p) {
  const int tid = launder_tid(), lane = tid & 63, w = tid >> 6;
  for (int g = blockIdx.x * 8 + w; g < kT / 4; g += gridDim.x * 8) {
    float4 v[4][4];
#pragma unroll
    for (int i = 0; i < 4; i++)
#pragma unroll
      for (int j = 0; j < 4; j++) {
        const int row = g * 4 + i;
        v[i][j] = *(const float4*)(p.X1 + (size_t)row * 1024 + j * 256 + lane * 4);
        if (row >= kNP) {
          const float* sl = p.SLAB + (size_t)((((row - kNP) >> 8) * 4 + j) * 11) * 65536 + (row & 255) * 256 + lane * 4;
#pragma unroll
          for (int kp = 0; kp < 11; kp++) {
            const float4 e = *(const float4*)(sl + (size_t)kp * 65536);
            v[i][j].x += e.x;
            v[i][j].y += e.y;
            v[i][j].z += e.z;
            v[i][j].w += e.w;
          }
        }
      }
#pragma unroll
    for (int i = 0; i < 4; i++) {
      const int row = g * 4 + i;
      float ss = 0.f;
#pragma unroll
      for (int j = 0; j < 4; j++)
        ss += v[i][j].x * v[i][j].x + v[i][j].y * v[i][j].y + v[i][j].z * v[i][j].z + v[i][j].w * v[i][j].w;
      ss = wave_sum(ss);
      float rstd = rsqrtf(ss * (1.0f / 1024.0f) + 1e-6f);
      float* o = p.out + (row < kNP ? O_YP + (size_t)row * 1024 : O_YS + (size_t)(row - kNP) * 1024);
#pragma unroll
      for (int j = 0; j < 4; j++) {
        int c = j * 256 + lane * 4;
        float4 gg = *(const float4*)(p.final_g + c);
        float4 r4;
        r4.x = v[i][j].x * rstd * gg.x;
        r4.y = v[i][j].y * rstd * gg.y;
        r4.z = v[i][j].z * rstd * gg.z;
        r4.w = v[i][j].w * rstd * gg.w;
        *(float4*)(o + c) = r4;
      }
    }
  }
}

#define XB_TMO      128
#define XB_XCNT(j)  (256  + 64 * (j))
#define XB_XSUB(j)  (1280 + 64 * (j))
#define XB_XGEN(j)  (2304 + 64 * (j))
#define XB_TOP      3328
#define XB_TOPGEN   3392
#define XCD_BAR_WORDS 3456
#define XB_SPIN_CAP (1u << 18)
#define LAS __attribute__((address_space(3)))

__device__ __forceinline__ unsigned xb_ld(unsigned* p)              { return __hip_atomic_load(p, __ATOMIC_RELAXED, __HIP_MEMORY_SCOPE_AGENT); }
__device__ __forceinline__ unsigned xb_add(unsigned* p, unsigned v) { return __hip_atomic_fetch_add(p, v, __ATOMIC_RELAXED, __HIP_MEMORY_SCOPE_AGENT); }
__device__ __forceinline__ unsigned xb_xcc_id() { return (unsigned)__builtin_amdgcn_s_getreg((3 << 11) | 20) & 0xFu; }
#define XB_SPIN(cond, bar) do { unsigned _sp = 0; while (cond) { __builtin_amdgcn_s_sleep(1); \
    if ((++_sp & 255u) == 0u) { if (xb_ld(&(bar)[XB_TMO])) break; if (_sp > XB_SPIN_CAP) { atomicAdd(&(bar)[XB_TMO], 1u); break; } } } } while (0)

struct XcdBarrier {
    unsigned* bar; unsigned x;
    volatile LAS unsigned* st;
};

__device__ __forceinline__ XcdBarrier xcd_barrier_post(unsigned* bar, volatile LAS unsigned* st) {
    XcdBarrier b; b.bar = bar; b.x = xb_xcc_id(); b.st = st;
    if (threadIdx.x == 0) (void)xb_add(&bar[XB_XCNT(b.x)], 1u);
    return b;
}
__device__ __forceinline__ void xcd_barrier_complete(unsigned* bar, unsigned x, unsigned& nloc, unsigned& nx) {
    const unsigned G = gridDim.x * gridDim.y * gridDim.z;
    unsigned sum, cnt, mine, sp = 0u;
    for (;;) {
        sum = 0u; cnt = 0u; mine = 0u;
#pragma unroll
        for (unsigned j = 0; j < 16; ++j) { const unsigned c = xb_ld(&bar[XB_XCNT(j)]); sum += c; cnt += (c > 0u) ? 1u : 0u; mine = (j == x) ? c : mine; }
        if (sum == G) break;
        __builtin_amdgcn_s_sleep(1);
        if ((++sp & 255u) == 0u) { if (xb_ld(&bar[XB_TMO])) break; if (sp > XB_SPIN_CAP) { atomicAdd(&bar[XB_TMO], 1u); break; } }
    }
    nloc = mine > 0u ? mine : 1u; nx = cnt > 0u ? cnt : 1u;
}

__device__ __forceinline__ void xcd_barrier(const XcdBarrier& b) {
    asm volatile("s_waitcnt vmcnt(0)" ::: "memory");
    __syncthreads();
    if (threadIdx.x == 0) {
        unsigned* bar = b.bar;
        __builtin_amdgcn_s_waitcnt(0);
        unsigned nloc = b.st[0], nx = b.st[1];
        if (nloc == 0u) { xcd_barrier_complete(bar, b.x, nloc, nx); b.st[0] = nloc; b.st[1] = nx; }
        const unsigned old = xb_add(&bar[XB_XSUB(b.x)], 1u);
        const unsigned gen = old / nloc;
        if (old + 1u == (gen + 1u) * nloc) {
            __builtin_amdgcn_fence(__ATOMIC_RELEASE, "agent");
            asm volatile("s_waitcnt vmcnt(0)" ::: "memory");
            const unsigned og = xb_add(&bar[XB_TOP], 1u);
            const unsigned tg = og / nx;
            if (og + 1u == (tg + 1u) * nx) xb_add(&bar[XB_TOPGEN], 1u);
            else XB_SPIN(xb_ld(&bar[XB_TOPGEN]) == tg, bar);
            __builtin_amdgcn_fence(__ATOMIC_ACQUIRE, "agent");
            xb_add(&bar[XB_XGEN(b.x)], 1u);
            asm volatile("s_waitcnt vmcnt(0)" ::: "memory");
        } else {
            XB_SPIN(xb_ld(&bar[XB_XGEN(b.x)]) == gen, bar);
            __builtin_amdgcn_fence(__ATOMIC_ACQUIRE, "agent");
            asm volatile("s_waitcnt vmcnt(0)" ::: "memory");
        }
    }
    __syncthreads();
}


extern __shared__ __attribute__((aligned(16))) char dyn_smem[];

#ifndef REP_A
#define REP_A 1
#endif
#ifndef REP_C
#define REP_C 1
#endif
#ifndef REP_D
#define REP_D 1
#endif
#ifndef REP_H
#define REP_H 1
#endif
#ifndef REP_E
#define REP_E 1
#endif
__global__ void __launch_bounds__(NTHREADS) mega_kernel(Params p) {
  cg::grid_group grid = cg::this_grid();
  volatile LAS unsigned* xst = (volatile LAS unsigned*)(dyn_smem + LDS_BYTES - 32);
  if (threadIdx.x < 4) xst[threadIdx.x] = 0u;
  __syncthreads();
  XcdBarrier xb = xcd_barrier_post(p.bar, xst);
  if (p.bar == nullptr) grid.sync();
#pragma unroll 1
  for (int r = 0; r < REP_A; r++) {
    phase_a(p, dyn_smem);
    xcd_barrier(xb);
  }
  phase_b(p, dyn_smem);
  xcd_barrier(xb);
#pragma unroll 1
  for (int r = 0; r < REP_C; r++) {
    phase_c(p, dyn_smem);
    xcd_barrier(xb);
  }
  phase_d0(p, dyn_smem);
  xcd_barrier(xb);
#pragma unroll 1
  for (int r = 0; r < REP_D; r++) {
    phase_d(p, dyn_smem, r);
    xcd_barrier(xb);
  }
#pragma unroll 1
  for (int r = 0; r < REP_E; r++) {
    phase_e(p, dyn_smem);
    xcd_barrier(xb);
  }
  phase_f(p, dyn_smem);
  xcd_barrier(xb);
  phase_g(p, dyn_smem);
  xcd_barrier(xb);
#pragma unroll 1
  for (int r = 0; r < REP_H; r++) {
    phase_h(p, dyn_smem);
    xcd_barrier(xb);
  }
  phase_i(p, dyn_smem);
  xcd_barrier(xb);
  phase_j(p);
}
extern "C" void kernel_launch(void* const* d_in, const int* in_sizes, int n_in, void* d_out, int out_size, void* d_ws,
                              size_t ws_size, hipStream_t stream) {
  Params p{};
  const float** pin = (const float**)&p;
  for (int i = 0; i < 26; i++) pin[i] = (const float*)d_in[i];
  p.out = (float*)d_out;
  char* ws = (char*)d_ws;
  size_t off = 0;
  auto alloc = [&](size_t bytes) {
    char* r = ws + off;
    off += (bytes + 255) & ~(size_t)255;
    return r;
  };
  p.Wt_in = (bf16_t*)alloc((size_t)5632 * 1024 * 2);
  p.Wt_a = (bf16_t*)alloc((size_t)1024 * 1024 * 2);
  p.Wt_b = p.Wt_a;
  p.Wt_out = (bf16_t*)alloc((size_t)1024 * 1024 * 2);
  p.Wt_gu = (bf16_t*)alloc((size_t)5632 * 1024 * 2);
  p.Wt_down = (bf16_t*)alloc((size_t)1024 * 2816 * 2);
  p.modp = (float*)alloc((size_t)8 * 24 * 6144 * 4);
  p.modf = (float*)alloc((size_t)24 * 6144 * 4);
  p.U = (bf16_t*)alloc((size_t)kT * 1024 * 2);
  char* r1 = ws + off;
  p.Qb = (bf16_t*)alloc((size_t)kT * 512 * 2);
  p.Kp = (bf16_t*)alloc((size_t)64 * 2048 * 64 * 2);
  p.Ks = (bf16_t*)alloc((size_t)128 * 1152 * 64 * 2);
  p.VTp = (bf16_t*)alloc((size_t)64 * 64 * 2048 * 2);
  p.VTs = (bf16_t*)alloc((size_t)128 * 64 * 1152 * 2);
  p.MQK = (bf16_t*)alloc((size_t)kT * 1024 * 2);
  const size_t r1_bytes = (size_t)(ws + off - r1);
  char* r2 = ws + off;
  p.MVTp = (bf16_t*)alloc((size_t)32 * 128 * 2048 * 2);
  p.MVTs = (bf16_t*)alloc((size_t)64 * 128 * 64 * 2);
  p.SO = (bf16_t*)alloc((size_t)kT * 512 * 2);
  const size_t r2_bytes = (size_t)(ws + off - r2);
  char* r3 = ws + off;
  p.GA = (bf16_t*)alloc((size_t)kT * 1024 * 2);
  p.GB = (bf16_t*)alloc((size_t)kT * 1024 * 2);
  const size_t r3_bytes = (size_t)(ws + off - r3);
  p.GI = (float*)alloc((size_t)kT * 4 * 4);
  p.LF = (float*)alloc((size_t)kT * 4 * 4);
  p.GV = (float*)alloc((size_t)1088 * 384 * 4);
  p.DENc = (float*)alloc((size_t)1088 * 64 * 4);
  char* r4 = ws + off;
  p.Qc = (bf16_t*)alloc((size_t)1088 * 8192 * 2);
  p.KTc = (bf16_t*)alloc((size_t)1088 * 8192 * 2);
  p.SWc = (bf16_t*)alloc((size_t)1088 * 4096 * 2);
  p.YA = (bf16_t*)alloc((size_t)kT * 1024 * 2);
  p.YB = p.YA;
  const size_t r4_bytes = (size_t)(ws + off - r4);
  p.counter = (unsigned*)alloc(256);
  p.bar = (unsigned*)alloc(XCD_BAR_WORDS * 4);
  p.HFF = (bf16_t*)r1;
  p.MER = (bf16_t*)r2;
  p.X1 = (float*)r4;
  p.SLAB = (float*)r3;
  if (r1_bytes < (size_t)kT * 2816 * 2 || r2_bytes < (size_t)kT * 1024 * 2 ||
      r4_bytes < (size_t)kT * 1024 * 4 || r3_bytes < (size_t)176 * 65536 * 4 || off > ws_size) {
    fprintf(stderr, "workspace layout error: need %zu bytes, have %zu\n", off, ws_size);
    return;
  }

#if ONE_LAUNCH
  static int grid_blocks = 0;
  if (!grid_blocks) {
    int dev = 0, cus = 0, per_cu = 0;
    hipGetDevice(&dev);
    hipDeviceGetAttribute(&cus, hipDeviceAttributeMultiprocessorCount, dev);
    hipFuncSetAttribute((const void*)mega_kernel, hipFuncAttributeMaxDynamicSharedMemorySize, LDS_BYTES);
    hipOccupancyMaxActiveBlocksPerMultiprocessor(&per_cu, mega_kernel, NTHREADS, LDS_BYTES);
    if (per_cu < 1) per_cu = 1;
    grid_blocks = cus * per_cu;
    if (grid_blocks > 256) grid_blocks = 256;
  }
  (void)hipMemsetAsync(p.bar, 0, XCD_BAR_WORDS * 4, stream);
  if (grid_blocks != 256) {
    fprintf(stderr, "unexpected co-resident grid %d (phase I is laid out for 256 workgroups)\n", grid_blocks);
    return;
  }
  void* args[] = {&p};
  hipError_t e = hipLaunchCooperativeKernel((void*)mega_kernel, dim3(grid_blocks), dim3(NTHREADS), args, LDS_BYTES, stream);
  if (e != hipSuccess) fprintf(stderr, "cooperative launch failed: %s (grid %d)\n", hipGetErrorString(e), grid_blocks);
#endif
}
```

```cpp
#include <hip/hip_runtime.h>
#include <hip/hip_cooperative_groups.h>
#include <stdint.h>
#include <stdio.h>
namespace cg = cooperative_groups;

#ifndef ONE_LAUNCH
#define ONE_LAUNCH 1
#endif

typedef unsigned short bf16_t;
using bf16x8 = __attribute__((ext_vector_type(8))) short;
using f32x4 = __attribute__((ext_vector_type(4))) float;

#define NTHREADS 512
#define LDS_BYTES 155648
constexpr int kNP = 16384;
constexpr int kT = 17408;
constexpr int kINW = 5640;

struct Params {
  const float *x_prompt, *x_sample, *c_prompt, *c_sample, *cache_k, *cache_v, *st_C, *st_n, *st_m, *st_conv;
  const float *norm1_g, *norm2_g, *w_ada, *b_ada, *w_in, *b_if, *w_conv, *b_conv, *ml_norm_g, *w_a, *w_b, *w_out,
      *w_gate, *w_up, *w_down, *final_g;
  float* out;
  bf16_t *Wt_in, *Wt_a, *Wt_b, *Wt_out, *Wt_gu, *Wt_down;
  float *modp, *modf;
  bf16_t *U, *Qb, *Kp, *Ks, *VTp, *VTs, *MQK, *MVTp, *MVTs, *SO, *GA, *GB;
  float *GI, *LF, *GV, *DENc;
  bf16_t *Qc, *KTc, *SWc;
  bf16_t *YA, *YB, *MER;
  float* X1;
  float* SLAB;
  bf16_t* HFF;
  unsigned* counter;
  unsigned* bar;
};

constexpr size_t O_YP = 0;
constexpr size_t O_YS = O_YP + 16777216;
constexpr size_t O_KP = O_YS + 1048576;
constexpr size_t O_VP = O_KP + 8388608;
constexpr size_t O_CP = O_VP + 8388608;
constexpr size_t O_NP = O_CP + 524288;
constexpr size_t O_MP = O_NP + 4096;
constexpr size_t O_CVP = O_MP + 32;
constexpr size_t O_KS = O_CVP + 24576;
constexpr size_t O_VS = O_KS + 524288;
constexpr size_t O_CS = O_VS + 524288;
constexpr size_t O_NS = O_CS + 1048576;
constexpr size_t O_MS = O_NS + 8192;
constexpr size_t O_CVS = O_MS + 64;

typedef __bf16 hwbf16x2_t __attribute__((ext_vector_type(2)));
typedef float hwf32x2_t __attribute__((ext_vector_type(2)));
__device__ __forceinline__ bf16_t f2bf(float f) {
  __bf16 r = (__bf16)f;
  return __builtin_bit_cast(unsigned short, r);
}
__device__ __forceinline__ float bf2f(bf16_t h) { return __uint_as_float(((unsigned)h) << 16); }
__device__ __forceinline__ unsigned pack2(float a, float b) {
  hwf32x2_t v = {a, b};
  hwbf16x2_t r = __builtin_convertvector(v, hwbf16x2_t);
  return __builtin_bit_cast(unsigned, r);
}
__device__ __forceinline__ float sigm(float x) { return __builtin_amdgcn_rcpf(1.0f + __expf(-x)); }
__device__ __forceinline__ float silu(float x) { return x * __builtin_amdgcn_rcpf(1.0f + __expf(-x)); }
__device__ __forceinline__ float logsig(float x) { return fminf(x, 0.f) - __logf(1.0f + __expf(-fabsf(x))); }
__device__ __forceinline__ float wave_max(float v) {
#pragma unroll
  for (int o = 32; o > 0; o >>= 1) v = fmaxf(v, __shfl_xor(v, o));
  return v;
}
#define DPP_ADD(v, ctrl) v += __int_as_float(__builtin_amdgcn_update_dpp(0, __float_as_int(v), ctrl, 0xF, 0xF, true))
__device__ __forceinline__ float row16_sum(float v) {
  DPP_ADD(v, 0xB1);
  DPP_ADD(v, 0x4E);
  DPP_ADD(v, 0x124);
  DPP_ADD(v, 0x128);
  return v;
}
__device__ __forceinline__ float half8_sum(float v) {
  DPP_ADD(v, 0xB1);
  DPP_ADD(v, 0x4E);
  DPP_ADD(v, 0x141);
  return v;
}
__device__ __forceinline__ float wave_sum(float v) {
  v = row16_sum(v);
  v += __shfl_xor(v, 16);
  v += __shfl_xor(v, 32);
  return v;
}
__device__ __forceinline__ int seq_of(int row) { return row < kNP ? (row >> 11) : 8 + ((row - kNP) >> 6); }
__device__ __forceinline__ const float* xrow(const Params& p, int row) {
  return row < kNP ? p.x_prompt + (size_t)row * 1024 : p.x_sample + (size_t)(row - kNP) * 1024;
}
__device__ __forceinline__ int launder_tid() {
  int t = threadIdx.x;
  asm volatile("" : "+v"(t));
  return t;
}
__device__ __forceinline__ bf16x8 lds8(const void* p) { return *(const bf16x8*)p; }
#define MFMA(a, b, c) __builtin_amdgcn_mfma_f32_16x16x32_bf16(a, b, c, 0, 0, 0)

namespace pg8 {
#define PG8_LAS __attribute__((address_space(3)))
typedef unsigned short bf16_t;
typedef short bf16x8 __attribute__((ext_vector_type(8)));
typedef float f32x4 __attribute__((ext_vector_type(4)));
typedef unsigned u32x4 __attribute__((ext_vector_type(4)));
constexpr int BM = 256, BK = 64, HALF = 128, HTB = HALF * BK * 2  , STAGE_BYTES = 8 * HTB, NXCD = 8, WGM = 8;

__host__ __device__ __forceinline__ int lds_byte(int r, int c) { const int st = (r >> 4) * 2 + (c >> 5), rr = r & 15, cc = c & 31, ob = rr * 64 + cc * 2; return st * 1024 + (ob ^ (((ob >> 9) & 1) << 5)); }
__host__ __device__ __forceinline__ void stage_rc(int b, int& R, int& C) { const int st = b / 1024, sb = b % 1024, swz = sb ^ (((sb >> 9) & 1) << 5); R = (st >> 1) * 16 + swz / 64; C = (st & 1) * 32 + (swz % 64) / 2; }
__host__ __device__ __forceinline__ int perm32(int rho) { const int n = rho >> 4, i = rho & 15; return 8 * (i >> 2) + 4 * n + (i & 3); }

struct Unit { int pm, pn; int ko = 0, nt = 0; };
struct Gemm { const bf16_t* A; const bf16_t* Bt; int M, N, K; int ld = 0; };

struct StaticOrder {
    int nM, nN, nwg, G, c;
    __host__ __device__ void init(int M, int N, int G_, int c_) { nM = M / BM; nN = N / BM; nwg = nM * nN; G = G_; c = c_; }
    __host__ __device__ bool next(int i, Unit& u) const {
        const long L = (long)i * G + c; if (L >= nwg) return false;
        int wgid = (int)L; { const int q = nwg / NXCD, r = nwg % NXCD, xcd = wgid % NXCD, off = wgid / NXCD; wgid = (xcd < r ? xcd * (q + 1) : r * (q + 1) + (xcd - r) * q) + off; }
        const int nig = WGM * nN, gid = wgid / nig, fm = gid * WGM, gsz = (nM - fm) < WGM ? (nM - fm) : WGM;
        u.pm = fm + ((wgid % nig) % gsz); u.pn = (wgid % nig) / gsz; return true;
    }
    __device__ __forceinline__ void a_ready(const Unit&) const {}
    __device__ __forceinline__ void done(const Unit&) const {}
};
__device__ __forceinline__ unsigned cvt_pk_bf16(float lo, float hi) { unsigned r; asm volatile("v_cvt_pk_bf16_f32 %0, %1, %2" : "=v"(r) : "v"(lo), "v"(hi)); return r; }
template <class Epi, class Sched, bool STAMP = false>
__device__ __forceinline__ void gemm_phase(PG8_LAS unsigned char* lds, const Gemm g, const Sched& S, const Epi& E, unsigned long long* stamps) {
    const int tid = launder_tid(), wid = __builtin_amdgcn_readfirstlane(tid >> 6), lane = tid & 63, wr = wid >> 2, wc = wid & 3, fr = lane & 15, fq = lane >> 4;
    const int K = g.K, nt = K / BK, ld = g.ld ? g.ld : K;
    int ts_lo = 0, ts_hi = 0, nts = 0; const unsigned long long rt_entry = STAMP ? (unsigned long long)wall_clock64() : 0ull;
#define PG8_STAMP() do { if (STAMP && wid == 0 && nts < 64) { const unsigned long long _c = (unsigned long long)clock64(); \
        ts_lo = (lane == nts) ? (int)(unsigned)_c : ts_lo; ts_hi = (lane == nts) ? (int)(unsigned)(_c >> 32) : ts_hi; ++nts; } } while (0)
    PG8_STAMP();
    unsigned voffA[2], voffB[2];
#pragma unroll
    for (int i = 0; i < 2; ++i) { int R, C; stage_rc(tid * 16 + i * 8192, R, C); const int Rb = Epi::PERM ? ((R & ~31) + perm32(R & 31)) : R;
        voffA[i] = (unsigned)(R * ld + C) * 2u; voffB[i] = (unsigned)(Rb * ld + C) * 2u; }
    const size_t kstep = (size_t)(BK * 2);
    const size_t hstep = (size_t)HALF * ld * 2;
    const size_t tstep = 2 * hstep;
    const unsigned ldsw = (unsigned)wid * 1024u;
    const int aoff = lds_byte(wr * 64 + fr, fq * 8), boff = lds_byte(wc * 32 + fr, fq * 8);
#define PG8_SA(b, h) (((b) * 2 + (h)) * HTB)
#define PG8_SB(b, h) ((4 + (b) * 2 + (h)) * HTB)
#define PG8_STAGE(bufoff, gbase, voff) do { _Pragma("unroll") for (int _i = 0; _i < 2; ++_i) \
        __builtin_amdgcn_global_load_lds((const unsigned*)((const char*)(gbase) + (voff)[_i]), (PG8_LAS unsigned*)(lds + (bufoff) + ldsw + _i * 8192), 16, 0, 0); } while (0)
#define PG8_LDA(dst, b, h) do { _Pragma("unroll") for (int m = 0; m < 4; ++m) _Pragma("unroll") for (int k = 0; k < 2; ++k) dst[m][k] = *(const PG8_LAS bf16x8*)(lds + PG8_SA(b, h) + aoff + m * 2048 + k * 1024); } while (0)
#define PG8_LDB(dst, b, h) do { _Pragma("unroll") for (int n = 0; n < 2; ++n) _Pragma("unroll") for (int k = 0; k < 2; ++k) dst[n][k] = *(const PG8_LAS bf16x8*)(lds + PG8_SB(b, h) + boff + n * 2048 + k * 1024); } while (0)
#define PG8_MMA(ai, bj, At, Bt) do { __builtin_amdgcn_s_setprio(1); _Pragma("unroll") for (int m = 0; m < 4; ++m) _Pragma("unroll") for (int n = 0; n < 2; ++n) _Pragma("unroll") for (int k = 0; k < 2; ++k) \
        acc[ai][bj][m][n] = __builtin_amdgcn_mfma_f32_16x16x32_bf16(Bt[n][k], At[m][k], acc[ai][bj][m][n], 0, 0, 0); __builtin_amdgcn_s_setprio(0); } while (0)
#define PG8_WAIT_V(n) asm volatile("s_waitcnt vmcnt(" #n ")" ::: "memory")
#define PG8_WAIT_L(n) asm volatile("s_waitcnt lgkmcnt(" #n ")" ::: "memory")
#define PG8_BAR __builtin_amdgcn_s_barrier()
#define PG8_SCHED __builtin_amdgcn_sched_barrier(0)
    Unit cur, nxt; int ui = 0;
    if (!S.next(0, cur)) return;
    f32x4 acc[2][2][4][2];
#pragma unroll
    for (int a = 0; a < 2; ++a)
#pragma unroll
        for (int b = 0; b < 2; ++b)
#pragma unroll
            for (int m = 0; m < 4; ++m)
#pragma unroll
                for (int n = 0; n < 2; ++n) acc[a][b][m][n] = (f32x4){0.f, 0.f, 0.f, 0.f};
    bf16x8 At[4][2], B0[2][2], B1[2][2];
    const char* cA = (const char*)g.A + (size_t)cur.pm * tstep + (size_t)cur.ko * 2; const char* cB = (const char*)g.Bt + (size_t)cur.pn * tstep + (size_t)cur.ko * 2;
    S.a_ready(cur);
    PG8_STAGE(PG8_SB(0, 0), cB, voffB); PG8_STAGE(PG8_SA(0, 0), cA, voffA); PG8_STAGE(PG8_SB(0, 1), cB + hstep, voffB); PG8_STAGE(PG8_SA(0, 1), cA + hstep, voffA);
    if (wr == 1) PG8_BAR;
    PG8_WAIT_V(4); PG8_BAR;
    PG8_STAGE(PG8_SB(1, 0), cB + kstep, voffB); PG8_STAGE(PG8_SA(1, 0), cA + kstep, voffA); PG8_STAGE(PG8_SB(1, 1), cB + hstep + kstep, voffB);
    PG8_WAIT_V(6); PG8_BAR;
    PG8_STAMP();
    for (;;) {
        const bool has_next = S.next(ui + 1, nxt);
        const char* nA = has_next ? (const char*)g.A + (size_t)nxt.pm * tstep + (size_t)nxt.ko * 2 : cA; const char* nB = has_next ? (const char*)g.Bt + (size_t)nxt.pn * tstep + (size_t)nxt.ko * 2 : cB;
        const int unt = cur.nt ? cur.nt : nt;
        for (int t = 0; t < unt; t += 2) {
            const bool last = (t == unt - 2);
            const char* a1 = cA + (size_t)(t + 1) * kstep;
            const char* a2 = last ? nA : cA + (size_t)(t + 2) * kstep; const char* b2 = last ? nB : cB + (size_t)(t + 2) * kstep;
            const char* a3 = a2 + kstep; const char* b3 = b2 + kstep;
            if (last && has_next) S.a_ready(nxt);
            PG8_LDB(B0, 0, 0); PG8_SCHED; PG8_LDA(At, 0, 0); PG8_STAGE(PG8_SA(1, 1), a1 + hstep, voffA);
            PG8_WAIT_L(8); PG8_BAR; PG8_WAIT_L(0); PG8_MMA(0, 0, At, B0); PG8_BAR; PG8_SCHED;
            PG8_LDB(B1, 0, 1); PG8_STAGE(PG8_SB(0, 0), b2, voffB);
            PG8_BAR; PG8_WAIT_L(0); PG8_MMA(0, 1, At, B1); PG8_BAR;
            PG8_LDA(At, 0, 1); PG8_STAGE(PG8_SA(0, 0), a2, voffA);
            PG8_BAR; PG8_WAIT_L(0); PG8_MMA(1, 0, At, B0); PG8_BAR; PG8_SCHED;
            PG8_STAGE(PG8_SB(0, 1), b2 + hstep, voffB);
            PG8_WAIT_V(6); PG8_BAR; PG8_MMA(1, 1, At, B1); PG8_BAR;
            PG8_LDB(B0, 1, 0); PG8_SCHED; PG8_LDA(At, 1, 0); PG8_STAGE(PG8_SA(0, 1), a2 + hstep, voffA);
            PG8_WAIT_L(8); PG8_BAR; PG8_WAIT_L(0); PG8_MMA(0, 0, At, B0); PG8_BAR; PG8_SCHED;
            PG8_LDB(B1, 1, 1); PG8_STAGE(PG8_SB(1, 0), b3, voffB);
            PG8_BAR; PG8_WAIT_L(0); PG8_MMA(0, 1, At, B1); PG8_BAR;
            PG8_LDA(At, 1, 1); PG8_STAGE(PG8_SA(1, 0), a3, voffA);
            PG8_BAR; PG8_WAIT_L(0); PG8_MMA(1, 0, At, B0); PG8_BAR; PG8_SCHED;
            PG8_STAGE(PG8_SB(1, 1), b3 + hstep, voffB);
            PG8_WAIT_V(6); PG8_BAR; PG8_MMA(1, 1, At, B1); PG8_BAR;
        }
        PG8_STAMP();
        if constexpr (!Epi::AFTER_DRAIN) { E(acc, cur, wr, wc, fr, fq); S.done(cur); }
        PG8_STAMP();
        if (!has_next) break;
#pragma unroll
        for (int a = 0; a < 2; ++a)
#pragma unroll
            for (int b = 0; b < 2; ++b)
#pragma unroll
                for (int m = 0; m < 4; ++m)
#pragma unroll
                    for (int n = 0; n < 2; ++n) acc[a][b][m][n] = (f32x4){0.f, 0.f, 0.f, 0.f};
        cur = nxt; cA = nA; cB = nB; ++ui;
    }
    PG8_WAIT_V(0);
    if (wr == 0) PG8_BAR;
    PG8_BAR;
    if constexpr (Epi::AFTER_DRAIN) { E.fused(acc, cur, wr, wc, fr, fq, lds, wid, lane); S.done(cur); }
    PG8_STAMP();
    if (STAMP && wid == 0) { stamps[lane] = lane < nts ? (((unsigned long long)(unsigned)ts_hi << 32) | (unsigned)ts_lo) : 0ull;
        if (lane == 62) stamps[62] = rt_entry; if (lane == 63) stamps[63] = (unsigned long long)wall_clock64(); }
#undef PG8_STAMP
#undef PG8_SA
#undef PG8_SB
#undef PG8_STAGE
#undef PG8_LDA
#undef PG8_LDB
#undef PG8_MMA
#undef PG8_WAIT_V
#undef PG8_WAIT_L
#undef PG8_BAR
#undef PG8_SCHED
}
}

__device__ __forceinline__ void transpose_quad(const float* __restrict__ src, int lds_, size_t sstep, bf16_t* __restrict__ dst, int ldd,
                               int k0, int kstep, int nbase, int nstep, int mode, char* smem) {
  float* tl = (float*)smem;
  const int tid = launder_tid();
  float4 v[4][2];
#pragma unroll
  for (int q = 0; q < 4; q++)
#pragma unroll
    for (int i = 0; i < 2; i++) {
      int idx = tid + i * 512;
      int k = idx >> 4, n4 = (idx & 15) * 4;
      v[q][i] = *(const float4*)(src + q * sstep + (size_t)k * lds_ + n4);
    }
  __syncthreads();
#pragma unroll
  for (int q = 0; q < 4; q++)
#pragma unroll
    for (int i = 0; i < 2; i++) {
      int idx = tid + i * 512;
      int k = idx >> 4, n4 = (idx & 15) * 4;
      float* t = tl + q * 4160 + k * 65 + n4;
      t[0] = v[q][i].x;
      t[1] = v[q][i].y;
      t[2] = v[q][i].z;
      t[3] = v[q][i].w;
    }
  __syncthreads();
  const int n = tid >> 3, kc = (tid & 7) * 8;
#pragma unroll
  for (int q = 0; q < 4; q++) {
    float o[8];
#pragma unroll
    for (int e = 0; e < 8; e++) o[e] = tl[q * 4160 + (kc + e) * 65 + n];
    const int nb = (mode == 2) ? nbase + (q >> 1) * 256 + (q & 1) * 64 : nbase + q * nstep;
    const int nrow = (mode != 1) ? (nb + n) : (nb + (n >> 5) * 64 + (n & 31));
    uint4 pk = {pack2(o[0], o[1]), pack2(o[2], o[3]), pack2(o[4], o[5]), pack2(o[6], o[7])};
    *(uint4*)(dst + (size_t)nrow * ldd + k0 + q * kstep + kc) = pk;
  }
}

__device__ __forceinline__ void weight_task(const Params& p, int id, char* smem) {
  const float* src;
  bf16_t* dst;
  int lds_, ldd, k0, nbase, nstep = 64, mode = 0;
  if (id < 352) {
    int kt = id / 22, nq = id % 22;
    int scol = nq < 14 ? nq * 256 : 3592 + (nq - 14) * 256;
    nbase = nq < 14 ? nq * 256 : 3584 + (nq - 14) * 256;
    src = p.w_in + (size_t)kt * 64 * kINW + scol; lds_ = kINW; dst = p.Wt_in; ldd = 1024; k0 = kt * 64;
  } else if (id < 384) {
    int i2 = id - 352, kt = i2 / 4, nq = i2 % 4;
    src = p.w_a + (size_t)kt * 64 * 1024 + nq * 256; lds_ = 1024; dst = p.Wt_a; ldd = 1024; k0 = kt * 64; nbase = nq * 256;
  } else if (id < 416) {
    int i2 = id - 384, kt = i2 / 4, nq = i2 % 4;
    src = p.w_b + (size_t)kt * 64 * 1024 + nq * 256; lds_ = 1024; dst = p.Wt_a; ldd = 1024; k0 = 512 + kt * 64; nbase = nq * 256;
  } else if (id < 480) {
    int i2 = id - 416, kt = i2 / 4, nq = i2 % 4;
    src = p.w_out + (size_t)kt * 64 * 1024 + nq * 256; lds_ = 1024; dst = p.Wt_out; ldd = 1024; k0 = kt * 64; nbase = nq * 256;
  } else if (id < 656) {
    int i2 = id - 480, kt = i2 / 11, nq = i2 % 11;
    src = p.w_gate + (size_t)kt * 64 * 2816 + nq * 256; lds_ = 2816; dst = p.Wt_gu; ldd = 1024; k0 = kt * 64; nbase = nq * 512; nstep = 0; mode = 2;
  } else if (id < 832) {
    int i2 = id - 656, kt = i2 / 11, nq = i2 % 11;
    src = p.w_up + (size_t)kt * 64 * 2816 + nq * 256; lds_ = 2816; dst = p.Wt_gu; ldd = 1024; k0 = kt * 64; nbase = nq * 512 + 128; nstep = 0; mode = 2;
  } else {
    int i2 = id - 832, kt = i2 / 4, nq = i2 % 4;
    src = p.w_down + (size_t)kt * 64 * 1024 + nq * 256; lds_ = 1024; dst = p.Wt_down; ldd = 2816; k0 = kt * 64; nbase = nq * 256;
  }
  transpose_quad(src, lds_, 64, dst, ldd, k0, 0, nbase, nstep, mode, smem);
}

constexpr int A_MOD = 96;
constexpr int A_WT = 352;
constexpr int A_VC = 512;
constexpr int A_KC = 256;
constexpr int A_PAD = 128;
constexpr int A_MISC = 1;
constexpr int A_TOTAL = A_MOD + A_WT + A_VC + A_KC + A_PAD + A_MISC;

__device__ __forceinline__ void phase_a(const Params& p, char* smem) {
  const int tid = launder_tid();
  for (int task = blockIdx.x; task < A_TOTAL; task += gridDim.x) {
    int id = task;
    if (id < A_MOD) {
      int cgp = id % 12, ks = id / 12;
      float* sc = (float*)smem;
      __syncthreads();
      for (int i = tid; i < 24 * 128; i += 512) {
        int s = i >> 7, kk = i & 127, k = ks * 128 + kk;
        float cv = s < 8 ? p.c_prompt[s * 1024 + k] : p.c_sample[(s - 8) * 1024 + k];
        sc[i] = silu(cv);
      }
      __syncthreads();
      int col = cgp * 512 + tid;
      float acc[24];
#pragma unroll
      for (int s = 0; s < 24; s++) acc[s] = 0.f;
      const float* wp = p.w_ada + (size_t)(ks * 128) * 6144 + col;
#pragma unroll 1
      for (int kb = 0; kb < 128; kb += 32) {
        float wv[32];
#pragma unroll
        for (int j = 0; j < 32; j++) wv[j] = wp[(size_t)(kb + j) * 6144];
#pragma unroll
        for (int j = 0; j < 32; j++)
#pragma unroll
          for (int s = 0; s < 24; s++) acc[s] += sc[s * 128 + kb + j] * wv[j];
      }
#pragma unroll
      for (int s = 0; s < 24; s++) p.modp[(size_t)(ks * 24 + s) * 6144 + col] = acc[s];
      continue;
    }
    id -= A_MOD;
    if (id < A_WT) {
      weight_task(p, id, smem);
      continue;
    }
    id -= A_WT;
    if (id < A_VC) {
      int bh = id >> 2, jq = id & 3;
      int b = bh >> 3, h = bh & 7;
      transpose_quad(p.cache_v + ((size_t)(b * 1024 + jq * 256) * 8 + h) * 64, 512, (size_t)64 * 512,
                     p.VTs + (size_t)bh * 64 * 1152, 1152, jq * 256, 64, 0, 0, 0, smem);
      continue;
    }
    id -= A_VC;
    if (id < A_KC) {
      int b = id >> 4, jb = id & 15;
#pragma unroll
      for (int it = 0; it < 8; it++) {
        int g = tid + it * 512;
        int j = g >> 6, col = (g & 63) * 8;
        int h = col >> 6, d = col & 63;
        const float* src = p.cache_k + ((size_t)(b * 1024 + jb * 64 + j)) * 512 + col;
        float4 v0 = *(const float4*)src, v1 = *(const float4*)(src + 4);
        uint4 o;
        o.x = pack2(v0.x, v0.y);
        o.y = pack2(v0.z, v0.w);
        o.z = pack2(v1.x, v1.y);
        o.w = pack2(v1.z, v1.w);
        *(uint4*)(p.Ks + ((size_t)((b * 8 + h) * 1152 + jb * 64 + j)) * 64 + d) = o;
      }
      continue;
    }
    id -= A_KC;
    if (id < A_PAD) {
      int bh = id;
      uint4 z = {0u, 0u, 0u, 0u};
      *(uint4*)(p.Ks + ((size_t)bh * 1152 + 1088) * 64 + tid * 8) = z;
      int d = tid >> 3, chn = tid & 7;
      *(uint4*)(p.VTs + ((size_t)bh * 64 + d) * 1152 + 1088 + chn * 8) = z;
      continue;
    }
    if (tid < 8) p.counter[tid] = 0u;
  }
}

__device__ __forceinline__ void norm_task(const Params& p, int task, int which, char* smem) {
  float* sm_scale = (float*)smem;
  float* sm_shift = sm_scale + 1024;
  const float* sm_wg = sm_shift + 1024;
  const int tid = launder_tid(), lane = tid & 63, w = tid >> 6;
  const int row0 = task * 32;
  const int seq = seq_of(row0);
  const float* g = which ? p.norm2_g : p.norm1_g;
  const int sh_off = which ? 3072 : 0, sc_off = which ? 4096 : 1024;
  __syncthreads();
  for (int c = tid; c < 1024; c += 512) {
    float sh, sc;
    if (which == 0) {
      sh = p.b_ada[sh_off + c];
      sc = p.b_ada[sc_off + c];
#pragma unroll
      for (int ks = 0; ks < 8; ks++) {
        sh += p.modp[(size_t)(ks * 24 + seq) * 6144 + sh_off + c];
        sc += p.modp[(size_t)(ks * 24 + seq) * 6144 + sc_off + c];
      }
    } else {
      sh = p.modf[seq * 6144 + sh_off + c];
      sc = p.modf[seq * 6144 + sc_off + c];
    }
    sm_scale[c] = g[c] * (1.0f + sc);
    sm_shift[c] = sh;
  }
  __syncthreads();
  float4 v[4][4];
#pragma unroll
  for (int i = 0; i < 4; i++) {
    const int row = row0 + w * 4 + i;
    const float* xr = which ? (p.X1 + (size_t)row * 1024) : xrow(p, row);
#pragma unroll
    for (int j = 0; j < 4; j++) {
      v[i][j] = *(const float4*)(xr + j * 256 + lane * 4);
      if (which && row >= kNP) {
        const float* sl = p.SLAB + (size_t)((((row - kNP) >> 8) * 4 + j) * 3) * 65536 + (row & 255) * 256 + lane * 4;
#pragma unroll
        for (int kp = 0; kp < 3; kp++) {
          const float4 e = *(const float4*)(sl + (size_t)kp * 65536);
          v[i][j].x += e.x;
          v[i][j].y += e.y;
          v[i][j].z += e.z;
          v[i][j].w += e.w;
        }
        *(float4*)(p.X1 + (size_t)row * 1024 + j * 256 + lane * 4) = v[i][j];
      }
    }
  }
#pragma unroll
  for (int i = 0; i < 4; i++) {
    const int row = row0 + w * 4 + i;
    float ss = 0.f;
#pragma unroll
    for (int j = 0; j < 4; j++)
      ss += v[i][j].x * v[i][j].x + v[i][j].y * v[i][j].y + v[i][j].z * v[i][j].z + v[i][j].w * v[i][j].w;
    ss = wave_sum(ss);
    float rstd = rsqrtf(ss * (1.0f / 1024.0f) + 1e-6f);
#pragma unroll
    for (int j = 0; j < 4; j++) {
      int c = j * 256 + lane * 4;
      float4 sc = *(const float4*)(sm_scale + c), sh = *(const float4*)(sm_shift + c);
      v[i][j].x = v[i][j].x * rstd * sc.x + sh.x;
      v[i][j].y = v[i][j].y * rstd * sc.y + sh.y;
      v[i][j].z = v[i][j].z * rstd * sc.z + sh.z;
      v[i][j].w = v[i][j].w * rstd * sc.w + sh.w;
      uint2 o;
      o.x = pack2(v[i][j].x, v[i][j].y);
      o.y = pack2(v[i][j].z, v[i][j].w);
      *(uint2*)(p.U + (size_t)row * 1024 + c) = o;
    }
    if (which == 0) {
      float gv[8];
#pragma unroll
      for (int gi = 0; gi < 8; gi++) {
        float a = 0.f;
#pragma unroll
        for (int j = 0; j < 4; j++) {
          float4 wv = *(const float4*)(sm_wg + gi * 1024 + j * 256 + lane * 4);
          a += v[i][j].x * wv.x + v[i][j].y * wv.y + v[i][j].z * wv.z + v[i][j].w * wv.w;
        }
        gv[gi] = wave_sum(a);
      }
      if (lane == 0) {
#pragma unroll
        for (int h = 0; h < 4; h++) {
          p.GI[row * 4 + h] = gv[h] + p.b_if[h];
          p.LF[row * 4 + h] = logsig(gv[4 + h] + p.b_if[4 + h]);
        }
      }
    }
  }
}
__device__ __forceinline__ void phase_b(const Params& p, char* smem) {
  const int NTASK = kT / 32;
  {
    float* swg = (float*)smem + 2048;
    for (int i = threadIdx.x; i < 8192; i += 512) swg[i] = p.w_in[(size_t)(i & 1023) * kINW + 3584 + (i >> 10)];
  }
  for (int task = blockIdx.x; task < NTASK + 288; task += gridDim.x) {
    if (task < NTASK) {
      norm_task(p, task, 0, smem);
    } else {
      int i = (task - NTASK) * 512 + threadIdx.x;
      int s = i / 6144, c = i - s * 6144;
      float a = p.b_ada[c];
#pragma unroll
      for (int ks = 0; ks < 8; ks++) a += p.modp[(size_t)(ks * 24 + s) * 6144 + c];
      p.modf[i] = a;
    }
  }
}
__device__ __forceinline__ void phase_g(const Params& p, char* smem) {
  for (int task = blockIdx.x; task < kT / 32; task += gridDim.x) norm_task(p, task, 1, smem);
}

__device__ __forceinline__ uint4 pack8(const f32x4& a, const f32x4& b) {
  return (uint4){pack2(a[0], a[1]), pack2(a[2], a[3]), pack2(b[0], b[1]), pack2(b[2], b[3])};
}
struct EpiC {
  static constexpr bool PERM = true, AFTER_DRAIN = false;
  Params p;
  __device__ __forceinline__ void operator()(const f32x4 (&acc)[2][2][4][2], const pg8::Unit& u, int wr, int wc, int fr, int fq) const {
#pragma unroll
    for (int ai = 0; ai < 2; ++ai) {
      const int rb = u.pm * 256 + ai * 128 + wr * 64;
      const int seq = seq_of(rb);
      const bool isp = seq < 8;
      const int sb = seq - 8;
      const int srow0 = isp ? seq * 2048 : kNP + sb * 64;
      const int L = isp ? 2048 : 64;
#pragma unroll
      for (int bj = 0; bj < 2; ++bj) {
        const int cb = u.pn * 256 + bj * 128;
        const int c0 = cb + wc * 32 + fq * 8;
#pragma unroll
        for (int m = 0; m < 4; ++m) {
          const int row = rb + m * 16 + fr;
          const int t = row - srow0;
          const f32x4 v0 = acc[ai][bj][m][0], v1 = acc[ai][bj][m][1];
          if (cb < 512) {
            *(uint4*)(p.Qb + (size_t)row * 512 + c0) = pack8(v0, v1);
          } else if (cb < 1024) {
            const int c = c0 - 512, h = c >> 6, d = c & 63;
            float* o = (isp ? p.out + O_KP + (size_t)row * 512 : p.out + O_KS + (size_t)(row - kNP) * 512) + c;
            *(f32x4*)o = v0;
            *(f32x4*)(o + 4) = v1;
            bf16_t* kb = isp ? p.Kp + ((size_t)(seq * 8 + h) * 2048 + t) * 64 + d
                             : p.Ks + ((size_t)(sb * 8 + h) * 1152 + 1024 + t) * 64 + d;
            *(uint4*)kb = pack8(v0, v1);
          } else if (cb < 1536) {
            const int c = c0 - 1024, h = c >> 6, d = c & 63;
            float* o = (isp ? p.out + O_VP + (size_t)row * 512 : p.out + O_VS + (size_t)(row - kNP) * 512) + c;
            *(f32x4*)o = v0;
            *(f32x4*)(o + 4) = v1;
            bf16_t* vt = isp ? p.VTp + ((size_t)(seq * 8 + h) * 64 + d) * 2048 + t
                             : p.VTs + ((size_t)(sb * 8 + h) * 64 + d) * 1152 + 1024 + t;
            const size_t tl = isp ? 2048 : 1152;
#pragma unroll
            for (int e = 0; e < 4; ++e) {
              vt[(size_t)e * tl] = f2bf(v0[e]);
              vt[(size_t)(e + 4) * tl] = f2bf(v1[e]);
            }
          } else if (cb < 2560) {
            const int c = c0 - 1536;
            *(uint4*)(p.MQK + (size_t)row * 1024 + c) = pack8(v0, v1);
            if (t >= L - 3) {
              float* o = (isp ? p.out + O_CVP + (size_t)(seq * 3 + (t - (L - 3))) * 1024
                              : p.out + O_CVS + (size_t)(sb * 3 + (t - (L - 3))) * 1024) + c;
              *(f32x4*)o = v0;
              *(f32x4*)(o + 4) = v1;
            }
          } else if (cb < 3072) {
            const int c = c0 - 2560, h = c >> 7, d = c & 127;
            bf16_t* vt = isp ? p.MVTp + ((size_t)(seq * 4 + h) * 128 + d) * 2048 + t
                             : p.MVTs + ((size_t)(sb * 4 + h) * 128 + d) * 64 + t;
            const size_t tl = isp ? 2048 : 64;
#pragma unroll
            for (int e = 0; e < 4; ++e) {
              vt[(size_t)e * tl] = f2bf(v0[e]);
              vt[(size_t)(e + 4) * tl] = f2bf(v1[e]);
            }
          } else {
            f32x4 s0, s1;
#pragma unroll
            for (int e = 0; e < 4; ++e) {
              s0[e] = sigm(v0[e]);
              s1[e] = sigm(v1[e]);
            }
            bf16_t* dst = (cb < 3584)   ? p.SO + (size_t)row * 512 + (c0 - 3072)
                          : (cb < 4608) ? p.GA + (size_t)row * 1024 + (c0 - 3584)
                                        : p.GB + (size_t)row * 1024 + (c0 - 4608);
            *(uint4*)dst = pack8(s0, s1);
          }
        }
      }
    }
  }
};
struct EpiH {
  static constexpr bool PERM = true, AFTER_DRAIN = false;
  bf16_t* HFF;
  __device__ __forceinline__ void operator()(const f32x4 (&acc)[2][2][4][2], const pg8::Unit& u, int wr, int wc, int fr, int fq) const {
    const int f0 = u.pn * 128 + wc * 32 + fq * 8;
#pragma unroll
    for (int ai = 0; ai < 2; ++ai)
#pragma unroll
      for (int m = 0; m < 4; ++m) {
        const int row = u.pm * 256 + ai * 128 + wr * 64 + m * 16 + fr;
        f32x4 o0, o1;
#pragma unroll
        for (int e = 0; e < 4; ++e) {
          o0[e] = silu(acc[ai][0][m][0][e]) * acc[ai][1][m][0][e];
          o1[e] = silu(acc[ai][0][m][1][e]) * acc[ai][1][m][1][e];
        }
        *(uint4*)(HFF + (size_t)row * 2816 + f0) = pack8(o0, o1);
      }
  }
};
__device__ __forceinline__ void gate_task(const Params& p, int seq, int h, char* smem);
__device__ __forceinline__ void phase_c(const Params& p, char* smem) {
  for (int item = blockIdx.x; item < 96; item += gridDim.x) {
    if (item < 32) gate_task(p, item >> 2, item & 3, smem);
    else gate_task(p, 8 + ((item - 32) >> 2), item & 3, smem);
  }
  __syncthreads();
  pg8::Gemm g{p.U, p.Wt_in, kT, 5632, 1024};
  pg8::StaticOrder S;
  S.init(kT, 5632, gridDim.x, blockIdx.x);
  EpiC E{p};
  pg8::gemm_phase<EpiC, pg8::StaticOrder, false>((PG8_LAS unsigned char*)smem, g, S, E, nullptr);
}

__device__ __forceinline__ void lds_barrier() { asm volatile("s_waitcnt lgkmcnt(0)\n\ts_barrier" ::: "memory"); }
__device__ __forceinline__ void attn_task(const Params& p, int seq, int h, int qt, char* smem) {
  const int tid = launder_tid(), lane = tid & 63, w = tid >> 6, fr = lane & 15, fq = lane >> 4;
  const bool isp = seq < 8;
  const int sb = seq - 8;
  const int past = isp ? 0 : 1024;
  const int Tlen = isp ? 2048 : 1152;
  const int row0 = (isp ? seq * 2048 : kNP + sb * 64) + qt * 64;
  const int p0 = past + qt * 64;
  const bf16_t* Kb = isp ? p.Kp + (size_t)(seq * 8 + h) * 2048 * 64 : p.Ks + (size_t)(sb * 8 + h) * 1152 * 64;
  const bf16_t* VT = isp ? p.VTp + (size_t)(seq * 8 + h) * 64 * 2048 : p.VTs + (size_t)(sb * 8 + h) * 64 * 1152;
  bf16_t* sQ = (bf16_t*)smem;
  bf16_t* sK = sQ + 64 * 72;
  bf16_t* sVT = sK + 128 * 72;
  bf16_t* sP = sVT + 64 * 136;
  float* sZ = (float*)(sP + 64 * 136);
  int* sFlag = (int*)(sZ + 64 * 132);

  __syncthreads();
  {
    int r = tid >> 3, chn = tid & 7;
    uint4 q = *(const uint4*)(p.Qb + (size_t)(row0 + r) * 512 + h * 64 + chn * 8);
    *(uint4*)(sQ + r * 72 + chn * 8) = q;
  }
  const int kt_d = (p0 + 62) >> 7;
  const int ki0 = tid, ki1 = tid + 512;
  const bf16_t* kptr0 = Kb + (size_t)(ki0 >> 3) * 64 + (ki0 & 7) * 8;
  const bf16_t* kptr1 = Kb + (size_t)(ki1 >> 3) * 64 + (ki1 & 7) * 8;
  const bf16_t* vptr0 = VT + (size_t)(ki0 >> 4) * Tlen + (ki0 & 15) * 8;
  const bf16_t* vptr1 = VT + (size_t)(ki1 >> 4) * Tlen + (ki1 & 15) * 8;
  uint4 kr0 = *(const uint4*)(kptr0 + (size_t)kt_d * 8192);
  uint4 kr1 = *(const uint4*)(kptr1 + (size_t)kt_d * 8192);
  uint4 vr0 = *(const uint4*)(vptr0 + kt_d * 128);
  uint4 vr1 = *(const uint4*)(vptr1 + kt_d * 128);
  float R = 0.f;
  f32x4 oacc[2];
  oacc[0] = (f32x4){0.f, 0.f, 0.f, 0.f};
  oacc[1] = (f32x4){0.f, 0.f, 0.f, 0.f};
  const int mf = w & 3;
  for (int kt = kt_d; kt >= 0; kt--) {
    lds_barrier();
    *(uint4*)(sK + (ki0 >> 3) * 72 + (ki0 & 7) * 8) = kr0;
    *(uint4*)(sK + (ki1 >> 3) * 72 + (ki1 & 7) * 8) = kr1;
    *(uint4*)(sVT + (ki0 >> 4) * 136 + (ki0 & 15) * 8) = vr0;
    *(uint4*)(sVT + (ki1 >> 4) * 136 + (ki1 & 15) * 8) = vr1;
    if (tid == 0) *sFlag = 0;
    lds_barrier();
    if (kt > 0) {
      kr0 = *(const uint4*)(kptr0 + (size_t)(kt - 1) * 8192);
      kr1 = *(const uint4*)(kptr1 + (size_t)(kt - 1) * 8192);
      vr0 = *(const uint4*)(vptr0 + (kt - 1) * 128);
      vr1 = *(const uint4*)(vptr1 + (kt - 1) * 128);
    }
    {
      const int nf0 = (w >> 2) * 4;
      bf16x8 a0 = lds8(sQ + (mf * 16 + fr) * 72 + fq * 8);
      bf16x8 a1 = lds8(sQ + (mf * 16 + fr) * 72 + 32 + fq * 8);
#pragma unroll
      for (int n = 0; n < 4; n++) {
        bf16x8 b0 = lds8(sK + ((nf0 + n) * 16 + fr) * 72 + fq * 8);
        bf16x8 b1 = lds8(sK + ((nf0 + n) * 16 + fr) * 72 + 32 + fq * 8);
        f32x4 s = (f32x4){0.f, 0.f, 0.f, 0.f};
        s = MFMA(a0, b0, s);
        s = MFMA(a1, b1, s);
#pragma unroll
        for (int r = 0; r < 4; r++) sZ[(mf * 16 + fq * 4 + r) * 132 + (nf0 + n) * 16 + fr] = s[r] * 0.125f;
      }
    }
    lds_barrier();
    {
      const int row = tid >> 3, part = tid & 7;
      const int pos = p0 + row;
      const int j0 = kt * 128 + part * 16;
      float z[16], ls[16];
#pragma unroll
      for (int i4 = 0; i4 < 4; i4++) {
        float4 t4 = *(const float4*)(sZ + row * 132 + part * 16 + i4 * 4);
        z[i4 * 4 + 0] = t4.x;
        z[i4 * 4 + 1] = t4.y;
        z[i4 * 4 + 2] = t4.z;
        z[i4 * 4 + 3] = t4.w;
      }
      float run = 0.f;
      float tl[16];
#pragma unroll
      for (int i = 15; i >= 0; i--) {
        bool valid = (j0 + i) < pos;
        float l = valid ? -(fmaxf(z[i], 0.f) + __logf(1.0f + __expf(-fabsf(z[i])))) : 0.f;
        ls[i] = l;
        tl[i] = run;
        run += l;
      }
      float incl = run;
#pragma unroll
      for (int dlt = 1; dlt < 8; dlt <<= 1) {
        float t = __shfl_down(incl, dlt, 8);
        if (part + dlt < 8) incl += t;
      }
      float excl = incl - run;
      float tot = __shfl(incl, 0, 8);
      float base = R + excl;
      unsigned pk[8];
#pragma unroll
      for (int i = 0; i < 16; i += 2) {
        bool v0 = (j0 + i) < pos, v1 = (j0 + i + 1) < pos;
        float a0 = v0 ? __expf(z[i] + ls[i] + tl[i] + base) : 0.f;
        float a1 = v1 ? __expf(z[i + 1] + ls[i + 1] + tl[i + 1] + base) : 0.f;
        pk[i >> 1] = pack2(a0, a1);
      }
      *(uint4*)(sP + row * 136 + part * 16) = (uint4){pk[0], pk[1], pk[2], pk[3]};
      *(uint4*)(sP + row * 136 + part * 16 + 8) = (uint4){pk[4], pk[5], pk[6], pk[7]};
      R += tot;
      if (R > -110.f) *sFlag = 1;
    }
    lds_barrier();
    const int more = *sFlag;
    {
      const int nf0 = (w >> 2) * 2;
#pragma unroll
      for (int ks = 0; ks < 4; ks++) {
        bf16x8 a = lds8(sP + (mf * 16 + fr) * 136 + ks * 32 + fq * 8);
#pragma unroll
        for (int n = 0; n < 2; n++) {
          bf16x8 b = lds8(sVT + ((nf0 + n) * 16 + fr) * 136 + ks * 32 + fq * 8);
          oacc[n] = MFMA(a, b, oacc[n]);
        }
      }
    }
    if (!more) break;
  }
  {
    const int nf0 = (w >> 2) * 2;
#pragma unroll
    for (int n = 0; n < 2; n++)
#pragma unroll
      for (int r = 0; r < 4; r++)
        p.YA[(size_t)(row0 + mf * 16 + fq * 4 + r) * 1024 + h * 64 + (nf0 + n) * 16 + fr] = f2bf(oacc[n][r]);
  }
}


__device__ __forceinline__ void gate_task(const Params& p, int seq, int h, char* smem) {
  const int tid = launder_tid(), lane = tid & 63, w = tid >> 6;
  const bool isp = seq < 8;
  const int sb = seq - 8;
  const int nchunks = isp ? 32 : 1;
  const int grow0 = isp ? seq * 2048 : kNP + sb * 64;
  float* gv = p.GV + (size_t)(isp ? (seq * 4 + h) * 32 : 1024 + sb * 4 + h) * 384;
  float* sBl = (float*)smem;
  float* sG = sBl + 32;
  float* sM = sG + 32;
  __syncthreads();
  float b_[4], as_[4], pm_[4], g_[4];
#pragma unroll
  for (int i = 0; i < 4; i++) {
    const int c = w + i * 8;
    b_[i] = 0.f; as_[i] = 0.f; pm_[i] = 0.f; g_[i] = 0.f;
    if (c < nchunks) {
      const int row = grow0 + c * 64 + lane;
      float li = p.GI[row * 4 + h], lf = p.LF[row * 4 + h];
      float b = lf;
#pragma unroll
      for (int d = 1; d < 64; d <<= 1) {
        float t_ = __shfl_up(b, d);
        if (lane >= d) b += t_;
      }
      float a_s = li - b;
      float pm = a_s;
#pragma unroll
      for (int d = 1; d < 64; d <<= 1) {
        float t_ = __shfl_up(pm, d);
        if (lane >= d) pm = fmaxf(pm, t_);
      }
      float blast = __shfl(b, 63);
      float g = blast - b + li;
      float G = wave_max(g);
      b_[i] = b; as_[i] = a_s; pm_[i] = pm; g_[i] = g;
      if (lane == 0) {
        sBl[c] = blast;
        sG[c] = G;
      }
    }
  }
  __syncthreads();
  if (tid == 0) {
    float m = isp ? 0.f : p.st_m[sb * 4 + h];
    for (int c = 0; c < nchunks; c++) {
      sM[c] = m;
      m = fmaxf(sBl[c] + m, sG[c]);
    }
    sM[nchunks] = m;
    if (isp) p.out[O_MP + seq * 4 + h] = m;
    else p.out[O_MS + sb * 4 + h] = m;
  }
  __syncthreads();
#pragma unroll
  for (int i = 0; i < 4; i++) {
    const int c = w + i * 8;
    if (c < nchunks) {
      const float m_run = sM[c], m_new = sM[c + 1];
      const float mt = b_[i] + fmaxf(m_run, pm_[i]);
      float* o = gv + (size_t)c * 384;
      o[lane] = b_[i] - mt;
      o[64 + lane] = as_[i];
      o[128 + lane] = __expf(b_[i] + m_run - mt);
      o[192 + lane] = __expf(g_[i] - m_new);
      o[256 + lane] = __expf(-mt);
      if (lane == 0) o[320] = __expf(sBl[c] + m_run - m_new);
    }
  }
}

__device__ __forceinline__ void mlpre_task(const Params& p, int seq, int h, int c, char* smem) {
  const bool isp = seq < 8;
  const int sb = seq - 8;
  const int grow0 = isp ? seq * 2048 : kNP + sb * 64;
  const int t0 = c * 64;
  const int cid = isp ? (seq * 4 + h) * 32 + c : 1024 + sb * 4 + h;
  bf16_t* sQ = (bf16_t*)smem;
  bf16_t* sK = sQ + 64 * 136;
  bf16_t* sKT = sK + 64 * 136;
  bf16_t* sSw = sKT + 128 * 72;
  float* sF = (float*)(sSw + 64 * 72);
  float* sV = sF;
  float* sDen = sF + 384;
  float* sCw = sF + 448;
  const float* sBt = sV;
  const float* sAs = sV + 64;
  const float* sWg = sV + 192;
  __syncthreads();
  uint4 xr0, xr1, xr2, xr3, xr4, xr5, xr6;
  {
    const int tid = launder_tid();
    for (int i = tid; i < 1280; i += 512) {
      int j = i >> 8, cc = i & 255;
      int gch = (cc >= 128 ? 512 : 0) + h * 128 + (cc & 127);
      sCw[i] = (j < 4) ? p.w_conv[j * 1024 + gch] : p.b_conv[gch];
    }
    if (tid < 384) sV[tid] = p.GV[(size_t)cid * 384 + tid];
    if (tid < 64) sDen[tid] = 0.f;
    const int rb_ = tid >> 5, cgp_ = tid & 31;
    const int ch_ = (cgp_ >= 16 ? 512 : 0) + h * 128 + (cgp_ & 15) * 8;
    const int tb0 = t0 + rb_ * 4 - 3;
    const bf16_t* xp = p.MQK + (size_t)(grow0 + tb0) * 1024 + ch_;
#define LDX(i, dst)                                                                                           \
  if (tb0 + i >= 0) dst = *(const uint4*)(xp + (size_t)i * 1024);                                             \
  else if (isp) dst = (uint4){0u, 0u, 0u, 0u};                                                                \
  else {                                                                                                      \
    const float* s0 = p.st_conv + (size_t)(sb * 3 + (tb0 + i + 3)) * 1024 + ch_;                              \
    dst = (uint4){pack2(s0[0], s0[1]), pack2(s0[2], s0[3]), pack2(s0[4], s0[5]), pack2(s0[6], s0[7])};        \
  }
    LDX(0, xr0) LDX(1, xr1) LDX(2, xr2)
#undef LDX
    xr3 = *(const uint4*)(xp + (size_t)3 * 1024);
    xr4 = *(const uint4*)(xp + (size_t)4 * 1024);
    xr5 = *(const uint4*)(xp + (size_t)5 * 1024);
    xr6 = *(const uint4*)(xp + (size_t)6 * 1024);
  }
  __syncthreads();
  {
    const int tid = launder_tid();
    const int rb = tid >> 5, cgp = tid & 31;
    const bool isk = cgp >= 16;
    float o0[8], o1[8], o2[8], o3[8];
    {
      const float* cwp = sCw + cgp * 8;
      float4 b0 = *(const float4*)(cwp + 1024), b1 = *(const float4*)(cwp + 1028);
      o0[0] = b0.x; o0[1] = b0.y; o0[2] = b0.z; o0[3] = b0.w; o0[4] = b1.x; o0[5] = b1.y; o0[6] = b1.z; o0[7] = b1.w;
#pragma unroll
      for (int e = 0; e < 8; e++) { o1[e] = o0[e]; o2[e] = o0[e]; o3[e] = o0[e]; }
#define FMAW(j, o, x) { float4 a0 = *(const float4*)(cwp + j * 256), a1 = *(const float4*)(cwp + j * 256 + 4); \
  o[0] += a0.x * x[0]; o[1] += a0.y * x[1]; o[2] += a0.z * x[2]; o[3] += a0.w * x[3];                              \
  o[4] += a1.x * x[4]; o[5] += a1.y * x[5]; o[6] += a1.z * x[6]; o[7] += a1.w * x[7]; }
#define UNP(xv, x) float x[8]; x[0] = __uint_as_float(xv.x << 16); x[1] = __uint_as_float(xv.x & 0xffff0000u); \
  x[2] = __uint_as_float(xv.y << 16); x[3] = __uint_as_float(xv.y & 0xffff0000u);                             \
  x[4] = __uint_as_float(xv.z << 16); x[5] = __uint_as_float(xv.z & 0xffff0000u);                             \
  x[6] = __uint_as_float(xv.w << 16); x[7] = __uint_as_float(xv.w & 0xffff0000u);
      { UNP(xr0, x) FMAW(0, o0, x) }
      { UNP(xr1, x) FMAW(1, o0, x) FMAW(0, o1, x) }
      { UNP(xr2, x) FMAW(2, o0, x) FMAW(1, o1, x) FMAW(0, o2, x) }
      { UNP(xr3, x) FMAW(3, o0, x) FMAW(2, o1, x) FMAW(1, o2, x) FMAW(0, o3, x) }
      { UNP(xr4, x) FMAW(3, o1, x) FMAW(2, o2, x) FMAW(1, o3, x) }
      { UNP(xr5, x) FMAW(3, o2, x) FMAW(2, o3, x) }
      { UNP(xr6, x) FMAW(3, o3, x) }
#undef FMAW
#undef UNP
    }
    const float ksc = isk ? 0.08838834764831845f : 1.0f;
#pragma unroll
    for (int e = 0; e < 8; e++) {
      o0[e] = silu(o0[e]) * ksc; o1[e] = silu(o1[e]) * ksc; o2[e] = silu(o2[e]) * ksc; o3[e] = silu(o3[e]) * ksc;
    }
    bf16_t* dstp = (isk ? sK + (cgp - 16) * 8 : sQ + cgp * 8) + (rb * 4) * 136;
    *(uint4*)(dstp) = (uint4){pack2(o0[0], o0[1]), pack2(o0[2], o0[3]), pack2(o0[4], o0[5]), pack2(o0[6], o0[7])};
    *(uint4*)(dstp + 136) = (uint4){pack2(o1[0], o1[1]), pack2(o1[2], o1[3]), pack2(o1[4], o1[5]), pack2(o1[6], o1[7])};
    *(uint4*)(dstp + 272) = (uint4){pack2(o2[0], o2[1]), pack2(o2[2], o2[3]), pack2(o2[4], o2[5]), pack2(o2[6], o2[7])};
    *(uint4*)(dstp + 408) = (uint4){pack2(o3[0], o3[1]), pack2(o3[2], o3[3]), pack2(o3[4], o3[5]), pack2(o3[6], o3[7])};
    if (isk) {
      float g0 = sWg[rb * 4], g1 = sWg[rb * 4 + 1], g2 = sWg[rb * 4 + 2], g3 = sWg[rb * 4 + 3];
#pragma unroll
      for (int e = 0; e < 8; e++) {
        uint2 pk;
        pk.x = pack2(o0[e] * g0, o1[e] * g1);
        pk.y = pack2(o2[e] * g2, o3[e] * g3);
        *(uint2*)(sKT + ((cgp - 16) * 8 + e) * 72 + rb * 4) = pk;
      }
    }
  }
  __syncthreads();
  {
    const int tid = launder_tid(), lane = tid & 63, w = tid >> 6, fr = lane & 15, fq = lane >> 4;
    const int mf = w >> 1, nf0 = (w & 1) * 2;
    f32x4 sa[2];
    sa[0] = (f32x4){0.f, 0.f, 0.f, 0.f};
    sa[1] = (f32x4){0.f, 0.f, 0.f, 0.f};
#pragma unroll
    for (int ks = 0; ks < 4; ks++) {
      bf16x8 a = lds8(sQ + (mf * 16 + fr) * 136 + ks * 32 + fq * 8);
#pragma unroll
      for (int n = 0; n < 2; n++) {
        bf16x8 b = lds8(sK + ((nf0 + n) * 16 + fr) * 136 + ks * 32 + fq * 8);
        sa[n] = MFMA(a, b, sa[n]);
      }
    }
#pragma unroll
    for (int r = 0; r < 4; r++) {
      const int t = mf * 16 + fq * 4 + r;
      const float bt = sBt[t];
      float rs = 0.f;
#pragma unroll
      for (int n = 0; n < 2; n++) {
        const int s = (nf0 + n) * 16 + fr;
        float wgt = (s <= t) ? __expf(bt + sAs[s]) : 0.f;
        float v = sa[n][r] * wgt;
        rs += v;
        sSw[t * 72 + s] = f2bf(v);
      }
      rs = row16_sum(rs);
      if (fr == 0) atomicAdd(&sDen[t], rs);
    }
  }
  __syncthreads();
  {
    const int tid = launder_tid();
    bf16_t* qo = p.Qc + (size_t)cid * 8192;
    bf16_t* ko = p.KTc + (size_t)cid * 8192;
    bf16_t* so = p.SWc + (size_t)cid * 4096;
    *(uint4*)(qo + tid * 8) = *(const uint4*)(sQ + (tid >> 4) * 136 + (tid & 15) * 8);
    *(uint4*)(qo + 4096 + tid * 8) = *(const uint4*)(sQ + (32 + (tid >> 4)) * 136 + (tid & 15) * 8);
    *(uint4*)(ko + tid * 8) = *(const uint4*)(sKT + (tid >> 3) * 72 + (tid & 7) * 8);
    *(uint4*)(ko + 4096 + tid * 8) = *(const uint4*)(sKT + (64 + (tid >> 3)) * 72 + (tid & 7) * 8);
    *(uint4*)(so + tid * 8) = *(const uint4*)(sSw + (tid >> 3) * 72 + (tid & 7) * 8);
    if (tid < 64) p.DENc[(size_t)cid * 64 + tid] = sDen[tid];
  }
}

__device__ __forceinline__ void mlstm_task(const Params& p, int seq, int h, char* smem) {
  const bool isp = seq < 8;
  const int sb = seq - 8;
  const int L = isp ? 2048 : 64;
  const int nchunks = L >> 6;
  const int grow0 = isp ? seq * 2048 : kNP + sb * 64;
  const int cid0 = isp ? (seq * 4 + h) * 32 : 1024 + sb * 4 + h;
  const bf16_t* MVT = isp ? p.MVTp + (size_t)(seq * 4 + h) * 128 * 2048 : p.MVTs + (size_t)(sb * 4 + h) * 128 * 64;
  bf16_t* sQ = (bf16_t*)smem;
  bf16_t* sH = sQ + 64 * 136;
  bf16_t* sKT = sH + 64 * 136;
  bf16_t* sVT = sKT + 128 * 72;
  bf16_t* sCb = sVT + 128 * 72;
  bf16_t* sSw = sCb + 128 * 136;
  float* sF = (float*)(sSw + 64 * 72);
  float* sVec = sF;
  float* sNq = sF + 512;
  float* sSS = sF + 576;
  float* sN = sF + 640;

  __syncthreads();
  f32x4 Cacc[8];
  {
    const int tid = launder_tid(), lane = tid & 63, w = tid >> 6, fr = lane & 15, fq = lane >> 4;
    if (isp) {
#pragma unroll
      for (int n = 0; n < 8; n++) Cacc[n] = (f32x4){0.f, 0.f, 0.f, 0.f};
      if (tid < 128) sN[tid] = 0.f;
    } else {
      const float* C0 = p.st_C + (size_t)(sb * 4 + h) * 16384;
#pragma unroll
      for (int n = 0; n < 8; n++)
#pragma unroll
        for (int r = 0; r < 4; r++) Cacc[n][r] = C0[(w * 16 + fq * 4 + r) * 128 + n * 16 + fr];
      if (tid < 128) sN[tid] = p.st_n[(sb * 4 + h) * 128 + tid];
    }
#pragma unroll
    for (int n = 0; n < 8; n++)
#pragma unroll
      for (int r = 0; r < 4; r++) sCb[(w * 16 + fq * 4 + r) * 136 + n * 16 + fr] = f2bf(Cacc[n][r]);
  }
  float mg0, mg1, mg2, mg3;
  {
    const int tid = launder_tid(), lane = tid & 63, w = tid >> 6, fr = lane & 15;
    const int cidx = h * 128 + (w >> 2) * 64 + fr;
    mg0 = p.ml_norm_g[cidx];
    mg1 = p.ml_norm_g[cidx + 16];
    mg2 = p.ml_norm_g[cidx + 32];
    mg3 = p.ml_norm_g[cidx + 48];
  }
  uint4 q0, q1, k0, k1, v0, v1, sw0;
  float gwi = 0.f, gem = 0.f, gden = 0.f, gdec = 0.f;
#define LOAD_CHUNK(C)                                                                         \
  {                                                                                           \
    const int tid_ = launder_tid();                                                           \
    const size_t cid_ = (size_t)(cid0 + (C));                                                 \
    const bf16_t* qp = p.Qc + cid_ * 8192 + tid_ * 8;                                         \
    const bf16_t* kp = p.KTc + cid_ * 8192 + tid_ * 8;                                        \
    q0 = *(const uint4*)qp;                                                                   \
    q1 = *(const uint4*)(qp + 4096);                                                          \
    k0 = *(const uint4*)kp;                                                                   \
    k1 = *(const uint4*)(kp + 4096);                                                          \
    sw0 = *(const uint4*)(p.SWc + cid_ * 4096 + tid_ * 8);                                    \
    v0 = *(const uint4*)(MVT + (size_t)(tid_ >> 3) * L + (C) * 64 + (tid_ & 7) * 8);          \
    v1 = *(const uint4*)(MVT + (size_t)((tid_ + 512) >> 3) * L + (C) * 64 + (tid_ & 7) * 8);  \
    if (tid_ < 64) {                                                                          \
      gwi = p.GV[cid_ * 384 + 128 + tid_];                                                    \
      gem = p.GV[cid_ * 384 + 256 + tid_];                                                    \
      gden = p.DENc[cid_ * 64 + tid_];                                                        \
      gdec = p.GV[cid_ * 384 + 320];                                                          \
    }                                                                                         \
  }
  LOAD_CHUNK(0)
  lds_barrier();

  for (int c = 0; c < nchunks; c++) {
    const int t0 = c * 64;
    float* sV = sVec + (c & 1) * 256;
    const float* sNo = sN + (c & 1) * 128;
    float* sNn = sN + ((c + 1) & 1) * 128;
    uint4 so0, so1;
    {
      const int tid = launder_tid();
      *(uint4*)(sQ + (tid >> 4) * 136 + (tid & 15) * 8) = q0;
      *(uint4*)(sQ + (32 + (tid >> 4)) * 136 + (tid & 15) * 8) = q1;
      *(uint4*)(sKT + (tid >> 3) * 72 + (tid & 7) * 8) = k0;
      *(uint4*)(sKT + (64 + (tid >> 3)) * 72 + (tid & 7) * 8) = k1;
      *(uint4*)(sVT + (tid >> 3) * 72 + (tid & 7) * 8) = v0;
      *(uint4*)(sVT + (64 + (tid >> 3)) * 72 + (tid & 7) * 8) = v1;
      *(uint4*)(sSw + (tid >> 3) * 72 + (tid & 7) * 8) = sw0;
      float decay = gdec;
      if (tid < 64) {
        sV[tid] = gwi;
        sV[64 + tid] = gem;
        sV[128 + tid] = gden;
        sSS[tid] = 0.f;
        if (tid == 0) sV[192] = gdec;
      }
      decay = __shfl(decay, 0);
#define UNP8(VV, AR) float AR[8]; AR[0] = __uint_as_float(VV.x << 16); AR[1] = __uint_as_float(VV.x & 0xffff0000u); \
  AR[2] = __uint_as_float(VV.y << 16); AR[3] = __uint_as_float(VV.y & 0xffff0000u);                                 \
  AR[4] = __uint_as_float(VV.z << 16); AR[5] = __uint_as_float(VV.z & 0xffff0000u);                                 \
  AR[6] = __uint_as_float(VV.w << 16); AR[7] = __uint_as_float(VV.w & 0xffff0000u);
      {
        const float4 n0 = *(const float4*)(sNo + (tid & 15) * 8), n1 = *(const float4*)(sNo + (tid & 15) * 8 + 4);
        UNP8(q0, a)
        UNP8(q1, b)
        float d0 = a[0] * n0.x + a[1] * n0.y + a[2] * n0.z + a[3] * n0.w + a[4] * n1.x + a[5] * n1.y + a[6] * n1.z + a[7] * n1.w;
        float d1 = b[0] * n0.x + b[1] * n0.y + b[2] * n0.z + b[3] * n0.w + b[4] * n1.x + b[5] * n1.y + b[6] * n1.z + b[7] * n1.w;
        d0 = row16_sum(d0);
        d1 = row16_sum(d1);
        if ((tid & 15) == 0) {
          sNq[tid >> 4] = d0;
          sNq[32 + (tid >> 4)] = d1;
        }
      }
      {
        UNP8(k0, a)
        UNP8(k1, b)
        float d0 = ((a[0] + a[1]) + (a[2] + a[3])) + ((a[4] + a[5]) + (a[6] + a[7]));
        float d1 = ((b[0] + b[1]) + (b[2] + b[3])) + ((b[4] + b[5]) + (b[6] + b[7]));
        d0 = half8_sum(d0);
        d1 = half8_sum(d1);
        if ((tid & 7) == 0) {
          sNn[tid >> 3] = d0;
          sNn[64 + (tid >> 3)] = d1;
        }
      }
#undef UNP8
      {
        const bf16_t* sop = p.SO + (size_t)(grow0 + t0 + (tid >> 4)) * 512 + h * 128 + (tid & 15) * 8;
        so0 = *(const uint4*)sop;
        so1 = *(const uint4*)(sop + (size_t)32 * 512);
      }
    }
    if (c + 1 < nchunks) LOAD_CHUNK(c + 1)
    lds_barrier();
    f32x4 hacc[4];
    {
      const int tid = launder_tid(), lane = tid & 63, w = tid >> 6, fr = lane & 15, fq = lane >> 4;
      const int mf = w & 3, nf0 = (w >> 2) * 4;
      const float* sWi = sV;
      const float* sEm = sV + 64;
      const float* sDn = sV + 128;
#pragma unroll
      for (int n = 0; n < 4; n++) hacc[n] = (f32x4){0.f, 0.f, 0.f, 0.f};
      {
        bf16x8 qa[4], cb[4][4], swa[2], vb[2][4];
#pragma unroll
        for (int ks = 0; ks < 4; ks++) {
          qa[ks] = lds8(sQ + (mf * 16 + fr) * 136 + ks * 32 + fq * 8);
#pragma unroll
          for (int n = 0; n < 4; n++) cb[ks][n] = lds8(sCb + ((nf0 + n) * 16 + fr) * 136 + ks * 32 + fq * 8);
        }
#pragma unroll
        for (int ks = 0; ks < 2; ks++) {
          swa[ks] = lds8(sSw + (mf * 16 + fr) * 72 + ks * 32 + fq * 8);
#pragma unroll
          for (int n = 0; n < 4; n++) vb[ks][n] = lds8(sVT + ((nf0 + n) * 16 + fr) * 72 + ks * 32 + fq * 8);
        }
        float wi4[4];
#pragma unroll
        for (int r = 0; r < 4; r++) wi4[r] = sWi[mf * 16 + fq * 4 + r];
#pragma unroll
        for (int ks = 0; ks < 4; ks++)
#pragma unroll
          for (int n = 0; n < 4; n++) hacc[n] = MFMA(qa[ks], cb[ks][n], hacc[n]);
#pragma unroll
        for (int r = 0; r < 4; r++)
#pragma unroll
          for (int n = 0; n < 4; n++) hacc[n][r] *= wi4[r];
#pragma unroll
        for (int ks = 0; ks < 2; ks++)
#pragma unroll
          for (int n = 0; n < 4; n++) hacc[n] = MFMA(swa[ks], vb[ks][n], hacc[n]);
      }
#pragma unroll
      for (int r = 0; r < 4; r++) {
        const int t = mf * 16 + fq * 4 + r;
        float den = sDn[t] + sWi[t] * sNq[t];
        float dn = fmaxf(fabsf(den), sEm[t]);
        float inv = __builtin_amdgcn_rcpf(dn);
        float ss = 0.f;
#pragma unroll
        for (int n = 0; n < 4; n++) {
          hacc[n][r] *= inv;
          ss += hacc[n][r] * hacc[n][r];
        }
        ss = row16_sum(ss);
        if (fr == 0) atomicAdd(&sSS[t], ss);
      }
    }
    lds_barrier();
    {
      const int tid = launder_tid(), lane = tid & 63, w = tid >> 6, fr = lane & 15, fq = lane >> 4;
      const int mf = w & 3, nf0 = (w >> 2) * 4;
#pragma unroll
      for (int r = 0; r < 4; r++) {
        const int t = mf * 16 + fq * 4 + r;
        const float rstd = rsqrtf(sSS[t] * (1.0f / 128.0f) + 1e-6f);
        bf16_t* hp = sH + t * 136 + nf0 * 16 + fr;
        hp[0] = f2bf(hacc[0][r] * rstd * mg0);
        hp[16] = f2bf(hacc[1][r] * rstd * mg1);
        hp[32] = f2bf(hacc[2][r] * rstd * mg2);
        hp[48] = f2bf(hacc[3][r] * rstd * mg3);
      }
      const float decay = sV[192];
#pragma unroll
      for (int n = 0; n < 8; n++) {
        Cacc[n][0] *= decay;
        Cacc[n][1] *= decay;
        Cacc[n][2] *= decay;
        Cacc[n][3] *= decay;
      }
      {
        bf16x8 va[2], kb[2][8];
#pragma unroll
        for (int ks = 0; ks < 2; ks++) {
          va[ks] = lds8(sVT + (w * 16 + fr) * 72 + ks * 32 + fq * 8);
#pragma unroll
          for (int n = 0; n < 8; n++) kb[ks][n] = lds8(sKT + (n * 16 + fr) * 72 + ks * 32 + fq * 8);
        }
#pragma unroll
        for (int ks = 0; ks < 2; ks++)
#pragma unroll
          for (int n = 0; n < 8; n++) Cacc[n] = MFMA(va[ks], kb[ks][n], Cacc[n]);
      }
#pragma unroll
      for (int n = 0; n < 8; n++)
#pragma unroll
        for (int r = 0; r < 4; r++) sCb[(w * 16 + fq * 4 + r) * 136 + n * 16 + fr] = f2bf(Cacc[n][r]);
      if (tid < 128) sNn[tid] = decay * sNo[tid] + sNn[tid];
    }
    lds_barrier();
    {
      const int tid = launder_tid();
      const int row = tid >> 4, c8 = (tid & 15) * 8;
      bf16_t* yp = p.YA + (size_t)(grow0 + t0 + row) * 1024 + 512 + h * 128 + c8;
      uint4 h0 = *(const uint4*)(sH + row * 136 + c8);
      uint4 h1 = *(const uint4*)(sH + (row + 32) * 136 + c8);
#define MUL2(a, b) pack2(__uint_as_float((a) << 16) * __uint_as_float((b) << 16), \
                         __uint_as_float((a) & 0xffff0000u) * __uint_as_float((b) & 0xffff0000u))
      uint4 y0 = {MUL2(h0.x, so0.x), MUL2(h0.y, so0.y), MUL2(h0.z, so0.z), MUL2(h0.w, so0.w)};
      uint4 y1 = {MUL2(h1.x, so1.x), MUL2(h1.y, so1.y), MUL2(h1.z, so1.z), MUL2(h1.w, so1.w)};
#undef MUL2
      *(uint4*)yp = y0;
      *(uint4*)(yp + (size_t)32 * 1024) = y1;
    }
  }
#undef LOAD_CHUNK
  lds_barrier();
  {
    const int tid = launder_tid(), lane = tid & 63, w = tid >> 6, fr = lane & 15, fq = lane >> 4;
    float* Cout = isp ? p.out + O_CP + (size_t)(seq * 4 + h) * 16384 : p.out + O_CS + (size_t)(sb * 4 + h) * 16384;
#pragma unroll
    for (int n = 0; n < 8; n++)
#pragma unroll
      for (int r = 0; r < 4; r++) Cout[(w * 16 + fq * 4 + r) * 128 + n * 16 + fr] = Cacc[n][r];
    float* nout = isp ? p.out + O_NP + (seq * 4 + h) * 128 : p.out + O_NS + (sb * 4 + h) * 128;
    if (tid < 128) nout[tid] = sN[(nchunks & 1) * 128 + tid];
  }
}

constexpr int D_ML_P = 32;
constexpr int D_AT_P = 2048;
constexpr int D_AT_S = 128;
constexpr int D_ML_S = 64;
constexpr int D_TOTAL = D_ML_P + D_AT_P + D_AT_S + D_ML_S;

__device__ __forceinline__ void phase_d0(const Params& p, char* smem) {
  for (int item = blockIdx.x; item < 1088; item += gridDim.x) {
    if (item < 1024) mlpre_task(p, item >> 7, (item >> 5) & 3, item & 31, smem);
    else mlpre_task(p, 8 + ((item - 1024) >> 2), item & 3, 0, smem);
  }
}
__device__ __forceinline__ void phase_d(const Params& p, char* smem, int cidx) {
  int* sTask = (int*)(smem + LDS_BYTES - 16);
  for (;;) {
    __syncthreads();
    if (threadIdx.x == 0) *sTask = (int)atomicAdd(p.counter + cidx, 1u);
    __syncthreads();
    int task = __builtin_amdgcn_readfirstlane(*sTask);
    if (task >= D_TOTAL + 656) break;
    if (task >= D_TOTAL) {
      weight_task(p, 352 + (task - D_TOTAL), smem);
      continue;
    }
    int kind, seq, h, qt = 0;
    if (task < D_ML_P) {
      kind = 0; seq = task >> 2; h = task & 3;
    } else if (task < D_ML_P + D_AT_P) {
      int t2 = task - D_ML_P;
      kind = 1; qt = 31 - (t2 >> 6); seq = (t2 & 63) >> 3; h = t2 & 7;
    } else if (task < D_ML_P + D_AT_P + D_AT_S) {
      int t2 = task - D_ML_P - D_AT_P;
      kind = 1; seq = 8 + (t2 >> 3); h = t2 & 7;
    } else {
      int t2 = task - D_ML_P - D_AT_P - D_AT_S;
      kind = 0; seq = 8 + (t2 >> 2); h = t2 & 3;
    }
    if (kind == 0) mlstm_task(p, seq, h, smem);
    else attn_task(p, seq, h, qt, smem);
  }
}

struct OrderE {
  __device__ __forceinline__ bool next(int i, pg8::Unit& u) const {
    const int b = blockIdx.x;
    if (i < 2) {
      const int xcd = b & 7, l = b >> 3;
      u.pm = xcd * 8 + (l >> 2);
      u.pn = l & 3;
    } else if (i < 4 && b < 16) {
      u.pm = 64 + (b >> 2);
      u.pn = b & 3;
    } else {
      return false;
    }
    u.ko = (i & 1) * 512;
    u.nt = 8;
    return true;
  }
  __device__ __forceinline__ void a_ready(const pg8::Unit&) const {}
  __device__ __forceinline__ void done(const pg8::Unit&) const {}
};
struct EpiE {
  static constexpr bool PERM = true, AFTER_DRAIN = false;
  const bf16_t* GA;
  const bf16_t* GB;
  bf16_t* MER;
  __device__ __forceinline__ void operator()(const f32x4 (&acc)[2][2][4][2], const pg8::Unit& u, int wr, int wc, int fr, int fq) const {
    const bool second = (u.ko != 0);
    const bf16_t* G = second ? GB : GA;
#pragma unroll
    for (int ai = 0; ai < 2; ++ai)
#pragma unroll
      for (int bj = 0; bj < 2; ++bj)
#pragma unroll
        for (int m = 0; m < 4; ++m) {
          const int row = u.pm * 256 + ai * 128 + wr * 64 + m * 16 + fr;
          const int c0 = u.pn * 256 + bj * 128 + wc * 32 + fq * 8;
          const uint4 gv = *(const uint4*)(G + (size_t)row * 1024 + c0);
          const unsigned gw[4] = {gv.x, gv.y, gv.z, gv.w};
          f32x4 o0 = acc[ai][bj][m][0], o1 = acc[ai][bj][m][1];
          o0[0] *= __uint_as_float(gw[0] << 16);
          o0[1] *= __uint_as_float(gw[0] & 0xffff0000u);
          o0[2] *= __uint_as_float(gw[1] << 16);
          o0[3] *= __uint_as_float(gw[1] & 0xffff0000u);
          o1[0] *= __uint_as_float(gw[2] << 16);
          o1[1] *= __uint_as_float(gw[2] & 0xffff0000u);
          o1[2] *= __uint_as_float(gw[3] << 16);
          o1[3] *= __uint_as_float(gw[3] & 0xffff0000u);
          bf16_t* mp = MER + (size_t)row * 1024 + c0;
          if (second) {
            const uint4 pv = *(const uint4*)mp;
            o0[0] += __uint_as_float(pv.x << 16);
            o0[1] += __uint_as_float(pv.x & 0xffff0000u);
            o0[2] += __uint_as_float(pv.y << 16);
            o0[3] += __uint_as_float(pv.y & 0xffff0000u);
            o1[0] += __uint_as_float(pv.z << 16);
            o1[1] += __uint_as_float(pv.z & 0xffff0000u);
            o1[2] += __uint_as_float(pv.w << 16);
            o1[3] += __uint_as_float(pv.w & 0xffff0000u);
          }
          *(uint4*)mp = pack8(o0, o1);
          if (m == 3) asm volatile("" ::: "memory");
        }
  }
};
__device__ __forceinline__ void phase_e(const Params& p, char* smem) {
  __syncthreads();
  pg8::Gemm g{p.YA, p.Wt_a, kT, 1024, 1024, 1024};
  OrderE S;
  EpiE E{p.GA, p.GB, p.MER};
  pg8::gemm_phase<EpiE, OrderE, false>((PG8_LAS unsigned char*)smem, g, S, E, nullptr);
}
struct OrderF {
  __device__ __forceinline__ bool next(int i, pg8::Unit& u) const {
    const int b = blockIdx.x;
    if (i == 0) {
      const int xcd = b & 7, l = b >> 3;
      u.pm = xcd * 8 + (l >> 2);
      u.pn = l & 3;
      u.ko = 0;
      u.nt = 16;
      return true;
    }
    if (i == 1 && b < 64) {
      const int t2 = b >> 2, kp = b & 3;
      u.pm = 64 + (t2 >> 2);
      u.pn = t2 & 3;
      u.ko = kp * 256;
      u.nt = 4;
      return true;
    }
    return false;
  }
  __device__ __forceinline__ void a_ready(const pg8::Unit&) const {}
  __device__ __forceinline__ void done(const pg8::Unit&) const {}
};
struct EpiF {
  static constexpr bool PERM = false, AFTER_DRAIN = false;
  const float* x_prompt;
  const float* x_sample;
  float* X1;
  float* SLAB;
  const float* modf;
  __device__ __forceinline__ void operator()(const f32x4 (&acc)[2][2][4][2], const pg8::Unit& u, int wr, int wc, int fr, int fq) const {
    const bool primary = (u.ko == 0);
    float* slab = SLAB + (size_t)(((u.pm - 64) * 4 + u.pn) * 3 + ((u.ko >> 8) - 1)) * 65536;
#pragma unroll
    for (int ai = 0; ai < 2; ++ai) {
      const int lr0 = ai * 128 + wr * 64 + fr;
      const int seq = seq_of(u.pm * 256 + ai * 128 + wr * 64);
#pragma unroll
      for (int bj = 0; bj < 2; ++bj)
#pragma unroll
        for (int n = 0; n < 2; ++n) {
          const int lc = bj * 128 + wc * 32 + n * 16 + fq * 4;
          const f32x4 g1 = *(const f32x4*)(modf + seq * 6144 + 2048 + u.pn * 256 + lc);
#pragma unroll
          for (int m = 0; m < 4; ++m) {
            const int lr = lr0 + m * 16;
            const f32x4 v = g1 * acc[ai][bj][m][n];
            if (primary) {
              const int row = u.pm * 256 + lr;
              const float* xr = (row < kNP ? x_prompt + (size_t)row * 1024 : x_sample + (size_t)(row - kNP) * 1024) + u.pn * 256 + lc;
              *(f32x4*)(X1 + (size_t)row * 1024 + u.pn * 256 + lc) = *(const f32x4*)xr + v;
            } else {
              *(f32x4*)(slab + lr * 256 + lc) = v;
            }
          }
          asm volatile("" ::: "memory");
        }
    }
  }
};
__device__ __forceinline__ void phase_f(const Params& p, char* smem) {
  __syncthreads();
  pg8::Gemm g{p.MER, p.Wt_out, kT, 1024, 1024};
  OrderF S;
  EpiF E{p.x_prompt, p.x_sample, p.X1, p.SLAB, p.modf};
  pg8::gemm_phase<EpiF, OrderF, false>((PG8_LAS unsigned char*)smem, g, S, E, nullptr);
}
__device__ __forceinline__ void phase_h(const Params& p, char* smem) {
  __syncthreads();
  pg8::Gemm g{p.U, p.Wt_gu, kT, 5632, 1024};
  pg8::StaticOrder S;
  S.init(kT, 5632, gridDim.x, blockIdx.x);
  EpiH E{p.HFF};
  pg8::gemm_phase<EpiH, pg8::StaticOrder, false>((PG8_LAS unsigned char*)smem, g, S, E, nullptr);
}
struct OrderI {
  __device__ __forceinline__ bool next(int i, pg8::Unit& u) const {
    const int b = blockIdx.x;
    if (i == 0) {
      const int xcd = b & 7, l = b >> 3;
      u.pm = xcd * 8 + (l >> 2);
      u.pn = l & 3;
      u.ko = 0;
      u.nt = 44;
      return true;
    }
    if (i == 1 && b < 176) {
      const int t2 = b / 11, kp = b - t2 * 11;
      u.pm = 64 + (t2 >> 2);
      u.pn = t2 & 3;
      u.ko = kp * 256;
      u.nt = 4;
      return true;
    }
    return false;
  }
  __device__ __forceinline__ void a_ready(const pg8::Unit&) const {}
  __device__ __forceinline__ void done(const pg8::Unit&) const {}
};
struct EpiI {
  static constexpr bool PERM = false, AFTER_DRAIN = false;
  float* X1;
  float* SLAB;
  const float* modf;
  __device__ __forceinline__ void operator()(const f32x4 (&acc)[2][2][4][2], const pg8::Unit& u, int wr, int wc, int fr, int fq) const {
    const bool primary = (u.nt == 44);
    float* slab = SLAB + (size_t)(((u.pm - 64) * 4 + u.pn) * 11 + (u.ko >> 8)) * 65536;
#pragma unroll
    for (int ai = 0; ai < 2; ++ai) {
      const int lr0 = ai * 128 + wr * 64 + fr;
      const int seq = seq_of(u.pm * 256 + ai * 128 + wr * 64);
#pragma unroll
      for (int bj = 0; bj < 2; ++bj)
#pragma unroll
        for (int n = 0; n < 2; ++n) {
          const int lc = bj * 128 + wc * 32 + n * 16 + fq * 4;
          const f32x4 g2 = *(const f32x4*)(modf + seq * 6144 + 5120 + u.pn * 256 + lc);
#pragma unroll
          for (int m = 0; m < 4; ++m) {
            const int lr = lr0 + m * 16;
            const f32x4 v = g2 * acc[ai][bj][m][n];
            if (primary) {
              float* px = X1 + (size_t)(u.pm * 256 + lr) * 1024 + u.pn * 256 + lc;
              *(f32x4*)px = *(const f32x4*)px + v;
            } else {
              *(f32x4*)(slab + lr * 256 + lc) = v;
            }
          }
          asm volatile("" ::: "memory");
        }
    }
  }
};
__device__ __forceinline__ void phase_i(const Params& p, char* smem) {
  __syncthreads();
  pg8::Gemm g{p.HFF, p.Wt_down, kT, 1024, 2816, 2816};
  OrderI S;
  EpiI E{p.X1, p.SLAB, p.modf};
  pg8::gemm_phase<EpiI, OrderI, false>((PG8_LAS unsigned char*)smem, g, S, E, nullptr);
}
__device__ __forceinline__ void phase_j(const Params& p) {
  const int tid = launder_tid(), lane = tid & 63, w = tid >> 6;
  for (int g = blockIdx.x * 8 + w; g < kT / 4; g += gridDim.x * 8) {
    float4 v[4][4];
#pragma unroll
    for (int i = 0; i < 4; i++)
#pragma unroll
      for (int j = 0; j < 4; j++) {
        const int row = g * 4 + i;
        v[i][j] = *(const float4*)(p.X1 + (size_t)row * 1024 + j * 256 + lane * 4);
        if (row >= kNP) {
          const float* sl = p.SLAB + (size_t)((((row - kNP) >> 8) * 4 + j) * 11) * 65536 + (row & 255) * 256 + lane * 4;
#pragma unroll
          for (int kp = 0; kp < 11; kp++) {
            const float4 e = *(const float4*)(sl + (size_t)kp * 65536);
            v[i][j].x += e.x;
            v[i][j].y += e.y;
            v[i][j].z += e.z;
            v[i][j].w += e.w;
          }
        }
      }
#pragma unroll
    for (int i = 0; i < 4; i++) {
      const int row = g * 4 + i;
      float ss = 0.f;
#pragma unroll
      for (int j = 0; j < 4; j++)
        ss += v[i][j].x * v[i][j].x + v[i][j].y * v[i][j].y + v[i][j].z * v[i][j].z + v[i][j].w * v[i][j].w;
      ss = wave_sum(ss);
      float rstd = rsqrtf(ss * (1.0f / 1024.0f) + 1e-6f);
      float* o = p.out + (row < kNP ? O_YP + (size_t)row * 1024 : O_YS + (size_t)(row - kNP) * 1024);
#pragma unroll
      for (int j = 0; j < 4; j++) {
        int c = j * 256 + lane * 4;
        float4 gg = *(const float4*)(p.final_g + c);
        float4 r4;
        r4.x = v[i][j].x * rstd * gg.x;
        r4.y = v[i][j].y * rstd * gg.y;
        r4.z = v[i][j].z * rstd * gg.z;
        r4.w = v[i][j].w * rstd * gg.w;
        *(float4*)(o + c) = r4;
      }
    }
  }
}

#define XB_TMO      128
#define XB_XCNT(j)  (256  + 64 * (j))
#define XB_XSUB(j)  (1280 + 64 * (j))
#define XB_XGEN(j)  (2304 + 64 * (j))
#define XB_TOP      3328
#define XB_TOPGEN   3392
#define XCD_BAR_WORDS 3456
#define XB_SPIN_CAP (1u << 18)
#define LAS __attribute__((address_space(3)))

__device__ __forceinline__ unsigned xb_ld(unsigned* p)              { return __hip_atomic_load(p, __ATOMIC_RELAXED, __HIP_MEMORY_SCOPE_AGENT); }
__device__ __forceinline__ unsigned xb_add(unsigned* p, unsigned v) { return __hip_atomic_fetch_add(p, v, __ATOMIC_RELAXED, __HIP_MEMORY_SCOPE_AGENT); }
__device__ __forceinline__ unsigned xb_xcc_id() { return (unsigned)__builtin_amdgcn_s_getreg((3 << 11) | 20) & 0xFu; }
#define XB_SPIN(cond, bar) do { unsigned _sp = 0; while (cond) { __builtin_amdgcn_s_sleep(1); \
    if ((++_sp & 255u) == 0u) { if (xb_ld(&(bar)[XB_TMO])) break; if (_sp > XB_SPIN_CAP) { atomicAdd(&(bar)[XB_TMO], 1u); break; } } } } while (0)

struct XcdBarrier {
    unsigned* bar; unsigned x;
    volatile LAS unsigned* st;
};

__device__ __forceinline__ XcdBarrier xcd_barrier_post(unsigned* bar, volatile LAS unsigned* st) {
    XcdBarrier b; b.bar = bar; b.x = xb_xcc_id(); b.st = st;
    if (threadIdx.x == 0) (void)xb_add(&bar[XB_XCNT(b.x)], 1u);
    return b;
}
__device__ __forceinline__ void xcd_barrier_complete(unsigned* bar, unsigned x, unsigned& nloc, unsigned& nx) {
    const unsigned G = gridDim.x * gridDim.y * gridDim.z;
    unsigned sum, cnt, mine, sp = 0u;
    for (;;) {
        sum = 0u; cnt = 0u; mine = 0u;
#pragma unroll
        for (unsigned j = 0; j < 16; ++j) { const unsigned c = xb_ld(&bar[XB_XCNT(j)]); sum += c; cnt += (c > 0u) ? 1u : 0u; mine = (j == x) ? c : mine; }
        if (sum == G) break;
        __builtin_amdgcn_s_sleep(1);
        if ((++sp & 255u) == 0u) { if (xb_ld(&bar[XB_TMO])) break; if (sp > XB_SPIN_CAP) { atomicAdd(&bar[XB_TMO], 1u); break; } }
    }
    nloc = mine > 0u ? mine : 1u; nx = cnt > 0u ? cnt : 1u;
}

__device__ __forceinline__ void xcd_barrier(const XcdBarrier& b) {
    asm volatile("s_waitcnt vmcnt(0)" ::: "memory");
    __syncthreads();
    if (threadIdx.x == 0) {
        unsigned* bar = b.bar;
        __builtin_amdgcn_s_waitcnt(0);
        unsigned nloc = b.st[0], nx = b.st[1];
        if (nloc == 0u) { xcd_barrier_complete(bar, b.x, nloc, nx); b.st[0] = nloc; b.st[1] = nx; }
        const unsigned old = xb_add(&bar[XB_XSUB(b.x)], 1u);
        const unsigned gen = old / nloc;
        if (old + 1u == (gen + 1u) * nloc) {
            __builtin_amdgcn_fence(__ATOMIC_RELEASE, "agent");
            asm volatile("s_waitcnt vmcnt(0)" ::: "memory");
            const unsigned og = xb_add(&bar[XB_TOP], 1u);
            const unsigned tg = og / nx;
            if (og + 1u == (tg + 1u) * nx) xb_add(&bar[XB_TOPGEN], 1u);
            else XB_SPIN(xb_ld(&bar[XB_TOPGEN]) == tg, bar);
            __builtin_amdgcn_fence(__ATOMIC_ACQUIRE, "agent");
            xb_add(&bar[XB_XGEN(b.x)], 1u);
            asm volatile("s_waitcnt vmcnt(0)" ::: "memory");
        } else {
            XB_SPIN(xb_ld(&bar[XB_XGEN(b.x)]) == gen, bar);
            __builtin_amdgcn_fence(__ATOMIC_ACQUIRE, "agent");
            asm volatile("s_waitcnt vmcnt(0)" ::: "memory");
        }
    }
    __syncthreads();
}


extern __shared__ __attribute__((aligned(16))) char dyn_smem[];

#ifndef REP_A
#define REP_A 1
#endif
#ifndef REP_C
#define REP_C 1
#endif
#ifndef REP_D
#define REP_D 1
#endif
#ifndef REP_H
#define REP_H 1
#endif
#ifndef REP_E
#define REP_E 1
#endif
__global__ void __launch_bounds__(NTHREADS) mega_kernel(Params p) {
  cg::grid_group grid = cg::this_grid();
  volatile LAS unsigned* xst = (volatile LAS unsigned*)(dyn_smem + LDS_BYTES - 32);
  if (threadIdx.x < 4) xst[threadIdx.x] = 0u;
  __syncthreads();
  XcdBarrier xb = xcd_barrier_post(p.bar, xst);
  if (p.bar == nullptr) grid.sync();
#pragma unroll 1
  for (int r = 0; r < REP_A; r++) {
    phase_a(p, dyn_smem);
    xcd_barrier(xb);
  }
  phase_b(p, dyn_smem);
  xcd_barrier(xb);
#pragma unroll 1
  for (int r = 0; r < REP_C; r++) {
    phase_c(p, dyn_smem);
    xcd_barrier(xb);
  }
  phase_d0(p, dyn_smem);
  xcd_barrier(xb);
#pragma unroll 1
  for (int r = 0; r < REP_D; r++) {
    phase_d(p, dyn_smem, r);
    xcd_barrier(xb);
  }
#pragma unroll 1
  for (int r = 0; r < REP_E; r++) {
    phase_e(p, dyn_smem);
    xcd_barrier(xb);
  }
  phase_f(p, dyn_smem);
  xcd_barrier(xb);
  phase_g(p, dyn_smem);
  xcd_barrier(xb);
#pragma unroll 1
  for (int r = 0; r < REP_H; r++) {
    phase_h(p, dyn_smem);
    xcd_barrier(xb);
  }
  phase_i(p, dyn_smem);
  xcd_barrier(xb);
  phase_j(p);
}
extern "C" void kernel_launch(void* const* d_in, const int* in_sizes, int n_in, void* d_out, int out_size, void* d_ws,
                              size_t ws_size, hipStream_t stream) {
  Params p{};
  const float** pin = (const float**)&p;
  for (int i = 0; i < 26; i++) pin[i] = (const float*)d_in[i];
  p.out = (float*)d_out;
  char* ws = (char*)d_ws;
  size_t off = 0;
  auto alloc = [&](size_t bytes) {
    char* r = ws + off;
    off += (bytes + 255) & ~(size_t)255;
    return r;
  };
  p.Wt_in = (bf16_t*)alloc((size_t)5632 * 1024 * 2);
  p.Wt_a = (bf16_t*)alloc((size_t)1024 * 1024 * 2);
  p.Wt_b = p.Wt_a;
  p.Wt_out = (bf16_t*)alloc((size_t)1024 * 1024 * 2);
  p.Wt_gu = (bf16_t*)alloc((size_t)5632 * 1024 * 2);
  p.Wt_down = (bf16_t*)alloc((size_t)1024 * 2816 * 2);
  p.modp = (float*)alloc((size_t)8 * 24 * 6144 * 4);
  p.modf = (float*)alloc((size_t)24 * 6144 * 4);
  p.U = (bf16_t*)alloc((size_t)kT * 1024 * 2);
  char* r1 = ws + off;
  p.Qb = (bf16_t*)alloc((size_t)kT * 512 * 2);
  p.Kp = (bf16_t*)alloc((size_t)64 * 2048 * 64 * 2);
  p.Ks = (bf16_t*)alloc((size_t)128 * 1152 * 64 * 2);
  p.VTp = (bf16_t*)alloc((size_t)64 * 64 * 2048 * 2);
  p.VTs = (bf16_t*)alloc((size_t)128 * 64 * 1152 * 2);
  p.MQK = (bf16_t*)alloc((size_t)kT * 1024 * 2);
  const size_t r1_bytes = (size_t)(ws + off - r1);
  char* r2 = ws + off;
  p.MVTp = (bf16_t*)alloc((size_t)32 * 128 * 2048 * 2);
  p.MVTs = (bf16_t*)alloc((size_t)64 * 128 * 64 * 2);
  p.SO = (bf16_t*)alloc((size_t)kT * 512 * 2);
  const size_t r2_bytes = (size_t)(ws + off - r2);
  char* r3 = ws + off;
  p.GA = (bf16_t*)alloc((size_t)kT * 1024 * 2);
  p.GB = (bf16_t*)alloc((size_t)kT * 1024 * 2);
  const size_t r3_bytes = (size_t)(ws + off - r3);
  p.GI = (float*)alloc((size_t)kT * 4 * 4);
  p.LF = (float*)alloc((size_t)kT * 4 * 4);
  p.GV = (float*)alloc((size_t)1088 * 384 * 4);
  p.DENc = (float*)alloc((size_t)1088 * 64 * 4);
  char* r4 = ws + off;
  p.Qc = (bf16_t*)alloc((size_t)1088 * 8192 * 2);
  p.KTc = (bf16_t*)alloc((size_t)1088 * 8192 * 2);
  p.SWc = (bf16_t*)alloc((size_t)1088 * 4096 * 2);
  p.YA = (bf16_t*)alloc((size_t)kT * 1024 * 2);
  p.YB = p.YA;
  const size_t r4_bytes = (size_t)(ws + off - r4);
  p.counter = (unsigned*)alloc(256);
  p.bar = (unsigned*)alloc(XCD_BAR_WORDS * 4);
  p.HFF = (bf16_t*)r1;
  p.MER = (bf16_t*)r2;
  p.X1 = (float*)r4;
  p.SLAB = (float*)r3;
  if (r1_bytes < (size_t)kT * 2816 * 2 || r2_bytes < (size_t)kT * 1024 * 2 ||
      r4_bytes < (size_t)kT * 1024 * 4 || r3_bytes < (size_t)176 * 65536 * 4 || off > ws_size) {
    fprintf(stderr, "workspace layout error: need %zu bytes, have %zu\n", off, ws_size);
    return;
  }

#if ONE_LAUNCH
  static int grid_blocks = 0;
  if (!grid_blocks) {
    int dev = 0, cus = 0, per_cu = 0;
    hipGetDevice(&dev);
    hipDeviceGetAttribute(&cus, hipDeviceAttributeMultiprocessorCount, dev);
    hipFuncSetAttribute((const void*)mega_kernel, hipFuncAttributeMaxDynamicSharedMemorySize, LDS_BYTES);
    hipOccupancyMaxActiveBlocksPerMultiprocessor(&per_cu, mega_kernel, NTHREADS, LDS_BYTES);
    if (per_cu < 1) per_cu = 1;
    grid_blocks = cus * per_cu;
    if (grid_blocks > 256) grid_blocks = 256;
  }
  (void)hipMemsetAsync(p.bar, 0, XCD_BAR_WORDS * 4, stream);
  if (grid_blocks != 256) {
    fprintf(stderr, "unexpected co-resident grid %d (phase I is laid out for 256 workgroups)\n", grid_blocks);
    return;
  }
  void* args[] = {&p};
  hipError_t e = hipLaunchCooperativeKernel((void*)mega_kernel, dim3(grid_blocks), dim3(NTHREADS), args, LDS_BYTES, stream);
  if (e != hipSuccess) fprintf(stderr, "cooperative launch failed: %s (grid %d)\n", hipGetErrorString(e), grid_blocks);
#endif
}
```

```cpp
#include <hip/hip_runtime.h>
#include <hip/hip_cooperative_groups.h>
#include <stdint.h>
#include <stdio.h>
namespace cg = cooperative_groups;

#ifndef ONE_LAUNCH
#define ONE_LAUNCH 1
#endif

typedef unsigned short bf16_t;
using bf16x8 = __attribute__((ext_vector_type(8))) short;
using f32x4 = __attribute__((ext_vector_type(4))) float;

#define NTHREADS 512
#define LDS_BYTES 155648
constexpr int kNP = 16384;
constexpr int kT = 17408;
constexpr int kINW = 5640;

struct Params {
  const float *x_prompt, *x_sample, *c_prompt, *c_sample, *cache_k, *cache_v, *st_C, *st_n, *st_m, *st_conv;
  const float *norm1_g, *norm2_g, *w_ada, *b_ada, *w_in, *b_if, *w_conv, *b_conv, *ml_norm_g, *w_a, *w_b, *w_out,
      *w_gate, *w_up, *w_down, *final_g;
  float* out;
  bf16_t *Wt_in, *Wt_a, *Wt_b, *Wt_out, *Wt_gu, *Wt_down;
  float *modp, *modf;
  bf16_t *U, *Qb, *Kp, *Ks, *VTp, *VTs, *MQK, *MVTp, *MVTs, *SO, *GA, *GB;
  float *GI, *LF, *GV, *DENc;
  bf16_t *Qc, *KTc, *SWc;
  bf16_t *YA, *YB, *MER;
  bf16_t* X1;
  float* SLAB;
  bf16_t* HFF;
  unsigned* counter;
  unsigned* bar;
};

constexpr size_t O_YP = 0;
constexpr size_t O_YS = O_YP + 16777216;
constexpr size_t O_KP = O_YS + 1048576;
constexpr size_t O_VP = O_KP + 8388608;
constexpr size_t O_CP = O_VP + 8388608;
constexpr size_t O_NP = O_CP + 524288;
constexpr size_t O_MP = O_NP + 4096;
constexpr size_t O_CVP = O_MP + 32;
constexpr size_t O_KS = O_CVP + 24576;
constexpr size_t O_VS = O_KS + 524288;
constexpr size_t O_CS = O_VS + 524288;
constexpr size_t O_NS = O_CS + 1048576;
constexpr size_t O_MS = O_NS + 8192;
constexpr size_t O_CVS = O_MS + 64;

typedef __bf16 hwbf16x2_t __attribute__((ext_vector_type(2)));
typedef float hwf32x2_t __attribute__((ext_vector_type(2)));
__device__ __forceinline__ bf16_t f2bf(float f) {
  __bf16 r = (__bf16)f;
  return __builtin_bit_cast(unsigned short, r);
}
__device__ __forceinline__ float bf2f(bf16_t h) { return __uint_as_float(((unsigned)h) << 16); }
__device__ __forceinline__ unsigned pack2(float a, float b) {
  hwf32x2_t v = {a, b};
  hwbf16x2_t r = __builtin_convertvector(v, hwbf16x2_t);
  return __builtin_bit_cast(unsigned, r);
}
__device__ __forceinline__ float4 ldbf4(const bf16_t* p_) {
  const uint2 u = *(const uint2*)p_;
  return make_float4(__uint_as_float(u.x << 16), __uint_as_float(u.x & 0xffff0000u), __uint_as_float(u.y << 16),
                     __uint_as_float(u.y & 0xffff0000u));
}
__device__ __forceinline__ void stbf4(bf16_t* p_, const float4& v) {
  uint2 u;
  u.x = pack2(v.x, v.y);
  u.y = pack2(v.z, v.w);
  *(uint2*)p_ = u;
}
__device__ __forceinline__ float sigm(float x) { return __builtin_amdgcn_rcpf(1.0f + __expf(-x)); }
__device__ __forceinline__ float silu(float x) { return x * __builtin_amdgcn_rcpf(1.0f + __expf(-x)); }
__device__ __forceinline__ float logsig(float x) { return fminf(x, 0.f) - __logf(1.0f + __expf(-fabsf(x))); }
__device__ __forceinline__ float wave_max(float v) {
#pragma unroll
  for (int o = 32; o > 0; o >>= 1) v = fmaxf(v, __shfl_xor(v, o));
  return v;
}
#define DPP_ADD(v, ctrl) v += __int_as_float(__builtin_amdgcn_update_dpp(0, __float_as_int(v), ctrl, 0xF, 0xF, true))
__device__ __forceinline__ float row16_sum(float v) {
  DPP_ADD(v, 0xB1);
  DPP_ADD(v, 0x4E);
  DPP_ADD(v, 0x124);
  DPP_ADD(v, 0x128);
  return v;
}
__device__ __forceinline__ float half8_sum(float v) {
  DPP_ADD(v, 0xB1);
  DPP_ADD(v, 0x4E);
  DPP_ADD(v, 0x141);
  return v;
}
__device__ __forceinline__ float wave_sum(float v) {
  v = row16_sum(v);
  v += __shfl_xor(v, 16);
  v += __shfl_xor(v, 32);
  return v;
}
__device__ __forceinline__ int seq_of(int row) { return row < kNP ? (row >> 11) : 8 + ((row - kNP) >> 6); }
__device__ __forceinline__ const float* xrow(const Params& p, int row) {
  return row < kNP ? p.x_prompt + (size_t)row * 1024 : p.x_sample + (size_t)(row - kNP) * 1024;
}
__device__ __forceinline__ int launder_tid() {
  int t = threadIdx.x;
  asm volatile("" : "+v"(t));
  return t;
}
__device__ __forceinline__ bf16x8 lds8(const void* p) { return *(const bf16x8*)p; }
#define MFMA(a, b, c) __builtin_amdgcn_mfma_f32_16x16x32_bf16(a, b, c, 0, 0, 0)

namespace pg8 {
#define PG8_LAS __attribute__((address_space(3)))
typedef unsigned short bf16_t;
typedef short bf16x8 __attribute__((ext_vector_type(8)));
typedef float f32x4 __attribute__((ext_vector_type(4)));
typedef unsigned u32x4 __attribute__((ext_vector_type(4)));
constexpr int BM = 256, BK = 64, HALF = 128, HTB = HALF * BK * 2  , STAGE_BYTES = 8 * HTB, NXCD = 8, WGM = 8;

__host__ __device__ __forceinline__ int lds_byte(int r, int c) { const int st = (r >> 4) * 2 + (c >> 5), rr = r & 15, cc = c & 31, ob = rr * 64 + cc * 2; return st * 1024 + (ob ^ (((ob >> 9) & 1) << 5)); }
__host__ __device__ __forceinline__ void stage_rc(int b, int& R, int& C) { const int st = b / 1024, sb = b % 1024, swz = sb ^ (((sb >> 9) & 1) << 5); R = (st >> 1) * 16 + swz / 64; C = (st & 1) * 32 + (swz % 64) / 2; }
__host__ __device__ __forceinline__ int perm32(int rho) { const int n = rho >> 4, i = rho & 15; return 8 * (i >> 2) + 4 * n + (i & 3); }

struct Unit { int pm, pn; int ko = 0, nt = 0; };
struct Gemm { const bf16_t* A; const bf16_t* Bt; int M, N, K; int ld = 0; };

struct StaticOrder {
    int nM, nN, nwg, G, c;
    __host__ __device__ void init(int M, int N, int G_, int c_) { nM = M / BM; nN = N / BM; nwg = nM * nN; G = G_; c = c_; }
    __host__ __device__ bool next(int i, Unit& u) const {
        const long L = (long)i * G + c; if (L >= nwg) return false;
        int wgid = (int)L; { const int q = nwg / NXCD, r = nwg % NXCD, xcd = wgid % NXCD, off = wgid / NXCD; wgid = (xcd < r ? xcd * (q + 1) : r * (q + 1) + (xcd - r) * q) + off; }
        const int nig = WGM * nN, gid = wgid / nig, fm = gid * WGM, gsz = (nM - fm) < WGM ? (nM - fm) : WGM;
        u.pm = fm + ((wgid % nig) % gsz); u.pn = (wgid % nig) / gsz; return true;
    }
    __device__ __forceinline__ void a_ready(const Unit&) const {}
    __device__ __forceinline__ void done(const Unit&) const {}
};
__device__ __forceinline__ unsigned cvt_pk_bf16(float lo, float hi) { unsigned r; asm volatile("v_cvt_pk_bf16_f32 %0, %1, %2" : "=v"(r) : "v"(lo), "v"(hi)); return r; }
template <class Epi, class Sched, bool STAMP = false>
__device__ __forceinline__ void gemm_phase(PG8_LAS unsigned char* lds, const Gemm g, const Sched& S, const Epi& E, unsigned long long* stamps) {
    const int tid = launder_tid(), wid = __builtin_amdgcn_readfirstlane(tid >> 6), lane = tid & 63, wr = wid >> 2, wc = wid & 3, fr = lane & 15, fq = lane >> 4;
    const int K = g.K, nt = K / BK, ld = g.ld ? g.ld : K;
    int ts_lo = 0, ts_hi = 0, nts = 0; const unsigned long long rt_entry = STAMP ? (unsigned long long)wall_clock64() : 0ull;
#define PG8_STAMP() do { if (STAMP && wid == 0 && nts < 64) { const unsigned long long _c = (unsigned long long)clock64(); \
        ts_lo = (lane == nts) ? (int)(unsigned)_c : ts_lo; ts_hi = (lane == nts) ? (int)(unsigned)(_c >> 32) : ts_hi; ++nts; } } while (0)
    PG8_STAMP();
    unsigned voffA[2], voffB[2];
#pragma unroll
    for (int i = 0; i < 2; ++i) { int R, C; stage_rc(tid * 16 + i * 8192, R, C); const int Rb = Epi::PERM ? ((R & ~31) + perm32(R & 31)) : R;
        voffA[i] = (unsigned)(R * ld + C) * 2u; voffB[i] = (unsigned)(Rb * ld + C) * 2u; }
    const size_t kstep = (size_t)(BK * 2);
    const size_t hstep = (size_t)HALF * ld * 2;
    const size_t tstep = 2 * hstep;
    const unsigned ldsw = (unsigned)wid * 1024u;
    const int aoff = lds_byte(wr * 64 + fr, fq * 8), boff = lds_byte(wc * 32 + fr, fq * 8);
#define PG8_SA(b, h) (((b) * 2 + (h)) * HTB)
#define PG8_SB(b, h) ((4 + (b) * 2 + (h)) * HTB)
#define PG8_STAGE(bufoff, gbase, voff) do { _Pragma("unroll") for (int _i = 0; _i < 2; ++_i) \
        __builtin_amdgcn_global_load_lds((const unsigned*)((const char*)(gbase) + (voff)[_i]), (PG8_LAS unsigned*)(lds + (bufoff) + ldsw + _i * 8192), 16, 0, 0); } while (0)
#define PG8_LDA(dst, b, h) do { _Pragma("unroll") for (int m = 0; m < 4; ++m) _Pragma("unroll") for (int k = 0; k < 2; ++k) dst[m][k] = *(const PG8_LAS bf16x8*)(lds + PG8_SA(b, h) + aoff + m * 2048 + k * 1024); } while (0)
#define PG8_LDB(dst, b, h) do { _Pragma("unroll") for (int n = 0; n < 2; ++n) _Pragma("unroll") for (int k = 0; k < 2; ++k) dst[n][k] = *(const PG8_LAS bf16x8*)(lds + PG8_SB(b, h) + boff + n * 2048 + k * 1024); } while (0)
#define PG8_MMA(ai, bj, At, Bt) do { __builtin_amdgcn_s_setprio(1); _Pragma("unroll") for (int m = 0; m < 4; ++m) _Pragma("unroll") for (int n = 0; n < 2; ++n) _Pragma("unroll") for (int k = 0; k < 2; ++k) \
        acc[ai][bj][m][n] = __builtin_amdgcn_mfma_f32_16x16x32_bf16(Bt[n][k], At[m][k], acc[ai][bj][m][n], 0, 0, 0); __builtin_amdgcn_s_setprio(0); } while (0)
#define PG8_WAIT_V(n) asm volatile("s_waitcnt vmcnt(" #n ")" ::: "memory")
#define PG8_WAIT_L(n) asm volatile("s_waitcnt lgkmcnt(" #n ")" ::: "memory")
#define PG8_BAR __builtin_amdgcn_s_barrier()
#define PG8_SCHED __builtin_amdgcn_sched_barrier(0)
    Unit cur, nxt; int ui = 0;
    if (!S.next(0, cur)) return;
    f32x4 acc[2][2][4][2];
#pragma unroll
    for (int a = 0; a < 2; ++a)
#pragma unroll
        for (int b = 0; b < 2; ++b)
#pragma unroll
            for (int m = 0; m < 4; ++m)
#pragma unroll
                for (int n = 0; n < 2; ++n) acc[a][b][m][n] = (f32x4){0.f, 0.f, 0.f, 0.f};
    bf16x8 At[4][2], B0[2][2], B1[2][2];
    const char* cA = (const char*)g.A + (size_t)cur.pm * tstep + (size_t)cur.ko * 2; const char* cB = (const char*)g.Bt + (size_t)cur.pn * tstep + (size_t)cur.ko * 2;
    S.a_ready(cur);
    PG8_STAGE(PG8_SB(0, 0), cB, voffB); PG8_STAGE(PG8_SA(0, 0), cA, voffA); PG8_STAGE(PG8_SB(0, 1), cB + hstep, voffB); PG8_STAGE(PG8_SA(0, 1), cA + hstep, voffA);
    if (wr == 1) PG8_BAR;
    PG8_WAIT_V(4); PG8_BAR;
    PG8_STAGE(PG8_SB(1, 0), cB + kstep, voffB); PG8_STAGE(PG8_SA(1, 0), cA + kstep, voffA); PG8_STAGE(PG8_SB(1, 1), cB + hstep + kstep, voffB);
    PG8_WAIT_V(6); PG8_BAR;
    PG8_STAMP();
    for (;;) {
        const bool has_next = S.next(ui + 1, nxt);
        const char* nA = has_next ? (const char*)g.A + (size_t)nxt.pm * tstep + (size_t)nxt.ko * 2 : cA; const char* nB = has_next ? (const char*)g.Bt + (size_t)nxt.pn * tstep + (size_t)nxt.ko * 2 : cB;
        const int unt = cur.nt ? cur.nt : nt;
        for (int t = 0; t < unt; t += 2) {
            const bool last = (t == unt - 2);
            const char* a1 = cA + (size_t)(t + 1) * kstep;
            const char* a2 = last ? nA : cA + (size_t)(t + 2) * kstep; const char* b2 = last ? nB : cB + (size_t)(t + 2) * kstep;
            const char* a3 = a2 + kstep; const char* b3 = b2 + kstep;
            if (last && has_next) S.a_ready(nxt);
            PG8_LDB(B0, 0, 0); PG8_SCHED; PG8_LDA(At, 0, 0); PG8_STAGE(PG8_SA(1, 1), a1 + hstep, voffA);
            PG8_WAIT_L(8); PG8_BAR; PG8_WAIT_L(0); PG8_MMA(0, 0, At, B0); PG8_BAR; PG8_SCHED;
            PG8_LDB(B1, 0, 1); PG8_STAGE(PG8_SB(0, 0), b2, voffB);
            PG8_BAR; PG8_WAIT_L(0); PG8_MMA(0, 1, At, B1); PG8_BAR;
            PG8_LDA(At, 0, 1); PG8_STAGE(PG8_SA(0, 0), a2, voffA);
            PG8_BAR; PG8_WAIT_L(0); PG8_MMA(1, 0, At, B0); PG8_BAR; PG8_SCHED;
            PG8_STAGE(PG8_SB(0, 1), b2 + hstep, voffB);
            PG8_WAIT_V(6); PG8_BAR; PG8_MMA(1, 1, At, B1); PG8_BAR;
            PG8_LDB(B0, 1, 0); PG8_SCHED; PG8_LDA(At, 1, 0); PG8_STAGE(PG8_SA(0, 1), a2 + hstep, voffA);
            PG8_WAIT_L(8); PG8_BAR; PG8_WAIT_L(0); PG8_MMA(0, 0, At, B0); PG8_BAR; PG8_SCHED;
            PG8_LDB(B1, 1, 1); PG8_STAGE(PG8_SB(1, 0), b3, voffB);
            PG8_BAR; PG8_WAIT_L(0); PG8_MMA(0, 1, At, B1); PG8_BAR;
            PG8_LDA(At, 1, 1); PG8_STAGE(PG8_SA(1, 0), a3, voffA);
            PG8_BAR; PG8_WAIT_L(0); PG8_MMA(1, 0, At, B0); PG8_BAR; PG8_SCHED;
            PG8_STAGE(PG8_SB(1, 1), b3 + hstep, voffB);
            PG8_WAIT_V(6); PG8_BAR; PG8_MMA(1, 1, At, B1); PG8_BAR;
        }
        PG8_STAMP();
        if constexpr (!Epi::AFTER_DRAIN) { E(acc, cur, wr, wc, fr, fq); S.done(cur); }
        PG8_STAMP();
        if (!has_next) break;
#pragma unroll
        for (int a = 0; a < 2; ++a)
#pragma unroll
            for (int b = 0; b < 2; ++b)
#pragma unroll
                for (int m = 0; m < 4; ++m)
#pragma unroll
                    for (int n = 0; n < 2; ++n) acc[a][b][m][n] = (f32x4){0.f, 0.f, 0.f, 0.f};
        cur = nxt; cA = nA; cB = nB; ++ui;
    }
    PG8_WAIT_V(0);
    if (wr == 0) PG8_BAR;
    PG8_BAR;
    if constexpr (Epi::AFTER_DRAIN) { E.fused(acc, cur, wr, wc, fr, fq, lds, wid, lane); S.done(cur); }
    PG8_STAMP();
    if (STAMP && wid == 0) { stamps[lane] = lane < nts ? (((unsigned long long)(unsigned)ts_hi << 32) | (unsigned)ts_lo) : 0ull;
        if (lane == 62) stamps[62] = rt_entry; if (lane == 63) stamps[63] = (unsigned long long)wall_clock64(); }
#undef PG8_STAMP
#undef PG8_SA
#undef PG8_SB
#undef PG8_STAGE
#undef PG8_LDA
#undef PG8_LDB
#undef PG8_MMA
#undef PG8_WAIT_V
#undef PG8_WAIT_L
#undef PG8_BAR
#undef PG8_SCHED
}
}

__device__ __forceinline__ void transpose_quad(const float* __restrict__ src, int lds_, size_t sstep, bf16_t* __restrict__ dst, int ldd,
                               int k0, int kstep, int nbase, int nstep, int mode, char* smem) {
  float* tl = (float*)smem;
  const int tid = launder_tid();
  float4 v[4][2];
#pragma unroll
  for (int q = 0; q < 4; q++)
#pragma unroll
    for (int i = 0; i < 2; i++) {
      int idx = tid + i * 512;
      int k = idx >> 4, n4 = (idx & 15) * 4;
      v[q][i] = *(const float4*)(src + q * sstep + (size_t)k * lds_ + n4);
    }
  __syncthreads();
#pragma unroll
  for (int q = 0; q < 4; q++)
#pragma unroll
    for (int i = 0; i < 2; i++) {
      int idx = tid + i * 512;
      int k = idx >> 4, n4 = (idx & 15) * 4;
      float* t = tl + q * 4160 + k * 65 + n4;
      t[0] = v[q][i].x;
      t[1] = v[q][i].y;
      t[2] = v[q][i].z;
      t[3] = v[q][i].w;
    }
  __syncthreads();
  const int n = tid >> 3, kc = (tid & 7) * 8;
#pragma unroll
  for (int q = 0; q < 4; q++) {
    float o[8];
#pragma unroll
    for (int e = 0; e < 8; e++) o[e] = tl[q * 4160 + (kc + e) * 65 + n];
    const int nb = (mode == 2) ? nbase + (q >> 1) * 256 + (q & 1) * 64 : nbase + q * nstep;
    const int nrow = (mode != 1) ? (nb + n) : (nb + (n >> 5) * 64 + (n & 31));
    uint4 pk = {pack2(o[0], o[1]), pack2(o[2], o[3]), pack2(o[4], o[5]), pack2(o[6], o[7])};
    *(uint4*)(dst + (size_t)nrow * ldd + k0 + q * kstep + kc) = pk;
  }
}

__device__ __forceinline__ void weight_task(const Params& p, int id, char* smem) {
  const float* src;
  bf16_t* dst;
  int lds_, ldd, k0, nbase, nstep = 64, mode = 0;
  if (id < 352) {
    int kt = id / 22, nq = id % 22;
    int scol = nq < 14 ? nq * 256 : 3592 + (nq - 14) * 256;
    nbase = nq < 14 ? nq * 256 : 3584 + (nq - 14) * 256;
    src = p.w_in + (size_t)kt * 64 * kINW + scol; lds_ = kINW; dst = p.Wt_in; ldd = 1024; k0 = kt * 64;
  } else if (id < 384) {
    int i2 = id - 352, kt = i2 / 4, nq = i2 % 4;
    src = p.w_a + (size_t)kt * 64 * 1024 + nq * 256; lds_ = 1024; dst = p.Wt_a; ldd = 1024; k0 = kt * 64; nbase = nq * 256;
  } else if (id < 416) {
    int i2 = id - 384, kt = i2 / 4, nq = i2 % 4;
    src = p.w_b + (size_t)kt * 64 * 1024 + nq * 256; lds_ = 1024; dst = p.Wt_a; ldd = 1024; k0 = 512 + kt * 64; nbase = nq * 256;
  } else if (id < 480) {
    int i2 = id - 416, kt = i2 / 4, nq = i2 % 4;
    src = p.w_out + (size_t)kt * 64 * 1024 + nq * 256; lds_ = 1024; dst = p.Wt_out; ldd = 1024; k0 = kt * 64; nbase = nq * 256;
  } else if (id < 656) {
    int i2 = id - 480, kt = i2 / 11, nq = i2 % 11;
    src = p.w_gate + (size_t)kt * 64 * 2816 + nq * 256; lds_ = 2816; dst = p.Wt_gu; ldd = 1024; k0 = kt * 64; nbase = nq * 512; nstep = 0; mode = 2;
  } else if (id < 832) {
    int i2 = id - 656, kt = i2 / 11, nq = i2 % 11;
    src = p.w_up + (size_t)kt * 64 * 2816 + nq * 256; lds_ = 2816; dst = p.Wt_gu; ldd = 1024; k0 = kt * 64; nbase = nq * 512 + 128; nstep = 0; mode = 2;
  } else {
    int i2 = id - 832, kt = i2 / 4, nq = i2 % 4;
    src = p.w_down + (size_t)kt * 64 * 1024 + nq * 256; lds_ = 1024; dst = p.Wt_down; ldd = 2816; k0 = kt * 64; nbase = nq * 256;
  }
  transpose_quad(src, lds_, 64, dst, ldd, k0, 0, nbase, nstep, mode, smem);
}

constexpr int A_MOD = 96;
constexpr int A_WT = 352;
constexpr int A_VC = 512;
constexpr int A_KC = 256;
constexpr int A_PAD = 128;
constexpr int A_MISC = 1;
constexpr int A_TOTAL = A_MOD + A_WT + A_VC + A_KC + A_PAD + A_MISC;

__device__ __forceinline__ void phase_a(const Params& p, char* smem) {
  const int tid = launder_tid();
  for (int task = blockIdx.x; task < A_TOTAL; task += gridDim.x) {
    int id = task;
    if (id < A_MOD) {
      int cgp = id % 12, ks = id / 12;
      float* sc = (float*)smem;
      __syncthreads();
      for (int i = tid; i < 24 * 128; i += 512) {
        int s = i >> 7, kk = i & 127, k = ks * 128 + kk;
        float cv = s < 8 ? p.c_prompt[s * 1024 + k] : p.c_sample[(s - 8) * 1024 + k];
        sc[i] = silu(cv);
      }
      __syncthreads();
      int col = cgp * 512 + tid;
      float acc[24];
#pragma unroll
      for (int s = 0; s < 24; s++) acc[s] = 0.f;
      const float* wp = p.w_ada + (size_t)(ks * 128) * 6144 + col;
#pragma unroll 1
      for (int kb = 0; kb < 128; kb += 32) {
        float wv[32];
#pragma unroll
        for (int j = 0; j < 32; j++) wv[j] = wp[(size_t)(kb + j) * 6144];
#pragma unroll
        for (int j = 0; j < 32; j++)
#pragma unroll
          for (int s = 0; s < 24; s++) acc[s] += sc[s * 128 + kb + j] * wv[j];
      }
#pragma unroll
      for (int s = 0; s < 24; s++) p.modp[(size_t)(ks * 24 + s) * 6144 + col] = acc[s];
      continue;
    }
    id -= A_MOD;
    if (id < A_WT) {
      weight_task(p, id, smem);
      continue;
    }
    id -= A_WT;
    if (id < A_VC) {
      int bh = id >> 2, jq = id & 3;
      int b = bh >> 3, h = bh & 7;
      transpose_quad(p.cache_v + ((size_t)(b * 1024 + jq * 256) * 8 + h) * 64, 512, (size_t)64 * 512,
                     p.VTs + (size_t)bh * 64 * 1152, 1152, jq * 256, 64, 0, 0, 0, smem);
      continue;
    }
    id -= A_VC;
    if (id < A_KC) {
      int b = id >> 4, jb = id & 15;
#pragma unroll
      for (int it = 0; it < 8; it++) {
        int g = tid + it * 512;
        int j = g >> 6, col = (g & 63) * 8;
        int h = col >> 6, d = col & 63;
        const float* src = p.cache_k + ((size_t)(b * 1024 + jb * 64 + j)) * 512 + col;
        float4 v0 = *(const float4*)src, v1 = *(const float4*)(src + 4);
        uint4 o;
        o.x = pack2(v0.x, v0.y);
        o.y = pack2(v0.z, v0.w);
        o.z = pack2(v1.x, v1.y);
        o.w = pack2(v1.z, v1.w);
        *(uint4*)(p.Ks + ((size_t)((b * 8 + h) * 1152 + jb * 64 + j)) * 64 + d) = o;
      }
      continue;
    }
    id -= A_KC;
    if (id < A_PAD) {
      int bh = id;
      uint4 z = {0u, 0u, 0u, 0u};
      *(uint4*)(p.Ks + ((size_t)bh * 1152 + 1088) * 64 + tid * 8) = z;
      int d = tid >> 3, chn = tid & 7;
      *(uint4*)(p.VTs + ((size_t)bh * 64 + d) * 1152 + 1088 + chn * 8) = z;
      continue;
    }
    if (tid < 8) p.counter[tid] = 0u;
  }
}

__device__ __forceinline__ void norm_task(const Params& p, int task, int which, char* smem) {
  float* sm_scale = (float*)smem;
  float* sm_shift = sm_scale + 1024;
  const float* sm_wg = sm_shift + 1024;
  const int tid = launder_tid(), lane = tid & 63, w = tid >> 6;
  const int row0 = task * 32;
  const int seq = seq_of(row0);
  const float* g = which ? p.norm2_g : p.norm1_g;
  const int sh_off = which ? 3072 : 0, sc_off = which ? 4096 : 1024;
  __syncthreads();
  for (int c = tid; c < 1024; c += 512) {
    float sh, sc;
    if (which == 0) {
      sh = p.b_ada[sh_off + c];
      sc = p.b_ada[sc_off + c];
#pragma unroll
      for (int ks = 0; ks < 8; ks++) {
        sh += p.modp[(size_t)(ks * 24 + seq) * 6144 + sh_off + c];
        sc += p.modp[(size_t)(ks * 24 + seq) * 6144 + sc_off + c];
      }
    } else {
      sh = p.modf[seq * 6144 + sh_off + c];
      sc = p.modf[seq * 6144 + sc_off + c];
    }
    sm_scale[c] = g[c] * (1.0f + sc);
    sm_shift[c] = sh;
  }
  __syncthreads();
  float4 v[4][4];
#pragma unroll
  for (int i = 0; i < 4; i++) {
    const int row = row0 + w * 4 + i;
    const float* xr = xrow(p, row);
#pragma unroll
    for (int j = 0; j < 4; j++) {
      v[i][j] = which ? ldbf4(p.X1 + (size_t)row * 1024 + j * 256 + lane * 4) : *(const float4*)(xr + j * 256 + lane * 4);
      if (which && row >= kNP) {
        const float* sl = p.SLAB + (size_t)((((row - kNP) >> 8) * 4 + j) * 3) * 65536 + (row & 255) * 256 + lane * 4;
#pragma unroll
        for (int kp = 0; kp < 3; kp++) {
          const float4 e = *(const float4*)(sl + (size_t)kp * 65536);
          v[i][j].x += e.x;
          v[i][j].y += e.y;
          v[i][j].z += e.z;
          v[i][j].w += e.w;
        }
        stbf4(p.X1 + (size_t)row * 1024 + j * 256 + lane * 4, v[i][j]);
      }
    }
  }
#pragma unroll
  for (int i = 0; i < 4; i++) {
    const int row = row0 + w * 4 + i;
    float ss = 0.f;
#pragma unroll
    for (int j = 0; j < 4; j++)
      ss += v[i][j].x * v[i][j].x + v[i][j].y * v[i][j].y + v[i][j].z * v[i][j].z + v[i][j].w * v[i][j].w;
    ss = wave_sum(ss);
    float rstd = rsqrtf(ss * (1.0f / 1024.0f) + 1e-6f);
#pragma unroll
    for (int j = 0; j < 4; j++) {
      int c = j * 256 + lane * 4;
      float4 sc = *(const float4*)(sm_scale + c), sh = *(const float4*)(sm_shift + c);
      v[i][j].x = v[i][j].x * rstd * sc.x + sh.x;
      v[i][j].y = v[i][j].y * rstd * sc.y + sh.y;
      v[i][j].z = v[i][j].z * rstd * sc.z + sh.z;
      v[i][j].w = v[i][j].w * rstd * sc.w + sh.w;
      uint2 o;
      o.x = pack2(v[i][j].x, v[i][j].y);
      o.y = pack2(v[i][j].z, v[i][j].w);
      *(uint2*)(p.U + (size_t)row * 1024 + c) = o;
    }
    if (which == 0) {
      float gv[8];
#pragma unroll
      for (int gi = 0; gi < 8; gi++) {
        float a = 0.f;
#pragma unroll
        for (int j = 0; j < 4; j++) {
          float4 wv = *(const float4*)(sm_wg + gi * 1024 + j * 256 + lane * 4);
          a += v[i][j].x * wv.x + v[i][j].y * wv.y + v[i][j].z * wv.z + v[i][j].w * wv.w;
        }
        gv[gi] = wave_sum(a);
      }
      if (lane == 0) {
#pragma unroll
        for (int h = 0; h < 4; h++) {
          p.GI[row * 4 + h] = gv[h] + p.b_if[h];
          p.LF[row * 4 + h] = logsig(gv[4 + h] + p.b_if[4 + h]);
        }
      }
    }
  }
}
__device__ __forceinline__ void phase_b(const Params& p, char* smem) {
  const int NTASK = kT / 32;
  {
    float* swg = (float*)smem + 2048;
    for (int i = threadIdx.x; i < 8192; i += 512) swg[i] = p.w_in[(size_t)(i & 1023) * kINW + 3584 + (i >> 10)];
  }
  for (int task = blockIdx.x; task < NTASK + 288; task += gridDim.x) {
    if (task < NTASK) {
      norm_task(p, task, 0, smem);
    } else {
      int i = (task - NTASK) * 512 + threadIdx.x;
      int s = i / 6144, c = i - s * 6144;
      float a = p.b_ada[c];
#pragma unroll
      for (int ks = 0; ks < 8; ks++) a += p.modp[(size_t)(ks * 24 + s) * 6144 + c];
      p.modf[i] = a;
    }
  }
}
__device__ __forceinline__ void phase_g(const Params& p, char* smem) {
  for (int task = blockIdx.x; task < kT / 32; task += gridDim.x) norm_task(p, task, 1, smem);
}

__device__ __forceinline__ uint4 pack8(const f32x4& a, const f32x4& b) {
  return (uint4){pack2(a[0], a[1]), pack2(a[2], a[3]), pack2(b[0], b[1]), pack2(b[2], b[3])};
}
struct EpiC {
  static constexpr bool PERM = true, AFTER_DRAIN = false;
  Params p;
  __device__ __forceinline__ void operator()(const f32x4 (&acc)[2][2][4][2], const pg8::Unit& u, int wr, int wc, int fr, int fq) const {
#pragma unroll
    for (int ai = 0; ai < 2; ++ai) {
      const int rb = u.pm * 256 + ai * 128 + wr * 64;
      const int seq = seq_of(rb);
      const bool isp = seq < 8;
      const int sb = seq - 8;
      const int srow0 = isp ? seq * 2048 : kNP + sb * 64;
      const int L = isp ? 2048 : 64;
#pragma unroll
      for (int bj = 0; bj < 2; ++bj) {
        const int cb = u.pn * 256 + bj * 128;
        const int c0 = cb + wc * 32 + fq * 8;
#pragma unroll
        for (int m = 0; m < 4; ++m) {
          const int row = rb + m * 16 + fr;
          const int t = row - srow0;
          const f32x4 v0 = acc[ai][bj][m][0], v1 = acc[ai][bj][m][1];
          if (cb < 512) {
            *(uint4*)(p.Qb + (size_t)row * 512 + c0) = pack8(v0, v1);
          } else if (cb < 1024) {
            const int c = c0 - 512, h = c >> 6, d = c & 63;
            float* o = (isp ? p.out + O_KP + (size_t)row * 512 : p.out + O_KS + (size_t)(row - kNP) * 512) + c;
            *(f32x4*)o = v0;
            *(f32x4*)(o + 4) = v1;
            bf16_t* kb = isp ? p.Kp + ((size_t)(seq * 8 + h) * 2048 + t) * 64 + d
                             : p.Ks + ((size_t)(sb * 8 + h) * 1152 + 1024 + t) * 64 + d;
            *(uint4*)kb = pack8(v0, v1);
          } else if (cb < 1536) {
            const int c = c0 - 1024, h = c >> 6, d = c & 63;
            float* o = (isp ? p.out + O_VP + (size_t)row * 512 : p.out + O_VS + (size_t)(row - kNP) * 512) + c;
            *(f32x4*)o = v0;
            *(f32x4*)(o + 4) = v1;
            bf16_t* vt = isp ? p.VTp + ((size_t)(seq * 8 + h) * 64 + d) * 2048 + t
                             : p.VTs + ((size_t)(sb * 8 + h) * 64 + d) * 1152 + 1024 + t;
            const size_t tl = isp ? 2048 : 1152;
#pragma unroll
            for (int e = 0; e < 4; ++e) {
              vt[(size_t)e * tl] = f2bf(v0[e]);
              vt[(size_t)(e + 4) * tl] = f2bf(v1[e]);
            }
          } else if (cb < 2560) {
            const int c = c0 - 1536;
            *(uint4*)(p.MQK + (size_t)row * 1024 + c) = pack8(v0, v1);
            if (t >= L - 3) {
              float* o = (isp ? p.out + O_CVP + (size_t)(seq * 3 + (t - (L - 3))) * 1024
                              : p.out + O_CVS + (size_t)(sb * 3 + (t - (L - 3))) * 1024) + c;
              *(f32x4*)o = v0;
              *(f32x4*)(o + 4) = v1;
            }
          } else if (cb < 3072) {
            const int c = c0 - 2560, h = c >> 7, d = c & 127;
            bf16_t* vt = isp ? p.MVTp + ((size_t)(seq * 4 + h) * 128 + d) * 2048 + t
                             : p.MVTs + ((size_t)(sb * 4 + h) * 128 + d) * 64 + t;
            const size_t tl = isp ? 2048 : 64;
#pragma unroll
            for (int e = 0; e < 4; ++e) {
              vt[(size_t)e * tl] = f2bf(v0[e]);
              vt[(size_t)(e + 4) * tl] = f2bf(v1[e]);
            }
          } else {
            f32x4 s0, s1;
#pragma unroll
            for (int e = 0; e < 4; ++e) {
              s0[e] = sigm(v0[e]);
              s1[e] = sigm(v1[e]);
            }
            bf16_t* dst = (cb < 3584)   ? p.SO + (size_t)row * 512 + (c0 - 3072)
                          : (cb < 4608) ? p.GA + (size_t)row * 1024 + (c0 - 3584)
                                        : p.GB + (size_t)row * 1024 + (c0 - 4608);
            *(uint4*)dst = pack8(s0, s1);
          }
        }
      }
    }
  }
};
struct EpiH {
  static constexpr bool PERM = true, AFTER_DRAIN = false;
  bf16_t* HFF;
  __device__ __forceinline__ void operator()(const f32x4 (&acc)[2][2][4][2], const pg8::Unit& u, int wr, int wc, int fr, int fq) const {
    const int f0 = u.pn * 128 + wc * 32 + fq * 8;
#pragma unroll
    for (int ai = 0; ai < 2; ++ai)
#pragma unroll
      for (int m = 0; m < 4; ++m) {
        const int row = u.pm * 256 + ai * 128 + wr * 64 + m * 16 + fr;
        f32x4 o0, o1;
#pragma unroll
        for (int e = 0; e < 4; ++e) {
          o0[e] = silu(acc[ai][0][m][0][e]) * acc[ai][1][m][0][e];
          o1[e] = silu(acc[ai][0][m][1][e]) * acc[ai][1][m][1][e];
        }
        *(uint4*)(HFF + (size_t)row * 2816 + f0) = pack8(o0, o1);
      }
  }
};
__device__ __forceinline__ void gate_task(const Params& p, int seq, int h, char* smem);
__device__ __forceinline__ void phase_c(const Params& p, char* smem) {
  for (int item = blockIdx.x; item < 96; item += gridDim.x) {
    if (item < 32) gate_task(p, item >> 2, item & 3, smem);
    else gate_task(p, 8 + ((item - 32) >> 2), item & 3, smem);
  }
  __syncthreads();
  pg8::Gemm g{p.U, p.Wt_in, kT, 5632, 1024};
  pg8::StaticOrder S;
  S.init(kT, 5632, gridDim.x, blockIdx.x);
  EpiC E{p};
  pg8::gemm_phase<EpiC, pg8::StaticOrder, false>((PG8_LAS unsigned char*)smem, g, S, E, nullptr);
}

__device__ __forceinline__ void lds_barrier() { asm volatile("s_waitcnt lgkmcnt(0)\n\ts_barrier" ::: "memory"); }
__device__ __forceinline__ void attn_task(const Params& p, int seq, int h, int qt, char* smem) {
  const int tid = launder_tid(), lane = tid & 63, w = tid >> 6, fr = lane & 15, fq = lane >> 4;
  const bool isp = seq < 8;
  const int sb = seq - 8;
  const int past = isp ? 0 : 1024;
  const int Tlen = isp ? 2048 : 1152;
  const int row0 = (isp ? seq * 2048 : kNP + sb * 64) + qt * 64;
  const int p0 = past + qt * 64;
  const bf16_t* Kb = isp ? p.Kp + (size_t)(seq * 8 + h) * 2048 * 64 : p.Ks + (size_t)(sb * 8 + h) * 1152 * 64;
  const bf16_t* VT = isp ? p.VTp + (size_t)(seq * 8 + h) * 64 * 2048 : p.VTs + (size_t)(sb * 8 + h) * 64 * 1152;
  bf16_t* sQ = (bf16_t*)smem;
  bf16_t* sK = sQ + 64 * 72;
  bf16_t* sVT = sK + 128 * 72;
  bf16_t* sP = sVT + 64 * 136;
  float* sZ = (float*)(sP + 64 * 136);
  int* sFlag = (int*)(sZ + 64 * 132);

  __syncthreads();
  {
    int r = tid >> 3, chn = tid & 7;
    uint4 q = *(const uint4*)(p.Qb + (size_t)(row0 + r) * 512 + h * 64 + chn * 8);
    *(uint4*)(sQ + r * 72 + chn * 8) = q;
  }
  const int kt_d = (p0 + 62) >> 7;
  const int ki0 = tid, ki1 = tid + 512;
  const bf16_t* kptr0 = Kb + (size_t)(ki0 >> 3) * 64 + (ki0 & 7) * 8;
  const bf16_t* kptr1 = Kb + (size_t)(ki1 >> 3) * 64 + (ki1 & 7) * 8;
  const bf16_t* vptr0 = VT + (size_t)(ki0 >> 4) * Tlen + (ki0 & 15) * 8;
  const bf16_t* vptr1 = VT + (size_t)(ki1 >> 4) * Tlen + (ki1 & 15) * 8;
  uint4 kr0 = *(const uint4*)(kptr0 + (size_t)kt_d * 8192);
  uint4 kr1 = *(const uint4*)(kptr1 + (size_t)kt_d * 8192);
  uint4 vr0 = *(const uint4*)(vptr0 + kt_d * 128);
  uint4 vr1 = *(const uint4*)(vptr1 + kt_d * 128);
  float R = 0.f;
  f32x4 oacc[2];
  oacc[0] = (f32x4){0.f, 0.f, 0.f, 0.f};
  oacc[1] = (f32x4){0.f, 0.f, 0.f, 0.f};
  const int mf = w & 3;
  for (int kt = kt_d; kt >= 0; kt--) {
    lds_barrier();
    *(uint4*)(sK + (ki0 >> 3) * 72 + (ki0 & 7) * 8) = kr0;
    *(uint4*)(sK + (ki1 >> 3) * 72 + (ki1 & 7) * 8) = kr1;
    *(uint4*)(sVT + (ki0 >> 4) * 136 + (ki0 & 15) * 8) = vr0;
    *(uint4*)(sVT + (ki1 >> 4) * 136 + (ki1 & 15) * 8) = vr1;
    if (tid == 0) *sFlag = 0;
    lds_barrier();
    if (kt > 0) {
      kr0 = *(const uint4*)(kptr0 + (size_t)(kt - 1) * 8192);
      kr1 = *(const uint4*)(kptr1 + (size_t)(kt - 1) * 8192);
      vr0 = *(const uint4*)(vptr0 + (kt - 1) * 128);
      vr1 = *(const uint4*)(vptr1 + (kt - 1) * 128);
    }
    {
      const int nf0 = (w >> 2) * 4;
      bf16x8 a0 = lds8(sQ + (mf * 16 + fr) * 72 + fq * 8);
      bf16x8 a1 = lds8(sQ + (mf * 16 + fr) * 72 + 32 + fq * 8);
#pragma unroll
      for (int n = 0; n < 4; n++) {
        bf16x8 b0 = lds8(sK + ((nf0 + n) * 16 + fr) * 72 + fq * 8);
        bf16x8 b1 = lds8(sK + ((nf0 + n) * 16 + fr) * 72 + 32 + fq * 8);
        f32x4 s = (f32x4){0.f, 0.f, 0.f, 0.f};
        s = MFMA(a0, b0, s);
        s = MFMA(a1, b1, s);
#pragma unroll
        for (int r = 0; r < 4; r++) sZ[(mf * 16 + fq * 4 + r) * 132 + (nf0 + n) * 16 + fr] = s[r] * 0.125f;
      }
    }
    lds_barrier();
    {
      const int row = tid >> 3, part = tid & 7;
      const int pos = p0 + row;
      const int j0 = kt * 128 + part * 16;
      float z[16], ls[16];
#pragma unroll
      for (int i4 = 0; i4 < 4; i4++) {
        float4 t4 = *(const float4*)(sZ + row * 132 + part * 16 + i4 * 4);
        z[i4 * 4 + 0] = t4.x;
        z[i4 * 4 + 1] = t4.y;
        z[i4 * 4 + 2] = t4.z;
        z[i4 * 4 + 3] = t4.w;
      }
      float run = 0.f;
      float tl[16];
#pragma unroll
      for (int i = 15; i >= 0; i--) {
        bool valid = (j0 + i) < pos;
        float l = valid ? -(fmaxf(z[i], 0.f) + __logf(1.0f + __expf(-fabsf(z[i])))) : 0.f;
        ls[i] = l;
        tl[i] = run;
        run += l;
      }
      float incl = run;
#pragma unroll
      for (int dlt = 1; dlt < 8; dlt <<= 1) {
        float t = __shfl_down(incl, dlt, 8);
        if (part + dlt < 8) incl += t;
      }
      float excl = incl - run;
      float tot = __shfl(incl, 0, 8);
      float base = R + excl;
      unsigned pk[8];
#pragma unroll
      for (int i = 0; i < 16; i += 2) {
        bool v0 = (j0 + i) < pos, v1 = (j0 + i + 1) < pos;
        float a0 = v0 ? __expf(z[i] + ls[i] + tl[i] + base) : 0.f;
        float a1 = v1 ? __expf(z[i + 1] + ls[i + 1] + tl[i + 1] + base) : 0.f;
        pk[i >> 1] = pack2(a0, a1);
      }
      *(uint4*)(sP + row * 136 + part * 16) = (uint4){pk[0], pk[1], pk[2], pk[3]};
      *(uint4*)(sP + row * 136 + part * 16 + 8) = (uint4){pk[4], pk[5], pk[6], pk[7]};
      R += tot;
      if (R > -110.f) *sFlag = 1;
    }
    lds_barrier();
    const int more = *sFlag;
    {
      const int nf0 = (w >> 2) * 2;
#pragma unroll
      for (int ks = 0; ks < 4; ks++) {
        bf16x8 a = lds8(sP + (mf * 16 + fr) * 136 + ks * 32 + fq * 8);
#pragma unroll
        for (int n = 0; n < 2; n++) {
          bf16x8 b = lds8(sVT + ((nf0 + n) * 16 + fr) * 136 + ks * 32 + fq * 8);
          oacc[n] = MFMA(a, b, oacc[n]);
        }
      }
    }
    if (!more) break;
  }
  {
    const int nf0 = (w >> 2) * 2;
#pragma unroll
    for (int n = 0; n < 2; n++)
#pragma unroll
      for (int r = 0; r < 4; r++)
        p.YA[(size_t)(row0 + mf * 16 + fq * 4 + r) * 1024 + h * 64 + (nf0 + n) * 16 + fr] = f2bf(oacc[n][r]);
  }
}


__device__ __forceinline__ void gate_task(const Params& p, int seq, int h, char* smem) {
  const int tid = launder_tid(), lane = tid & 63, w = tid >> 6;
  const bool isp = seq < 8;
  const int sb = seq - 8;
  const int nchunks = isp ? 32 : 1;
  const int grow0 = isp ? seq * 2048 : kNP + sb * 64;
  float* gv = p.GV + (size_t)(isp ? (seq * 4 + h) * 32 : 1024 + sb * 4 + h) * 384;
  float* sBl = (float*)smem;
  float* sG = sBl + 32;
  float* sM = sG + 32;
  __syncthreads();
  float b_[4], as_[4], pm_[4], g_[4];
#pragma unroll
  for (int i = 0; i < 4; i++) {
    const int c = w + i * 8;
    b_[i] = 0.f; as_[i] = 0.f; pm_[i] = 0.f; g_[i] = 0.f;
    if (c < nchunks) {
      const int row = grow0 + c * 64 + lane;
      float li = p.GI[row * 4 + h], lf = p.LF[row * 4 + h];
      float b = lf;
#pragma unroll
      for (int d = 1; d < 64; d <<= 1) {
        float t_ = __shfl_up(b, d);
        if (lane >= d) b += t_;
      }
      float a_s = li - b;
      float pm = a_s;
#pragma unroll
      for (int d = 1; d < 64; d <<= 1) {
        float t_ = __shfl_up(pm, d);
        if (lane >= d) pm = fmaxf(pm, t_);
      }
      float blast = __shfl(b, 63);
      float g = blast - b + li;
      float G = wave_max(g);
      b_[i] = b; as_[i] = a_s; pm_[i] = pm; g_[i] = g;
      if (lane == 0) {
        sBl[c] = blast;
        sG[c] = G;
      }
    }
  }
  __syncthreads();
  if (tid == 0) {
    float m = isp ? 0.f : p.st_m[sb * 4 + h];
    for (int c = 0; c < nchunks; c++) {
      sM[c] = m;
      m = fmaxf(sBl[c] + m, sG[c]);
    }
    sM[nchunks] = m;
    if (isp) p.out[O_MP + seq * 4 + h] = m;
    else p.out[O_MS + sb * 4 + h] = m;
  }
  __syncthreads();
#pragma unroll
  for (int i = 0; i < 4; i++) {
    const int c = w + i * 8;
    if (c < nchunks) {
      const float m_run = sM[c], m_new = sM[c + 1];
      const float mt = b_[i] + fmaxf(m_run, pm_[i]);
      float* o = gv + (size_t)c * 384;
      o[lane] = b_[i] - mt;
      o[64 + lane] = as_[i];
      o[128 + lane] = __expf(b_[i] + m_run - mt);
      o[192 + lane] = __expf(g_[i] - m_new);
      o[256 + lane] = __expf(-mt);
      if (lane == 0) o[320] = __expf(sBl[c] + m_run - m_new);
    }
  }
}

__device__ __forceinline__ void mlpre_task(const Params& p, int seq, int h, int c, char* smem) {
  const bool isp = seq < 8;
  const int sb = seq - 8;
  const int grow0 = isp ? seq * 2048 : kNP + sb * 64;
  const int t0 = c * 64;
  const int cid = isp ? (seq * 4 + h) * 32 + c : 1024 + sb * 4 + h;
  bf16_t* sQ = (bf16_t*)smem;
  bf16_t* sK = sQ + 64 * 136;
  bf16_t* sKT = sK + 64 * 136;
  bf16_t* sSw = sKT + 128 * 72;
  float* sF = (float*)(sSw + 64 * 72);
  float* sV = sF;
  float* sDen = sF + 384;
  float* sCw = sF + 448;
  const float* sBt = sV;
  const float* sAs = sV + 64;
  const float* sWg = sV + 192;
  __syncthreads();
  uint4 xr0, xr1, xr2, xr3, xr4, xr5, xr6;
  {
    const int tid = launder_tid();
    for (int i = tid; i < 1280; i += 512) {
      int j = i >> 8, cc = i & 255;
      int gch = (cc >= 128 ? 512 : 0) + h * 128 + (cc & 127);
      sCw[i] = (j < 4) ? p.w_conv[j * 1024 + gch] : p.b_conv[gch];
    }
    if (tid < 384) sV[tid] = p.GV[(size_t)cid * 384 + tid];
    if (tid < 64) sDen[tid] = 0.f;
    const int rb_ = tid >> 5, cgp_ = tid & 31;
    const int ch_ = (cgp_ >= 16 ? 512 : 0) + h * 128 + (cgp_ & 15) * 8;
    const int tb0 = t0 + rb_ * 4 - 3;
    const bf16_t* xp = p.MQK + (size_t)(grow0 + tb0) * 1024 + ch_;
#define LDX(i, dst)                                                                                           \
  if (tb0 + i >= 0) dst = *(const uint4*)(xp + (size_t)i * 1024);                                             \
  else if (isp) dst = (uint4){0u, 0u, 0u, 0u};                                                                \
  else {                                                                                                      \
    const float* s0 = p.st_conv + (size_t)(sb * 3 + (tb0 + i + 3)) * 1024 + ch_;                              \
    dst = (uint4){pack2(s0[0], s0[1]), pack2(s0[2], s0[3]), pack2(s0[4], s0[5]), pack2(s0[6], s0[7])};        \
  }
    LDX(0, xr0) LDX(1, xr1) LDX(2, xr2)
#undef LDX
    xr3 = *(const uint4*)(xp + (size_t)3 * 1024);
    xr4 = *(const uint4*)(xp + (size_t)4 * 1024);
    xr5 = *(const uint4*)(xp + (size_t)5 * 1024);
    xr6 = *(const uint4*)(xp + (size_t)6 * 1024);
  }
  __syncthreads();
  {
    const int tid = launder_tid();
    const int rb = tid >> 5, cgp = tid & 31;
    const bool isk = cgp >= 16;
    float o0[8], o1[8], o2[8], o3[8];
    {
      const float* cwp = sCw + cgp * 8;
      float4 b0 = *(const float4*)(cwp + 1024), b1 = *(const float4*)(cwp + 1028);
      o0[0] = b0.x; o0[1] = b0.y; o0[2] = b0.z; o0[3] = b0.w; o0[4] = b1.x; o0[5] = b1.y; o0[6] = b1.z; o0[7] = b1.w;
#pragma unroll
      for (int e = 0; e < 8; e++) { o1[e] = o0[e]; o2[e] = o0[e]; o3[e] = o0[e]; }
#define FMAW(j, o, x) { float4 a0 = *(const float4*)(cwp + j * 256), a1 = *(const float4*)(cwp + j * 256 + 4); \
  o[0] += a0.x * x[0]; o[1] += a0.y * x[1]; o[2] += a0.z * x[2]; o[3] += a0.w * x[3];                              \
  o[4] += a1.x * x[4]; o[5] += a1.y * x[5]; o[6] += a1.z * x[6]; o[7] += a1.w * x[7]; }
#define UNP(xv, x) float x[8]; x[0] = __uint_as_float(xv.x << 16); x[1] = __uint_as_float(xv.x & 0xffff0000u); \
  x[2] = __uint_as_float(xv.y << 16); x[3] = __uint_as_float(xv.y & 0xffff0000u);                             \
  x[4] = __uint_as_float(xv.z << 16); x[5] = __uint_as_float(xv.z & 0xffff0000u);                             \
  x[6] = __uint_as_float(xv.w << 16); x[7] = __uint_as_float(xv.w & 0xffff0000u);
      { UNP(xr0, x) FMAW(0, o0, x) }
      { UNP(xr1, x) FMAW(1, o0, x) FMAW(0, o1, x) }
      { UNP(xr2, x) FMAW(2, o0, x) FMAW(1, o1, x) FMAW(0, o2, x) }
      { UNP(xr3, x) FMAW(3, o0, x) FMAW(2, o1, x) FMAW(1, o2, x) FMAW(0, o3, x) }
      { UNP(xr4, x) FMAW(3, o1, x) FMAW(2, o2, x) FMAW(1, o3, x) }
      { UNP(xr5, x) FMAW(3, o2, x) FMAW(2, o3, x) }
      { UNP(xr6, x) FMAW(3, o3, x) }
#undef FMAW
#undef UNP
    }
    const float ksc = isk ? 0.08838834764831845f : 1.0f;
#pragma unroll
    for (int e = 0; e < 8; e++) {
      o0[e] = silu(o0[e]) * ksc; o1[e] = silu(o1[e]) * ksc; o2[e] = silu(o2[e]) * ksc; o3[e] = silu(o3[e]) * ksc;
    }
    bf16_t* dstp = (isk ? sK + (cgp - 16) * 8 : sQ + cgp * 8) + (rb * 4) * 136;
    *(uint4*)(dstp) = (uint4){pack2(o0[0], o0[1]), pack2(o0[2], o0[3]), pack2(o0[4], o0[5]), pack2(o0[6], o0[7])};
    *(uint4*)(dstp + 136) = (uint4){pack2(o1[0], o1[1]), pack2(o1[2], o1[3]), pack2(o1[4], o1[5]), pack2(o1[6], o1[7])};
    *(uint4*)(dstp + 272) = (uint4){pack2(o2[0], o2[1]), pack2(o2[2], o2[3]), pack2(o2[4], o2[5]), pack2(o2[6], o2[7])};
    *(uint4*)(dstp + 408) = (uint4){pack2(o3[0], o3[1]), pack2(o3[2], o3[3]), pack2(o3[4], o3[5]), pack2(o3[6], o3[7])};
    if (isk) {
      float g0 = sWg[rb * 4], g1 = sWg[rb * 4 + 1], g2 = sWg[rb * 4 + 2], g3 = sWg[rb * 4 + 3];
#pragma unroll
      for (int e = 0; e < 8; e++) {
        uint2 pk;
        pk.x = pack2(o0[e] * g0, o1[e] * g1);
        pk.y = pack2(o2[e] * g2, o3[e] * g3);
        *(uint2*)(sKT + ((cgp - 16) * 8 + e) * 72 + rb * 4) = pk;
      }
    }
  }
  __syncthreads();
  {
    const int tid = launder_tid(), lane = tid & 63, w = tid >> 6, fr = lane & 15, fq = lane >> 4;
    const int mf = w >> 1, nf0 = (w & 1) * 2;
    f32x4 sa[2];
    sa[0] = (f32x4){0.f, 0.f, 0.f, 0.f};
    sa[1] = (f32x4){0.f, 0.f, 0.f, 0.f};
#pragma unroll
    for (int ks = 0; ks < 4; ks++) {
      bf16x8 a = lds8(sQ + (mf * 16 + fr) * 136 + ks * 32 + fq * 8);
#pragma unroll
      for (int n = 0; n < 2; n++) {
        bf16x8 b = lds8(sK + ((nf0 + n) * 16 + fr) * 136 + ks * 32 + fq * 8);
        sa[n] = MFMA(a, b, sa[n]);
      }
    }
#pragma unroll
    for (int r = 0; r < 4; r++) {
      const int t = mf * 16 + fq * 4 + r;
      const float bt = sBt[t];
      float rs = 0.f;
#pragma unroll
      for (int n = 0; n < 2; n++) {
        const int s = (nf0 + n) * 16 + fr;
        float wgt = (s <= t) ? __expf(bt + sAs[s]) : 0.f;
        float v = sa[n][r] * wgt;
        rs += v;
        sSw[t * 72 + s] = f2bf(v);
      }
      rs = row16_sum(rs);
      if (fr == 0) atomicAdd(&sDen[t], rs);
    }
  }
  __syncthreads();
  {
    const int tid = launder_tid();
    bf16_t* qo = p.Qc + (size_t)cid * 8192;
    bf16_t* ko = p.KTc + (size_t)cid * 8192;
    bf16_t* so = p.SWc + (size_t)cid * 4096;
    *(uint4*)(qo + tid * 8) = *(const uint4*)(sQ + (tid >> 4) * 136 + (tid & 15) * 8);
    *(uint4*)(qo + 4096 + tid * 8) = *(const uint4*)(sQ + (32 + (tid >> 4)) * 136 + (tid & 15) * 8);
    *(uint4*)(ko + tid * 8) = *(const uint4*)(sKT + (tid >> 3) * 72 + (tid & 7) * 8);
    *(uint4*)(ko + 4096 + tid * 8) = *(const uint4*)(sKT + (64 + (tid >> 3)) * 72 + (tid & 7) * 8);
    *(uint4*)(so + tid * 8) = *(const uint4*)(sSw + (tid >> 3) * 72 + (tid & 7) * 8);
    if (tid < 64) p.DENc[(size_t)cid * 64 + tid] = sDen[tid];
  }
}

__device__ __forceinline__ void mlstm_task(const Params& p, int seq, int h, char* smem) {
  const bool isp = seq < 8;
  const int sb = seq - 8;
  const int L = isp ? 2048 : 64;
  const int nchunks = L >> 6;
  const int grow0 = isp ? seq * 2048 : kNP + sb * 64;
  const int cid0 = isp ? (seq * 4 + h) * 32 : 1024 + sb * 4 + h;
  const bf16_t* MVT = isp ? p.MVTp + (size_t)(seq * 4 + h) * 128 * 2048 : p.MVTs + (size_t)(sb * 4 + h) * 128 * 64;
  bf16_t* sQ = (bf16_t*)smem;
  bf16_t* sH = sQ + 64 * 136;
  bf16_t* sKT = sH + 64 * 136;
  bf16_t* sVT = sKT + 128 * 72;
  bf16_t* sCb = sVT + 128 * 72;
  bf16_t* sSw = sCb + 128 * 136;
  float* sF = (float*)(sSw + 64 * 72);
  float* sVec = sF;
  float* sNq = sF + 512;
  float* sSS = sF + 576;
  float* sN = sF + 640;

  __syncthreads();
  f32x4 Cacc[8];
  {
    const int tid = launder_tid(), lane = tid & 63, w = tid >> 6, fr = lane & 15, fq = lane >> 4;
    if (isp) {
#pragma unroll
      for (int n = 0; n < 8; n++) Cacc[n] = (f32x4){0.f, 0.f, 0.f, 0.f};
      if (tid < 128) sN[tid] = 0.f;
    } else {
      const float* C0 = p.st_C + (size_t)(sb * 4 + h) * 16384;
#pragma unroll
      for (int n = 0; n < 8; n++)
#pragma unroll
        for (int r = 0; r < 4; r++) Cacc[n][r] = C0[(w * 16 + fq * 4 + r) * 128 + n * 16 + fr];
      if (tid < 128) sN[tid] = p.st_n[(sb * 4 + h) * 128 + tid];
    }
#pragma unroll
    for (int n = 0; n < 8; n++)
#pragma unroll
      for (int r = 0; r < 4; r++) sCb[(w * 16 + fq * 4 + r) * 136 + n * 16 + fr] = f2bf(Cacc[n][r]);
  }
  float mg0, mg1, mg2, mg3;
  {
    const int tid = launder_tid(), lane = tid & 63, w = tid >> 6, fr = lane & 15;
    const int cidx = h * 128 + (w >> 2) * 64 + fr;
    mg0 = p.ml_norm_g[cidx];
    mg1 = p.ml_norm_g[cidx + 16];
    mg2 = p.ml_norm_g[cidx + 32];
    mg3 = p.ml_norm_g[cidx + 48];
  }
  uint4 q0, q1, k0, k1, v0, v1, sw0;
  float gwi = 0.f, gem = 0.f, gden = 0.f, gdec = 0.f;
#define LOAD_CHUNK(C)                                                                         \
  {                                                                                           \
    const int tid_ = launder_tid();                                                           \
    const size_t cid_ = (size_t)(cid0 + (C));                                                 \
    const bf16_t* qp = p.Qc + cid_ * 8192 + tid_ * 8;                                         \
    const bf16_t* kp = p.KTc + cid_ * 8192 + tid_ * 8;                                        \
    q0 = *(const uint4*)qp;                                                                   \
    q1 = *(const uint4*)(qp + 4096);                                                          \
    k0 = *(const uint4*)kp;                                                                   \
    k1 = *(const uint4*)(kp + 4096);                                                          \
    sw0 = *(const uint4*)(p.SWc + cid_ * 4096 + tid_ * 8);                                    \
    v0 = *(const uint4*)(MVT + (size_t)(tid_ >> 3) * L + (C) * 64 + (tid_ & 7) * 8);          \
    v1 = *(const uint4*)(MVT + (size_t)((tid_ + 512) >> 3) * L + (C) * 64 + (tid_ & 7) * 8);  \
    if (tid_ < 64) {                                                                          \
      gwi = p.GV[cid_ * 384 + 128 + tid_];                                                    \
      gem = p.GV[cid_ * 384 + 256 + tid_];                                                    \
      gden = p.DENc[cid_ * 64 + tid_];                                                        \
      gdec = p.GV[cid_ * 384 + 320];                                                          \
    }                                                                                         \
  }
  LOAD_CHUNK(0)
  lds_barrier();

  for (int c = 0; c < nchunks; c++) {
    const int t0 = c * 64;
    float* sV = sVec + (c & 1) * 256;
    const float* sNo = sN + (c & 1) * 128;
    float* sNn = sN + ((c + 1) & 1) * 128;
    uint4 so0, so1;
    {
      const int tid = launder_tid();
      *(uint4*)(sQ + (tid >> 4) * 136 + (tid & 15) * 8) = q0;
      *(uint4*)(sQ + (32 + (tid >> 4)) * 136 + (tid & 15) * 8) = q1;
      *(uint4*)(sKT + (tid >> 3) * 72 + (tid & 7) * 8) = k0;
      *(uint4*)(sKT + (64 + (tid >> 3)) * 72 + (tid & 7) * 8) = k1;
      *(uint4*)(sVT + (tid >> 3) * 72 + (tid & 7) * 8) = v0;
      *(uint4*)(sVT + (64 + (tid >> 3)) * 72 + (tid & 7) * 8) = v1;
      *(uint4*)(sSw + (tid >> 3) * 72 + (tid & 7) * 8) = sw0;
      float decay = gdec;
      if (tid < 64) {
        sV[tid] = gwi;
        sV[64 + tid] = gem;
        sV[128 + tid] = gden;
        sSS[tid] = 0.f;
        if (tid == 0) sV[192] = gdec;
      }
      decay = __shfl(decay, 0);
#define UNP8(VV, AR) float AR[8]; AR[0] = __uint_as_float(VV.x << 16); AR[1] = __uint_as_float(VV.x & 0xffff0000u); \
  AR[2] = __uint_as_float(VV.y << 16); AR[3] = __uint_as_float(VV.y & 0xffff0000u);                                 \
  AR[4] = __uint_as_float(VV.z << 16); AR[5] = __uint_as_float(VV.z & 0xffff0000u);                                 \
  AR[6] = __uint_as_float(VV.w << 16); AR[7] = __uint_as_float(VV.w & 0xffff0000u);
      {
        const float4 n0 = *(const float4*)(sNo + (tid & 15) * 8), n1 = *(const float4*)(sNo + (tid & 15) * 8 + 4);
        UNP8(q0, a)
        UNP8(q1, b)
        float d0 = a[0] * n0.x + a[1] * n0.y + a[2] * n0.z + a[3] * n0.w + a[4] * n1.x + a[5] * n1.y + a[6] * n1.z + a[7] * n1.w;
        float d1 = b[0] * n0.x + b[1] * n0.y + b[2] * n0.z + b[3] * n0.w + b[4] * n1.x + b[5] * n1.y + b[6] * n1.z + b[7] * n1.w;
        d0 = row16_sum(d0);
        d1 = row16_sum(d1);
        if ((tid & 15) == 0) {
          sNq[tid >> 4] = d0;
          sNq[32 + (tid >> 4)] = d1;
        }
      }
      {
        UNP8(k0, a)
        UNP8(k1, b)
        float d0 = ((a[0] + a[1]) + (a[2] + a[3])) + ((a[4] + a[5]) + (a[6] + a[7]));
        float d1 = ((b[0] + b[1]) + (b[2] + b[3])) + ((b[4] + b[5]) + (b[6] + b[7]));
        d0 = half8_sum(d0);
        d1 = half8_sum(d1);
        if ((tid & 7) == 0) {
          sNn[tid >> 3] = d0;
          sNn[64 + (tid >> 3)] = d1;
        }
      }
#undef UNP8
      {
        const bf16_t* sop = p.SO + (size_t)(grow0 + t0 + (tid >> 4)) * 512 + h * 128 + (tid & 15) * 8;
        so0 = *(const uint4*)sop;
        so1 = *(const uint4*)(sop + (size_t)32 * 512);
      }
    }
    if (c + 1 < nchunks) LOAD_CHUNK(c + 1)
    lds_barrier();
    f32x4 hacc[4];
    {
      const int tid = launder_tid(), lane = tid & 63, w = tid >> 6, fr = lane & 15, fq = lane >> 4;
      const int mf = w & 3, nf0 = (w >> 2) * 4;
      const float* sWi = sV;
      const float* sEm = sV + 64;
      const float* sDn = sV + 128;
#pragma unroll
      for (int n = 0; n < 4; n++) hacc[n] = (f32x4){0.f, 0.f, 0.f, 0.f};
      {
        bf16x8 qa[4], cb[4][4], swa[2], vb[2][4];
#pragma unroll
        for (int ks = 0; ks < 4; ks++) {
          qa[ks] = lds8(sQ + (mf * 16 + fr) * 136 + ks * 32 + fq * 8);
#pragma unroll
          for (int n = 0; n < 4; n++) cb[ks][n] = lds8(sCb + ((nf0 + n) * 16 + fr) * 136 + ks * 32 + fq * 8);
        }
#pragma unroll
        for (int ks = 0; ks < 2; ks++) {
          swa[ks] = lds8(sSw + (mf * 16 + fr) * 72 + ks * 32 + fq * 8);
#pragma unroll
          for (int n = 0; n < 4; n++) vb[ks][n] = lds8(sVT + ((nf0 + n) * 16 + fr) * 72 + ks * 32 + fq * 8);
        }
        float wi4[4];
#pragma unroll
        for (int r = 0; r < 4; r++) wi4[r] = sWi[mf * 16 + fq * 4 + r];
#pragma unroll
        for (int ks = 0; ks < 4; ks++)
#pragma unroll
          for (int n = 0; n < 4; n++) hacc[n] = MFMA(qa[ks], cb[ks][n], hacc[n]);
#pragma unroll
        for (int r = 0; r < 4; r++)
#pragma unroll
          for (int n = 0; n < 4; n++) hacc[n][r] *= wi4[r];
#pragma unroll
        for (int ks = 0; ks < 2; ks++)
#pragma unroll
          for (int n = 0; n < 4; n++) hacc[n] = MFMA(swa[ks], vb[ks][n], hacc[n]);
      }
#pragma unroll
      for (int r = 0; r < 4; r++) {
        const int t = mf * 16 + fq * 4 + r;
        float den = sDn[t] + sWi[t] * sNq[t];
        float dn = fmaxf(fabsf(den), sEm[t]);
        float inv = __builtin_amdgcn_rcpf(dn);
        float ss = 0.f;
#pragma unroll
        for (int n = 0; n < 4; n++) {
          hacc[n][r] *= inv;
          ss += hacc[n][r] * hacc[n][r];
        }
        ss = row16_sum(ss);
        if (fr == 0) atomicAdd(&sSS[t], ss);
      }
    }
    lds_barrier();
    {
      const int tid = launder_tid(), lane = tid & 63, w = tid >> 6, fr = lane & 15, fq = lane >> 4;
      const int mf = w & 3, nf0 = (w >> 2) * 4;
#pragma unroll
      for (int r = 0; r < 4; r++) {
        const int t = mf * 16 + fq * 4 + r;
        const float rstd = rsqrtf(sSS[t] * (1.0f / 128.0f) + 1e-6f);
        bf16_t* hp = sH + t * 136 + nf0 * 16 + fr;
        hp[0] = f2bf(hacc[0][r] * rstd * mg0);
        hp[16] = f2bf(hacc[1][r] * rstd * mg1);
        hp[32] = f2bf(hacc[2][r] * rstd * mg2);
        hp[48] = f2bf(hacc[3][r] * rstd * mg3);
      }
      const float decay = sV[192];
#pragma unroll
      for (int n = 0; n < 8; n++) {
        Cacc[n][0] *= decay;
        Cacc[n][1] *= decay;
        Cacc[n][2] *= decay;
        Cacc[n][3] *= decay;
      }
      {
        bf16x8 va[2], kb[2][8];
#pragma unroll
        for (int ks = 0; ks < 2; ks++) {
          va[ks] = lds8(sVT + (w * 16 + fr) * 72 + ks * 32 + fq * 8);
#pragma unroll
          for (int n = 0; n < 8; n++) kb[ks][n] = lds8(sKT + (n * 16 + fr) * 72 + ks * 32 + fq * 8);
        }
#pragma unroll
        for (int ks = 0; ks < 2; ks++)
#pragma unroll
          for (int n = 0; n < 8; n++) Cacc[n] = MFMA(va[ks], kb[ks][n], Cacc[n]);
      }
#pragma unroll
      for (int n = 0; n < 8; n++)
#pragma unroll
        for (int r = 0; r < 4; r++) sCb[(w * 16 + fq * 4 + r) * 136 + n * 16 + fr] = f2bf(Cacc[n][r]);
      if (tid < 128) sNn[tid] = decay * sNo[tid] + sNn[tid];
    }
    lds_barrier();
    {
      const int tid = launder_tid();
      const int row = tid >> 4, c8 = (tid & 15) * 8;
      bf16_t* yp = p.YA + (size_t)(grow0 + t0 + row) * 1024 + 512 + h * 128 + c8;
      uint4 h0 = *(const uint4*)(sH + row * 136 + c8);
      uint4 h1 = *(const uint4*)(sH + (row + 32) * 136 + c8);
#define MUL2(a, b) pack2(__uint_as_float((a) << 16) * __uint_as_float((b) << 16), \
                         __uint_as_float((a) & 0xffff0000u) * __uint_as_float((b) & 0xffff0000u))
      uint4 y0 = {MUL2(h0.x, so0.x), MUL2(h0.y, so0.y), MUL2(h0.z, so0.z), MUL2(h0.w, so0.w)};
      uint4 y1 = {MUL2(h1.x, so1.x), MUL2(h1.y, so1.y), MUL2(h1.z, so1.z), MUL2(h1.w, so1.w)};
#undef MUL2
      *(uint4*)yp = y0;
      *(uint4*)(yp + (size_t)32 * 1024) = y1;
    }
  }
#undef LOAD_CHUNK
  lds_barrier();
  {
    const int tid = launder_tid(), lane = tid & 63, w = tid >> 6, fr = lane & 15, fq = lane >> 4;
    float* Cout = isp ? p.out + O_CP + (size_t)(seq * 4 + h) * 16384 : p.out + O_CS + (size_t)(sb * 4 + h) * 16384;
#pragma unroll
    for (int n = 0; n < 8; n++)
#pragma unroll
      for (int r = 0; r < 4; r++) Cout[(w * 16 + fq * 4 + r) * 128 + n * 16 + fr] = Cacc[n][r];
    float* nout = isp ? p.out + O_NP + (seq * 4 + h) * 128 : p.out + O_NS + (sb * 4 + h) * 128;
    if (tid < 128) nout[tid] = sN[(nchunks & 1) * 128 + tid];
  }
}

constexpr int D_ML_P = 32;
constexpr int D_AT_P = 2048;
constexpr int D_AT_S = 128;
constexpr int D_ML_S = 64;
constexpr int D_TOTAL = D_ML_P + D_AT_P + D_AT_S + D_ML_S;

__device__ __forceinline__ void phase_d0(const Params& p, char* smem) {
  for (int item = blockIdx.x; item < 1088; item += gridDim.x) {
    if (item < 1024) mlpre_task(p, item >> 7, (item >> 5) & 3, item & 31, smem);
    else mlpre_task(p, 8 + ((item - 1024) >> 2), item & 3, 0, smem);
  }
}
__device__ __forceinline__ void phase_d(const Params& p, char* smem, int cidx) {
  int* sTask = (int*)(smem + LDS_BYTES - 16);
  for (;;) {
    __syncthreads();
    if (threadIdx.x == 0) *sTask = (int)atomicAdd(p.counter + cidx, 1u);
    __syncthreads();
    int task = __builtin_amdgcn_readfirstlane(*sTask);
    if (task >= D_TOTAL + 656) break;
    if (task >= D_TOTAL) {
      weight_task(p, 352 + (task - D_TOTAL), smem);
      continue;
    }
    int kind, seq, h, qt = 0;
    if (task < D_ML_P) {
      kind = 0; seq = task >> 2; h = task & 3;
    } else if (task < D_ML_P + D_AT_P) {
      int t2 = task - D_ML_P;
      kind = 1; qt = 31 - (t2 >> 6); seq = (t2 & 63) >> 3; h = t2 & 7;
    } else if (task < D_ML_P + D_AT_P + D_AT_S) {
      int t2 = task - D_ML_P - D_AT_P;
      kind = 1; seq = 8 + (t2 >> 3); h = t2 & 7;
    } else {
      int t2 = task - D_ML_P - D_AT_P - D_AT_S;
      kind = 0; seq = 8 + (t2 >> 2); h = t2 & 3;
    }
    if (kind == 0) mlstm_task(p, seq, h, smem);
    else attn_task(p, seq, h, qt, smem);
  }
}

struct OrderE {
  __device__ __forceinline__ bool next(int i, pg8::Unit& u) const {
    const int b = blockIdx.x;
    if (i < 2) {
      const int xcd = b & 7, l = b >> 3;
      u.pm = xcd * 8 + (l >> 2);
      u.pn = l & 3;
    } else if (i < 4 && b < 16) {
      u.pm = 64 + (b >> 2);
      u.pn = b & 3;
    } else {
      return false;
    }
    u.ko = (i & 1) * 512;
    u.nt = 8;
    return true;
  }
  __device__ __forceinline__ void a_ready(const pg8::Unit&) const {}
  __device__ __forceinline__ void done(const pg8::Unit&) const {}
};
struct EpiE {
  static constexpr bool PERM = true, AFTER_DRAIN = false;
  const bf16_t* GA;
  const bf16_t* GB;
  bf16_t* MER;
  __device__ __forceinline__ void operator()(const f32x4 (&acc)[2][2][4][2], const pg8::Unit& u, int wr, int wc, int fr, int fq) const {
    const bool second = (u.ko != 0);
    const bf16_t* G = second ? GB : GA;
#pragma unroll
    for (int ai = 0; ai < 2; ++ai)
#pragma unroll
      for (int bj = 0; bj < 2; ++bj)
#pragma unroll
        for (int m = 0; m < 4; ++m) {
          const int row = u.pm * 256 + ai * 128 + wr * 64 + m * 16 + fr;
          const int c0 = u.pn * 256 + bj * 128 + wc * 32 + fq * 8;
          const uint4 gv = *(const uint4*)(G + (size_t)row * 1024 + c0);
          const unsigned gw[4] = {gv.x, gv.y, gv.z, gv.w};
          f32x4 o0 = acc[ai][bj][m][0], o1 = acc[ai][bj][m][1];
          o0[0] *= __uint_as_float(gw[0] << 16);
          o0[1] *= __uint_as_float(gw[0] & 0xffff0000u);
          o0[2] *= __uint_as_float(gw[1] << 16);
          o0[3] *= __uint_as_float(gw[1] & 0xffff0000u);
          o1[0] *= __uint_as_float(gw[2] << 16);
          o1[1] *= __uint_as_float(gw[2] & 0xffff0000u);
          o1[2] *= __uint_as_float(gw[3] << 16);
          o1[3] *= __uint_as_float(gw[3] & 0xffff0000u);
          bf16_t* mp = MER + (size_t)row * 1024 + c0;
          if (second) {
            const uint4 pv = *(const uint4*)mp;
            o0[0] += __uint_as_float(pv.x << 16);
            o0[1] += __uint_as_float(pv.x & 0xffff0000u);
            o0[2] += __uint_as_float(pv.y << 16);
            o0[3] += __uint_as_float(pv.y & 0xffff0000u);
            o1[0] += __uint_as_float(pv.z << 16);
            o1[1] += __uint_as_float(pv.z & 0xffff0000u);
            o1[2] += __uint_as_float(pv.w << 16);
            o1[3] += __uint_as_float(pv.w & 0xffff0000u);
          }
          *(uint4*)mp = pack8(o0, o1);
          if (m == 3) asm volatile("" ::: "memory");
        }
  }
};
__device__ __forceinline__ void phase_e(const Params& p, char* smem) {
  __syncthreads();
  pg8::Gemm g{p.YA, p.Wt_a, kT, 1024, 1024, 1024};
  OrderE S;
  EpiE E{p.GA, p.GB, p.MER};
  pg8::gemm_phase<EpiE, OrderE, false>((PG8_LAS unsigned char*)smem, g, S, E, nullptr);
}
struct OrderF {
  __device__ __forceinline__ bool next(int i, pg8::Unit& u) const {
    const int b = blockIdx.x;
    if (i == 0) {
      const int xcd = b & 7, l = b >> 3;
      u.pm = xcd * 8 + (l >> 2);
      u.pn = l & 3;
      u.ko = 0;
      u.nt = 16;
      return true;
    }
    if (i == 1 && b < 64) {
      const int t2 = b >> 2, kp = b & 3;
      u.pm = 64 + (t2 >> 2);
      u.pn = t2 & 3;
      u.ko = kp * 256;
      u.nt = 4;
      return true;
    }
    return false;
  }
  __device__ __forceinline__ void a_ready(const pg8::Unit&) const {}
  __device__ __forceinline__ void done(const pg8::Unit&) const {}
};
struct EpiF {
  static constexpr bool PERM = true, AFTER_DRAIN = false;
  const float* x_prompt;
  const float* x_sample;
  bf16_t* X1;
  float* SLAB;
  const float* modf;
  __device__ __forceinline__ void operator()(const f32x4 (&acc)[2][2][4][2], const pg8::Unit& u, int wr, int wc, int fr, int fq) const {
    const bool primary = (u.ko == 0);
    float* slab = SLAB + (size_t)(((u.pm - 64) * 4 + u.pn) * 3 + ((u.ko >> 8) - 1)) * 65536;
#pragma unroll
    for (int ai = 0; ai < 2; ++ai) {
      const int lr0 = ai * 128 + wr * 64 + fr;
      const int seq = seq_of(u.pm * 256 + ai * 128 + wr * 64);
#pragma unroll
      for (int bj = 0; bj < 2; ++bj) {
        const int lc = bj * 128 + wc * 32 + fq * 8;
        const f32x4 g1a = *(const f32x4*)(modf + seq * 6144 + 2048 + u.pn * 256 + lc);
        const f32x4 g1b = *(const f32x4*)(modf + seq * 6144 + 2048 + u.pn * 256 + lc + 4);
#pragma unroll
        for (int m = 0; m < 4; ++m) {
          const int lr = lr0 + m * 16;
          const f32x4 v0 = g1a * acc[ai][bj][m][0], v1 = g1b * acc[ai][bj][m][1];
          if (primary) {
            const int row = u.pm * 256 + lr;
            const float* xr = (row < kNP ? x_prompt + (size_t)row * 1024 : x_sample + (size_t)(row - kNP) * 1024) + u.pn * 256 + lc;
            const f32x4 x0 = *(const f32x4*)xr, x1 = *(const f32x4*)(xr + 4);
            *(uint4*)(X1 + (size_t)row * 1024 + u.pn * 256 + lc) = pack8(x0 + v0, x1 + v1);
          } else {
            *(f32x4*)(slab + lr * 256 + lc) = v0;
            *(f32x4*)(slab + lr * 256 + lc + 4) = v1;
          }
        }
        asm volatile("" ::: "memory");
      }
    }
  }
};
__device__ __forceinline__ void phase_f(const Params& p, char* smem) {
  __syncthreads();
  pg8::Gemm g{p.MER, p.Wt_out, kT, 1024, 1024};
  OrderF S;
  EpiF E{p.x_prompt, p.x_sample, p.X1, p.SLAB, p.modf};
  pg8::gemm_phase<EpiF, OrderF, false>((PG8_LAS unsigned char*)smem, g, S, E, nullptr);
}
__device__ __forceinline__ void phase_h(const Params& p, char* smem) {
  __syncthreads();
  pg8::Gemm g{p.U, p.Wt_gu, kT, 5632, 1024};
  pg8::StaticOrder S;
  S.init(kT, 5632, gridDim.x, blockIdx.x);
  EpiH E{p.HFF};
  pg8::gemm_phase<EpiH, pg8::StaticOrder, false>((PG8_LAS unsigned char*)smem, g, S, E, nullptr);
}
struct OrderI {
  __device__ __forceinline__ bool next(int i, pg8::Unit& u) const {
    const int b = blockIdx.x;
    if (i == 0) {
      const int xcd = b & 7, l = b >> 3;
      u.pm = xcd * 8 + (l >> 2);
      u.pn = l & 3;
      u.ko = 0;
      u.nt = 44;
      return true;
    }
    if (i == 1 && b < 176) {
      const int t2 = b / 11, kp = b - t2 * 11;
      u.pm = 64 + (t2 >> 2);
      u.pn = t2 & 3;
      u.ko = kp * 256;
      u.nt = 4;
      return true;
    }
    return false;
  }
  __device__ __forceinline__ void a_ready(const pg8::Unit&) const {}
  __device__ __forceinline__ void done(const pg8::Unit&) const {}
};
struct EpiI {
  static constexpr bool PERM = true, AFTER_DRAIN = false;
  bf16_t* X1;
  float* SLAB;
  const float* modf;
  __device__ __forceinline__ void operator()(const f32x4 (&acc)[2][2][4][2], const pg8::Unit& u, int wr, int wc, int fr, int fq) const {
    const bool primary = (u.nt == 44);
    float* slab = SLAB + (size_t)(((u.pm - 64) * 4 + u.pn) * 11 + (u.ko >> 8)) * 65536;
#pragma unroll
    for (int ai = 0; ai < 2; ++ai) {
      const int lr0 = ai * 128 + wr * 64 + fr;
      const int seq = seq_of(u.pm * 256 + ai * 128 + wr * 64);
#pragma unroll
      for (int bj = 0; bj < 2; ++bj) {
        const int lc = bj * 128 + wc * 32 + fq * 8;
        const f32x4 g2a = *(const f32x4*)(modf + seq * 6144 + 5120 + u.pn * 256 + lc);
        const f32x4 g2b = *(const f32x4*)(modf + seq * 6144 + 5120 + u.pn * 256 + lc + 4);
#pragma unroll
        for (int m = 0; m < 4; ++m) {
          const int lr = lr0 + m * 16;
          const f32x4 v0 = g2a * acc[ai][bj][m][0], v1 = g2b * acc[ai][bj][m][1];
          if (primary) {
            bf16_t* px = X1 + (size_t)(u.pm * 256 + lr) * 1024 + u.pn * 256 + lc;
            const uint4 pv = *(const uint4*)px;
            f32x4 x0, x1;
            x0[0] = __uint_as_float(pv.x << 16); x0[1] = __uint_as_float(pv.x & 0xffff0000u);
            x0[2] = __uint_as_float(pv.y << 16); x0[3] = __uint_as_float(pv.y & 0xffff0000u);
            x1[0] = __uint_as_float(pv.z << 16); x1[1] = __uint_as_float(pv.z & 0xffff0000u);
            x1[2] = __uint_as_float(pv.w << 16); x1[3] = __uint_as_float(pv.w & 0xffff0000u);
            *(uint4*)px = pack8(x0 + v0, x1 + v1);
          } else {
            *(f32x4*)(slab + lr * 256 + lc) = v0;
            *(f32x4*)(slab + lr * 256 + lc + 4) = v1;
          }
        }
        asm volatile("" ::: "memory");
      }
    }
  }
};
__device__ __forceinline__ void phase_i(const Params& p, char* smem) {
  __syncthreads();
  pg8::Gemm g{p.HFF, p.Wt_down, kT, 1024, 2816, 2816};
  OrderI S;
  EpiI E{p.X1, p.SLAB, p.modf};
  pg8::gemm_phase<EpiI, OrderI, false>((PG8_LAS unsigned char*)smem, g, S, E, nullptr);
}
__device__ __forceinline__ void phase_j(const Params& p) {
  const int tid = launder_tid(), lane = tid & 63, w = tid >> 6;
  for (int g = blockIdx.x * 8 + w; g < kT / 4; g += gridDim.x * 8) {
    float4 v[4][4];
#pragma unroll
    for (int i = 0; i < 4; i++)
#pragma unroll
      for (int j = 0; j < 4; j++) {
        const int row = g * 4 + i;
        v[i][j] = ldbf4(p.X1 + (size_t)row * 1024 + j * 256 + lane * 4);
        if (row >= kNP) {
          const float* sl = p.SLAB + (size_t)((((row - kNP) >> 8) * 4 + j) * 11) * 65536 + (row & 255) * 256 + lane * 4;
#pragma unroll
          for (int kp = 0; kp < 11; kp++) {
            const float4 e = *(const float4*)(sl + (size_t)kp * 65536);
            v[i][j].x += e.x;
            v[i][j].y += e.y;
            v[i][j].z += e.z;
            v[i][j].w += e.w;
          }
        }
      }
#pragma unroll
    for (int i = 0; i < 4; i++) {
      const int row = g * 4 + i;
      float ss = 0.f;
#pragma unroll
      for (int j = 0; j < 4; j++)
        ss += v[i][j].x * v[i][j].x + v[i][j].y * v[i][j].y + v[i][j].z * v[i][j].z + v[i][j].w * v[i][j].w;
      ss = wave_sum(ss);
      float rstd = rsqrtf(ss * (1.0f / 1024.0f) + 1e-6f);
      float* o = p.out + (row < kNP ? O_YP + (size_t)row * 1024 : O_YS + (size_t)(row - kNP) * 1024);
#pragma unroll
      for (int j = 0; j < 4; j++) {
        int c = j * 256 + lane * 4;
        float4 gg = *(const float4*)(p.final_g + c);
        float4 r4;
        r4.x = v[i][j].x * rstd * gg.x;
        r4.y = v[i][j].y * rstd * gg.y;
        r4.z = v[i][j].z * rstd * gg.z;
        r4.w = v[i][j].w * rstd * gg.w;
        *(float4*)(o + c) = r4;
      }
    }
  }
}

#define XB_TMO      128
#define XB_XCNT(j)  (256  + 64 * (j))
#define XB_XSUB(j)  (1280 + 64 * (j))
#define XB_XGEN(j)  (2304 + 64 * (j))
#define XB_TOP      3328
#define XB_TOPGEN   3392
#define XCD_BAR_WORDS 3456
#define XB_SPIN_CAP (1u << 18)
#define LAS __attribute__((address_space(3)))

__device__ __forceinline__ unsigned xb_ld(unsigned* p)              { return __hip_atomic_load(p, __ATOMIC_RELAXED, __HIP_MEMORY_SCOPE_AGENT); }
__device__ __forceinline__ unsigned xb_add(unsigned* p, unsigned v) { return __hip_atomic_fetch_add(p, v, __ATOMIC_RELAXED, __HIP_MEMORY_SCOPE_AGENT); }
__device__ __forceinline__ unsigned xb_xcc_id() { return (unsigned)__builtin_amdgcn_s_getreg((3 << 11) | 20) & 0xFu; }
#define XB_SPIN(cond, bar) do { unsigned _sp = 0; while (cond) { __builtin_amdgcn_s_sleep(1); \
    if ((++_sp & 255u) == 0u) { if (xb_ld(&(bar)[XB_TMO])) break; if (_sp > XB_SPIN_CAP) { atomicAdd(&(bar)[XB_TMO], 1u); break; } } } } while (0)

struct XcdBarrier {
    unsigned* bar; unsigned x;
    volatile LAS unsigned* st;
};

__device__ __forceinline__ XcdBarrier xcd_barrier_post(unsigned* bar, volatile LAS unsigned* st) {
    XcdBarrier b; b.bar = bar; b.x = xb_xcc_id(); b.st = st;
    if (threadIdx.x == 0) (void)xb_add(&bar[XB_XCNT(b.x)], 1u);
    return b;
}
__device__ __forceinline__ void xcd_barrier_complete(unsigned* bar, unsigned x, unsigned& nloc, unsigned& nx) {
    const unsigned G = gridDim.x * gridDim.y * gridDim.z;
    unsigned sum, cnt, mine, sp = 0u;
    for (;;) {
        sum = 0u; cnt = 0u; mine = 0u;
#pragma unroll
        for (unsigned j = 0; j < 16; ++j) { const unsigned c = xb_ld(&bar[XB_XCNT(j)]); sum += c; cnt += (c > 0u) ? 1u : 0u; mine = (j == x) ? c : mine; }
        if (sum == G) break;
        __builtin_amdgcn_s_sleep(1);
        if ((++sp & 255u) == 0u) { if (xb_ld(&bar[XB_TMO])) break; if (sp > XB_SPIN_CAP) { atomicAdd(&bar[XB_TMO], 1u); break; } }
    }
    nloc = mine > 0u ? mine : 1u; nx = cnt > 0u ? cnt : 1u;
}

__device__ __forceinline__ void xcd_barrier(const XcdBarrier& b) {
    asm volatile("s_waitcnt vmcnt(0)" ::: "memory");
    __syncthreads();
    if (threadIdx.x == 0) {
        unsigned* bar = b.bar;
        __builtin_amdgcn_s_waitcnt(0);
        unsigned nloc = b.st[0], nx = b.st[1];
        if (nloc == 0u) { xcd_barrier_complete(bar, b.x, nloc, nx); b.st[0] = nloc; b.st[1] = nx; }
        const unsigned old = xb_add(&bar[XB_XSUB(b.x)], 1u);
        const unsigned gen = old / nloc;
        if (old + 1u == (gen + 1u) * nloc) {
            __builtin_amdgcn_fence(__ATOMIC_RELEASE, "agent");
            asm volatile("s_waitcnt vmcnt(0)" ::: "memory");
            const unsigned og = xb_add(&bar[XB_TOP], 1u);
            const unsigned tg = og / nx;
            if (og + 1u == (tg + 1u) * nx) xb_add(&bar[XB_TOPGEN], 1u);
            else XB_SPIN(xb_ld(&bar[XB_TOPGEN]) == tg, bar);
            __builtin_amdgcn_fence(__ATOMIC_ACQUIRE, "agent");
            xb_add(&bar[XB_XGEN(b.x)], 1u);
            asm volatile("s_waitcnt vmcnt(0)" ::: "memory");
        } else {
            XB_SPIN(xb_ld(&bar[XB_XGEN(b.x)]) == gen, bar);
            __builtin_amdgcn_fence(__ATOMIC_ACQUIRE, "agent");
            asm volatile("s_waitcnt vmcnt(0)" ::: "memory");
        }
    }
    __syncthreads();
}


extern __shared__ __attribute__((aligned(16))) char dyn_smem[];

#ifndef REP_A
#define REP_A 1
#endif
#ifndef REP_C
#define REP_C 1
#endif
#ifndef REP_D
#define REP_D 1
#endif
#ifndef REP_H
#define REP_H 1
#endif
#ifndef REP_E
#define REP_E 1
#endif
__global__ void __launch_bounds__(NTHREADS) mega_kernel(Params p) {
  cg::grid_group grid = cg::this_grid();
  volatile LAS unsigned* xst = (volatile LAS unsigned*)(dyn_smem + LDS_BYTES - 32);
  if (threadIdx.x < 4) xst[threadIdx.x] = 0u;
  __syncthreads();
  XcdBarrier xb = xcd_barrier_post(p.bar, xst);
  if (p.bar == nullptr) grid.sync();
#pragma unroll 1
  for (int r = 0; r < REP_A; r++) {
    phase_a(p, dyn_smem);
    xcd_barrier(xb);
  }
  phase_b(p, dyn_smem);
  xcd_barrier(xb);
#pragma unroll 1
  for (int r = 0; r < REP_C; r++) {
    phase_c(p, dyn_smem);
    xcd_barrier(xb);
  }
  phase_d0(p, dyn_smem);
  xcd_barrier(xb);
#pragma unroll 1
  for (int r = 0; r < REP_D; r++) {
    phase_d(p, dyn_smem, r);
    xcd_barrier(xb);
  }
#pragma unroll 1
  for (int r = 0; r < REP_E; r++) {
    phase_e(p, dyn_smem);
    xcd_barrier(xb);
  }
  phase_f(p, dyn_smem);
  xcd_barrier(xb);
  phase_g(p, dyn_smem);
  xcd_barrier(xb);
#pragma unroll 1
  for (int r = 0; r < REP_H; r++) {
    phase_h(p, dyn_smem);
    xcd_barrier(xb);
  }
  phase_i(p, dyn_smem);
  xcd_barrier(xb);
  phase_j(p);
}
extern "C" void kernel_launch(void* const* d_in, const int* in_sizes, int n_in, void* d_out, int out_size, void* d_ws,
                              size_t ws_size, hipStream_t stream) {
  Params p{};
  const float** pin = (const float**)&p;
  for (int i = 0; i < 26; i++) pin[i] = (const float*)d_in[i];
  p.out = (float*)d_out;
  char* ws = (char*)d_ws;
  size_t off = 0;
  auto alloc = [&](size_t bytes) {
    char* r = ws + off;
    off += (bytes + 255) & ~(size_t)255;
    return r;
  };
  p.Wt_in = (bf16_t*)alloc((size_t)5632 * 1024 * 2);
  p.Wt_a = (bf16_t*)alloc((size_t)1024 * 1024 * 2);
  p.Wt_b = p.Wt_a;
  p.Wt_out = (bf16_t*)alloc((size_t)1024 * 1024 * 2);
  p.Wt_gu = (bf16_t*)alloc((size_t)5632 * 1024 * 2);
  p.Wt_down = (bf16_t*)alloc((size_t)1024 * 2816 * 2);
  p.modp = (float*)alloc((size_t)8 * 24 * 6144 * 4);
  p.modf = (float*)alloc((size_t)24 * 6144 * 4);
  p.U = (bf16_t*)alloc((size_t)kT * 1024 * 2);
  char* r1 = ws + off;
  p.Qb = (bf16_t*)alloc((size_t)kT * 512 * 2);
  p.Kp = (bf16_t*)alloc((size_t)64 * 2048 * 64 * 2);
  p.Ks = (bf16_t*)alloc((size_t)128 * 1152 * 64 * 2);
  p.VTp = (bf16_t*)alloc((size_t)64 * 64 * 2048 * 2);
  p.VTs = (bf16_t*)alloc((size_t)128 * 64 * 1152 * 2);
  p.MQK = (bf16_t*)alloc((size_t)kT * 1024 * 2);
  const size_t r1_bytes = (size_t)(ws + off - r1);
  char* r2 = ws + off;
  p.MVTp = (bf16_t*)alloc((size_t)32 * 128 * 2048 * 2);
  p.MVTs = (bf16_t*)alloc((size_t)64 * 128 * 64 * 2);
  p.SO = (bf16_t*)alloc((size_t)kT * 512 * 2);
  const size_t r2_bytes = (size_t)(ws + off - r2);
  char* r3 = ws + off;
  p.GA = (bf16_t*)alloc((size_t)kT * 1024 * 2);
  p.GB = (bf16_t*)alloc((size_t)kT * 1024 * 2);
  const size_t r3_bytes = (size_t)(ws + off - r3);
  p.GI = (float*)alloc((size_t)kT * 4 * 4);
  p.LF = (float*)alloc((size_t)kT * 4 * 4);
  p.GV = (float*)alloc((size_t)1088 * 384 * 4);
  p.DENc = (float*)alloc((size_t)1088 * 64 * 4);
  char* r4 = ws + off;
  p.Qc = (bf16_t*)alloc((size_t)1088 * 8192 * 2);
  p.KTc = (bf16_t*)alloc((size_t)1088 * 8192 * 2);
  p.SWc = (bf16_t*)alloc((size_t)1088 * 4096 * 2);
  p.YA = (bf16_t*)alloc((size_t)kT * 1024 * 2);
  p.YB = p.YA;
  const size_t r4_bytes = (size_t)(ws + off - r4);
  p.counter = (unsigned*)alloc(256);
  p.bar = (unsigned*)alloc(XCD_BAR_WORDS * 4);
  p.HFF = (bf16_t*)r1;
  p.MER = (bf16_t*)r2;
  p.X1 = (bf16_t*)r4;
  p.SLAB = (float*)r3;
  if (r1_bytes < (size_t)kT * 2816 * 2 || r2_bytes < (size_t)kT * 1024 * 2 ||
      r4_bytes < (size_t)kT * 1024 * 4 || r3_bytes < (size_t)176 * 65536 * 4 || off > ws_size) {
    fprintf(stderr, "workspace layout error: need %zu bytes, have %zu\n", off, ws_size);
    return;
  }

#if ONE_LAUNCH
  static int grid_blocks = 0;
  if (!grid_blocks) {
    int dev = 0, cus = 0, per_cu = 0;
    hipGetDevice(&dev);
    hipDeviceGetAttribute(&cus, hipDeviceAttributeMultiprocessorCount, dev);
    hipFuncSetAttribute((const void*)mega_kernel, hipFuncAttributeMaxDynamicSharedMemorySize, LDS_BYTES);
    hipOccupancyMaxActiveBlocksPerMultiprocessor(&per_cu, mega_kernel, NTHREADS, LDS_BYTES);
    if (per_cu < 1) per_cu = 1;
    grid_blocks = cus * per_cu;
    if (grid_blocks > 256) grid_blocks = 256;
  }
  (void)hipMemsetAsync(p.bar, 0, XCD_BAR_WORDS * 4, stream);
  if (grid_blocks != 256) {
    fprintf(stderr, "unexpected co-resident grid %d (phase I is laid out for 256 workgroups)\n", grid_blocks);
    return;
  }
  void* args[] = {&p};
  hipError_t e = hipLaunchCooperativeKernel((void*)mega_kernel, dim3(grid_blocks), dim3(NTHREADS), args, LDS_BYTES, stream);
  if (e != hipSuccess) fprintf(stderr, "cooperative launch failed: %s (grid %d)\n", hipGetErrorString(e), grid_blocks);
#endif
}
```
